# Optimizing an MI355X kernel written in HIP

```python
import jax
import jax.numpy as jnp
from jax import lax
import numpy as np

D_MODEL = 1024
BATCH = 4
SEQ = 8192
DEPTH = 4

HEAD_DIM = 64
ROPE_THETA = 10000.0
NORM_EPS = 1e-6
Q_BLOCK = 128
NEG_INF = -1e30

NSA_Q_HEADS = 8
NSA_KV_HEADS = 2
NSA_GROUP = NSA_Q_HEADS // NSA_KV_HEADS
N_BRANCH = 3
CMP_LEN = 32
CMP_STRIDE = 16
CMP_HIDDEN = 256
SLC_LEN = 64
SLC_TOPN = 16
WIN_LEN = 512
FORCE_BONUS = 1e4

DIL_PAIRS = ((128, 1), (512, 4), (2048, 16))
DIL_N_GROUPS = len(DIL_PAIRS)
DIL_HEADS_PER_GROUP = 4
DIL_SLOT_HEADS = DIL_N_GROUPS * DIL_HEADS_PER_GROUP
DIL_MAX_WINDOW = max(w for w, _ in DIL_PAIRS)

SB_HEADS = D_MODEL // HEAD_DIM

D_FF = 2816
CONV_WIDTH = 3

NSA_Q_COLS = NSA_Q_HEADS * HEAD_DIM
NSA_KV_COLS = 2 * N_BRANCH * NSA_KV_HEADS * HEAD_DIM
NSA_GATE_COLS = NSA_Q_HEADS * N_BRANCH
DIL_COLS = 3 * DIL_SLOT_HEADS * HEAD_DIM
EVEN_IN = NSA_Q_COLS + NSA_KV_COLS + NSA_GATE_COLS + DIL_COLS
EVEN_OUT = NSA_Q_HEADS * HEAD_DIM + DIL_HEADS_PER_GROUP * HEAD_DIM
ODD_IN = 3 * SB_HEADS * HEAD_DIM
ODD_OUT = SB_HEADS * HEAD_DIM

kernel_name = 'hybrid_nsa_dilated_stickbreaking_convffn'


def rmsnorm(x, g):
    xf = x.astype(jnp.float32)
    y = xf * lax.rsqrt(jnp.mean(xf * xf, axis=-1, keepdims=True) + NORM_EPS)
    return (y * g.astype(jnp.float32)).astype(x.dtype)


def rope(x, pos):
    half = x.shape[-1] // 2
    inv = jnp.power(ROPE_THETA, -jnp.arange(half, dtype=jnp.float32) / half)
    ang = pos.astype(jnp.float32)[:, None] * inv[None, :]
    cos = jnp.cos(ang)[:, None, :]
    sin = jnp.sin(ang)[:, None, :]
    xf = x.astype(jnp.float32)
    x1, x2 = xf[..., :half], xf[..., half:]
    return jnp.concatenate([x1 * cos - x2 * sin, x2 * cos + x1 * sin], axis=-1).astype(x.dtype)


def masked_softmax(s, mask):
    s = jnp.where(mask, s, NEG_INF)
    return jax.nn.softmax(s, axis=-1) * mask


def compress_blocks(x_raw, pe, w1, w2):
    B, S, G, D = x_raw.shape
    nc = (S - CMP_LEN) // CMP_STRIDE + 1
    idx = jnp.arange(nc)[:, None] * CMP_STRIDE + jnp.arange(CMP_LEN)[None, :]
    blocks = x_raw[:, idx] + pe[:, None, :]
    blocks = jnp.moveaxis(blocks, 3, 2).reshape(B, nc, G, CMP_LEN * D)
    return jax.nn.gelu(blocks @ w1, approximate=True) @ w2


def cmp_to_slc_overlap(n_cmp, n_slc):
    cs = np.arange(n_cmp) * CMP_STRIDE
    ss = np.arange(n_slc) * SLC_LEN
    lo = np.maximum(cs[:, None], ss[None, :])
    hi = np.minimum(cs[:, None] + CMP_LEN, ss[None, :] + SLC_LEN)
    return (np.maximum(hi - lo, 0) / CMP_LEN).astype(np.float32)


def nsa_attention(q, k_cmp, v_cmp, k_slc, v_slc, k_win, v_win, gates):
    B, S, Hq, D = q.shape
    G, Hg = NSA_KV_HEADS, NSA_GROUP
    nc = k_cmp.shape[1]
    ns = S // SLC_LEN
    top_n = min(SLC_TOPN, ns)
    scale = D ** -0.5
    cmp_end = jnp.arange(nc) * CMP_STRIDE + CMP_LEN - 1
    overlap = jnp.asarray(cmp_to_slc_overlap(nc, ns))
    kbs = k_slc.reshape(B, ns, SLC_LEN, G, D).transpose(0, 3, 1, 2, 4)
    vbs = v_slc.reshape(B, ns, SLC_LEN, G, D).transpose(0, 3, 1, 2, 4)
    kw_pad = jnp.pad(k_win, ((0, 0), (WIN_LEN, 0), (0, 0), (0, 0)))
    vw_pad = jnp.pad(v_win, ((0, 0), (WIN_LEN, 0), (0, 0), (0, 0)))
    b_ix = jnp.arange(B)[:, None, None, None]
    g_ix = jnp.arange(G)[None, :, None, None]
    blk = jnp.arange(ns)

    def block(qb):
        s0 = qb * Q_BLOCK
        t = s0 + jnp.arange(Q_BLOCK)
        qt = lax.dynamic_slice_in_dim(q, s0, Q_BLOCK, 1).reshape(B, Q_BLOCK, G, Hg, D)
        gt = lax.dynamic_slice_in_dim(gates, s0, Q_BLOCK, 1).reshape(B, Q_BLOCK, G, Hg, N_BRANCH)
        sc = jnp.einsum('btghd,bngd->bghtn', qt, k_cmp).astype(jnp.float32) * scale
        pc = masked_softmax(sc, cmp_end[None, :] <= t[:, None])
        o_c = jnp.einsum('bghtn,bngd->btghd', pc.astype(v_cmp.dtype), v_cmp)
        imp = jnp.einsum('bghtn,nj->bgtj', pc, overlap)
        cur = t // SLC_LEN
        forced = (blk[None, :] == 0) | (blk[None, :] == cur[:, None]) | (blk[None, :] == cur[:, None] - 1)
        future = blk[None, :] * SLC_LEN > t[:, None]
        imp = jnp.where(future, -1.0, imp) + jnp.where(forced, FORCE_BONUS, 0.0)
        _, idx = lax.top_k(imp, top_n)
        ks = kbs[b_ix, g_ix, idx]
        vs = vbs[b_ix, g_ix, idx].reshape(B, G, Q_BLOCK, top_n * SLC_LEN, D)
        kpos = (idx[..., None] * SLC_LEN + jnp.arange(SLC_LEN)).reshape(B, G, 1, Q_BLOCK, top_n * SLC_LEN)
        ss = jnp.einsum('btghd,bgtnld->bghtnl', qt, ks).astype(jnp.float32)
        ss = ss.reshape(B, G, Hg, Q_BLOCK, top_n * SLC_LEN) * scale
        ps = masked_softmax(ss, kpos <= t[:, None])
        o_s = jnp.einsum('bghtm,bgtmd->btghd', ps.astype(vs.dtype), vs)
        kw = lax.dynamic_slice_in_dim(kw_pad, s0, WIN_LEN + Q_BLOCK, 1)
        vw = lax.dynamic_slice_in_dim(vw_pad, s0, WIN_LEN + Q_BLOCK, 1)
        kp = s0 - WIN_LEN + jnp.arange(WIN_LEN + Q_BLOCK)
        dist = t[:, None] - kp[None, :]
        wmask = (dist >= 0) & (dist < WIN_LEN) & (kp[None, :] >= 0)
        sw = jnp.einsum('btghd,bkgd->bghtk', qt, kw).astype(jnp.float32) * scale
        pw = masked_softmax(sw, wmask)
        o_w = jnp.einsum('bghtk,bkgd->btghd', pw.astype(vw.dtype), vw)
        o = gt[..., 0:1] * o_c + gt[..., 1:2] * o_s + gt[..., 2:3] * o_w
        return o.reshape(B, Q_BLOCK, Hq * D).astype(q.dtype)

    out = lax.map(block, jnp.arange(S // Q_BLOCK))
    return jnp.moveaxis(out, 0, 1).reshape(B, S, Hq * D)


def dilated_attention(q, k, v):
    B, S, _, D = q.shape
    NG, HG = DIL_N_GROUPS, DIL_HEADS_PER_GROUP
    scale = D ** -0.5
    pad = DIL_MAX_WINDOW
    q = q.reshape(B, S, NG, HG, D)
    kp = jnp.pad(k, ((0, 0), (pad, 0), (0, 0), (0, 0))).reshape(B, S + pad, NG, HG, D)
    vp = jnp.pad(v, ((0, 0), (pad, 0), (0, 0), (0, 0))).reshape(B, S + pad, NG, HG, D)
    k_groups = [kp[:, :, g] for g in range(NG)]
    v_groups = [vp[:, :, g] for g in range(NG)]

    def block(qb):
        s0 = qb * Q_BLOCK
        t = s0 + jnp.arange(Q_BLOCK)
        qt = lax.dynamic_slice_in_dim(q, s0, Q_BLOCK, 1)
        outs, lses = [], []
        for g, (window, dil) in enumerate(DIL_PAIRS):
            offs = jnp.arange(window // dil + 1) * dil
            kpos = t[:, None] - offs[None, :]
            kg = k_groups[g][:, kpos + pad]
            vg = v_groups[g][:, kpos + pad]
            s = jnp.einsum('bthd,btkhd->bhtk', qt[:, :, g], kg).astype(jnp.float32) * scale
            s = jnp.where(kpos >= 0, s, NEG_INF)
            lse = jax.nn.logsumexp(s, axis=-1)
            p = jnp.exp(s - lse[..., None])
            outs.append(jnp.einsum('bhtk,btkhd->bthd', p.astype(vg.dtype), vg))
            lses.append(lse)
        alpha = jax.nn.softmax(jnp.stack(lses), axis=0)
        alpha = jnp.transpose(alpha, (0, 1, 3, 2))[..., None]
        o = jnp.sum(alpha * jnp.stack(outs), axis=0)
        return o.reshape(B, Q_BLOCK, HG * D).astype(q.dtype)

    out = lax.map(block, jnp.arange(S // Q_BLOCK))
    return jnp.moveaxis(out, 0, 1).reshape(B, S, HG * D)


def stick_breaking_attention(q, k, v):
    B, S, H, D = q.shape
    scale = D ** -0.5
    s_idx = jnp.arange(S)

    def block(qb):
        s0 = qb * Q_BLOCK
        t = s0 + jnp.arange(Q_BLOCK)
        qt = lax.dynamic_slice_in_dim(q, s0, Q_BLOCK, 1)
        z = jnp.einsum('bthd,bshd->bhts', qt, k).astype(jnp.float32) * scale
        strict = s_idx[None, :] < t[:, None]
        log_beta = jax.nn.log_sigmoid(z)
        log_1mb = jnp.where(strict, log_beta - z, 0.0)
        after = lax.cumsum(log_1mb, axis=3, reverse=True) - log_1mb
        a = jnp.where(strict, jnp.exp(log_beta + after), 0.0)
        o = jnp.einsum('bhts,bshd->bthd', a.astype(v.dtype), v)
        return o.reshape(B, Q_BLOCK, H * D).astype(q.dtype)

    out = lax.map(block, jnp.arange(S // Q_BLOCK))
    return jnp.moveaxis(out, 0, 1).reshape(B, S, H * D)


def even_mixer(h, w_in, w_out, cmp_pe, cmp_w1, cmp_w2):
    B, S, _ = h.shape
    proj = h @ w_in
    o1 = NSA_Q_COLS
    o2 = o1 + NSA_KV_COLS
    o3 = o2 + NSA_GATE_COLS
    pos = jnp.arange(S)
    nsa_q = rope(proj[..., :o1].reshape(B, S, NSA_Q_HEADS, HEAD_DIM), pos)
    kv = proj[..., o1:o2].reshape(B, S, 2 * N_BRANCH, NSA_KV_HEADS, HEAD_DIM)
    gates = jax.nn.sigmoid(proj[..., o2:o3].astype(jnp.float32)).reshape(B, S, NSA_Q_HEADS, N_BRANCH)
    nc = (S - CMP_LEN) // CMP_STRIDE + 1
    cmp_end = jnp.arange(nc) * CMP_STRIDE + CMP_LEN - 1
    k_cmp = rope(compress_blocks(kv[:, :, 0], cmp_pe[0], cmp_w1[0], cmp_w2[0]), cmp_end)
    v_cmp = compress_blocks(kv[:, :, 1], cmp_pe[1], cmp_w1[1], cmp_w2[1])
    k_slc = rope(kv[:, :, 2], pos)
    k_win = rope(kv[:, :, 4], pos)
    o_nsa = nsa_attention(nsa_q, k_cmp, v_cmp, k_slc, kv[:, :, 3], k_win, kv[:, :, 5], gates)
    dil = proj[..., o3:].reshape(B, S, 3, DIL_SLOT_HEADS, HEAD_DIM)
    o_dil = dilated_attention(rope(dil[:, :, 0], pos), rope(dil[:, :, 1], pos), dil[:, :, 2])
    return jnp.concatenate([o_nsa, o_dil], axis=-1) @ w_out


def odd_mixer(h, w_in, w_out):
    B, S, _ = h.shape
    qkv = (h @ w_in).reshape(B, S, 3, SB_HEADS, HEAD_DIM)
    return stick_breaking_attention(qkv[:, :, 0], qkv[:, :, 1], qkv[:, :, 2]) @ w_out


def conv_ffn(h, w_up, conv_w, conv_b, w_down):
    S = h.shape[1]
    u = h @ w_up
    up = jnp.pad(u, ((0, 0), (CONV_WIDTH - 1, 0), (0, 0)))
    c = conv_b
    for tap in range(CONV_WIDTH):
        c = c + conv_w[tap] * up[:, tap:tap + S]
    gate, val = jnp.split(c, 2, axis=-1)
    return (jax.nn.gelu(gate, approximate=True) * val) @ w_down


def setup_inputs(seed: int = 0) -> dict:
    key = jax.random.key(seed)
    ks = jax.random.split(key, 13)
    n_even = (DEPTH + 1) // 2
    n_odd = DEPTH // 2
    f32 = jnp.float32

    def w(k, shape, fan_in):
        return jax.random.normal(k, shape, f32) * fan_in ** -0.5

    return {
        'x': jax.random.normal(ks[0], (BATCH, SEQ, D_MODEL), f32),
        'norm_g': 1.0 + 0.05 * jax.random.normal(ks[1], (DEPTH, 4, D_MODEL), f32),
        'even_w_in': w(ks[2], (n_even, D_MODEL, EVEN_IN), D_MODEL),
        'even_w_out': w(ks[3], (n_even, EVEN_OUT, D_MODEL), EVEN_OUT),
        'cmp_pe': 0.02 * jax.random.normal(ks[4], (n_even, 2, CMP_LEN, HEAD_DIM), f32),
        'cmp_w1': w(ks[5], (n_even, 2, CMP_LEN * HEAD_DIM, CMP_HIDDEN), CMP_LEN * HEAD_DIM),
        'cmp_w2': w(ks[6], (n_even, 2, CMP_HIDDEN, HEAD_DIM), CMP_HIDDEN),
        'odd_w_in': w(ks[7], (n_odd, D_MODEL, ODD_IN), D_MODEL),
        'odd_w_out': w(ks[8], (n_odd, ODD_OUT, D_MODEL), ODD_OUT),
        'ffn_w_up': w(ks[9], (DEPTH, D_MODEL, 2 * D_FF), D_MODEL),
        'ffn_conv_w': w(ks[10], (DEPTH, CONV_WIDTH, 2 * D_FF), CONV_WIDTH),
        'ffn_conv_b': 0.02 * jax.random.normal(ks[11], (DEPTH, 2 * D_FF), f32),
        'ffn_w_down': w(ks[12], (DEPTH, D_FF, D_MODEL), D_FF),
    }


def reference(x, norm_g, even_w_in, even_w_out, cmp_pe, cmp_w1, cmp_w2, odd_w_in, odd_w_out,
              ffn_w_up, ffn_conv_w, ffn_conv_b, ffn_w_down):
    h = x
    for layer in range(DEPTH):
        i = layer // 2
        y = rmsnorm(h, norm_g[layer, 0])
        if layer % 2 == 0:
            y = even_mixer(y, even_w_in[i], even_w_out[i], cmp_pe[i], cmp_w1[i], cmp_w2[i])
        else:
            y = odd_mixer(y, odd_w_in[i], odd_w_out[i])
        h = h + rmsnorm(y, norm_g[layer, 1])
        y = conv_ffn(rmsnorm(h, norm_g[layer, 2]), ffn_w_up[layer], ffn_conv_w[layer],
                     ffn_conv_b[layer], ffn_w_down[layer])
        h = h + rmsnorm(y, norm_g[layer, 3])
    return h
```

```cpp
#include <hip/hip_runtime.h>
#include <cstdio>
#include <cstdint>
#include <cmath>
#ifdef HOST_TEST
#include <cmath>
#include <cstring>
#include <cstdio>
#include <cstdlib>
#define HD
static int cB = 1, cS = 1024, cDM = 128, cDFF = 192;
#else
#define HD __device__ __forceinline__
constexpr int cB = 4, cS = 8192, cDM = 1024, cDFF = 2816;
#endif
typedef unsigned short bf16;
#define cM (cB * cS)
#define cNC ((cS - 32) / 16 + 1)
#define cNS (cS / 64)
#define cTOPN (cNS < 16 ? cNS : 16)
#define cNSB (cDM / 64)
#define LDE 3584
#define LDE2 2560
#define LDO2 2048
#define LDO (3 * cDM)
#define EIN_W 3608
#define KCMP_ROWS 512
#define PE_LD (LDE2 + 128)
#define PO_LD (LDO2 + 128)
#define VT_LD (cM + 128)
#define VCT_LD (KCMP_ROWS + 128)

struct alignas(16) U4 { unsigned x, y, z, w; };
HD float u2f(unsigned u) { float f; __builtin_memcpy(&f, &u, 4); return f; }
HD unsigned f2u(float f) { unsigned u; __builtin_memcpy(&u, &f, 4); return u; }
HD float bf2f(bf16 v) { return u2f((unsigned)v << 16); }
HD bf16 f2bf(float f) { unsigned u = f2u(f); return (bf16)((u + 0x7fffu + ((u >> 16) & 1u)) >> 16); }
HD unsigned pk2bf(float lo, float hi) {
#if defined(__HIP_DEVICE_COMPILE__)
    typedef float pk2f_t __attribute__((ext_vector_type(2))); typedef __bf16 pk2b_t __attribute__((ext_vector_type(2)));
    pk2f_t v = {lo, hi}; pk2b_t b = __builtin_convertvector(v, pk2b_t); return __builtin_bit_cast(unsigned, b);
#else
    return (unsigned)f2bf(lo) | ((unsigned)f2bf(hi) << 16);
#endif
}
HD float fast_exp2(float x) {
#if defined(__HIP_DEVICE_COMPILE__)
    return __builtin_amdgcn_exp2f(x);
#else
    return exp2f(x);
#endif
}
HD float fast_rcp(float x) {
#if defined(__HIP_DEVICE_COMPILE__)
    return __builtin_amdgcn_rcpf(x);
#else
    return 1.f / x;
#endif
}
HD float bflo(unsigned w) { return u2f(w << 16); }
HD float bfhi(unsigned w) { return u2f(w & 0xffff0000u); }

struct P {
    const float *x, *norm_g, *even_w_in, *even_w_out, *cmp_pe, *cmp_w1, *cmp_w2, *odd_w_in, *odd_w_out, *ffn_w_up, *ffn_conv_w, *ffn_conv_b, *ffn_w_down;
    float* out;
    bf16 *Wt_in, *Wt_out, *Wt_up, *Wt_dn;
    float* ROPE;
    float* GATES;
    bf16* KCMP;
    float* HID;
    bf16 *Y, *PROJ, *ATT, *Y2, *ACT;
    bf16* VT;
    bf16* VCT;
};

HD float gelu_tanh(float x) { return 0.5f * x * (1.f + tanhf(0.7978845608028654f * (x + 0.044715f * x * x * x))); }

HD void rope_table_item(const P& p, long idx) {
    const int pos = (int)(idx / 32), i = (int)(idx % 32);
    const double ang = (double)pos * pow(10000.0, -(double)i / 32.0);
    p.ROPE[idx * 2] = (float)cos(ang); p.ROPE[idx * 2 + 1] = (float)sin(ang);
}
HD void cmp2_item(const P& p, const float* w2, long idx) {
    const int i = (int)(idx % 32), g = (int)((idx / 32) % 2), n = (int)((idx / 64) % cNC), b = (int)((idx / (64L * cNC)) % cB), which = (int)(idx / (64L * cNC * cB));
    const float* hid = p.HID + ((((size_t)which * cB + b) * cNC + n) * 2 + g) * 256; const float* ww = w2 + (size_t)which * 256 * 64;
    float a1 = 0.f, a2 = 0.f;
    for (int j = 0; j < 256; ++j) { a1 += hid[j] * ww[j * 64 + i]; a2 += hid[j] * ww[j * 64 + i + 32]; }
    bf16* o = p.KCMP + (((size_t)b * KCMP_ROWS + n) * 2 + g) * 64;
    if (which == 0) { const int pos = 16 * n + 31; const float c = p.ROPE[(pos * 32 + i) * 2], s = p.ROPE[(pos * 32 + i) * 2 + 1];
        o[i] = f2bf(a1 * c - a2 * s); o[i + 32] = f2bf(a2 * c + a1 * s); }
    else { bf16* ot = p.VCT + ((size_t)(b * 2 + g) * 64 + i) * VCT_LD + n; ot[0] = f2bf(a1); ot[(size_t)32 * VCT_LD] = f2bf(a2);
        if (n == 0) { ot[511] = 0; ot[(size_t)32 * VCT_LD + 511] = 0; } }
    if (which == 0 && n == 0) { bf16* oz = p.KCMP + (((size_t)b * KCMP_ROWS + 511) * 2 + g) * 64; oz[i] = 0; oz[i + 32] = 0; }
}
HD void peb_item(const float* pe, const float* w1, float* PEB, long idx) {
    const int j = (int)(idx % 256), which = (int)(idx / 256);
    float acc = 0.f;
    for (int k = 0; k < 2048; ++k) acc += pe[(size_t)which * 2048 + k] * w1[((size_t)which * 2048 + k) * 256 + j];
    PEB[idx] = acc;
}
HD int wsrc_col(int mode, int n) {
    if (mode == 1) { const int u = n >> 8, c = n & 255, hiu = c >> 6, w = c & 63;
        if (u == 2) return 512 + c;
        const int d = (w & 7) < 4 ? 4 * (w >> 3) + (w & 7) : 32 + 4 * (w >> 3) + ((w & 7) - 4);
        int base;
        if (u < 2) base = 64 * (4 * u + hiu); else if (u == 3) base = hiu < 2 ? 768 + 64 * hiu : 1024 + 64 * (hiu - 2);
        else if (u < 7) base = 1304 + 64 * (4 * (u - 4) + hiu); else base = 1304 + 768 + 64 * (4 * (u - 7) + hiu);
        return base + d; }
    if (mode == 2) return n < 128 ? 896 + n : n < 256 ? 1152 + (n - 128) : 2840 + (n - 256);
    if (mode == 3) { const int pn = n >> 8, bj = (n >> 7) & 1, x = n & 127; return bj * cDFF + 128 * pn + x; }
    return n;
}
HD float gelu_fast_h(float x) { const float z = x + 0.044715f * x * x * x; return x * fast_rcp(1.f + fast_exp2(-2.3022081981f * z)); }
struct alignas(16) F4 { float v[4]; };
HD void convfix_item(const P& p, const float* SB, const float* cw, const float* cb, long idx) {
    constexpr int Q = cDFF / 4; const int j = 4 * (int)(idx % Q), rr = (int)((idx / Q) % 2); const long blk = idx / (2L * Q); const long row = blk * 64 + rr; const int t = (int)(row % cS), LD2 = 2 * cDFF;
    const float* s0 = SB + ((size_t)blk * 4 + rr) * LD2; const float* sp = SB + ((size_t)(blk - 1) * 4) * LD2;
    const float* sm = SB + ((size_t)blk * 4) * LD2;
#define LD4(ptr) (*(const F4*)(ptr))
    const F4 bg = LD4(cb + j), bv = LD4(cb + cDFF + j), w2g = LD4(cw + 2 * LD2 + j), w2v = LD4(cw + 2 * LD2 + cDFF + j), w1g = LD4(cw + LD2 + j), w1v = LD4(cw + LD2 + cDFF + j), w0g = LD4(cw + j), w0v = LD4(cw + cDFF + j);
    const F4 ug = LD4(s0 + j), uv = LD4(s0 + cDFF + j);
    F4 g1 = {{0.f, 0.f, 0.f, 0.f}}, v1 = g1, g2 = g1, v2 = g1;
    if (rr == 0) { if (t >= 1) { g1 = LD4(sp + 3 * LD2 + j); v1 = LD4(sp + 3 * LD2 + cDFF + j); g2 = LD4(sp + 2 * LD2 + j); v2 = LD4(sp + 2 * LD2 + cDFF + j); } }
    else { g1 = LD4(sm + j); v1 = LD4(sm + cDFF + j); if (t >= 2) { g2 = LD4(sp + 3 * LD2 + j); v2 = LD4(sp + 3 * LD2 + cDFF + j); } }
#undef LD4
    float o[4];
#pragma unroll
    for (int e = 0; e < 4; ++e) { const float cg = bg.v[e] + w2g.v[e] * ug.v[e] + w1g.v[e] * g1.v[e] + w0g.v[e] * g2.v[e], cv = bv.v[e] + w2v.v[e] * uv.v[e] + w1v.v[e] * v1.v[e] + w0v.v[e] * v2.v[e];
        o[e] = gelu_fast_h(cg) * cv; }
    uint2 w; w.x = pk2bf(o[0], o[1]); w.y = pk2bf(o[2], o[3]);
    *(uint2*)(p.ACT + (size_t)row * cDFF + j) = w;
}
HD size_t vt_tile_off(int ngrp, int b, int grp, int tile) { return (((size_t)b * ngrp + grp) * (cS / 32) + tile) * 2048; }
HD size_t vt_elem_off(int ngrp, int b, int dg, int tk) { return vt_tile_off(ngrp, b, dg >> 6, tk >> 5) + (size_t)(dg & 63) * 32 + (tk & 31); }
template <int dil> HD void vtp_run(const bf16* src, bf16* VTP, int b, int pr, int G) {
    unsigned in[64];
#pragma unroll
    for (int q = 0; q < 4; ++q)
#pragma unroll
        for (int c = 0; c < 4; ++c) { const U4 v = *(const U4*)(src + (size_t)q * 2048 + 8 * c); in[16 * q + 4 * c] = v.x; in[16 * q + 4 * c + 1] = v.y; in[16 * q + 4 * c + 2] = v.z; in[16 * q + 4 * c + 3] = v.w; }
    constexpr int per = cS / dil, nm = 128 / dil;
#pragma unroll
    for (int rc = 0; rc < dil; ++rc)
#pragma unroll
        for (int o8 = 0; o8 < nm / 8; ++o8) { unsigned w[4];
#pragma unroll
            for (int e = 0; e < 4; ++e) { const int t0_ = dil * (8 * o8 + 2 * e) + rc, t1_ = t0_ + dil;
                const unsigned lo = (t0_ & 1) ? (in[t0_ >> 1] >> 16) : (in[t0_ >> 1] & 0xFFFFu), hi = (t1_ & 1) ? (in[t1_ >> 1] & 0xFFFF0000u) : (in[t1_ >> 1] << 16);
                w[e] = lo | hi; }
            U4 v; v.x = w[0]; v.y = w[1]; v.z = w[2]; v.w = w[3];
            *(U4*)(VTP + vt_elem_off(8, b, pr, rc * per + nm * G + 8 * o8)) = v; }
}
HD void vtp_item(const bf16* VT, bf16* VTP, long idx) {
    const int ng = cS / 128; const int G = (int)(idx % ng), b = (int)((idx / ng) % cB), pr = (int)(idx / ((long)ng * cB));
    const bf16* src = VT + vt_elem_off(16, b, 512 + pr, 128 * G);
    if (pr < 256) vtp_run<4>(src, VTP, b, pr, G); else vtp_run<16>(src, VTP, b, pr, G);
}
HD void dil_combine_item(const P& p, const bf16* DOUT, const float* DLSE, long idx) {
    const int c8 = (int)(idx % 8), hd = (int)((idx / 8) % 4); const long row = idx / 32;
    const float l0 = DLSE[((size_t)0 * cM + row) * 4 + hd], l1 = DLSE[((size_t)1 * cM + row) * 4 + hd], l2 = DLSE[((size_t)2 * cM + row) * 4 + hd];
    const float mx = fmaxf(l0, fmaxf(l1, l2)), e0 = fast_exp2(l0 - mx), e1 = fast_exp2(l1 - mx), e2 = fast_exp2(l2 - mx), rs = fast_rcp(e0 + e1 + e2);
    const U4 a = *(const U4*)(DOUT + ((size_t)0 * cM + row) * 256 + hd * 64 + 8 * c8), bq = *(const U4*)(DOUT + ((size_t)1 * cM + row) * 256 + hd * 64 + 8 * c8), cq = *(const U4*)(DOUT + ((size_t)2 * cM + row) * 256 + hd * 64 + 8 * c8);
    const float w0 = e0 * rs, w1 = e1 * rs, w2 = e2 * rs;
    U4 o;
    o.x = pk2bf(w0 * bflo(a.x) + w1 * bflo(bq.x) + w2 * bflo(cq.x), w0 * bfhi(a.x) + w1 * bfhi(bq.x) + w2 * bfhi(cq.x));
    o.y = pk2bf(w0 * bflo(a.y) + w1 * bflo(bq.y) + w2 * bflo(cq.y), w0 * bfhi(a.y) + w1 * bfhi(bq.y) + w2 * bfhi(cq.y));
    o.z = pk2bf(w0 * bflo(a.z) + w1 * bflo(bq.z) + w2 * bflo(cq.z), w0 * bfhi(a.z) + w1 * bfhi(bq.z) + w2 * bfhi(cq.z));
    o.w = pk2bf(w0 * bflo(a.w) + w1 * bflo(bq.w) + w2 * bflo(cq.w), w0 * bfhi(a.w) + w1 * bfhi(bq.w) + w2 * bfhi(cq.w));
    *(U4*)(p.ATT + (size_t)row * 768 + 512 + hd * 64 + 8 * c8) = o;
}
#define LAS __attribute__((address_space(3)))
typedef short bf16x8v __attribute__((ext_vector_type(8)));
typedef short bf16x4v __attribute__((ext_vector_type(4)));
typedef float f32x16 __attribute__((ext_vector_type(16)));
typedef float f32x2_t __attribute__((ext_vector_type(2)));
typedef float f32x4v __attribute__((ext_vector_type(4)));
typedef __bf16 bf16x2_t __attribute__((ext_vector_type(2)));
__device__ __forceinline__ unsigned cvtpk(float lo, float hi) { f32x2_t v = {lo, hi}; bf16x2_t b = __builtin_convertvector(v, bf16x2_t); return __builtin_bit_cast(unsigned, b); }
__device__ __forceinline__ float fexp2(float x) { return __builtin_amdgcn_exp2f(x); }
#define ATT_C2 (0.125f * 1.4426950408889634f)
#define ATT_NEG (-1e30f)
#define ATT_THR 8.0f

typedef unsigned u32x2v __attribute__((ext_vector_type(2)));
__device__ __forceinline__ float vmax2(float a, float b) { float d; asm("v_max_f32 %0, %1, %2" : "=v"(d) : "v"(a), "v"(b)); return d; }
__device__ __forceinline__ float vmax3(float a, float b, float c) { float d; asm("v_max3_f32 %0, %1, %2, %3" : "=v"(d) : "v"(a), "v"(b), "v"(c)); return d; }
__device__ __forceinline__ float vmax16(const f32x16& s) {
    const float a = vmax3(s[0], s[1], s[2]), b = vmax3(s[3], s[4], s[5]), c = vmax3(s[6], s[7], s[8]), d = vmax3(s[9], s[10], s[11]), e = vmax3(s[12], s[13], s[14]);
    return vmax2(vmax3(vmax3(a, b, c), d, e), s[15]); }
__device__ __forceinline__ float vmax16_acc(const f32x16& s) { float d;
    asm("s_nop 11\n\tv_max3_f32 %0, %1, %2, %3\n\tv_max3_f32 %0, %0, %4, %5\n\tv_max3_f32 %0, %0, %6, %7\n\tv_max3_f32 %0, %0, %8, %9\n\t"
        "v_max3_f32 %0, %0, %10, %11\n\tv_max3_f32 %0, %0, %12, %13\n\tv_max3_f32 %0, %0, %14, %15\n\tv_max_f32 %0, %0, %16"
        : "=&v"(d) : "v"(s[0]), "v"(s[1]), "v"(s[2]), "v"(s[3]), "v"(s[4]), "v"(s[5]), "v"(s[6]), "v"(s[7]), "v"(s[8]), "v"(s[9]), "v"(s[10]), "v"(s[11]), "v"(s[12]), "v"(s[13]), "v"(s[14]), "v"(s[15]));
    return d; }
#define OPQ(x) asm("" : "+v"(x))
__device__ __forceinline__ float vsum16(const f32x16& s) {
    float a0 = s[0] + s[1], a1 = s[2] + s[3], a2 = s[4] + s[5], a3 = s[6] + s[7], a4 = s[8] + s[9], a5 = s[10] + s[11], a6 = s[12] + s[13], a7 = s[14] + s[15];
    OPQ(a0); OPQ(a1); OPQ(a2); OPQ(a3); OPQ(a4); OPQ(a5); OPQ(a6); OPQ(a7);
    float b0 = a0 + a1, b1 = a2 + a3, b2 = a4 + a5, b3 = a6 + a7; OPQ(b0); OPQ(b1); OPQ(b2); OPQ(b3);
    float c0 = b0 + b1, c1 = b2 + b3; OPQ(c0); OPQ(c1);
    return c0 + c1; }
__device__ __forceinline__ float xmax32(float x) { float y; asm volatile("v_mov_b32 %0, %1\n\ts_nop 1" : "=v"(y) : "v"(x));
    auto r = __builtin_amdgcn_permlane32_swap(__builtin_bit_cast(unsigned, x), __builtin_bit_cast(unsigned, y), false, false); const unsigned a = r[0], b = r[1];
    return vmax2(__builtin_bit_cast(float, a), __builtin_bit_cast(float, b)); }
__device__ __forceinline__ float xsum32(float x) { float y; asm volatile("v_mov_b32 %0, %1\n\ts_nop 1" : "=v"(y) : "v"(x));
    auto r = __builtin_amdgcn_permlane32_swap(__builtin_bit_cast(unsigned, x), __builtin_bit_cast(unsigned, y), false, false); const unsigned a = r[0], b = r[1];
    return __builtin_bit_cast(float, a) + __builtin_bit_cast(float, b); }
__device__ __forceinline__ f32x16 zero16() { f32x16 z;
#pragma unroll
    for (int i = 0; i < 16; ++i) z[i] = 0.f;
    return z; }
__device__ __forceinline__ f32x16 qk32(const bf16* kp, const bf16x8v (&qf)[4]) {
    f32x16 acc = zero16();
#pragma unroll
    for (int ks = 0; ks < 4; ++ks) { const bf16x8v kf = *(const bf16x8v*)(kp + 16 * ks); acc = __builtin_amdgcn_mfma_f32_32x32x16_bf16(kf, qf[ks], acc, 0, 0, 0); }
    return acc;
}
__device__ __forceinline__ void pv32(f32x16& o0, f32x16& o1, const bf16* vt, size_t dstep, const unsigned (&pb)[8]) {
#pragma unroll
    for (int s = 0; s < 2; ++s) {
        const bf16x4v a00 = *(const bf16x4v*)(vt + 16 * s), a01 = *(const bf16x4v*)(vt + 16 * s + 8);
        const bf16x4v a10 = *(const bf16x4v*)(vt + dstep + 16 * s), a11 = *(const bf16x4v*)(vt + dstep + 16 * s + 8);
        bf16x8v A0, A1, B;
        A0 = __builtin_shufflevector(a00, a01, 0, 1, 2, 3, 4, 5, 6, 7); A1 = __builtin_shufflevector(a10, a11, 0, 1, 2, 3, 4, 5, 6, 7);
        typedef unsigned u32x4v __attribute__((ext_vector_type(4)));
        u32x4v bw = {pb[4 * s + 0], pb[4 * s + 1], pb[4 * s + 2], pb[4 * s + 3]};
        B = __builtin_bit_cast(bf16x8v, bw);
        o0 = __builtin_amdgcn_mfma_f32_32x32x16_bf16(A0, B, o0, 0, 0, 0);
        o1 = __builtin_amdgcn_mfma_f32_32x32x16_bf16(A1, B, o1, 0, 0, 0);
    }
}
struct KF { bf16x8v k[4]; };
struct VF { bf16x4v v[8]; };
__device__ __forceinline__ void load_k(KF& f, const bf16* kp) {
#pragma unroll
    for (int ks = 0; ks < 4; ++ks) f.k[ks] = *(const bf16x8v*)(kp + 16 * ks); }
__device__ __forceinline__ void load_v(VF& f, const bf16* vt, size_t dstep) {
#pragma unroll
    for (int s = 0; s < 2; ++s) { f.v[2 * s] = *(const bf16x4v*)(vt + 16 * s); f.v[2 * s + 1] = *(const bf16x4v*)(vt + 16 * s + 8);
        f.v[4 + 2 * s] = *(const bf16x4v*)(vt + dstep + 16 * s); f.v[4 + 2 * s + 1] = *(const bf16x4v*)(vt + dstep + 16 * s + 8); } }
__device__ __forceinline__ f32x16 qk32r(const KF& f, const bf16x8v (&qf)[4]) {
    f32x16 acc = zero16();
#pragma unroll
    for (int ks = 0; ks < 4; ++ks) acc = __builtin_amdgcn_mfma_f32_32x32x16_bf16(f.k[ks], qf[ks], acc, 0, 0, 0);
    return acc; }
__device__ __forceinline__ void pv32r(f32x16& o0, f32x16& o1, const VF& f, const unsigned (&pb)[8]) {
    typedef unsigned u32x4v __attribute__((ext_vector_type(4)));
#pragma unroll
    for (int s = 0; s < 2; ++s) {
        const bf16x8v A0 = __builtin_shufflevector(f.v[2 * s], f.v[2 * s + 1], 0, 1, 2, 3, 4, 5, 6, 7), A1 = __builtin_shufflevector(f.v[4 + 2 * s], f.v[4 + 2 * s + 1], 0, 1, 2, 3, 4, 5, 6, 7);
        const u32x4v bw = {pb[4 * s + 0], pb[4 * s + 1], pb[4 * s + 2], pb[4 * s + 3]}; const bf16x8v B = __builtin_bit_cast(bf16x8v, bw);
        o0 = __builtin_amdgcn_mfma_f32_32x32x16_bf16(A0, B, o0, 0, 0, 0); o1 = __builtin_amdgcn_mfma_f32_32x32x16_bf16(A1, B, o1, 0, 0, 0); } }
__device__ __forceinline__ unsigned long long wave_or64(unsigned long long x) {
    unsigned lo = (unsigned)x, hi = (unsigned)(x >> 32);
#pragma unroll
    for (int o = 1; o < 64; o <<= 1) { lo |= (unsigned)__shfl_xor((int)lo, o); hi |= (unsigned)__shfl_xor((int)hi, o); }
    return ((unsigned long long)(unsigned)__builtin_amdgcn_readfirstlane((int)hi) << 32) | (unsigned)__builtin_amdgcn_readfirstlane((int)lo); }
struct LaneAddr { unsigned ck, cv; unsigned rk[4], rv[4], rw[4]; };
__device__ __forceinline__ LaneAddr lane_addr(LAS unsigned char* slot, int lane) {
    LaneAddr a; const int r = lane & 31, hh = lane >> 5; const unsigned sb = (unsigned)(size_t)slot;
    a.ck = (unsigned)lane; a.cv = (unsigned)lane;
#pragma unroll
    for (int ks = 0; ks < 4; ++ks) a.rk[ks] = sb + r * 128 + (((2 * ks + hh) ^ (r & 7)) * 16);
#pragma unroll
    for (int c = 0; c < 4; ++c) { a.rv[c] = sb + 4096 + r * 64 + ((c ^ ((r >> 2) & 3)) * 16) + 8 * hh; unsigned w = a.rv[c] + 2048; asm volatile("" : "+v"(w)); a.rw[c] = w; }
    return a; }
__device__ __forceinline__ unsigned kvoff(int lane, size_t pitch) { const int row = lane >> 3, ch = (lane & 7) ^ (row & 7); return (unsigned)((row * pitch + ch * 8) * 2); }
__device__ __forceinline__ unsigned vvoff(int lane, size_t pitch) { const int row = lane >> 2, ch = (lane & 3) ^ ((row >> 2) & 3); return (unsigned)((row * pitch + ch * 8) * 2); }
typedef __amdgpu_buffer_rsrc_t rsrc_t;
__device__ __forceinline__ rsrc_t mkrsrc(const void* base) { return __builtin_amdgcn_make_buffer_rsrc((void*)base, 0, 0x7FFFFFF0, 0x00020000); }
__device__ __forceinline__ void dma_k(LAS unsigned char* slot, rsrc_t rs, unsigned tile_off, unsigned pitchB, unsigned voff) {
#pragma unroll
    for (int q = 0; q < 4; ++q) __builtin_amdgcn_raw_ptr_buffer_load_lds(rs, (LAS unsigned*)(slot + q * 1024), 16, voff, tile_off + q * 8 * pitchB, 0, 0); }
__device__ __forceinline__ void dma_v(LAS unsigned char* slot, rsrc_t rs, unsigned tile_off, unsigned pitchB, unsigned voff) {
#pragma unroll
    for (int q = 0; q < 4; ++q) __builtin_amdgcn_raw_ptr_buffer_load_lds(rs, (LAS unsigned*)(slot + 4096 + q * 1024), 16, voff, tile_off + q * 16 * pitchB, 0, 0); }
__device__ __forceinline__ void read_k(KF& f, const LaneAddr& a) {
#pragma unroll
    for (int ks = 0; ks < 4; ++ks) f.k[ks] = *(const LAS bf16x8v*)(size_t)a.rk[ks]; }
__device__ __forceinline__ void read_v(VF& f, const LaneAddr& a) {
#pragma unroll
    for (int dt = 0; dt < 2; ++dt)
#pragma unroll
        for (int s = 0; s < 2; ++s) { f.v[4 * dt + 2 * s] = *(const LAS bf16x4v*)(size_t)(dt ? a.rw[2 * s] : a.rv[2 * s]); f.v[4 * dt + 2 * s + 1] = *(const LAS bf16x4v*)(size_t)(dt ? a.rw[2 * s + 1] : a.rv[2 * s + 1]); } }
#define DMA_WAIT() asm volatile("s_waitcnt vmcnt(0)" ::: "memory")
#define LDS_DRAIN() asm volatile("s_waitcnt lgkmcnt(0)" ::: "memory")
#define LDS_DRAIN_PINNED() do { __builtin_amdgcn_sched_barrier(0); asm volatile("s_waitcnt lgkmcnt(0)" ::: "memory"); } while (0)
#define ATT_BIG 1.152921504606847e18f
__device__ __forceinline__ void sm_fast(f32x16& s, const KF& kc, const bf16x8v (&qf)[4], bool lane_on, float& m, float& l, f32x16& o0, f32x16& o1, unsigned (&pb)[8]) {
    float nb = lane_on ? -m : -INFINITY;
#pragma unroll
    for (int reg = 0; reg < 16; ++reg) s[reg] = fexp2(__builtin_fmaf(s[reg], ATT_C2, nb));
    float rs = vsum16(s);
    if (__any(!(rs < ATT_BIG))) {
        s = qk32r(kc, qf);
        float mx = vmax16_acc(s);
        mx = xmax32(lane_on ? mx * ATT_C2 : ATT_NEG);
        const float mn = (mx > m + ATT_THR) ? mx : m, alpha = fexp2(m - mn); m = mn; l *= alpha;
#pragma unroll
        for (int reg = 0; reg < 16; ++reg) { o0[reg] *= alpha; o1[reg] *= alpha; }
        nb = lane_on ? -m : -INFINITY;
#pragma unroll
        for (int reg = 0; reg < 16; ++reg) s[reg] = fexp2(__builtin_fmaf(s[reg], ATT_C2, nb));
        rs = vsum16(s); }
    l += rs;
#pragma unroll
    for (int i = 0; i < 8; ++i) pb[i] = cvtpk(s[2 * i], s[2 * i + 1]);
}
__device__ __forceinline__ void sm_step(f32x16& s, const KF& kc, const bf16x8v (&qf)[4], int lo, int hi, int hh, float& m, float& l, f32x16& o0, f32x16& o1, unsigned (&pb)[8]) {
    const float nb = -m;
#pragma unroll
    for (int reg = 0; reg < 16; ++reg) { const int ko = (reg & 3) + 8 * (reg >> 2) + 4 * hh; const bool v = (ko >= lo) && (ko <= hi);
        const float e = fexp2(__builtin_fmaf(s[reg], ATT_C2, nb)); s[reg] = v ? e : 0.f; }
    float rs = vsum16(s);
    if (__any(!(rs < ATT_BIG))) {
        s = qk32r(kc, qf);
#pragma unroll
        for (int reg = 0; reg < 16; ++reg) { const int ko = (reg & 3) + 8 * (reg >> 2) + 4 * hh; const bool v = (ko >= lo) && (ko <= hi);
            s[reg] = v ? s[reg] * ATT_C2 : ATT_NEG; }
        const float mx = xmax32(vmax16(s));
        const float mn = (mx > m + ATT_THR) ? mx : m, alpha = fexp2(m - mn); m = mn; l *= alpha;
#pragma unroll
        for (int reg = 0; reg < 16; ++reg) { o0[reg] *= alpha; o1[reg] *= alpha; }
#pragma unroll
        for (int reg = 0; reg < 16; ++reg) s[reg] = (s[reg] > -1e29f) ? fexp2(s[reg] - m) : 0.f;
        rs = vsum16(s); }
    l += rs;
#pragma unroll
    for (int i = 0; i < 8; ++i) pb[i] = cvtpk(s[2 * i], s[2 * i + 1]);
}

__device__ __forceinline__ float dpp_xor1(float x) { return __builtin_bit_cast(float, __builtin_amdgcn_update_dpp(0, __builtin_bit_cast(int, x), 0xB1, 0xF, 0xF, true)); }
__device__ __forceinline__ float dpp_xor2(float x) { return __builtin_bit_cast(float, __builtin_amdgcn_update_dpp(0, __builtin_bit_cast(int, x), 0x4E, 0xF, 0xF, true)); }
#define IMP_LD 132
__device__ __forceinline__ void nsa_unit(const P& p, const bf16* VCT, const bf16* VT, LAS unsigned char* wl, int b, int g, int t0, int lane) {
    const LaneAddr la = lane_addr(wl, lane);
    LAS float* imp = (LAS float*)(wl + 8192);
    const int r = lane & 31, hh = lane >> 5, tl = r >> 2, hg = r & 3, head = g * 4 + hg, t = t0 + tl;
    const long row = (long)b * cS + t;
    bf16x8v qf[4];
    { const bf16* qp = p.PROJ + (size_t)row * PE_LD + head * 64 + 8 * hh;
#pragma unroll
      for (int ks = 0; ks < 4; ++ks) qf[ks] = *(const bf16x8v*)(qp + 16 * ks); }
    float outacc[32];
    unsigned pb[8];
    unsigned long long m0 = 0ull, m1 = 0ull;
    {
        for (int i = lane; i < 8 * IMP_LD; i += 64) imp[i] = 0.f;
        const int nv = t >= 31 ? (t - 31) / 16 + 1 : 0, nvmax = (t0 + 7) >= 31 ? (t0 + 7 - 31) / 16 + 1 : 0, ntile = (nvmax + 31) >> 5;
        float m = ATT_NEG, l = 0.f;
        const bf16* kc0 = p.KCMP + ((size_t)b * KCMP_ROWS * 2 + g) * 64;
        const bf16* vc0 = VCT + (size_t)(b * 2 + g) * 64 * VCT_LD;
        const rsrc_t rsK = mkrsrc(kc0), rsV = mkrsrc(vc0); const unsigned kvo = kvoff(lane, 128), vvo = vvoff(lane, VCT_LD);
        KF kc; VF vc;
        if (ntile > 0) { dma_k(wl, rsK, 0u, 128 * 2, kvo); DMA_WAIT(); read_k(kc, la); }
        for (int kt = 0; kt < ntile; ++kt) { const int key0 = 32 * kt;
            LDS_DRAIN();
            if (kt + 1 < ntile) dma_k(wl, rsK, (unsigned)(key0 + 32) * (128 * 2), 128 * 2, kvo);
            f32x16 s = qk32r(kc, qf);
            float mx = ATT_NEG;
#pragma unroll
            for (int reg = 0; reg < 16; ++reg) { const int ko = (reg & 3) + 8 * (reg >> 2) + 4 * hh; const float x = (key0 + ko < nv) ? s[reg] * ATT_C2 : ATT_NEG; s[reg] = x; mx = fmaxf(mx, x); }
            mx = xmax32(mx);
            const float mn = fmaxf(m, mx); float rs = 0.f;
#pragma unroll
            for (int reg = 0; reg < 16; ++reg) rs += (s[reg] > -1e29f) ? fexp2(s[reg] - mn) : 0.f;
            rs = xsum32(rs);
            l = l * fexp2(m - mn) + rs; m = mn;
            if (kt + 1 < ntile) { DMA_WAIT(); read_k(kc, la); } }
        const float rl = l > 0.f ? 1.f / l : 0.f;
        f32x16 o0 = zero16(), o1 = zero16();
        if (ntile > 0) { dma_k(wl, rsK, 0u, 128 * 2, kvo); dma_v(wl, rsV, 0u, VCT_LD * 2, vvo); DMA_WAIT(); read_k(kc, la); }
        for (int kt = 0; kt < ntile; ++kt) { const int key0 = 32 * kt;
            LDS_DRAIN(); if (kt + 1 < ntile) dma_k(wl, rsK, (unsigned)(key0 + 32) * (128 * 2), 128 * 2, kvo);
            read_v(vc, la);
            f32x16 s = qk32r(kc, qf);
            LDS_DRAIN_PINNED(); if (kt + 1 < ntile) dma_v(wl, rsV, (unsigned)(key0 + 32) * 2, VCT_LD * 2, vvo);
#pragma unroll
            for (int reg = 0; reg < 16; ++reg) { const int ko = (reg & 3) + 8 * (reg >> 2) + 4 * hh; s[reg] = (key0 + ko < nv) ? fexp2(s[reg] * ATT_C2 - m) * rl : 0.f; }
#pragma unroll
            for (int i = 0; i < 8; ++i) pb[i] = cvtpk(s[2 * i], s[2 * i + 1]);
            pv32r(o0, o1, vc, pb);
#pragma unroll
            for (int k = 0; k < 4; ++k) { float a = s[4 * k] + s[4 * k + 1] + s[4 * k + 2] + 0.5f * s[4 * k + 3], c = 0.5f * s[4 * k + 3];
                a += dpp_xor1(a); a += dpp_xor2(a); c += dpp_xor1(c); c += dpp_xor2(c);
                if (hg == 0) { const int j = (key0 >> 2) + 2 * k + hh; (void)__hip_atomic_fetch_add(imp + tl * IMP_LD + j, a, __ATOMIC_RELAXED, __HIP_MEMORY_SCOPE_WORKGROUP); (void)__hip_atomic_fetch_add(imp + tl * IMP_LD + j + 1, c, __ATOMIC_RELAXED, __HIP_MEMORY_SCOPE_WORKGROUP); } }
            if (kt + 1 < ntile) { DMA_WAIT(); read_k(kc, la); } }
        const float g0 = p.GATES[row * 24 + head * 3 + 0];
#pragma unroll
        for (int reg = 0; reg < 16; ++reg) { outacc[reg] = o0[reg] * g0; outacc[16 + reg] = o1[reg] * g0; }
    }
    for (int tk = 0; tk < 8; ++tk) { const int tt = t0 + tk, cur = tt >> 6; LAS float* row = imp + tk * IMP_LD;
        float v0 = (64 * lane > tt) ? -1.f : row[lane], v1 = (64 * (lane + 64) > tt) ? -1.f : row[lane + 64];
        if (lane == 0 || lane == cur || lane == cur - 1) v0 += 1e4f;
        if (lane + 64 == cur || lane + 64 == cur - 1) v1 += 1e4f;
        row[lane] = v0; row[lane + 64] = v1;
        int r0 = 0, r1 = 0;
        const int nq4 = min(32, ((cur >> 2) + 4) & ~3);
#pragma unroll 4
        for (int q4 = 0; q4 < nq4; ++q4) { const f32x4v w = *(const LAS f32x4v*)(row + 4 * q4);
#pragma unroll
            for (int e = 0; e < 4; ++e) { const int jj = 4 * q4 + e; const float x = w[e];
                r0 += (x > v0 || (x == v0 && jj < lane)) ? 1 : 0; r1 += (x > v1 || (x == v1 && jj < lane + 64)) ? 1 : 0; } }
        const unsigned long long s0 = __ballot(r0 < 16), s1 = __ballot(r1 < 16);
        if (tl == tk) { m0 = s0; m1 = s1; } }
    {
        f32x16 o0 = zero16(), o1 = zero16(); float m = ATT_NEG, l = 0.f;
        const bf16* k0p = p.PROJ + (size_t)b * cS * PE_LD + 768 + g * 64;
        const bf16* v0p = VT + vt_tile_off(16, b, g, 0);
        const rsrc_t rsK = mkrsrc(k0p), rsV = mkrsrc(v0p); const unsigned kvo = kvoff(lane, PE_LD), vvo = vvoff(lane, 32);
        unsigned long long u0 = wave_or64(m0), u1 = wave_or64(m1);
        const int tmax = (t0 + 7) >> 5;
#define NSA_NEXT_TILE(tc) ({ int tt_ = (tc) + 1; if ((tt_ & 1) == 0) { const int j_ = tt_ >> 1; \
            const unsigned long long lo_ = j_ < 64 ? (u0 >> j_) : 0ull, hi_ = j_ < 64 ? u1 : (j_ < 128 ? (u1 >> (j_ - 64)) : 0ull); \
            tt_ = lo_ ? 2 * (j_ + __builtin_ctzll(lo_)) : (hi_ ? 2 * ((j_ < 64 ? 64 : j_) + __builtin_ctzll(hi_)) : 1 << 20); } tt_ <= tmax ? tt_ : -1; })
        int tn = NSA_NEXT_TILE(-1);
        KF kc; VF vc;
        if (tn >= 0) { dma_k(wl, rsK, (unsigned)(32 * tn) * (PE_LD * 2), PE_LD * 2, kvo); dma_v(wl, rsV, (unsigned)tn * 4096u, 64, vvo); DMA_WAIT(); read_k(kc, la); }
        while (tn >= 0 && 32 * tn + 31 <= t0) { const int tc = tn, key0 = 32 * tc, j = tc >> 1;
            tn = NSA_NEXT_TILE(tc);
            LDS_DRAIN(); if (tn >= 0) dma_k(wl, rsK, (unsigned)(32 * tn) * (PE_LD * 2), PE_LD * 2, kvo);
            read_v(vc, la);
            const bool selj = ((j < 64 ? m0 : m1) >> (j & 63)) & 1ull;
            f32x16 s = qk32r(kc, qf);
            LDS_DRAIN_PINNED(); if (tn >= 0) dma_v(wl, rsV, (unsigned)tn * 4096u, 64, vvo);
            sm_fast(s, kc, qf, selj, m, l, o0, o1, pb);
            pv32r(o0, o1, vc, pb);
            if (tn >= 0) { DMA_WAIT(); read_k(kc, la); } }
        while (tn >= 0) { const int tc = tn, key0 = 32 * tc, j = tc >> 1;
            tn = NSA_NEXT_TILE(tc);
            LDS_DRAIN(); if (tn >= 0) dma_k(wl, rsK, (unsigned)(32 * tn) * (PE_LD * 2), PE_LD * 2, kvo);
            read_v(vc, la);
            const bool selj = ((j < 64 ? m0 : m1) >> (j & 63)) & 1ull;
            f32x16 s = qk32r(kc, qf);
            LDS_DRAIN_PINNED(); if (tn >= 0) dma_v(wl, rsV, (unsigned)tn * 4096u, 64, vvo);
            sm_step(s, kc, qf, 0, selj ? t - key0 : -1, hh, m, l, o0, o1, pb);
            pv32r(o0, o1, vc, pb);
            if (tn >= 0) { DMA_WAIT(); read_k(kc, la); } }
        l = xsum32(l);
        const float sc = (l > 0.f ? 1.f / l : 0.f) * p.GATES[row * 24 + head * 3 + 1];
#pragma unroll
        for (int reg = 0; reg < 16; ++reg) { outacc[reg] += o0[reg] * sc; outacc[16 + reg] += o1[reg] * sc; }
    }
    {
        f32x16 o0 = zero16(), o1 = zero16(); float m = ATT_NEG, l = 0.f;
        const bf16* k0p = p.PROJ + (size_t)b * cS * PE_LD + 896 + g * 64;
        const bf16* v0p = VT + vt_tile_off(16, b, 2 + g, 0);
        const rsrc_t rsK = mkrsrc(k0p), rsV = mkrsrc(v0p); const unsigned kvo = kvoff(lane, PE_LD), vvo = vvoff(lane, 32);
        const int k_lo = t0 >= 511 ? (t0 - 511) >> 5 : 0, k_hi = (t0 + 7) >> 5;
        KF kc; VF vc;
        dma_k(wl, rsK, (unsigned)(32 * k_lo) * (PE_LD * 2), PE_LD * 2, kvo); dma_v(wl, rsV, (unsigned)k_lo * 4096u, 64, vvo); DMA_WAIT(); read_k(kc, la);
#define WIN_TILE(SM_) { const int key0 = 32 * kt; \
            LDS_DRAIN(); if (kt < k_hi) dma_k(wl, rsK, (unsigned)(key0 + 32) * (PE_LD * 2), PE_LD * 2, kvo); \
            read_v(vc, la); \
            f32x16 s = qk32r(kc, qf); \
            LDS_DRAIN_PINNED(); if (kt < k_hi) dma_v(wl, rsV, (unsigned)(kt + 1) * 4096u, 64, vvo); \
            SM_; \
            pv32r(o0, o1, vc, pb); \
            if (kt < k_hi) { DMA_WAIT(); read_k(kc, la); } }
        int kt = k_lo;
        for (; kt <= k_hi && 32 * kt < t0 + 7 - 511; ++kt) WIN_TILE(sm_step(s, kc, qf, t - 511 - key0, 31, hh, m, l, o0, o1, pb))
        for (; kt <= k_hi && 32 * kt + 31 <= t0; ++kt) WIN_TILE(sm_fast(s, kc, qf, true, m, l, o0, o1, pb))
        for (; kt <= k_hi; ++kt) WIN_TILE(sm_step(s, kc, qf, 0, t - key0, hh, m, l, o0, o1, pb))
#undef WIN_TILE
        l = xsum32(l);
        const float sc = (l > 0.f ? 1.f / l : 0.f) * p.GATES[row * 24 + head * 3 + 2];
#pragma unroll
        for (int reg = 0; reg < 16; ++reg) { outacc[reg] += o0[reg] * sc; outacc[16 + reg] += o1[reg] * sc; }
    }
    bf16* ao = p.ATT + (size_t)row * 768 + head * 64 + 4 * hh;
#pragma unroll
    for (int dt = 0; dt < 2; ++dt)
#pragma unroll
        for (int k = 0; k < 4; ++k) { uint2 nw;
            nw.x = cvtpk(outacc[16 * dt + 4 * k + 0], outacc[16 * dt + 4 * k + 1]); nw.y = cvtpk(outacc[16 * dt + 4 * k + 2], outacc[16 * dt + 4 * k + 3]); *(uint2*)(ao + 32 * dt + 8 * k) = nw; }
}

__device__ __forceinline__ void cmp1_unit(const P& p, const bf16* W1T, const float* PEB, int u, int lane) {
    const int r = lane & 31, hh = lane >> 5;
    const int ct = u & 7, rt = (u >> 3) & 127, which = u >> 10;
    const int NR = cB * cNC * 2;
    int i = rt * 32 + r; if (i >= NR) i = NR - 1;
    const int g = i & 1, n = (i >> 1) % cNC, b = (i >> 1) / cNC;
    const bf16* ap = p.PROJ + (size_t)(b * cS + 16 * n) * PE_LD + 512 + which * 128 + g * 64 + 8 * hh;
    const bf16* bp = W1T + ((size_t)which * 256 + ct * 32 + r) * 2048 + 8 * hh;
    f32x16 acc = zero16();
    for (int l = 0; l < 32; ++l) {
#pragma unroll
        for (int q = 0; q < 4; ++q) { const bf16x8v a = *(const bf16x8v*)(ap + (size_t)l * PE_LD + 16 * q), bb = *(const bf16x8v*)(bp + l * 64 + 16 * q);
            acc = __builtin_amdgcn_mfma_f32_32x32x16_bf16(a, bb, acc, 0, 0, 0); } }
    const int j = ct * 32 + r; const float bias = PEB[which * 256 + j];
#pragma unroll
    for (int reg = 0; reg < 16; ++reg) { const int io = rt * 32 + (reg & 3) + 8 * (reg >> 2) + 4 * hh;
        if (io < NR) p.HID[((size_t)which * NR + io) * 256 + j] = gelu_tanh(acc[reg] + bias); }
}
__device__ __forceinline__ void gates_unit(const P& p, const bf16* WGT, int u, int lane) {
    const int r = lane & 31, hh = lane >> 5;
    const bf16* ap = p.Y + (size_t)(u * 32 + r) * cDM + 8 * hh; const bf16* bp = WGT + (size_t)r * cDM + 8 * hh;
    f32x16 acc = zero16();
#pragma unroll 8
    for (int ks = 0; ks < cDM / 16; ++ks) { const bf16x8v a = *(const bf16x8v*)(ap + 16 * ks), bb = *(const bf16x8v*)(bp + 16 * ks);
        acc = __builtin_amdgcn_mfma_f32_32x32x16_bf16(a, bb, acc, 0, 0, 0); }
    if (r < 24) {
#pragma unroll
        for (int reg = 0; reg < 16; ++reg) { const int row = u * 32 + (reg & 3) + 8 * (reg >> 2) + 4 * hh; p.GATES[(size_t)row * 24 + r] = 1.f / (1.f + __expf(-acc[reg])); } }
}

__device__ __forceinline__ float xlo32(float x) { float y; asm volatile("v_mov_b32 %0, %1\n\ts_nop 1" : "=v"(y) : "v"(x));
    auto r = __builtin_amdgcn_permlane32_swap(__builtin_bit_cast(unsigned, x), __builtin_bit_cast(unsigned, y), false, false); const unsigned a = r[0]; return __builtin_bit_cast(float, a); }
template <bool DIAG>
__device__ __forceinline__ void sb_tile(const f32x16& z, const VF& vc, const bf16x8v (&TA)[2], int r, int hh, float& carry, f32x16& o0, f32x16& o1) {
    f32x16 l1; float lbv[16];
#pragma unroll
    for (int reg = 0; reg < 16; ++reg) { const int ko = (reg & 3) + 8 * (reg >> 2) + 4 * hh; float zr = z[reg]; OPQ(zr); const float zz = zr * 0.125f;
        const float e = fexp2(-fabsf(zz) * 1.4426950408889634f); const float sp = __builtin_amdgcn_logf(1.f + e) * 0.6931471805599453f;
        float lb = fminf(zz, 0.f) - sp; OPQ(lb); lbv[reg] = lb; float x = (!DIAG || ko < r) ? lb - zz : 0.f; OPQ(x); l1[reg] = x; }
    unsigned bh[8], bl[8];
#pragma unroll
    for (int i = 0; i < 8; ++i) { const float x0 = l1[2 * i], x1 = l1[2 * i + 1]; const unsigned hw = cvtpk(x0, x1); bh[i] = hw; float d0 = x0 - bflo(hw), d1 = x1 - bfhi(hw); OPQ(d0); OPQ(d1); bl[i] = cvtpk(d0, d1); }
    f32x16 af = zero16();
    typedef unsigned u32x4v __attribute__((ext_vector_type(4)));
#pragma unroll
    for (int s = 0; s < 2; ++s) { const u32x4v wh = {bh[4 * s], bh[4 * s + 1], bh[4 * s + 2], bh[4 * s + 3]}, wl = {bl[4 * s], bl[4 * s + 1], bl[4 * s + 2], bl[4 * s + 3]};
        af = __builtin_amdgcn_mfma_f32_32x32x16_bf16(TA[s], __builtin_bit_cast(bf16x8v, wh), af, 0, 0, 0);
        af = __builtin_amdgcn_mfma_f32_32x32x16_bf16(TA[s], __builtin_bit_cast(bf16x8v, wl), af, 0, 0, 0); }
    unsigned pb[8]; float av[16];
#pragma unroll
    for (int reg = 0; reg < 16; ++reg) { const int ko = (reg & 3) + 8 * (reg >> 2) + 4 * hh;
        float t = lbv[reg] + af[reg]; OPQ(t); av[reg] = (!DIAG || ko < r) ? fexp2((t + carry) * 1.4426950408889634f) : 0.f; }
#pragma unroll
    for (int i = 0; i < 8; ++i) pb[i] = cvtpk(av[2 * i], av[2 * i + 1]);
    pv32r(o0, o1, vc, pb);
    carry += xlo32(af[0] + l1[0]);
}
__device__ __forceinline__ void sb_unit(const P& p, const bf16* VT, LAS unsigned char* wl, int b, int h, int t0, int lane) {
    const int r = lane & 31, hh = lane >> 5; const long row = (long)b * cS + t0 + r; const LaneAddr la = lane_addr(wl, lane);
    bf16x8v qf[4];
    { const bf16* qp = p.PROJ + (size_t)row * PO_LD + h * 64 + 8 * hh;
#pragma unroll
      for (int ks = 0; ks < 4; ++ks) qf[ks] = *(const bf16x8v*)(qp + 16 * ks); }
    bf16x8v TA[2];
#pragma unroll
    for (int s = 0; s < 2; ++s)
#pragma unroll
        for (int j = 0; j < 8; ++j) { const int kk = 16 * s + 8 * (j >> 2) + 4 * hh + (j & 3); TA[s][j] = (short)(kk > r ? 0x3F80 : 0); }
    f32x16 o0 = zero16(), o1 = zero16(); float carry = 0.f;
    const bf16* k0p = p.PROJ + (size_t)b * cS * PO_LD + cDM + h * 64;
    const bf16* v0p = VT + vt_tile_off(16, b, h, 0);
    const rsrc_t rsK = mkrsrc(k0p), rsV = mkrsrc(v0p); const unsigned kvo = kvoff(lane, PO_LD), vvo = vvoff(lane, 32);
    KF kc; VF vc;
    dma_k(wl, rsK, (unsigned)t0 * (PO_LD * 2), PO_LD * 2, kvo); dma_v(wl, rsV, (unsigned)(t0 >> 5) * 4096u, 64, vvo); DMA_WAIT(); read_k(kc, la);
#define SB_TILE(DIAG_, key0_) do { LDS_DRAIN(); if ((key0_) > 0) dma_k(wl, rsK, (unsigned)((key0_) - 32) * (PO_LD * 2), PO_LD * 2, kvo); \
        read_v(vc, la); const f32x16 z_ = qk32r(kc, qf); \
        LDS_DRAIN_PINNED(); if ((key0_) > 0) dma_v(wl, rsV, (unsigned)(((key0_) - 32) >> 5) * 4096u, 64, vvo); \
        sb_tile<DIAG_>(z_, vc, TA, r, hh, carry, o0, o1); } while (0)
    int kt = t0 >> 5;
    SB_TILE(true, t0);
    for (--kt; kt >= 0; --kt) { const int key0 = 32 * kt;
        DMA_WAIT(); read_k(kc, la);
        SB_TILE(false, key0);
        if (__all(carry < -93.f)) break; }
#undef SB_TILE
    DMA_WAIT();
    bf16* ao = p.ATT + (size_t)row * cDM + h * 64 + 4 * hh;
#pragma unroll
    for (int dt = 0; dt < 2; ++dt)
#pragma unroll
        for (int k = 0; k < 4; ++k) { uint2 nw; const f32x16& o = dt ? o1 : o0;
            nw.x = cvtpk(o[4 * k + 0], o[4 * k + 1]); nw.y = cvtpk(o[4 * k + 2], o[4 * k + 3]); *(uint2*)(ao + 32 * dt + 8 * k) = nw; }
}

template <int G>
__device__ __forceinline__ void dil_unit(const P& p, const bf16* VT, const bf16* VTP, bf16* DOUT, float* DLSE, LAS unsigned char* wl, int b, int hd, int rc, int tile, int lane) {
    constexpr int dil = G == 0 ? 1 : G == 1 ? 4 : 16; constexpr int slot0 = 4 * G;
    const int r = lane & 31, hh = lane >> 5, slot = slot0 + hd; const LaneAddr la = lane_addr(wl, lane);
    const long row = (long)b * cS + rc + (long)dil * (32 * tile + r);
    bf16x8v qf[4];
    { const bf16* qp = p.PROJ + (size_t)row * PE_LD + 1024 + slot * 64 + 8 * hh;
#pragma unroll
      for (int ks = 0; ks < 4; ++ks) qf[ks] = *(const bf16x8v*)(qp + 16 * ks); }
    f32x16 o0 = zero16(), o1 = zero16(); float m = ATT_NEG, l = 0.f; unsigned pb[8];
    const bf16* k0p = p.PROJ + ((size_t)b * cS + rc) * PE_LD + 1792 + slot * 64;
    const bf16* v0p = G == 0 ? VT + vt_tile_off(16, b, 4 + slot, 0)
                             : VTP + vt_tile_off(8, b, (G - 1) * 4 + hd, rc * (cS / dil / 32));
    const rsrc_t rsK = mkrsrc(k0p), rsV = mkrsrc(v0p); const unsigned kvo = kvoff(lane, (size_t)dil * PE_LD), vvo = vvoff(lane, 32);
    const int k_lo = tile >= 4 ? tile - 4 : 0;
    KF kc; VF vc;
    dma_k(wl, rsK, (unsigned)(32 * k_lo) * (dil * PE_LD * 2), dil * PE_LD * 2, kvo); dma_v(wl, rsV, (unsigned)k_lo * 4096u, 64, vvo); DMA_WAIT(); read_k(kc, la);
    for (int kt = k_lo; kt <= tile; ++kt) { const int D0 = 32 * (tile - kt);
        LDS_DRAIN(); if (kt < tile) dma_k(wl, rsK, (unsigned)(32 * kt + 32) * (dil * PE_LD * 2), dil * PE_LD * 2, kvo);
        read_v(vc, la);
        f32x16 s = qk32r(kc, qf);
        LDS_DRAIN_PINNED(); if (kt < tile) dma_v(wl, rsV, (unsigned)(kt + 1) * 4096u, 64, vvo);
        if (D0 >= 32 && D0 <= 96) sm_fast(s, kc, qf, true, m, l, o0, o1, pb);
        else sm_step(s, kc, qf, D0 + r - 128, D0 + r, hh, m, l, o0, o1, pb);
        pv32r(o0, o1, vc, pb);
        if (kt < tile) { DMA_WAIT(); read_k(kc, la); } }
    l = xsum32(l);
    const float rl = 1.f / l;
    bf16* ao = DOUT + ((size_t)G * cM + row) * 256 + hd * 64 + 4 * hh;
#pragma unroll
    for (int dt = 0; dt < 2; ++dt)
#pragma unroll
        for (int k = 0; k < 4; ++k) { uint2 nw; const f32x16& o = dt ? o1 : o0;
            nw.x = cvtpk(o[4 * k + 0] * rl, o[4 * k + 1] * rl); nw.y = cvtpk(o[4 * k + 2] * rl, o[4 * k + 3] * rl); *(uint2*)(ao + 32 * dt + 8 * k) = nw; }
    if (hh == 0) DLSE[((size_t)G * cM + row) * 4 + hd] = m + __builtin_amdgcn_logf(l);
}
namespace pg8 {
#define PG8_LAS __attribute__((address_space(3)))
typedef unsigned short bf16_t;
typedef short bf16x8 __attribute__((ext_vector_type(8)));
typedef float f32x4 __attribute__((ext_vector_type(4)));
typedef unsigned u32x4 __attribute__((ext_vector_type(4)));
constexpr int BM = 256, BK = 64, HALF = 128, HTB = HALF * BK * 2  , STAGE_BYTES = 8 * HTB, NXCD = 8, WGM = 8;

__host__ __device__ __forceinline__ int lds_byte(int r, int c) { const int st = (r >> 4) * 2 + (c >> 5), rr = r & 15, cc = c & 31, ob = rr * 64 + cc * 2; return st * 1024 + (ob ^ (((ob >> 9) & 1) << 5)); }
__host__ __device__ __forceinline__ void stage_rc(int b, int& R, int& C) { const int st = b / 1024, sb = b % 1024, swz = sb ^ (((sb >> 9) & 1) << 5); R = (st >> 1) * 16 + swz / 64; C = (st & 1) * 32 + (swz % 64) / 2; }
__host__ __device__ __forceinline__ int perm32(int rho) { const int n = rho >> 4, i = rho & 15; return 8 * (i >> 2) + 4 * n + (i & 3); }

struct Unit { int pm, pn; };
struct Gemm { const bf16_t* A; const bf16_t* Bt; int M, N, K; };

struct StaticOrder {
    int nM, nN, nwg, G, c;
    __host__ __device__ void init(int M, int N, int G_, int c_) { nM = M / BM; nN = N / BM; nwg = nM * nN; G = G_; c = c_; }
    __host__ __device__ bool next(int i, Unit& u) const {
        const long L = (long)i * G + c; if (L >= nwg) return false;
        int wgid = (int)L; { const int q = nwg / NXCD, r = nwg % NXCD, xcd = wgid % NXCD, off = wgid / NXCD; wgid = (xcd < r ? xcd * (q + 1) : r * (q + 1) + (xcd - r) * q) + off; }
        const int nig = WGM * nN, gid = wgid / nig, fm = gid * WGM, gsz = (nM - fm) < WGM ? (nM - fm) : WGM;
        u.pm = fm + ((wgid % nig) % gsz); u.pn = (wgid % nig) / gsz; return true;
    }
    __device__ __forceinline__ void a_ready(const Unit&) const {}
    __device__ __forceinline__ void done(const Unit&) const {}
};

__device__ __forceinline__ unsigned cvt_pk_bf16(float lo, float hi) { unsigned r; asm volatile("v_cvt_pk_bf16_f32 %0, %1, %2" : "=v"(r) : "v"(lo), "v"(hi)); return r; }
typedef float f32x2 __attribute__((ext_vector_type(2)));
__device__ __forceinline__ f32x2 gelu_pk(f32x2 v) {
    const f32x2 av = __builtin_elementwise_abs(v), d = av * 0.2316418882f + 1.0f;
    f32x2 t; t.x = __builtin_amdgcn_rcpf(d.x); t.y = __builtin_amdgcn_rcpf(d.y);
    f32x2 q = t * 0.5307027145f + (-0.7265760135f); q = q * t + 0.7107068705f; q = q * t + (-0.142248368f); q = q * t + 0.127414796f; q = q * t;
    const f32x2 s = (v * v) * (-0.72134752044f);
    f32x2 e; e.x = __builtin_amdgcn_exp2f(s.x); e.y = __builtin_amdgcn_exp2f(s.y);
    const f32x2 m = v * (q * e), r = v - m;
    f32x2 o; o.x = v.x < 0.f ? m.x : r.x; o.y = v.y < 0.f ? m.y : r.y; return o;
}

template <int ACT  > struct EpiBf16 {
    static constexpr bool PERM = true, AFTER_DRAIN = false, TABLE = false; static_assert(ACT == 0 || ACT == 1, "EpiBf16: ACT is 0 (none) or 1 (gelu_pk)");
    bf16_t* O; int ldc; const float* bias; int split_cols; size_t split_stride; float scale0;
    __device__ __forceinline__ void operator()(const f32x4 (&acc)[2][2][4][2], const Unit& u, int wr, int wc, int fr, int fq) const {
        const int row0 = u.pm * BM + wr * 64 + fr; int colt = u.pn * BM; bf16_t* base = O;
        float sc = 1.f; if (split_cols) { const int t = colt / split_cols; base += (size_t)t * split_stride; colt -= t * split_cols; if (t == 0) sc = scale0; }
        const int col0 = colt + wc * 32 + 8 * fq, bcol0 = u.pn * BM + wc * 32 + 8 * fq;
        f32x4 bv[2][2];
#pragma unroll
        for (int bj = 0; bj < 2; ++bj)
#pragma unroll
            for (int n = 0; n < 2; ++n) bv[bj][n] = bias ? *(const f32x4*)(bias + bcol0 + bj * HALF + 4 * n) : (f32x4){0.f, 0.f, 0.f, 0.f};
#pragma unroll
        for (int ai = 0; ai < 2; ++ai)
#pragma unroll
            for (int m = 0; m < 4; ++m) { bf16_t* rowp = base + (size_t)(row0 + ai * HALF + m * 16) * ldc + col0;
#pragma unroll
                for (int bj = 0; bj < 2; ++bj) { f32x4 v0 = acc[ai][bj][m][0] + bv[bj][0], v1 = acc[ai][bj][m][1] + bv[bj][1];
                    if (ACT == 1) { f32x2 a = gelu_pk((f32x2){v0[0], v0[1]}), b = gelu_pk((f32x2){v0[2], v0[3]}), c = gelu_pk((f32x2){v1[0], v1[1]}), d = gelu_pk((f32x2){v1[2], v1[3]});
                        v0 = (f32x4){a.x, a.y, b.x, b.y}; v1 = (f32x4){c.x, c.y, d.x, d.y}; }
                    v0 = v0 * sc; v1 = v1 * sc; u32x4 w; w.x = cvt_pk_bf16(v0[0], v0[1]); w.y = cvt_pk_bf16(v0[2], v0[3]); w.z = cvt_pk_bf16(v1[0], v1[1]); w.w = cvt_pk_bf16(v1[2], v1[3]);
                    *(u32x4*)(rowp + bj * HALF) = w; } }
    }
};
template <class Epi, class Sched, bool ALIGN_EPI = false, bool SP2 = false>
__device__ __forceinline__ void gemm_phase(PG8_LAS unsigned char* lds, const Gemm g, const Sched& S, const Epi& E) {
    int tid_ = threadIdx.x; asm volatile("" : "+v"(tid_));
    const int tid = tid_, wid = __builtin_amdgcn_readfirstlane(tid >> 6), lane = tid & 63, wr = wid >> 2, wc = wid & 3, fr = lane & 15, fq = lane >> 4;
    const int K = g.K, nt = K / BK;
    unsigned voffA[2], voffB[2];
#pragma unroll
    for (int i = 0; i < 2; ++i) { int R, C; stage_rc(tid * 16 + i * 8192, R, C); const int Rb = Epi::PERM ? ((R & ~31) + perm32(R & 31)) : R;
        voffA[i] = (unsigned)(R * K + C) * 2u; voffB[i] = (unsigned)(Rb * K + C) * 2u; }
    const size_t kstep = (size_t)(BK * 2);
    const size_t hstep = (size_t)HALF * K * 2;
    const size_t tstep = 2 * hstep;
    const unsigned ldsw = (unsigned)wid * 1024u;
    const int aoff = lds_byte(wr * 64 + fr, fq * 8), boff = lds_byte(wc * 32 + fr, fq * 8);
#define PG8_SA(b, h) (((b) * 2 + (h)) * HTB)
#define PG8_SB(b, h) ((4 + (b) * 2 + (h)) * HTB)
#define PG8_STAGE(bufoff, gbase, voff) do { _Pragma("unroll") for (int _i = 0; _i < 2; ++_i) \
        __builtin_amdgcn_global_load_lds((const unsigned*)((const char*)(gbase) + (voff)[_i]), (PG8_LAS unsigned*)(lds + (bufoff) + ldsw + _i * 8192), 16, 0, 0); } while (0)
#define PG8_LDA(dst, b, h) do { _Pragma("unroll") for (int m = 0; m < 4; ++m) _Pragma("unroll") for (int k = 0; k < 2; ++k) dst[m][k] = *(const PG8_LAS bf16x8*)(lds + PG8_SA(b, h) + aoff + m * 2048 + k * 1024); } while (0)
#define PG8_LDB(dst, b, h) do { _Pragma("unroll") for (int n = 0; n < 2; ++n) _Pragma("unroll") for (int k = 0; k < 2; ++k) dst[n][k] = *(const PG8_LAS bf16x8*)(lds + PG8_SB(b, h) + boff + n * 2048 + k * 1024); } while (0)
#define PG8_MMA(ai, bj, At, Bt) do { __builtin_amdgcn_s_setprio(1); _Pragma("unroll") for (int m = 0; m < 4; ++m) _Pragma("unroll") for (int n = 0; n < 2; ++n) _Pragma("unroll") for (int k = 0; k < 2; ++k) \
        acc[ai][bj][m][n] = __builtin_amdgcn_mfma_f32_16x16x32_bf16(Bt[n][k], At[m][k], acc[ai][bj][m][n], 0, 0, 0); __builtin_amdgcn_s_setprio(0); } while (0)
#define PG8_WAIT_V(n) asm volatile("s_waitcnt vmcnt(" #n ")" ::: "memory")
#define PG8_WAIT_L(n) asm volatile("s_waitcnt lgkmcnt(" #n ")" ::: "memory")
#define PG8_BAR __builtin_amdgcn_s_barrier()
#define PG8_SCHED __builtin_amdgcn_sched_barrier(0)
    Unit cur, nxt; int ui = 0;
    if (!S.next(0, cur)) return;
    f32x4 acc[2][2][4][2];
#pragma unroll
    for (int a = 0; a < 2; ++a)
#pragma unroll
        for (int b = 0; b < 2; ++b)
#pragma unroll
            for (int m = 0; m < 4; ++m)
#pragma unroll
                for (int n = 0; n < 2; ++n) acc[a][b][m][n] = (f32x4){0.f, 0.f, 0.f, 0.f};
    bf16x8 At[4][2], B0[2][2], B1[2][2];
    const char* cA = (const char*)g.A + (size_t)cur.pm * tstep; const char* cB = (const char*)g.Bt + (size_t)cur.pn * tstep;
    S.a_ready(cur);
    if constexpr (SP2) {
        PG8_STAGE(PG8_SB(0, 0), cB, voffB); PG8_STAGE(PG8_SB(0, 1), cB + hstep, voffB); PG8_STAGE(PG8_SA(0, 0), cA, voffA); PG8_STAGE(PG8_SA(0, 1), cA + hstep, voffA);
        if (wr == 1) PG8_BAR;
        PG8_WAIT_V(2); PG8_BAR;
        PG8_STAGE(PG8_SB(1, 0), cB + kstep, voffB); PG8_STAGE(PG8_SA(1, 0), cA + kstep, voffA); PG8_STAGE(PG8_SB(1, 1), cB + hstep + kstep, voffB);
        PG8_WAIT_V(6); PG8_BAR;
    } else {
        PG8_STAGE(PG8_SB(0, 0), cB, voffB); PG8_STAGE(PG8_SA(0, 0), cA, voffA); PG8_STAGE(PG8_SB(0, 1), cB + hstep, voffB); PG8_STAGE(PG8_SA(0, 1), cA + hstep, voffA);
        if (wr == 1) PG8_BAR;
        PG8_WAIT_V(4); PG8_BAR;
        PG8_STAGE(PG8_SB(1, 0), cB + kstep, voffB); PG8_STAGE(PG8_SA(1, 0), cA + kstep, voffA); PG8_STAGE(PG8_SB(1, 1), cB + hstep + kstep, voffB);
        PG8_WAIT_V(6); PG8_BAR;
    }
    for (;;) {
        const bool has_next = S.next(ui + 1, nxt);
        if constexpr (Epi::TABLE) { if (tid < 256) E.stage_table(cur, lds + 131072 + (ui & 1) * 4096, tid); }
        const char* nA = has_next ? (const char*)g.A + (size_t)nxt.pm * tstep : cA; const char* nB = has_next ? (const char*)g.Bt + (size_t)nxt.pn * tstep : cB;
        for (int t = 0; t < nt; t += 2) {
            const bool last = (t == nt - 2);
            const char* a1 = cA + (size_t)(t + 1) * kstep;
            const char* a2 = last ? nA : cA + (size_t)(t + 2) * kstep; const char* b2 = last ? nB : cB + (size_t)(t + 2) * kstep;
            const char* a3 = a2 + kstep; const char* b3 = b2 + kstep;
            if (last && has_next) S.a_ready(nxt);
            if constexpr (SP2) {
            PG8_LDB(B0, 0, 0); PG8_LDB(B1, 0, 1); PG8_SCHED; PG8_LDA(At, 0, 0); PG8_STAGE(PG8_SA(1, 1), a1 + hstep, voffA);
            PG8_WAIT_V(8); PG8_WAIT_L(0); PG8_BAR; PG8_MMA(0, 0, At, B0); PG8_MMA(0, 1, At, B1); PG8_BAR; PG8_SCHED;
            PG8_LDA(At, 0, 1); PG8_STAGE(PG8_SB(0, 0), b2, voffB); PG8_STAGE(PG8_SB(0, 1), b2 + hstep, voffB); PG8_STAGE(PG8_SA(0, 0), a2, voffA);
            PG8_WAIT_V(8); PG8_WAIT_L(0); PG8_BAR; PG8_MMA(1, 0, At, B0); PG8_MMA(1, 1, At, B1); PG8_BAR; PG8_SCHED;
            PG8_LDB(B0, 1, 0); PG8_LDB(B1, 1, 1); PG8_SCHED; PG8_LDA(At, 1, 0); PG8_STAGE(PG8_SA(0, 1), a2 + hstep, voffA);
            PG8_WAIT_V(8); PG8_WAIT_L(0); PG8_BAR; PG8_MMA(0, 0, At, B0); PG8_MMA(0, 1, At, B1); PG8_BAR; PG8_SCHED;
            PG8_LDA(At, 1, 1); PG8_STAGE(PG8_SB(1, 0), b3, voffB); PG8_STAGE(PG8_SB(1, 1), b3 + hstep, voffB); PG8_STAGE(PG8_SA(1, 0), a3, voffA);
            PG8_WAIT_V(8); PG8_WAIT_L(0); PG8_BAR; PG8_MMA(1, 0, At, B0); PG8_MMA(1, 1, At, B1); PG8_BAR; PG8_SCHED;
            } else {
            PG8_LDB(B0, 0, 0); PG8_SCHED; PG8_LDA(At, 0, 0); PG8_STAGE(PG8_SA(1, 1), a1 + hstep, voffA);
            PG8_WAIT_L(8); PG8_BAR; PG8_WAIT_L(0); PG8_MMA(0, 0, At, B0); PG8_BAR; PG8_SCHED;
            PG8_LDB(B1, 0, 1); PG8_STAGE(PG8_SB(0, 0), b2, voffB);
            PG8_BAR; PG8_WAIT_L(0); PG8_MMA(0, 1, At, B1); PG8_BAR;
            PG8_LDA(At, 0, 1); PG8_STAGE(PG8_SA(0, 0), a2, voffA);
            PG8_BAR; PG8_WAIT_L(0); PG8_MMA(1, 0, At, B0); PG8_BAR; PG8_SCHED;
            PG8_STAGE(PG8_SB(0, 1), b2 + hstep, voffB);
            PG8_WAIT_V(6); PG8_BAR; PG8_MMA(1, 1, At, B1); PG8_BAR;
            PG8_LDB(B0, 1, 0); PG8_SCHED; PG8_LDA(At, 1, 0); PG8_STAGE(PG8_SA(0, 1), a2 + hstep, voffA);
            PG8_WAIT_L(8); PG8_BAR; PG8_WAIT_L(0); PG8_MMA(0, 0, At, B0); PG8_BAR; PG8_SCHED;
            PG8_LDB(B1, 1, 1); PG8_STAGE(PG8_SB(1, 0), b3, voffB);
            PG8_BAR; PG8_WAIT_L(0); PG8_MMA(0, 1, At, B1); PG8_BAR;
            PG8_LDA(At, 1, 1); PG8_STAGE(PG8_SA(1, 0), a3, voffA);
            PG8_BAR; PG8_WAIT_L(0); PG8_MMA(1, 0, At, B0); PG8_BAR; PG8_SCHED;
            PG8_STAGE(PG8_SB(1, 1), b3 + hstep, voffB);
            PG8_WAIT_V(6); PG8_BAR; PG8_MMA(1, 1, At, B1); PG8_BAR;
            }
        }
        if constexpr (ALIGN_EPI) { if (wr == 0) PG8_BAR; }
        if constexpr (!Epi::AFTER_DRAIN) { if constexpr (Epi::TABLE) E.run(acc, cur, wr, wc, fr, fq, lds + 131072 + (ui & 1) * 4096); else E(acc, cur, wr, wc, fr, fq); S.done(cur); }
        if (!has_next) break;
#pragma unroll
        for (int a = 0; a < 2; ++a)
#pragma unroll
            for (int b = 0; b < 2; ++b)
#pragma unroll
                for (int m = 0; m < 4; ++m)
#pragma unroll
                    for (int n = 0; n < 2; ++n) acc[a][b][m][n] = (f32x4){0.f, 0.f, 0.f, 0.f};
        cur = nxt; cA = nA; cB = nB; ++ui;
        if constexpr (ALIGN_EPI) { if (wr == 1) PG8_BAR; }
    }
    PG8_WAIT_V(0);
    if constexpr (!ALIGN_EPI) { if (wr == 0) PG8_BAR; }
    PG8_BAR;
    if constexpr (Epi::AFTER_DRAIN) { E.fused(acc, cur, wr, wc, fr, fq, lds, wid, lane); S.done(cur); }
#undef PG8_SA
#undef PG8_SB
#undef PG8_STAGE
#undef PG8_LDA
#undef PG8_LDB
#undef PG8_MMA
#undef PG8_WAIT_V
#undef PG8_WAIT_L
#undef PG8_BAR
#undef PG8_SCHED
}
}
namespace pg8 {
struct EpiRopeE {
    static constexpr bool PERM = true, AFTER_DRAIN = false, TABLE = false;
    bf16_t* O; int ldc; const float* rope;
    __device__ __forceinline__ void operator()(const f32x4 (&acc)[2][2][4][2], const Unit& u, int wr, int wc, int fr, int fq) const {
        const int row0 = u.pm * BM + wr * 64 + fr;
        if (u.pn == 2) {
            const int col0 = u.pn * BM + wc * 32 + 8 * fq;
#pragma unroll
            for (int ai = 0; ai < 2; ++ai)
#pragma unroll
                for (int m = 0; m < 4; ++m) { bf16_t* rowp = O + (size_t)(row0 + ai * HALF + m * 16) * ldc + col0;
#pragma unroll
                    for (int bj = 0; bj < 2; ++bj) { const f32x4 v0 = acc[ai][bj][m][0], v1 = acc[ai][bj][m][1]; u32x4 w;
                        w.x = cvt_pk_bf16(v0[0], v0[1]); w.y = cvt_pk_bf16(v0[2], v0[3]); w.z = cvt_pk_bf16(v1[0], v1[1]); w.w = cvt_pk_bf16(v1[2], v1[3]); *(u32x4*)(rowp + bj * HALF) = w; } }
        } else {
            const int kk = 4 * (wc & 1) + fq;
#pragma unroll
            for (int ai = 0; ai < 2; ++ai)
#pragma unroll
                for (int m = 0; m < 4; ++m) { const int row = row0 + ai * HALF + m * 16, pos = row & (cS - 1);
                    const f32x4 c0 = *(const f32x4*)(rope + (size_t)(pos * 32 + 4 * kk) * 2), c1 = *(const f32x4*)(rope + (size_t)(pos * 32 + 4 * kk) * 2 + 4);
#pragma unroll
                    for (int bj = 0; bj < 2; ++bj) { const f32x4 x1 = acc[ai][bj][m][0], x2 = acc[ai][bj][m][1];
                        bf16_t* op = O + (size_t)row * ldc + u.pn * BM + (2 * bj + (wc >> 1)) * 64 + 4 * kk;
                        typedef unsigned u32x2 __attribute__((ext_vector_type(2)));
                        u32x2 a, b;
                        a.x = cvt_pk_bf16(x1[0] * c0[0] - x2[0] * c0[1], x1[1] * c0[2] - x2[1] * c0[3]); a.y = cvt_pk_bf16(x1[2] * c1[0] - x2[2] * c1[1], x1[3] * c1[2] - x2[3] * c1[3]);
                        b.x = cvt_pk_bf16(x2[0] * c0[0] + x1[0] * c0[1], x2[1] * c0[2] + x1[1] * c0[3]); b.y = cvt_pk_bf16(x2[2] * c1[0] + x1[2] * c1[1], x2[3] * c1[2] + x1[3] * c1[3]);
                        *(u32x2*)op = a; *(u32x2*)(op + 32) = b; } }
        }
    }
};
struct EpiVT {
    static constexpr bool PERM = true, AFTER_DRAIN = false, TABLE = false;
    bf16_t* O;
    __device__ __forceinline__ void operator()(const f32x4 (&acc)[2][2][4][2], const Unit& u, int wr, int wc, int fr, int fq) const {
        const int row0 = u.pm * BM + wr * 64 + fr, col0 = u.pn * BM + wc * 32 + 8 * fq;
#pragma unroll
        for (int ai = 0; ai < 2; ++ai)
#pragma unroll
            for (int m = 0; m < 4; ++m) { const int dg = row0 + ai * HALF + m * 16;
#pragma unroll
                for (int bj = 0; bj < 2; ++bj) { const int col = col0 + bj * HALF, b = col / cS, tk = col & (cS - 1);
                    const f32x4 v0 = acc[ai][bj][m][0], v1 = acc[ai][bj][m][1]; u32x4 w;
                    w.x = cvt_pk_bf16(v0[0], v0[1]); w.y = cvt_pk_bf16(v0[2], v0[3]); w.z = cvt_pk_bf16(v1[0], v1[1]); w.w = cvt_pk_bf16(v1[2], v1[3]);
                    *(u32x4*)(O + vt_elem_off(16, b, dg, tk)) = w; } }
    }
};
__device__ __forceinline__ float ror1f(float x) { return __builtin_bit_cast(float, __builtin_amdgcn_mov_dpp(__builtin_bit_cast(int, x), 0x121, 0xF, 0xF, false)); }
__device__ __forceinline__ float ror2f(float x) { return __builtin_bit_cast(float, __builtin_amdgcn_mov_dpp(__builtin_bit_cast(int, x), 0x122, 0xF, 0xF, false)); }
__device__ __forceinline__ float gelu_fast(float x) { const float w = __builtin_fmaf(x * x, -2.3022081981f * 0.044715f, -2.3022081981f); return x * __builtin_amdgcn_rcpf(1.f + __builtin_amdgcn_exp2f(x * w)); }
struct EpiConvGelu {
    static constexpr bool PERM = true, AFTER_DRAIN = false, TABLE = true;
    bf16_t* ACT; const float* cw; const float* cb; float* SB;
    __device__ __forceinline__ void stage_table(const Unit& u, PG8_LAS unsigned char* tab, int tid) const {
        constexpr int LD2 = 2 * cDFF; const int v = tid >> 5, c4 = tid & 31, j = u.pn * 128 + 4 * c4;
        const float* src = ((v & 3) == 3 ? cb : cw + (v & 3) * LD2) + (v >> 2) * cDFF + j;
        *(PG8_LAS f32x4*)(tab + (v * 128 + 4 * c4) * 4) = *(const f32x4*)src; }
    __device__ __forceinline__ void run(const f32x4 (&acc)[2][2][4][2], const Unit& u, int wr, int wc, int fr, int fq, const PG8_LAS unsigned char* tab) const {
        constexpr int LD2 = 2 * cDFF;
        typedef unsigned u32x2 __attribute__((ext_vector_type(2)));
        u32x2 hold[2][4];
#pragma unroll
        for (int n = 0; n < 2; ++n) {
            const int ch0 = wc * 32 + 8 * fq + 4 * n, j0 = u.pn * 128 + ch0;
            const PG8_LAS f32x4* tv = (const PG8_LAS f32x4*)(tab + ch0 * 4);
            const f32x4 w0g = tv[0], w1g = tv[32], w2g = tv[64], bg = tv[96], w0v = tv[128], w1v = tv[160], w2v = tv[192], bv = tv[224];
#pragma unroll
            for (int ai = 0; ai < 2; ++ai) { const int rb = u.pm * BM + ai * HALF + wr * 64, blk = rb >> 6;
                f32x4 pg1, pg2, pv1, pv2;
#pragma unroll
                for (int m = 0; m < 4; ++m) { const f32x4 g = acc[ai][0][m][n], v = acc[ai][1][m][n]; const int row = rb + 16 * m + fr;
                    f32x4 g1, g2, v1, v2;
#pragma unroll
                    for (int e = 0; e < 4; ++e) { g1[e] = ror1f(g[e]); g2[e] = ror2f(g[e]); v1[e] = ror1f(v[e]); v2[e] = ror2f(v[e]); }
                    f32x4 a1g = g1, a2g = g2, a1v = v1, a2v = v2;
                    if (m > 0) { if (fr < 1) { a1g = pg1; a1v = pv1; } if (fr < 2) { a2g = pg2; a2v = pv2; } }
                    pg1 = g1; pg2 = g2; pv1 = v1; pv2 = v2;
                    if (m > 0 || fr >= 2) { float o[4];
#pragma unroll
                        for (int e = 0; e < 4; ++e) { const float cg = bg[e] + w0g[e] * a2g[e] + w1g[e] * a1g[e] + w2g[e] * g[e], cv = bv[e] + w0v[e] * a2v[e] + w1v[e] * a1v[e] + w2v[e] * v[e]; o[e] = gelu_fast(cg) * cv; }
                        u32x2 w; w.x = cvt_pk_bf16(o[0], o[1]); w.y = cvt_pk_bf16(o[2], o[3]);
                        if (n == 0) hold[ai][m] = w; else { u32x4 q; q.x = hold[ai][m].x; q.y = hold[ai][m].y; q.z = w.x; q.w = w.y; *(u32x4*)(ACT + (size_t)row * cDFF + j0 - 4) = q; } }
                    if (m == 0 && fr < 2) { float* sp = SB + ((size_t)blk * 4 + fr) * LD2; *(f32x4*)(sp + j0) = g; *(f32x4*)(sp + cDFF + j0) = v; }
                    if (m == 3 && fr >= 14) { float* sp = SB + ((size_t)blk * 4 + 2 + (fr - 14)) * LD2; *(f32x4*)(sp + j0) = g; *(f32x4*)(sp + cDFF + j0) = v; }
                } }
        }
    }
};
}
#define XB_TMO      128
#define XB_XCNT(j)  (256  + 64 * (j))
#define XB_XSUB(j)  (1280 + 64 * (j))
#define XB_XGEN(j)  (2304 + 64 * (j))
#define XB_TOP      3328
#define XB_TOPGEN   3392
#define XCD_BAR_WORDS 3456
#define XB_SPIN_CAP (1u << 18)

__device__ __forceinline__ unsigned xb_ld(unsigned* p)              { return __hip_atomic_load(p, __ATOMIC_RELAXED, __HIP_MEMORY_SCOPE_AGENT); }
__device__ __forceinline__ unsigned xb_add(unsigned* p, unsigned v) { return __hip_atomic_fetch_add(p, v, __ATOMIC_RELAXED, __HIP_MEMORY_SCOPE_AGENT); }
__device__ __forceinline__ unsigned xb_xcc_id() { return (unsigned)__builtin_amdgcn_s_getreg((3 << 11) | 20) & 0xFu; }
#define XB_SPIN(cond, bar) do { unsigned _sp = 0; while (cond) { __builtin_amdgcn_s_sleep(1); \
    if ((++_sp & 255u) == 0u) { if (xb_ld(&(bar)[XB_TMO])) break; if (_sp > XB_SPIN_CAP) { atomicAdd(&(bar)[XB_TMO], 1u); break; } } } } while (0)

struct XcdBarrier {
    unsigned* bar; unsigned x;
    volatile LAS unsigned* st;
};

__device__ __forceinline__ XcdBarrier xcd_barrier_post(unsigned* bar, volatile LAS unsigned* st) {
    XcdBarrier b; b.bar = bar; b.x = xb_xcc_id(); b.st = st;
    if (threadIdx.x == 0) (void)xb_add(&bar[XB_XCNT(b.x)], 1u);
    return b;
}
__device__ __forceinline__ void xcd_barrier_complete(unsigned* bar, unsigned x, unsigned& nloc, unsigned& nx) {
    const unsigned G = gridDim.x * gridDim.y * gridDim.z;
    unsigned sum, cnt, mine, sp = 0u;
    for (;;) {
        sum = 0u; cnt = 0u; mine = 0u;
#pragma unroll
        for (unsigned j = 0; j < 16; ++j) { const unsigned c = xb_ld(&bar[XB_XCNT(j)]); sum += c; cnt += (c > 0u) ? 1u : 0u; mine = (j == x) ? c : mine; }
        if (sum == G) break;
        __builtin_amdgcn_s_sleep(1);
        if ((++sp & 255u) == 0u) { if (xb_ld(&bar[XB_TMO])) break; if (sp > XB_SPIN_CAP) { atomicAdd(&bar[XB_TMO], 1u); break; } }
    }
    nloc = mine > 0u ? mine : 1u; nx = cnt > 0u ? cnt : 1u;
}

__device__ __forceinline__ void xcd_barrier(const XcdBarrier& b) {
    asm volatile("s_waitcnt vmcnt(0)" ::: "memory");
    __syncthreads();
    if (threadIdx.x == 0) {
        unsigned* bar = b.bar;
        __builtin_amdgcn_s_waitcnt(0);
        unsigned nloc = b.st[0], nx = b.st[1];
        if (nloc == 0u) { xcd_barrier_complete(bar, b.x, nloc, nx); b.st[0] = nloc; b.st[1] = nx; }
        const unsigned old = xb_add(&bar[XB_XSUB(b.x)], 1u);
        const unsigned gen = old / nloc;
        if (old + 1u == (gen + 1u) * nloc) {
            __builtin_amdgcn_fence(__ATOMIC_RELEASE, "agent");
            asm volatile("s_waitcnt vmcnt(0)" ::: "memory");
            const unsigned og = xb_add(&bar[XB_TOP], 1u);
            const unsigned tg = og / nx;
            if (og + 1u == (tg + 1u) * nx) xb_add(&bar[XB_TOPGEN], 1u);
            else XB_SPIN(xb_ld(&bar[XB_TOPGEN]) == tg, bar);
            __builtin_amdgcn_fence(__ATOMIC_ACQUIRE, "agent");
            xb_add(&bar[XB_XGEN(b.x)], 1u);
            asm volatile("s_waitcnt vmcnt(0)" ::: "memory");
        } else {
            XB_SPIN(xb_ld(&bar[XB_XGEN(b.x)]) == gen, bar);
            __builtin_amdgcn_fence(__ATOMIC_ACQUIRE, "agent");
            asm volatile("s_waitcnt vmcnt(0)" ::: "memory");
        }
    }
    __syncthreads();
}
constexpr int NWAVES = 8, NTHREADS = 512;
constexpr size_t MiB = 1u << 20;
constexpr size_t WS_CTL = 0, CTL_ZERO_BYTES = 65536;
constexpr size_t WS_WGT = 128 * 1024, WS_PEB = 256 * 1024;
constexpr size_t WS_WIN = 1 * MiB, WS_WV = 6 * MiB, WS_WOUT = 8 * MiB, WS_WUP = 10 * MiB, WS_WDN = 21 * MiB, WS_ROPE = 27 * MiB, WS_GATES = 29 * MiB, WS_KCMP = 32 * MiB,
                 WS_HID = 33 * MiB, WS_VCT = 41 * MiB, WS_W1T = 42 * MiB, WS_Y = 44 * MiB, WS_ATT = 44 * MiB  ,
                 WS_H16 = 108 * MiB  , WS_PROJ = 172 * MiB, WS_VT = 340 * MiB, WS_ACT = 172 * MiB  ,
                 WS_SB = 348 * MiB  , WS_Y2 = 406 * MiB,
                 WS_DOUT = 406 * MiB  , WS_DLSE = 454 * MiB, WS_VTP = 470 * MiB, WS_END = 504 * MiB;
static_assert((size_t)3 * cM * 256 * 2 <= WS_DLSE - WS_DOUT && WS_DLSE + (size_t)3 * cM * 4 * 4 <= WS_VTP && WS_VTP + (size_t)512 * VT_LD * 2 <= WS_END && (size_t)cM * PE_LD * 2 <= WS_VT - WS_PROJ && (size_t)1024 * VT_LD * 2 <= WS_Y2 - WS_VT
              && WS_ACT + (size_t)cM * cDFF * 2 <= WS_SB && WS_SB + (size_t)(cM / 64) * 4 * 2 * cDFF * 4 <= WS_Y2 && WS_H16 + (size_t)cM * cDM * 2 <= WS_PROJ, "workspace map");
constexpr int CW_BAR = 4096;
constexpr int RING_BYTES = 131072, LDSCTL_OFF = 8 * 17408  , MISC_OFF = LDSCTL_OFF + 320, LDS_BYTES = 147456;
typedef float f32x4 __attribute__((ext_vector_type(4)));

__device__ __forceinline__ int opaque(int x) { asm volatile("" : "+v"(x)); return x; }
__device__ __forceinline__ float wave_sum(float v) {
#pragma unroll
    for (int o = 1; o < 64; o <<= 1) v += __shfl_xor(v, o);
    return v;
}
__device__ __forceinline__ void n_row_dev(const float* xrow, const float* g, bf16* yrow, int lane) {
    float v[16]; float ss = 0.f;
#pragma unroll
    for (int j = 0; j < 2; ++j)
#pragma unroll
        for (int q = 0; q < 2; ++q) { const f32x4 t = *(const f32x4*)(xrow + 8 * lane + 512 * j + 4 * q);
            v[8 * j + 4 * q + 0] = t.x; v[8 * j + 4 * q + 1] = t.y; v[8 * j + 4 * q + 2] = t.z; v[8 * j + 4 * q + 3] = t.w; ss += t.x * t.x + t.y * t.y + t.z * t.z + t.w * t.w; }
    const float r = 1.f / sqrtf(wave_sum(ss) * (1.f / cDM) + 1e-6f);
#pragma unroll
    for (int j = 0; j < 2; ++j) { const float* gp = g + 8 * lane + 512 * j; U4 o;
        o.x = cvtpk(v[8 * j + 0] * r * gp[0], v[8 * j + 1] * r * gp[1]); o.y = cvtpk(v[8 * j + 2] * r * gp[2], v[8 * j + 3] * r * gp[3]);
        o.z = cvtpk(v[8 * j + 4] * r * gp[4], v[8 * j + 5] * r * gp[5]); o.w = cvtpk(v[8 * j + 6] * r * gp[6], v[8 * j + 7] * r * gp[7]);
        *(U4*)(yrow + 8 * lane + 512 * j) = o; }
}
template <bool HIN_F32, bool HOUT_F32>
__device__ __forceinline__ void nrn_row_dev(const void* hin_, const bf16* y2, const float* g1, const float* g2, void* hout_, bf16* yrow, int lane) {
    float v[16]; float ss = 0.f;
#pragma unroll
    for (int j = 0; j < 2; ++j) { const U4 t = *(const U4*)(y2 + 8 * lane + 512 * j);
        v[8 * j + 0] = bflo(t.x); v[8 * j + 1] = bfhi(t.x); v[8 * j + 2] = bflo(t.y); v[8 * j + 3] = bfhi(t.y); v[8 * j + 4] = bflo(t.z); v[8 * j + 5] = bfhi(t.z); v[8 * j + 6] = bflo(t.w); v[8 * j + 7] = bfhi(t.w); }
#pragma unroll
    for (int e = 0; e < 16; ++e) ss += v[e] * v[e];
    const float r = 1.f / sqrtf(wave_sum(ss) * (1.f / cDM) + 1e-6f);
    float s2 = 0.f;
#pragma unroll
    for (int j = 0; j < 2; ++j) { const int e0 = 8 * lane + 512 * j; float hv[8];
        if (HIN_F32) { const f32x4 a = *(const f32x4*)((const float*)hin_ + e0), b = *(const f32x4*)((const float*)hin_ + e0 + 4); hv[0] = a.x; hv[1] = a.y; hv[2] = a.z; hv[3] = a.w; hv[4] = b.x; hv[5] = b.y; hv[6] = b.z; hv[7] = b.w; }
        else { const U4 t = *(const U4*)((const bf16*)hin_ + e0); hv[0] = bflo(t.x); hv[1] = bfhi(t.x); hv[2] = bflo(t.y); hv[3] = bfhi(t.y); hv[4] = bflo(t.z); hv[5] = bfhi(t.z); hv[6] = bflo(t.w); hv[7] = bfhi(t.w); }
        const f32x4 ga = *(const f32x4*)(g1 + e0), gb = *(const f32x4*)(g1 + e0 + 4); const float gg[8] = {ga.x, ga.y, ga.z, ga.w, gb.x, gb.y, gb.z, gb.w};
#pragma unroll
        for (int e = 0; e < 8; ++e) { const float hn = hv[e] + v[8 * j + e] * r * gg[e]; v[8 * j + e] = hn; }
        if (HOUT_F32) { f32x4 a, b; a.x = v[8 * j]; a.y = v[8 * j + 1]; a.z = v[8 * j + 2]; a.w = v[8 * j + 3]; b.x = v[8 * j + 4]; b.y = v[8 * j + 5]; b.z = v[8 * j + 6]; b.w = v[8 * j + 7];
            *(f32x4*)((float*)hout_ + e0) = a; *(f32x4*)((float*)hout_ + e0 + 4) = b; }
        else { U4 o; o.x = cvtpk(v[8 * j], v[8 * j + 1]); o.y = cvtpk(v[8 * j + 2], v[8 * j + 3]);
            o.z = cvtpk(v[8 * j + 4], v[8 * j + 5]); o.w = cvtpk(v[8 * j + 6], v[8 * j + 7]);
            *(U4*)((bf16*)hout_ + e0) = o;
            v[8 * j + 0] = bflo(o.x); v[8 * j + 1] = bfhi(o.x); v[8 * j + 2] = bflo(o.y); v[8 * j + 3] = bfhi(o.y); v[8 * j + 4] = bflo(o.z); v[8 * j + 5] = bfhi(o.z); v[8 * j + 6] = bflo(o.w); v[8 * j + 7] = bfhi(o.w); }
#pragma unroll
        for (int e = 0; e < 8; ++e) s2 += v[8 * j + e] * v[8 * j + e]; }
    if (g2) { const float r2 = 1.f / sqrtf(wave_sum(s2) * (1.f / cDM) + 1e-6f);
#pragma unroll
        for (int j = 0; j < 2; ++j) { const float* gp = g2 + 8 * lane + 512 * j; U4 o;
            o.x = cvtpk(v[8 * j + 0] * r2 * gp[0], v[8 * j + 1] * r2 * gp[1]); o.y = cvtpk(v[8 * j + 2] * r2 * gp[2], v[8 * j + 3] * r2 * gp[3]);
            o.z = cvtpk(v[8 * j + 4] * r2 * gp[4], v[8 * j + 5] * r2 * gp[5]); o.w = cvtpk(v[8 * j + 6] * r2 * gp[6], v[8 * j + 7] * r2 * gp[7]);
            *(U4*)(yrow + 8 * lane + 512 * j) = o; } }
}

template <int K, int ldw, int N, int mode, int c0>
__device__ __forceinline__ void wprep_tile(const float* W, bf16* Bt, int tile, int lane, LAS float* scr) {
    constexpr int nblk = N / 32; const int kb = tile / nblk, nb = tile % nblk, k0 = 64 * kb, n0 = 32 * nb;
    const int c4 = 4 * (lane & 7), col = c0 + (mode ? wsrc_col(mode, n0 + c4) : n0 + c4);
#pragma unroll
    for (int i = 0; i < 8; ++i) { const int kk = 8 * i + (lane >> 3); const f32x4 t = *(const f32x4*)(W + (size_t)(k0 + kk) * ldw + col);
        scr[kk * 33 + c4] = t.x; scr[kk * 33 + c4 + 1] = t.y; scr[kk * 33 + c4 + 2] = t.z; scr[kk * 33 + c4 + 3] = t.w; }
    const int c = lane & 7;
#pragma unroll
    for (int j = 0; j < 4; ++j) { const int n = (lane >> 3) + 8 * j; const LAS float* s = scr + (8 * c) * 33 + n;
        U4 o; o.x = cvtpk(s[0], s[33]); o.y = cvtpk(s[2 * 33], s[3 * 33]);
        o.z = cvtpk(s[4 * 33], s[5 * 33]); o.w = cvtpk(s[6 * 33], s[7 * 33]);
        *(U4*)(Bt + (size_t)(n0 + n) * K + k0 + 8 * c) = o; }
    asm volatile("s_waitcnt lgkmcnt(0)" ::: "memory");
}
struct Args { const float* in[13]; float* out; unsigned char* ws; };

__global__ void __launch_bounds__(NTHREADS, 2) fwd(Args a) {
    extern __shared__ __attribute__((aligned(16))) unsigned char lds[];
    LAS unsigned char* L = (LAS unsigned char*)lds;
    const int tid = threadIdx.x, lane = tid & 63, wave = __builtin_amdgcn_readfirstlane(tid >> 6);
#define VCU() ((gridDim.x % 8 == 0) ? (int)((blockIdx.x % 8) * (gridDim.x / 8) + blockIdx.x / 8) : (int)blockIdx.x)
    for (int u = tid; u < (LDS_BYTES - LDSCTL_OFF) / 4; u += NTHREADS) ((LAS unsigned*)(L + LDSCTL_OFF))[u] = 0u;
    __syncthreads();
    XcdBarrier bar;
    { unsigned char* ws0 = a.ws; bar = xcd_barrier_post((unsigned*)(ws0 + WS_CTL) + CW_BAR, (volatile LAS unsigned*)(L + MISC_OFF) + 8); }
#define MKP() P p; unsigned char* wsb; { int z_ = 0; asm volatile("" : "+s"(z_)); unsigned char* ws = a.ws + z_; wsb = ws; const float* const* in_ = a.in + z_; \
    p.x = in_[0]; p.norm_g = in_[1]; p.even_w_in = in_[2]; p.even_w_out = in_[3]; p.cmp_pe = in_[4]; p.cmp_w1 = in_[5]; p.cmp_w2 = in_[6]; p.odd_w_in = in_[7]; p.odd_w_out = in_[8]; \
    p.ffn_w_up = in_[9]; p.ffn_conv_w = in_[10]; p.ffn_conv_b = in_[11]; p.ffn_w_down = in_[12]; p.out = (&a.out)[z_]; \
    p.Wt_in = (bf16*)(ws + WS_WIN); p.Wt_out = (bf16*)(ws + WS_WOUT); p.Wt_up = (bf16*)(ws + WS_WUP); p.Wt_dn = (bf16*)(ws + WS_WDN); \
    p.ROPE = (float*)(ws + WS_ROPE); p.GATES = (float*)(ws + WS_GATES); p.KCMP = (bf16*)(ws + WS_KCMP); \
    p.HID = (float*)(ws + WS_HID); p.Y = (bf16*)(ws + WS_Y); p.PROJ = (bf16*)(ws + WS_PROJ); p.ATT = (bf16*)(ws + WS_ATT); p.Y2 = (bf16*)(ws + WS_Y2); \
    p.ACT = (bf16*)(ws + WS_ACT); p.VT = (bf16*)(ws + WS_VT); p.VCT = (bf16*)(ws + WS_VCT); }

#define GRUN(N, call) do { const long _n = (long)(N); const long gthreads = (long)gridDim.x * NTHREADS; for (long i = (long)blockIdx.x * NTHREADS + opaque((int)threadIdx.x); i < _n; i += gthreads) { call; } } while (0)
#define GRID_BAR() xcd_barrier(bar)
#define GEMM_E(EpiT, Einit, Aptr, Btptr, Mrows, Ncols, Kdim) do { pg8::Gemm g{(const pg8::bf16_t*)(Aptr), (const pg8::bf16_t*)(Btptr), (int)(Mrows), (int)(Ncols), (int)(Kdim)}; \
        pg8::StaticOrder S; S.init((int)(Mrows), (int)(Ncols), (int)gridDim.x, (int)blockIdx.x); EpiT E Einit; \
        pg8::gemm_phase<EpiT, pg8::StaticOrder, true, true>(L, g, S, E); } while (0)
#define COMMA ,
#define GEMM(Aptr, Btptr, Mrows, Ncols, Kdim, Optr, ldo) GEMM_E(pg8::EpiBf16<0>, {(pg8::bf16_t*)(Optr) COMMA (int)(ldo) COMMA nullptr COMMA 0 COMMA 0 COMMA 1.f}, Aptr, Btptr, Mrows, Ncols, Kdim)
#define WT(Wp, K_, ldw_, N_, Btp, mode_, c0_) do { const int nt_ = ((N_) / 32) * ((K_) / 64); LAS float* scr_ = (LAS float*)(L + wave * 17408); \
        for (int t_ = blockIdx.x * NWAVES + wave; t_ < nt_; t_ += gridDim.x * NWAVES) wprep_tile<(K_), (ldw_), (N_), (mode_), (c0_)>((Wp), (Btp), t_, lane, scr_); } while (0)
#define WPREP(LL) do { const int _li = (LL) / 2; \
        if (((LL) & 1) == 0) { const float* W = p.even_w_in + (size_t)_li * cDM * EIN_W; \
            WT(W, cDM, EIN_W, LDE2, p.Wt_in, 1, 0); \
            WT(W, cDM, EIN_W, 1024, (bf16*)(wsb + WS_WV), 2, 0); \
            WT(p.even_w_out + (size_t)_li * 768 * cDM, 768, cDM, cDM, p.Wt_out, 0, 0); \
            WT(W, cDM, EIN_W, 32, (bf16*)(wsb + WS_WGT), 0, 1280); \
            WT(p.cmp_w1 + ((size_t)_li * 2 + 0) * 2048 * 256, 2048, 256, 256, (bf16*)(wsb + WS_W1T), 0, 0); \
            WT(p.cmp_w1 + ((size_t)_li * 2 + 1) * 2048 * 256, 2048, 256, 256, (bf16*)(wsb + WS_W1T) + (size_t)256 * 2048, 0, 0); \
            GRUN(512, peb_item(p.cmp_pe + (size_t)_li * 2 * 2048, p.cmp_w1 + (size_t)_li * 2 * 2048 * 256, (float*)(wsb + WS_PEB), i)); } \
        else { const float* W = p.odd_w_in + (size_t)_li * cDM * 3 * cDM; \
            WT(W, cDM, 3 * cDM, 2 * cDM, p.Wt_in, 0, 0); \
            WT(W, cDM, 3 * cDM, cDM, (bf16*)(wsb + WS_WV), 0, 2 * cDM); \
            WT(p.odd_w_out + (size_t)_li * cDM * cDM, cDM, cDM, cDM, p.Wt_out, 0, 0); } \
        WT(p.ffn_w_up + (size_t)(LL) * cDM * 2 * cDFF, cDM, 2 * cDFF, 2 * cDFF, p.Wt_up, 3, 0); \
        WT(p.ffn_w_down + (size_t)(LL) * cDFF * cDM, cDFF, cDM, cDM, p.Wt_dn, 0, 0); } while (0)
#define NRN(FIN, FOUT, hin_, hout_, g1_, g2_) do { for (long r = blockIdx.x * NWAVES + wave; r < cM; r += gridDim.x * NWAVES) nrn_row_dev<FIN, FOUT>((hin_) + r * cDM, p.Y2 + r * cDM, (g1_), (g2_), (hout_) + r * cDM, p.Y + r * cDM, lane); } while (0)
#define H16P ((bf16*)(wsb + WS_H16))
#define FFN(LL) do { \
        { MKP(); GEMM_E(pg8::EpiConvGelu, {(pg8::bf16_t*)p.ACT COMMA p.ffn_conv_w + (size_t)(LL) * 3 * 2 * cDFF COMMA p.ffn_conv_b + (size_t)(LL) * 2 * cDFF COMMA (float*)(wsb + WS_SB)}, p.Y, p.Wt_up, cM, 2 * cDFF, cDM); } GRID_BAR(); \
        { MKP(); GRUN((long)(cM / 64) * 2 * (cDFF / 4), convfix_item(p, (const float*)(wsb + WS_SB), p.ffn_conv_w + (size_t)(LL) * 3 * 2 * cDFF, p.ffn_conv_b + (size_t)(LL) * 2 * cDFF, i)); } GRID_BAR(); \
        { MKP(); GEMM(p.ACT, p.Wt_dn, cM, cDM, cDFF, p.Y2, cDM); } GRID_BAR(); \
        { MKP(); const float* ng = p.norm_g + (size_t)(LL) * 4 * cDM; if ((LL) + 1 < 4) NRN(false, false, H16P, H16P, ng + 3 * cDM, ng + 4 * cDM); else NRN(false, true, H16P, p.out, ng + 3 * cDM, (const float*)nullptr); \
          if ((LL) + 1 < 4) WPREP((LL) + 1); } GRID_BAR(); } while (0)
#define EVEN_LAYER(lp) do { const int LL = 2 * (lp); \
          { MKP(); GEMM_E(pg8::EpiRopeE, {(pg8::bf16_t*)p.PROJ COMMA PE_LD COMMA p.ROPE}, p.Y, p.Wt_in, cM, LDE2, cDM); } \
          { MKP(); GEMM_E(pg8::EpiVT, {(pg8::bf16_t*)p.VT}, (const bf16*)(wsb + WS_WV), p.Y, 1024, cM, cDM); } GRID_BAR();            \
          { MKP(); GRUN((long)512 * cB * (cS / 128), vtp_item(p.VT, (bf16*)(wsb + WS_VTP), i)); for (int u = blockIdx.x * NWAVES + wave; u < cM / 32; u += gridDim.x * NWAVES) gates_unit(p, (const bf16*)(wsb + WS_WGT), u, lane); \
            for (int u = blockIdx.x * NWAVES + wave; u < 2048; u += gridDim.x * NWAVES) cmp1_unit(p, (const bf16*)(wsb + WS_W1T), (const float*)(wsb + WS_PEB), u, lane); } GRID_BAR(); \
          { MKP(); GRUN((long)2 * cB * cNC * 2 * 32, cmp2_item(p, p.cmp_w2 + (size_t)(lp) * 2 * 256 * 64, i)); } GRID_BAR(); \
          { MKP(); const int ngw = gridDim.x * NWAVES; bf16* DO_ = (bf16*)(wsb + WS_DOUT); float* DL_ = (float*)(wsb + WS_DLSE); const bf16* VP_ = (const bf16*)(wsb + WS_VTP); \
              \
            for (int u = VCU() * NWAVES + wave; u < cB * 4 * 256; u += ngw) { const int bh = u >> 8, x = u & 255; \
                dil_unit<0>(p, p.VT, VP_, DO_, DL_, L + wave * 17408, bh >> 2, bh & 3, 0, x, lane); \
                dil_unit<1>(p, p.VT, VP_, DO_, DL_, L + wave * 17408, bh >> 2, bh & 3, x >> 6, x & 63, lane); \
                dil_unit<2>(p, p.VT, VP_, DO_, DL_, L + wave * 17408, bh >> 2, bh & 3, x >> 4, x & 15, lane); } } \
          { MKP(); const int ngw = gridDim.x * NWAVES, NT = cS / 8; LAS unsigned char* wl = L + wave * 17408; \
              \
            for (int u = VCU() * NWAVES + wave; u < cB * 2 * NT; u += ngw) { const int gw = u % ngw, k = u / ngw; int bg, tile; \
                if (ngw == 2048) { bg = gw >> 8; const int i = gw & 255; tile = 256 * k + ((k & 1) ? 255 - i : i); } else { bg = u / NT; tile = u % NT; } \
                nsa_unit(p, p.VCT, p.VT, wl, bg >> 1, bg & 1, tile * 8, lane); } } GRID_BAR(); \
          { MKP(); GRUN((long)cM * 32, dil_combine_item(p, (const bf16*)(wsb + WS_DOUT), (const float*)(wsb + WS_DLSE), i)); } GRID_BAR(); \
          { MKP(); GEMM(p.ATT, p.Wt_out, cM, cDM, 768, p.Y2, cDM); } GRID_BAR(); \
          { MKP(); const float* ng = p.norm_g + (size_t)LL * 4 * cDM; if ((lp) == 0) NRN(true, false, p.x, H16P, ng + cDM, ng + 2 * cDM); else NRN(false, false, H16P, H16P, ng + cDM, ng + 2 * cDM); } GRID_BAR(); \
          FFN(LL); } while (0)
#define ODD_LAYER(lp) do { const int LL = 2 * (lp) + 1; \
          { MKP(); GEMM(p.Y, p.Wt_in, cM, LDO2, cDM, p.PROJ, PO_LD); } \
          { MKP(); GEMM_E(pg8::EpiVT, {(pg8::bf16_t*)p.VT}, (const bf16*)(wsb + WS_WV), p.Y, 1024, cM, cDM); } GRID_BAR(); \
          { MKP(); const int NT = cS / 32; for (int u = VCU() * NWAVES + wave; u < cB * cNSB * NT; u += gridDim.x * NWAVES) { const int bh = u / NT; \
                sb_unit(p, p.VT, L + wave * 17408, bh / cNSB, bh % cNSB, (u % NT) * 32, lane); } } GRID_BAR(); \
          { MKP(); GEMM(p.ATT, p.Wt_out, cM, cDM, cDM, p.Y2, cDM); } GRID_BAR(); \
          { MKP(); const float* ng = p.norm_g + (size_t)LL * 4 * cDM; NRN(false, false, H16P, H16P, ng + cDM, ng + 2 * cDM); } GRID_BAR(); \
          FFN(LL); } while (0)

    { MKP();
      GRUN((long)cS * 32, rope_table_item(p, i));
      WPREP(0);
      for (long r = blockIdx.x * NWAVES + wave; r < cM; r += gridDim.x * NWAVES) n_row_dev(p.x + r * cDM, p.norm_g, p.Y + r * cDM, lane); }
    GRID_BAR();
    EVEN_LAYER(0); ODD_LAYER(0); EVEN_LAYER(1); ODD_LAYER(1);
}

extern "C" void kernel_launch(void* const* d_in, const int* in_sizes, int n_in, void* d_out, int out_size, void* d_ws, size_t ws_size, hipStream_t stream) {
    static int grid = 0;
    if (grid == 0) {
        if (n_in != 13 || out_size != cM * cDM || ws_size < WS_END) { fprintf(stderr, "kernel_launch: unexpected shapes (n_in %d out %d ws %zu)\n", n_in, out_size, ws_size); grid = -1; return; }
        int dev = 0, cus = 0;
        if (hipGetDevice(&dev) != hipSuccess || hipDeviceGetAttribute(&cus, hipDeviceAttributeMultiprocessorCount, dev) != hipSuccess) { grid = -1; return; }
        if (hipFuncSetAttribute((const void*)fwd, hipFuncAttributeMaxDynamicSharedMemorySize, LDS_BYTES) != hipSuccess) { grid = -1; return; }
        int per_cu = 0; (void)hipOccupancyMaxActiveBlocksPerMultiprocessor(&per_cu, (const void*)fwd, NTHREADS, LDS_BYTES); (void)hipGetLastError();
        grid = cus;
    }
    if (grid < 0) return;
    (void)hipMemsetAsync((char*)d_ws + WS_CTL, 0, CTL_ZERO_BYTES, stream);
    Args a{};
    for (int i = 0; i < 13; ++i) a.in[i] = (const float*)d_in[i];
    a.out = (float*)d_out; a.ws = (unsigned char*)d_ws;
    hipLaunchKernelGGL(fwd, dim3(grid), dim3(NTHREADS), LDS_BYTES, stream, a);
}
```

```cpp
#include <hip/hip_runtime.h>
#include <cstdio>
#include <cstdint>
#include <cmath>
#ifdef HOST_TEST
#include <cmath>
#include <cstring>
#include <cstdio>
#include <cstdlib>
#define HD
static int cB = 1, cS = 1024, cDM = 128, cDFF = 192;
#else
#define HD __device__ __forceinline__
constexpr int cB = 4, cS = 8192, cDM = 1024, cDFF = 2816;
#endif
typedef unsigned short bf16;
#define cM (cB * cS)
#define cNC ((cS - 32) / 16 + 1)
#define cNS (cS / 64)
#define cTOPN (cNS < 16 ? cNS : 16)
#define cNSB (cDM / 64)
#define LDE 3584
#define LDE2 2560
#define LDO2 2048
#define LDO (3 * cDM)
#define EIN_W 3608
#define KCMP_ROWS 512
#define PE_LD (LDE2 + 128)
#define PO_LD (LDO2 + 128)
#define VT_LD (cM + 128)
#define VCT_LD (KCMP_ROWS + 128)

struct alignas(16) U4 { unsigned x, y, z, w; };
HD float u2f(unsigned u) { float f; __builtin_memcpy(&f, &u, 4); return f; }
HD unsigned f2u(float f) { unsigned u; __builtin_memcpy(&u, &f, 4); return u; }
HD float bf2f(bf16 v) { return u2f((unsigned)v << 16); }
HD bf16 f2bf(float f) { unsigned u = f2u(f); return (bf16)((u + 0x7fffu + ((u >> 16) & 1u)) >> 16); }
HD unsigned pk2bf(float lo, float hi) {
#if defined(__HIP_DEVICE_COMPILE__)
    typedef float pk2f_t __attribute__((ext_vector_type(2))); typedef __bf16 pk2b_t __attribute__((ext_vector_type(2)));
    pk2f_t v = {lo, hi}; pk2b_t b = __builtin_convertvector(v, pk2b_t); return __builtin_bit_cast(unsigned, b);
#else
    return (unsigned)f2bf(lo) | ((unsigned)f2bf(hi) << 16);
#endif
}
HD float fast_exp2(float x) {
#if defined(__HIP_DEVICE_COMPILE__)
    return __builtin_amdgcn_exp2f(x);
#else
    return exp2f(x);
#endif
}
HD float fast_rcp(float x) {
#if defined(__HIP_DEVICE_COMPILE__)
    return __builtin_amdgcn_rcpf(x);
#else
    return 1.f / x;
#endif
}
HD float bflo(unsigned w) { return u2f(w << 16); }
HD float bfhi(unsigned w) { return u2f(w & 0xffff0000u); }

struct P {
    const float *x, *norm_g, *even_w_in, *even_w_out, *cmp_pe, *cmp_w1, *cmp_w2, *odd_w_in, *odd_w_out, *ffn_w_up, *ffn_conv_w, *ffn_conv_b, *ffn_w_down;
    float* out;
    bf16 *Wt_in, *Wt_out, *Wt_up, *Wt_dn;
    float* ROPE;
    float* GATES;
    bf16* KCMP;
    float* HID;
    bf16 *Y, *PROJ, *ATT, *Y2, *ACT;
    bf16* VT;
    bf16* VCT;
};

HD float gelu_tanh(float x) { return 0.5f * x * (1.f + tanhf(0.7978845608028654f * (x + 0.044715f * x * x * x))); }

HD void rope_table_item(const P& p, long idx) {
    const int pos = (int)(idx / 32), i = (int)(idx % 32);
    const double ang = (double)pos * pow(10000.0, -(double)i / 32.0);
    p.ROPE[idx * 2] = (float)cos(ang); p.ROPE[idx * 2 + 1] = (float)sin(ang);
}
HD void cmp2_item(const P& p, const float* w2, long idx) {
    const int i = (int)(idx % 32), g = (int)((idx / 32) % 2), n = (int)((idx / 64) % cNC), b = (int)((idx / (64L * cNC)) % cB), which = (int)(idx / (64L * cNC * cB));
    const float* hid = p.HID + ((((size_t)which * cB + b) * cNC + n) * 2 + g) * 256; const float* ww = w2 + (size_t)which * 256 * 64;
    float a1 = 0.f, a2 = 0.f;
    for (int j = 0; j < 256; ++j) { a1 += hid[j] * ww[j * 64 + i]; a2 += hid[j] * ww[j * 64 + i + 32]; }
    bf16* o = p.KCMP + (((size_t)b * KCMP_ROWS + n) * 2 + g) * 64;
    if (which == 0) { const int pos = 16 * n + 31; const float c = p.ROPE[(pos * 32 + i) * 2], s = p.ROPE[(pos * 32 + i) * 2 + 1];
        o[i] = f2bf(a1 * c - a2 * s); o[i + 32] = f2bf(a2 * c + a1 * s); }
    else { bf16* ot = p.VCT + ((size_t)(b * 2 + g) * 64 + i) * VCT_LD + n; ot[0] = f2bf(a1); ot[(size_t)32 * VCT_LD] = f2bf(a2);
        if (n == 0) { ot[511] = 0; ot[(size_t)32 * VCT_LD + 511] = 0; } }
    if (which == 0 && n == 0) { bf16* oz = p.KCMP + (((size_t)b * KCMP_ROWS + 511) * 2 + g) * 64; oz[i] = 0; oz[i + 32] = 0; }
}
HD void peb_item(const float* pe, const float* w1, float* PEB, long idx) {
    const int j = (int)(idx % 256), which = (int)(idx / 256);
    float acc = 0.f;
    for (int k = 0; k < 2048; ++k) acc += pe[(size_t)which * 2048 + k] * w1[((size_t)which * 2048 + k) * 256 + j];
    PEB[idx] = acc;
}
HD int wsrc_col(int mode, int n) {
    if (mode == 1) { const int u = n >> 8, c = n & 255, hiu = c >> 6, w = c & 63;
        if (u == 2) return 512 + c;
        const int d = (w & 7) < 4 ? 4 * (w >> 3) + (w & 7) : 32 + 4 * (w >> 3) + ((w & 7) - 4);
        int base;
        if (u < 2) base = 64 * (4 * u + hiu); else if (u == 3) base = hiu < 2 ? 768 + 64 * hiu : 1024 + 64 * (hiu - 2);
        else if (u < 7) base = 1304 + 64 * (4 * (u - 4) + hiu); else base = 1304 + 768 + 64 * (4 * (u - 7) + hiu);
        return base + d; }
    if (mode == 2) return n < 128 ? 896 + n : n < 256 ? 1152 + (n - 128) : 2840 + (n - 256);
    if (mode == 3) { const int pn = n >> 8, bj = (n >> 7) & 1, x = n & 127; return bj * cDFF + 128 * pn + x; }
    return n;
}
HD float gelu_fast_h(float x) { const float z = x + 0.044715f * x * x * x; return x * fast_rcp(1.f + fast_exp2(-2.3022081981f * z)); }
struct alignas(16) F4 { float v[4]; };
HD void convfix_item(const P& p, const float* SB, const float* cw, const float* cb, long idx) {
    constexpr int Q = cDFF / 4; const int j = 4 * (int)(idx % Q), rr = (int)((idx / Q) % 2); const long blk = idx / (2L * Q); const long row = blk * 64 + rr; const int t = (int)(row % cS), LD2 = 2 * cDFF;
    const float* s0 = SB + ((size_t)blk * 4 + rr) * LD2; const float* sp = SB + ((size_t)(blk - 1) * 4) * LD2;
    const float* sm = SB + ((size_t)blk * 4) * LD2;
#define LD4(ptr) (*(const F4*)(ptr))
    const F4 bg = LD4(cb + j), bv = LD4(cb + cDFF + j), w2g = LD4(cw + 2 * LD2 + j), w2v = LD4(cw + 2 * LD2 + cDFF + j), w1g = LD4(cw + LD2 + j), w1v = LD4(cw + LD2 + cDFF + j), w0g = LD4(cw + j), w0v = LD4(cw + cDFF + j);
    const F4 ug = LD4(s0 + j), uv = LD4(s0 + cDFF + j);
    F4 g1 = {{0.f, 0.f, 0.f, 0.f}}, v1 = g1, g2 = g1, v2 = g1;
    if (rr == 0) { if (t >= 1) { g1 = LD4(sp + 3 * LD2 + j); v1 = LD4(sp + 3 * LD2 + cDFF + j); g2 = LD4(sp + 2 * LD2 + j); v2 = LD4(sp + 2 * LD2 + cDFF + j); } }
    else { g1 = LD4(sm + j); v1 = LD4(sm + cDFF + j); if (t >= 2) { g2 = LD4(sp + 3 * LD2 + j); v2 = LD4(sp + 3 * LD2 + cDFF + j); } }
#undef LD4
    float o[4];
#pragma unroll
    for (int e = 0; e < 4; ++e) { const float cg = bg.v[e] + w2g.v[e] * ug.v[e] + w1g.v[e] * g1.v[e] + w0g.v[e] * g2.v[e], cv = bv.v[e] + w2v.v[e] * uv.v[e] + w1v.v[e] * v1.v[e] + w0v.v[e] * v2.v[e];
        o[e] = gelu_fast_h(cg) * cv; }
    uint2 w; w.x = pk2bf(o[0], o[1]); w.y = pk2bf(o[2], o[3]);
    *(uint2*)(p.ACT + (size_t)row * cDFF + j) = w;
}
HD size_t vt_tile_off(int ngrp, int b, int grp, int tile) { return (((size_t)b * ngrp + grp) * (cS / 32) + tile) * 2048; }
HD size_t vt_elem_off(int ngrp, int b, int dg, int tk) { return vt_tile_off(ngrp, b, dg >> 6, tk >> 5) + (size_t)(dg & 63) * 32 + (tk & 31); }
template <int dil> HD void vtp_run(const bf16* src, bf16* VTP, int b, int pr, int G) {
    unsigned in[64];
#pragma unroll
    for (int q = 0; q < 4; ++q)
#pragma unroll
        for (int c = 0; c < 4; ++c) { const U4 v = *(const U4*)(src + (size_t)q * 2048 + 8 * c); in[16 * q + 4 * c] = v.x; in[16 * q + 4 * c + 1] = v.y; in[16 * q + 4 * c + 2] = v.z; in[16 * q + 4 * c + 3] = v.w; }
    constexpr int per = cS / dil, nm = 128 / dil;
#pragma unroll
    for (int rc = 0; rc < dil; ++rc)
#pragma unroll
        for (int o8 = 0; o8 < nm / 8; ++o8) { unsigned w[4];
#pragma unroll
            for (int e = 0; e < 4; ++e) { const int t0_ = dil * (8 * o8 + 2 * e) + rc, t1_ = t0_ + dil;
                const unsigned lo = (t0_ & 1) ? (in[t0_ >> 1] >> 16) : (in[t0_ >> 1] & 0xFFFFu), hi = (t1_ & 1) ? (in[t1_ >> 1] & 0xFFFF0000u) : (in[t1_ >> 1] << 16);
                w[e] = lo | hi; }
            U4 v; v.x = w[0]; v.y = w[1]; v.z = w[2]; v.w = w[3];
            *(U4*)(VTP + vt_elem_off(8, b, pr, rc * per + nm * G + 8 * o8)) = v; }
}
HD void vtp_item(const bf16* VT, bf16* VTP, long idx) {
    const int ng = cS / 128; const int G = (int)(idx % ng), b = (int)((idx / ng) % cB), pr = (int)(idx / ((long)ng * cB));
    const bf16* src = VT + vt_elem_off(16, b, 512 + pr, 128 * G);
    if (pr < 256) vtp_run<4>(src, VTP, b, pr, G); else vtp_run<16>(src, VTP, b, pr, G);
}
HD void dil_combine_item(const P& p, const bf16* DOUT, const float* DLSE, long idx) {
    const int c8 = (int)(idx % 8), hd = (int)((idx / 8) % 4); const long row = idx / 32;
    const float l0 = DLSE[((size_t)0 * cM + row) * 4 + hd], l1 = DLSE[((size_t)1 * cM + row) * 4 + hd], l2 = DLSE[((size_t)2 * cM + row) * 4 + hd];
    const float mx = fmaxf(l0, fmaxf(l1, l2)), e0 = fast_exp2(l0 - mx), e1 = fast_exp2(l1 - mx), e2 = fast_exp2(l2 - mx), rs = fast_rcp(e0 + e1 + e2);
    const U4 a = *(const U4*)(DOUT + ((size_t)0 * cM + row) * 256 + hd * 64 + 8 * c8), bq = *(const U4*)(DOUT + ((size_t)1 * cM + row) * 256 + hd * 64 + 8 * c8), cq = *(const U4*)(DOUT + ((size_t)2 * cM + row) * 256 + hd * 64 + 8 * c8);
    const float w0 = e0 * rs, w1 = e1 * rs, w2 = e2 * rs;
    U4 o;
    o.x = pk2bf(w0 * bflo(a.x) + w1 * bflo(bq.x) + w2 * bflo(cq.x), w0 * bfhi(a.x) + w1 * bfhi(bq.x) + w2 * bfhi(cq.x));
    o.y = pk2bf(w0 * bflo(a.y) + w1 * bflo(bq.y) + w2 * bflo(cq.y), w0 * bfhi(a.y) + w1 * bfhi(bq.y) + w2 * bfhi(cq.y));
    o.z = pk2bf(w0 * bflo(a.z) + w1 * bflo(bq.z) + w2 * bflo(cq.z), w0 * bfhi(a.z) + w1 * bfhi(bq.z) + w2 * bfhi(cq.z));
    o.w = pk2bf(w0 * bflo(a.w) + w1 * bflo(bq.w) + w2 * bflo(cq.w), w0 * bfhi(a.w) + w1 * bfhi(bq.w) + w2 * bfhi(cq.w));
    *(U4*)(p.ATT + (size_t)row * 768 + 512 + hd * 64 + 8 * c8) = o;
}
#define LAS __attribute__((address_space(3)))
typedef short bf16x8v __attribute__((ext_vector_type(8)));
typedef short bf16x4v __attribute__((ext_vector_type(4)));
typedef float f32x16 __attribute__((ext_vector_type(16)));
typedef float f32x2_t __attribute__((ext_vector_type(2)));
typedef float f32x4v __attribute__((ext_vector_type(4)));
typedef __bf16 bf16x2_t __attribute__((ext_vector_type(2)));
__device__ __forceinline__ unsigned cvtpk(float lo, float hi) { f32x2_t v = {lo, hi}; bf16x2_t b = __builtin_convertvector(v, bf16x2_t); return __builtin_bit_cast(unsigned, b); }
__device__ __forceinline__ float fexp2(float x) { return __builtin_amdgcn_exp2f(x); }
#define ATT_C2 (0.125f * 1.4426950408889634f)
#define ATT_NEG (-1e30f)
#define ATT_THR 8.0f

typedef unsigned u32x2v __attribute__((ext_vector_type(2)));
__device__ __forceinline__ float vmax2(float a, float b) { float d; asm("v_max_f32 %0, %1, %2" : "=v"(d) : "v"(a), "v"(b)); return d; }
__device__ __forceinline__ float vmax3(float a, float b, float c) { float d; asm("v_max3_f32 %0, %1, %2, %3" : "=v"(d) : "v"(a), "v"(b), "v"(c)); return d; }
__device__ __forceinline__ float vmax16(const f32x16& s) {
    const float a = vmax3(s[0], s[1], s[2]), b = vmax3(s[3], s[4], s[5]), c = vmax3(s[6], s[7], s[8]), d = vmax3(s[9], s[10], s[11]), e = vmax3(s[12], s[13], s[14]);
    return vmax2(vmax3(vmax3(a, b, c), d, e), s[15]); }
__device__ __forceinline__ float vmax16_acc(const f32x16& s) { float d;
    asm("s_nop 11\n\tv_max3_f32 %0, %1, %2, %3\n\tv_max3_f32 %0, %0, %4, %5\n\tv_max3_f32 %0, %0, %6, %7\n\tv_max3_f32 %0, %0, %8, %9\n\t"
        "v_max3_f32 %0, %0, %10, %11\n\tv_max3_f32 %0, %0, %12, %13\n\tv_max3_f32 %0, %0, %14, %15\n\tv_max_f32 %0, %0, %16"
        : "=&v"(d) : "v"(s[0]), "v"(s[1]), "v"(s[2]), "v"(s[3]), "v"(s[4]), "v"(s[5]), "v"(s[6]), "v"(s[7]), "v"(s[8]), "v"(s[9]), "v"(s[10]), "v"(s[11]), "v"(s[12]), "v"(s[13]), "v"(s[14]), "v"(s[15]));
    return d; }
#define OPQ(x) asm("" : "+v"(x))
__device__ __forceinline__ float vsum16(const f32x16& s) {
    float a0 = s[0] + s[1], a1 = s[2] + s[3], a2 = s[4] + s[5], a3 = s[6] + s[7], a4 = s[8] + s[9], a5 = s[10] + s[11], a6 = s[12] + s[13], a7 = s[14] + s[15];
    OPQ(a0); OPQ(a1); OPQ(a2); OPQ(a3); OPQ(a4); OPQ(a5); OPQ(a6); OPQ(a7);
    float b0 = a0 + a1, b1 = a2 + a3, b2 = a4 + a5, b3 = a6 + a7; OPQ(b0); OPQ(b1); OPQ(b2); OPQ(b3);
    float c0 = b0 + b1, c1 = b2 + b3; OPQ(c0); OPQ(c1);
    return c0 + c1; }
__device__ __forceinline__ float xmax32(float x) { float y; asm volatile("v_mov_b32 %0, %1\n\ts_nop 1" : "=v"(y) : "v"(x));
    auto r = __builtin_amdgcn_permlane32_swap(__builtin_bit_cast(unsigned, x), __builtin_bit_cast(unsigned, y), false, false); const unsigned a = r[0], b = r[1];
    return vmax2(__builtin_bit_cast(float, a), __builtin_bit_cast(float, b)); }
__device__ __forceinline__ float xsum32(float x) { float y; asm volatile("v_mov_b32 %0, %1\n\ts_nop 1" : "=v"(y) : "v"(x));
    auto r = __builtin_amdgcn_permlane32_swap(__builtin_bit_cast(unsigned, x), __builtin_bit_cast(unsigned, y), false, false); const unsigned a = r[0], b = r[1];
    return __builtin_bit_cast(float, a) + __builtin_bit_cast(float, b); }
__device__ __forceinline__ void store_row64(bf16* rowp, int hh, const float (&o)[32], float sc) {
#pragma unroll
    for (int dt = 0; dt < 2; ++dt)
#pragma unroll
        for (int kp = 0; kp < 2; ++kp) { const float* q = o + 16 * dt + 8 * kp;
            const unsigned a0 = cvtpk(q[0] * sc, q[1] * sc), a1 = cvtpk(q[2] * sc, q[3] * sc), b0 = cvtpk(q[4] * sc, q[5] * sc), b1 = cvtpk(q[6] * sc, q[7] * sc);
            auto r0 = __builtin_amdgcn_permlane32_swap(a0, b0, false, false); auto r1 = __builtin_amdgcn_permlane32_swap(a1, b1, false, false);
            U4 w; w.x = r0[0]; w.y = r1[0]; w.z = r0[1]; w.w = r1[1];
            *(U4*)(rowp + 32 * dt + 16 * kp + 8 * hh) = w; }
}
__device__ __forceinline__ f32x16 zero16() { f32x16 z;
#pragma unroll
    for (int i = 0; i < 16; ++i) z[i] = 0.f;
    return z; }
__device__ __forceinline__ f32x16 qk32(const bf16* kp, const bf16x8v (&qf)[4]) {
    f32x16 acc = zero16();
#pragma unroll
    for (int ks = 0; ks < 4; ++ks) { const bf16x8v kf = *(const bf16x8v*)(kp + 16 * ks); acc = __builtin_amdgcn_mfma_f32_32x32x16_bf16(kf, qf[ks], acc, 0, 0, 0); }
    return acc;
}
__device__ __forceinline__ void pv32(f32x16& o0, f32x16& o1, const bf16* vt, size_t dstep, const unsigned (&pb)[8]) {
#pragma unroll
    for (int s = 0; s < 2; ++s) {
        const bf16x4v a00 = *(const bf16x4v*)(vt + 16 * s), a01 = *(const bf16x4v*)(vt + 16 * s + 8);
        const bf16x4v a10 = *(const bf16x4v*)(vt + dstep + 16 * s), a11 = *(const bf16x4v*)(vt + dstep + 16 * s + 8);
        bf16x8v A0, A1, B;
        A0 = __builtin_shufflevector(a00, a01, 0, 1, 2, 3, 4, 5, 6, 7); A1 = __builtin_shufflevector(a10, a11, 0, 1, 2, 3, 4, 5, 6, 7);
        typedef unsigned u32x4v __attribute__((ext_vector_type(4)));
        u32x4v bw = {pb[4 * s + 0], pb[4 * s + 1], pb[4 * s + 2], pb[4 * s + 3]};
        B = __builtin_bit_cast(bf16x8v, bw);
        o0 = __builtin_amdgcn_mfma_f32_32x32x16_bf16(A0, B, o0, 0, 0, 0);
        o1 = __builtin_amdgcn_mfma_f32_32x32x16_bf16(A1, B, o1, 0, 0, 0);
    }
}
struct KF { bf16x8v k[4]; };
struct VF { bf16x4v v[8]; };
__device__ __forceinline__ void load_k(KF& f, const bf16* kp) {
#pragma unroll
    for (int ks = 0; ks < 4; ++ks) f.k[ks] = *(const bf16x8v*)(kp + 16 * ks); }
__device__ __forceinline__ void load_v(VF& f, const bf16* vt, size_t dstep) {
#pragma unroll
    for (int s = 0; s < 2; ++s) { f.v[2 * s] = *(const bf16x4v*)(vt + 16 * s); f.v[2 * s + 1] = *(const bf16x4v*)(vt + 16 * s + 8);
        f.v[4 + 2 * s] = *(const bf16x4v*)(vt + dstep + 16 * s); f.v[4 + 2 * s + 1] = *(const bf16x4v*)(vt + dstep + 16 * s + 8); } }
__device__ __forceinline__ f32x16 qk32r(const KF& f, const bf16x8v (&qf)[4]) {
    f32x16 acc = zero16();
#pragma unroll
    for (int ks = 0; ks < 4; ++ks) acc = __builtin_amdgcn_mfma_f32_32x32x16_bf16(f.k[ks], qf[ks], acc, 0, 0, 0);
    return acc; }
__device__ __forceinline__ void pv32r(f32x16& o0, f32x16& o1, const VF& f, const unsigned (&pb)[8]) {
    typedef unsigned u32x4v __attribute__((ext_vector_type(4)));
#pragma unroll
    for (int s = 0; s < 2; ++s) {
        const bf16x8v A0 = __builtin_shufflevector(f.v[2 * s], f.v[2 * s + 1], 0, 1, 2, 3, 4, 5, 6, 7), A1 = __builtin_shufflevector(f.v[4 + 2 * s], f.v[4 + 2 * s + 1], 0, 1, 2, 3, 4, 5, 6, 7);
        const u32x4v bw = {pb[4 * s + 0], pb[4 * s + 1], pb[4 * s + 2], pb[4 * s + 3]}; const bf16x8v B = __builtin_bit_cast(bf16x8v, bw);
        o0 = __builtin_amdgcn_mfma_f32_32x32x16_bf16(A0, B, o0, 0, 0, 0); o1 = __builtin_amdgcn_mfma_f32_32x32x16_bf16(A1, B, o1, 0, 0, 0); } }
__device__ __forceinline__ unsigned long long wave_or64(unsigned long long x) {
    unsigned lo = (unsigned)x, hi = (unsigned)(x >> 32);
#pragma unroll
    for (int o = 1; o < 64; o <<= 1) { lo |= (unsigned)__shfl_xor((int)lo, o); hi |= (unsigned)__shfl_xor((int)hi, o); }
    return ((unsigned long long)(unsigned)__builtin_amdgcn_readfirstlane((int)hi) << 32) | (unsigned)__builtin_amdgcn_readfirstlane((int)lo); }
struct LaneAddr { unsigned ck, cv; unsigned rk[4], rv[4], rw[4]; };
__device__ __forceinline__ LaneAddr lane_addr(LAS unsigned char* slot, int lane) {
    LaneAddr a; const int r = lane & 31, hh = lane >> 5; const unsigned sb = (unsigned)(size_t)slot;
    a.ck = (unsigned)lane; a.cv = (unsigned)lane;
#pragma unroll
    for (int ks = 0; ks < 4; ++ks) a.rk[ks] = sb + r * 128 + (((2 * ks + hh) ^ (r & 7)) * 16);
#pragma unroll
    for (int c = 0; c < 4; ++c) { a.rv[c] = sb + 4096 + r * 64 + ((c ^ ((r >> 2) & 3)) * 16) + 8 * hh; unsigned w = a.rv[c] + 2048; asm volatile("" : "+v"(w)); a.rw[c] = w; }
    return a; }
__device__ __forceinline__ unsigned kvoff(int lane, size_t pitch) { const int row = lane >> 3, ch = (lane & 7) ^ (row & 7); return (unsigned)((row * pitch + ch * 8) * 2); }
__device__ __forceinline__ unsigned vvoff(int lane, size_t pitch) { const int row = lane >> 2, ch = (lane & 3) ^ ((row >> 2) & 3); return (unsigned)((row * pitch + ch * 8) * 2); }
typedef __amdgpu_buffer_rsrc_t rsrc_t;
__device__ __forceinline__ rsrc_t mkrsrc(const void* base) { return __builtin_amdgcn_make_buffer_rsrc((void*)base, 0, 0x7FFFFFF0, 0x00020000); }
__device__ __forceinline__ void dma_k(LAS unsigned char* slot, rsrc_t rs, unsigned tile_off, unsigned pitchB, unsigned voff) {
#pragma unroll
    for (int q = 0; q < 4; ++q) __builtin_amdgcn_raw_ptr_buffer_load_lds(rs, (LAS unsigned*)(slot + q * 1024), 16, voff, tile_off + q * 8 * pitchB, 0, 0); }
__device__ __forceinline__ void dma_v(LAS unsigned char* slot, rsrc_t rs, unsigned tile_off, unsigned pitchB, unsigned voff) {
#pragma unroll
    for (int q = 0; q < 4; ++q) __builtin_amdgcn_raw_ptr_buffer_load_lds(rs, (LAS unsigned*)(slot + 4096 + q * 1024), 16, voff, tile_off + q * 16 * pitchB, 0, 0); }
__device__ __forceinline__ void read_k(KF& f, const LaneAddr& a) {
#pragma unroll
    for (int ks = 0; ks < 4; ++ks) f.k[ks] = *(const LAS bf16x8v*)(size_t)a.rk[ks]; }
__device__ __forceinline__ void read_v(VF& f, const LaneAddr& a) {
#pragma unroll
    for (int dt = 0; dt < 2; ++dt)
#pragma unroll
        for (int s = 0; s < 2; ++s) { f.v[4 * dt + 2 * s] = *(const LAS bf16x4v*)(size_t)(dt ? a.rw[2 * s] : a.rv[2 * s]); f.v[4 * dt + 2 * s + 1] = *(const LAS bf16x4v*)(size_t)(dt ? a.rw[2 * s + 1] : a.rv[2 * s + 1]); } }
#define DMA_WAIT() asm volatile("s_waitcnt vmcnt(0)" ::: "memory")
#define LDS_DRAIN() asm volatile("s_waitcnt lgkmcnt(0)" ::: "memory")
#define LDS_DRAIN_PINNED() do { __builtin_amdgcn_sched_barrier(0); asm volatile("s_waitcnt lgkmcnt(0)" ::: "memory"); } while (0)
#define ATT_BIG 1.152921504606847e18f
__device__ __forceinline__ void sm_fast(f32x16& s, const KF& kc, const bf16x8v (&qf)[4], bool lane_on, float& m, float& l, f32x16& o0, f32x16& o1, unsigned (&pb)[8]) {
    float nb = lane_on ? -m : -INFINITY;
#pragma unroll
    for (int reg = 0; reg < 16; ++reg) s[reg] = fexp2(__builtin_fmaf(s[reg], ATT_C2, nb));
    float rs = vsum16(s);
    if (__any(!(rs < ATT_BIG))) {
        s = qk32r(kc, qf);
        float mx = vmax16_acc(s);
        mx = xmax32(lane_on ? mx * ATT_C2 : ATT_NEG);
        const float mn = (mx > m + ATT_THR) ? mx : m, alpha = fexp2(m - mn); m = mn; l *= alpha;
#pragma unroll
        for (int reg = 0; reg < 16; ++reg) { o0[reg] *= alpha; o1[reg] *= alpha; }
        nb = lane_on ? -m : -INFINITY;
#pragma unroll
        for (int reg = 0; reg < 16; ++reg) s[reg] = fexp2(__builtin_fmaf(s[reg], ATT_C2, nb));
        rs = vsum16(s); }
    l += rs;
#pragma unroll
    for (int i = 0; i < 8; ++i) pb[i] = cvtpk(s[2 * i], s[2 * i + 1]);
}
__device__ __forceinline__ void sm_step(f32x16& s, const KF& kc, const bf16x8v (&qf)[4], int lo, int hi, int hh, float& m, float& l, f32x16& o0, f32x16& o1, unsigned (&pb)[8]) {
    const float nb = -m;
#pragma unroll
    for (int reg = 0; reg < 16; ++reg) { const int ko = (reg & 3) + 8 * (reg >> 2) + 4 * hh; const bool v = (ko >= lo) && (ko <= hi);
        const float e = fexp2(__builtin_fmaf(s[reg], ATT_C2, nb)); s[reg] = v ? e : 0.f; }
    float rs = vsum16(s);
    if (__any(!(rs < ATT_BIG))) {
        s = qk32r(kc, qf);
#pragma unroll
        for (int reg = 0; reg < 16; ++reg) { const int ko = (reg & 3) + 8 * (reg >> 2) + 4 * hh; const bool v = (ko >= lo) && (ko <= hi);
            s[reg] = v ? s[reg] * ATT_C2 : ATT_NEG; }
        const float mx = xmax32(vmax16(s));
        const float mn = (mx > m + ATT_THR) ? mx : m, alpha = fexp2(m - mn); m = mn; l *= alpha;
#pragma unroll
        for (int reg = 0; reg < 16; ++reg) { o0[reg] *= alpha; o1[reg] *= alpha; }
#pragma unroll
        for (int reg = 0; reg < 16; ++reg) s[reg] = (s[reg] > -1e29f) ? fexp2(s[reg] - m) : 0.f;
        rs = vsum16(s); }
    l += rs;
#pragma unroll
    for (int i = 0; i < 8; ++i) pb[i] = cvtpk(s[2 * i], s[2 * i + 1]);
}

__device__ __forceinline__ float dpp_xor1(float x) { return __builtin_bit_cast(float, __builtin_amdgcn_update_dpp(0, __builtin_bit_cast(int, x), 0xB1, 0xF, 0xF, true)); }
__device__ __forceinline__ float dpp_xor2(float x) { return __builtin_bit_cast(float, __builtin_amdgcn_update_dpp(0, __builtin_bit_cast(int, x), 0x4E, 0xF, 0xF, true)); }
#define IMP_LD 132
__device__ __forceinline__ void nsa_unit(const P& p, const bf16* VCT, const bf16* VT, LAS unsigned char* wl, int b, int g, int t0, int lane) {
    const LaneAddr la = lane_addr(wl, lane);
    LAS float* imp = (LAS float*)(wl + 8192);
    const int r = lane & 31, hh = lane >> 5, tl = r >> 2, hg = r & 3, head = g * 4 + hg, t = t0 + tl;
    const long row = (long)b * cS + t;
    bf16x8v qf[4];
    { const bf16* qp = p.PROJ + (size_t)row * PE_LD + head * 64 + 8 * hh;
#pragma unroll
      for (int ks = 0; ks < 4; ++ks) qf[ks] = *(const bf16x8v*)(qp + 16 * ks); }
    float outacc[32];
    unsigned pb[8];
    unsigned long long m0 = 0ull, m1 = 0ull;
    {
        for (int i = lane; i < 8 * IMP_LD; i += 64) imp[i] = 0.f;
        const int nv = t >= 31 ? (t - 31) / 16 + 1 : 0, nvmax = (t0 + 7) >= 31 ? (t0 + 7 - 31) / 16 + 1 : 0, ntile = (nvmax + 31) >> 5;
        float m = ATT_NEG, l = 0.f;
        const bf16* kc0 = p.KCMP + ((size_t)b * KCMP_ROWS * 2 + g) * 64;
        const bf16* vc0 = VCT + (size_t)(b * 2 + g) * 64 * VCT_LD;
        const rsrc_t rsK = mkrsrc(kc0), rsV = mkrsrc(vc0); const unsigned kvo = kvoff(lane, 128), vvo = vvoff(lane, VCT_LD);
        KF kc; VF vc;
        if (ntile > 0) { dma_k(wl, rsK, 0u, 128 * 2, kvo); DMA_WAIT(); read_k(kc, la); }
        for (int kt = 0; kt < ntile; ++kt) { const int key0 = 32 * kt;
            LDS_DRAIN();
            if (kt + 1 < ntile) dma_k(wl, rsK, (unsigned)(key0 + 32) * (128 * 2), 128 * 2, kvo);
            f32x16 s = qk32r(kc, qf);
            float mx = ATT_NEG;
#pragma unroll
            for (int reg = 0; reg < 16; ++reg) { const int ko = (reg & 3) + 8 * (reg >> 2) + 4 * hh; const float x = (key0 + ko < nv) ? s[reg] * ATT_C2 : ATT_NEG; s[reg] = x; mx = fmaxf(mx, x); }
            mx = xmax32(mx);
            const float mn = fmaxf(m, mx); float rs = 0.f;
#pragma unroll
            for (int reg = 0; reg < 16; ++reg) rs += (s[reg] > -1e29f) ? fexp2(s[reg] - mn) : 0.f;
            rs = xsum32(rs);
            l = l * fexp2(m - mn) + rs; m = mn;
            if (kt + 1 < ntile) { DMA_WAIT(); read_k(kc, la); } }
        const float rl = l > 0.f ? 1.f / l : 0.f;
        f32x16 o0 = zero16(), o1 = zero16();
        if (ntile > 0) { dma_k(wl, rsK, 0u, 128 * 2, kvo); dma_v(wl, rsV, 0u, VCT_LD * 2, vvo); DMA_WAIT(); read_k(kc, la); }
        for (int kt = 0; kt < ntile; ++kt) { const int key0 = 32 * kt;
            LDS_DRAIN(); if (kt + 1 < ntile) dma_k(wl, rsK, (unsigned)(key0 + 32) * (128 * 2), 128 * 2, kvo);
            read_v(vc, la);
            f32x16 s = qk32r(kc, qf);
            LDS_DRAIN_PINNED(); if (kt + 1 < ntile) dma_v(wl, rsV, (unsigned)(key0 + 32) * 2, VCT_LD * 2, vvo);
#pragma unroll
            for (int reg = 0; reg < 16; ++reg) { const int ko = (reg & 3) + 8 * (reg >> 2) + 4 * hh; s[reg] = (key0 + ko < nv) ? fexp2(s[reg] * ATT_C2 - m) * rl : 0.f; }
#pragma unroll
            for (int i = 0; i < 8; ++i) pb[i] = cvtpk(s[2 * i], s[2 * i + 1]);
            pv32r(o0, o1, vc, pb);
#pragma unroll
            for (int k = 0; k < 4; ++k) { float a = s[4 * k] + s[4 * k + 1] + s[4 * k + 2] + 0.5f * s[4 * k + 3], c = 0.5f * s[4 * k + 3];
                a += dpp_xor1(a); a += dpp_xor2(a); c += dpp_xor1(c); c += dpp_xor2(c);
                if (hg == 0) { const int j = (key0 >> 2) + 2 * k + hh; (void)__hip_atomic_fetch_add(imp + tl * IMP_LD + j, a, __ATOMIC_RELAXED, __HIP_MEMORY_SCOPE_WORKGROUP); (void)__hip_atomic_fetch_add(imp + tl * IMP_LD + j + 1, c, __ATOMIC_RELAXED, __HIP_MEMORY_SCOPE_WORKGROUP); } }
            if (kt + 1 < ntile) { DMA_WAIT(); read_k(kc, la); } }
        const float g0 = p.GATES[row * 24 + head * 3 + 0];
#pragma unroll
        for (int reg = 0; reg < 16; ++reg) { outacc[reg] = o0[reg] * g0; outacc[16 + reg] = o1[reg] * g0; }
    }
    for (int tk = 0; tk < 8; ++tk) { const int tt = t0 + tk, cur = tt >> 6; LAS float* row = imp + tk * IMP_LD;
        float v0 = (64 * lane > tt) ? -1.f : row[lane], v1 = (64 * (lane + 64) > tt) ? -1.f : row[lane + 64];
        if (lane == 0 || lane == cur || lane == cur - 1) v0 += 1e4f;
        if (lane + 64 == cur || lane + 64 == cur - 1) v1 += 1e4f;
        row[lane] = v0; row[lane + 64] = v1;
        int r0 = 0, r1 = 0;
        const int nq4 = min(32, ((cur >> 2) + 4) & ~3);
#pragma unroll 4
        for (int q4 = 0; q4 < nq4; ++q4) { const f32x4v w = *(const LAS f32x4v*)(row + 4 * q4);
#pragma unroll
            for (int e = 0; e < 4; ++e) { const int jj = 4 * q4 + e; const float x = w[e];
                r0 += (x > v0 || (x == v0 && jj < lane)) ? 1 : 0; r1 += (x > v1 || (x == v1 && jj < lane + 64)) ? 1 : 0; } }
        const unsigned long long s0 = __ballot(r0 < 16), s1 = __ballot(r1 < 16);
        if (tl == tk) { m0 = s0; m1 = s1; } }
    {
        f32x16 o0 = zero16(), o1 = zero16(); float m = ATT_NEG, l = 0.f;
        const bf16* k0p = p.PROJ + (size_t)b * cS * PE_LD + 768 + g * 64;
        const bf16* v0p = VT + vt_tile_off(16, b, g, 0);
        const rsrc_t rsK = mkrsrc(k0p), rsV = mkrsrc(v0p); const unsigned kvo = kvoff(lane, PE_LD), vvo = vvoff(lane, 32);
        unsigned long long u0 = wave_or64(m0), u1 = wave_or64(m1);
        const int tmax = (t0 + 7) >> 5;
#define NSA_NEXT_TILE(tc) ({ int tt_ = (tc) + 1; if ((tt_ & 1) == 0) { const int j_ = tt_ >> 1; \
            const unsigned long long lo_ = j_ < 64 ? (u0 >> j_) : 0ull, hi_ = j_ < 64 ? u1 : (j_ < 128 ? (u1 >> (j_ - 64)) : 0ull); \
            tt_ = lo_ ? 2 * (j_ + __builtin_ctzll(lo_)) : (hi_ ? 2 * ((j_ < 64 ? 64 : j_) + __builtin_ctzll(hi_)) : 1 << 20); } tt_ <= tmax ? tt_ : -1; })
        int tn = NSA_NEXT_TILE(-1);
        KF kc; VF vc;
        if (tn >= 0) { dma_k(wl, rsK, (unsigned)(32 * tn) * (PE_LD * 2), PE_LD * 2, kvo); dma_v(wl, rsV, (unsigned)tn * 4096u, 64, vvo); DMA_WAIT(); read_k(kc, la); }
        while (tn >= 0 && 32 * tn + 31 <= t0) { const int tc = tn, key0 = 32 * tc, j = tc >> 1;
            tn = NSA_NEXT_TILE(tc);
            LDS_DRAIN(); if (tn >= 0) dma_k(wl, rsK, (unsigned)(32 * tn) * (PE_LD * 2), PE_LD * 2, kvo);
            read_v(vc, la);
            const bool selj = ((j < 64 ? m0 : m1) >> (j & 63)) & 1ull;
            f32x16 s = qk32r(kc, qf);
            LDS_DRAIN_PINNED(); if (tn >= 0) dma_v(wl, rsV, (unsigned)tn * 4096u, 64, vvo);
            sm_fast(s, kc, qf, selj, m, l, o0, o1, pb);
            pv32r(o0, o1, vc, pb);
            if (tn >= 0) { DMA_WAIT(); read_k(kc, la); } }
        while (tn >= 0) { const int tc = tn, key0 = 32 * tc, j = tc >> 1;
            tn = NSA_NEXT_TILE(tc);
            LDS_DRAIN(); if (tn >= 0) dma_k(wl, rsK, (unsigned)(32 * tn) * (PE_LD * 2), PE_LD * 2, kvo);
            read_v(vc, la);
            const bool selj = ((j < 64 ? m0 : m1) >> (j & 63)) & 1ull;
            f32x16 s = qk32r(kc, qf);
            LDS_DRAIN_PINNED(); if (tn >= 0) dma_v(wl, rsV, (unsigned)tn * 4096u, 64, vvo);
            sm_step(s, kc, qf, 0, selj ? t - key0 : -1, hh, m, l, o0, o1, pb);
            pv32r(o0, o1, vc, pb);
            if (tn >= 0) { DMA_WAIT(); read_k(kc, la); } }
        l = xsum32(l);
        const float sc = (l > 0.f ? 1.f / l : 0.f) * p.GATES[row * 24 + head * 3 + 1];
#pragma unroll
        for (int reg = 0; reg < 16; ++reg) { outacc[reg] += o0[reg] * sc; outacc[16 + reg] += o1[reg] * sc; }
    }
    {
        f32x16 o0 = zero16(), o1 = zero16(); float m = ATT_NEG, l = 0.f;
        const bf16* k0p = p.PROJ + (size_t)b * cS * PE_LD + 896 + g * 64;
        const bf16* v0p = VT + vt_tile_off(16, b, 2 + g, 0);
        const rsrc_t rsK = mkrsrc(k0p), rsV = mkrsrc(v0p); const unsigned kvo = kvoff(lane, PE_LD), vvo = vvoff(lane, 32);
        const int k_lo = t0 >= 511 ? (t0 - 511) >> 5 : 0, k_hi = (t0 + 7) >> 5;
        KF kc; VF vc;
        dma_k(wl, rsK, (unsigned)(32 * k_lo) * (PE_LD * 2), PE_LD * 2, kvo); dma_v(wl, rsV, (unsigned)k_lo * 4096u, 64, vvo); DMA_WAIT(); read_k(kc, la);
#define WIN_TILE(SM_) { const int key0 = 32 * kt; \
            LDS_DRAIN(); if (kt < k_hi) dma_k(wl, rsK, (unsigned)(key0 + 32) * (PE_LD * 2), PE_LD * 2, kvo); \
            read_v(vc, la); \
            f32x16 s = qk32r(kc, qf); \
            LDS_DRAIN_PINNED(); if (kt < k_hi) dma_v(wl, rsV, (unsigned)(kt + 1) * 4096u, 64, vvo); \
            SM_; \
            pv32r(o0, o1, vc, pb); \
            if (kt < k_hi) { DMA_WAIT(); read_k(kc, la); } }
        int kt = k_lo;
        for (; kt <= k_hi && 32 * kt < t0 + 7 - 511; ++kt) WIN_TILE(sm_step(s, kc, qf, t - 511 - key0, 31, hh, m, l, o0, o1, pb))
        for (; kt <= k_hi && 32 * kt + 31 <= t0; ++kt) WIN_TILE(sm_fast(s, kc, qf, true, m, l, o0, o1, pb))
        for (; kt <= k_hi; ++kt) WIN_TILE(sm_step(s, kc, qf, 0, t - key0, hh, m, l, o0, o1, pb))
#undef WIN_TILE
        l = xsum32(l);
        const float sc = (l > 0.f ? 1.f / l : 0.f) * p.GATES[row * 24 + head * 3 + 2];
#pragma unroll
        for (int reg = 0; reg < 16; ++reg) { outacc[reg] += o0[reg] * sc; outacc[16 + reg] += o1[reg] * sc; }
    }
    store_row64(p.ATT + (size_t)row * 768 + head * 64, hh, outacc, 1.f);
}

__device__ __forceinline__ void cmp1_unit(const P& p, const bf16* W1T, const float* PEB, int u, int lane) {
    const int r = lane & 31, hh = lane >> 5;
    const int ct = u & 7, rt = (u >> 3) & 127, which = u >> 10;
    const int NR = cB * cNC * 2;
    int i = rt * 32 + r; if (i >= NR) i = NR - 1;
    const int g = i & 1, n = (i >> 1) % cNC, b = (i >> 1) / cNC;
    const bf16* ap = p.PROJ + (size_t)(b * cS + 16 * n) * PE_LD + 512 + which * 128 + g * 64 + 8 * hh;
    const bf16* bp = W1T + ((size_t)which * 256 + ct * 32 + r) * 2048 + 8 * hh;
    f32x16 acc = zero16();
    for (int l = 0; l < 32; ++l) {
#pragma unroll
        for (int q = 0; q < 4; ++q) { const bf16x8v a = *(const bf16x8v*)(ap + (size_t)l * PE_LD + 16 * q), bb = *(const bf16x8v*)(bp + l * 64 + 16 * q);
            acc = __builtin_amdgcn_mfma_f32_32x32x16_bf16(a, bb, acc, 0, 0, 0); } }
    const int j = ct * 32 + r; const float bias = PEB[which * 256 + j];
#pragma unroll
    for (int reg = 0; reg < 16; ++reg) { const int io = rt * 32 + (reg & 3) + 8 * (reg >> 2) + 4 * hh;
        if (io < NR) p.HID[((size_t)which * NR + io) * 256 + j] = gelu_tanh(acc[reg] + bias); }
}
__device__ __forceinline__ void gates_unit(const P& p, const bf16* WGT, int u, int lane) {
    const int r = lane & 31, hh = lane >> 5;
    const bf16* ap = p.Y + (size_t)(u * 32 + r) * cDM + 8 * hh; const bf16* bp = WGT + (size_t)r * cDM + 8 * hh;
    f32x16 acc = zero16();
#pragma unroll 8
    for (int ks = 0; ks < cDM / 16; ++ks) { const bf16x8v a = *(const bf16x8v*)(ap + 16 * ks), bb = *(const bf16x8v*)(bp + 16 * ks);
        acc = __builtin_amdgcn_mfma_f32_32x32x16_bf16(a, bb, acc, 0, 0, 0); }
    if (r < 24) {
#pragma unroll
        for (int reg = 0; reg < 16; ++reg) { const int row = u * 32 + (reg & 3) + 8 * (reg >> 2) + 4 * hh; p.GATES[(size_t)row * 24 + r] = 1.f / (1.f + __expf(-acc[reg])); } }
}

__device__ __forceinline__ float xlo32(float x) { float y; asm volatile("v_mov_b32 %0, %1\n\ts_nop 1" : "=v"(y) : "v"(x));
    auto r = __builtin_amdgcn_permlane32_swap(__builtin_bit_cast(unsigned, x), __builtin_bit_cast(unsigned, y), false, false); const unsigned a = r[0]; return __builtin_bit_cast(float, a); }
template <bool DIAG>
__device__ __forceinline__ void sb_tile(const f32x16& z, const VF& vc, const bf16x8v (&TA)[2], int r, int hh, float& carry, f32x16& o0, f32x16& o1) {
    f32x16 l1; float lbv[16];
#pragma unroll
    for (int reg = 0; reg < 16; ++reg) { const int ko = (reg & 3) + 8 * (reg >> 2) + 4 * hh; float zr = z[reg]; OPQ(zr); const float zz = zr * 0.125f;
        const float e = fexp2(-fabsf(zz) * 1.4426950408889634f); const float sp = __builtin_amdgcn_logf(1.f + e) * 0.6931471805599453f;
        float lb = fminf(zz, 0.f) - sp; OPQ(lb); lbv[reg] = lb; float x = (!DIAG || ko < r) ? lb - zz : 0.f; OPQ(x); l1[reg] = x; }
    unsigned bh[8], bl[8];
#pragma unroll
    for (int i = 0; i < 8; ++i) { const float x0 = l1[2 * i], x1 = l1[2 * i + 1]; const unsigned hw = cvtpk(x0, x1); bh[i] = hw; float d0 = x0 - bflo(hw), d1 = x1 - bfhi(hw); OPQ(d0); OPQ(d1); bl[i] = cvtpk(d0, d1); }
    f32x16 af = zero16();
    typedef unsigned u32x4v __attribute__((ext_vector_type(4)));
#pragma unroll
    for (int s = 0; s < 2; ++s) { const u32x4v wh = {bh[4 * s], bh[4 * s + 1], bh[4 * s + 2], bh[4 * s + 3]}, wl = {bl[4 * s], bl[4 * s + 1], bl[4 * s + 2], bl[4 * s + 3]};
        af = __builtin_amdgcn_mfma_f32_32x32x16_bf16(TA[s], __builtin_bit_cast(bf16x8v, wh), af, 0, 0, 0);
        af = __builtin_amdgcn_mfma_f32_32x32x16_bf16(TA[s], __builtin_bit_cast(bf16x8v, wl), af, 0, 0, 0); }
    unsigned pb[8]; float av[16];
#pragma unroll
    for (int reg = 0; reg < 16; ++reg) { const int ko = (reg & 3) + 8 * (reg >> 2) + 4 * hh;
        float t = lbv[reg] + af[reg]; OPQ(t); av[reg] = (!DIAG || ko < r) ? fexp2((t + carry) * 1.4426950408889634f) : 0.f; }
#pragma unroll
    for (int i = 0; i < 8; ++i) pb[i] = cvtpk(av[2 * i], av[2 * i + 1]);
    pv32r(o0, o1, vc, pb);
    carry += xlo32(af[0] + l1[0]);
}
__device__ __forceinline__ void sb_unit(const P& p, const bf16* VT, LAS unsigned char* wl, int b, int h, int t0, int lane) {
    const int r = lane & 31, hh = lane >> 5; const long row = (long)b * cS + t0 + r; const LaneAddr la = lane_addr(wl, lane);
    bf16x8v qf[4];
    { const bf16* qp = p.PROJ + (size_t)row * PO_LD + h * 64 + 8 * hh;
#pragma unroll
      for (int ks = 0; ks < 4; ++ks) qf[ks] = *(const bf16x8v*)(qp + 16 * ks); }
    bf16x8v TA[2];
#pragma unroll
    for (int s = 0; s < 2; ++s)
#pragma unroll
        for (int j = 0; j < 8; ++j) { const int kk = 16 * s + 8 * (j >> 2) + 4 * hh + (j & 3); TA[s][j] = (short)(kk > r ? 0x3F80 : 0); }
    f32x16 o0 = zero16(), o1 = zero16(); float carry = 0.f;
    const bf16* k0p = p.PROJ + (size_t)b * cS * PO_LD + cDM + h * 64;
    const bf16* v0p = VT + vt_tile_off(16, b, h, 0);
    const rsrc_t rsK = mkrsrc(k0p), rsV = mkrsrc(v0p); const unsigned kvo = kvoff(lane, PO_LD), vvo = vvoff(lane, 32);
    KF kc; VF vc;
    dma_k(wl, rsK, (unsigned)t0 * (PO_LD * 2), PO_LD * 2, kvo); dma_v(wl, rsV, (unsigned)(t0 >> 5) * 4096u, 64, vvo); DMA_WAIT(); read_k(kc, la);
#define SB_TILE(DIAG_, key0_) do { LDS_DRAIN(); if ((key0_) > 0) dma_k(wl, rsK, (unsigned)((key0_) - 32) * (PO_LD * 2), PO_LD * 2, kvo); \
        read_v(vc, la); const f32x16 z_ = qk32r(kc, qf); \
        LDS_DRAIN_PINNED(); if ((key0_) > 0) dma_v(wl, rsV, (unsigned)(((key0_) - 32) >> 5) * 4096u, 64, vvo); \
        sb_tile<DIAG_>(z_, vc, TA, r, hh, carry, o0, o1); } while (0)
    int kt = t0 >> 5;
    SB_TILE(true, t0);
    for (--kt; kt >= 0; --kt) { const int key0 = 32 * kt;
        DMA_WAIT(); read_k(kc, la);
        SB_TILE(false, key0);
        if (__all(carry < -93.f)) break; }
#undef SB_TILE
    DMA_WAIT();
    { float ov[32];
#pragma unroll
      for (int reg = 0; reg < 16; ++reg) { ov[reg] = o0[reg]; ov[16 + reg] = o1[reg]; }
      store_row64(p.ATT + (size_t)row * cDM + h * 64, hh, ov, 1.f); }
}

template <int G>
__device__ __forceinline__ void dil_unit(const P& p, const bf16* VT, const bf16* VTP, bf16* DOUT, float* DLSE, LAS unsigned char* wl, int b, int hd, int rc, int tile, int lane) {
    constexpr int dil = G == 0 ? 1 : G == 1 ? 4 : 16; constexpr int slot0 = 4 * G;
    const int r = lane & 31, hh = lane >> 5, slot = slot0 + hd; const LaneAddr la = lane_addr(wl, lane);
    const long row = (long)b * cS + rc + (long)dil * (32 * tile + r);
    bf16x8v qf[4];
    { const bf16* qp = p.PROJ + (size_t)row * PE_LD + 1024 + slot * 64 + 8 * hh;
#pragma unroll
      for (int ks = 0; ks < 4; ++ks) qf[ks] = *(const bf16x8v*)(qp + 16 * ks); }
    f32x16 o0 = zero16(), o1 = zero16(); float m = ATT_NEG, l = 0.f; unsigned pb[8];
    const bf16* k0p = p.PROJ + ((size_t)b * cS + rc) * PE_LD + 1792 + slot * 64;
    const bf16* v0p = G == 0 ? VT + vt_tile_off(16, b, 4 + slot, 0)
                             : VTP + vt_tile_off(8, b, (G - 1) * 4 + hd, rc * (cS / dil / 32));
    const rsrc_t rsK = mkrsrc(k0p), rsV = mkrsrc(v0p); const unsigned kvo = kvoff(lane, (size_t)dil * PE_LD), vvo = vvoff(lane, 32);
    const int k_lo = tile >= 4 ? tile - 4 : 0;
    KF kc; VF vc;
    dma_k(wl, rsK, (unsigned)(32 * k_lo) * (dil * PE_LD * 2), dil * PE_LD * 2, kvo); dma_v(wl, rsV, (unsigned)k_lo * 4096u, 64, vvo); DMA_WAIT(); read_k(kc, la);
    for (int kt = k_lo; kt <= tile; ++kt) { const int D0 = 32 * (tile - kt);
        LDS_DRAIN(); if (kt < tile) dma_k(wl, rsK, (unsigned)(32 * kt + 32) * (dil * PE_LD * 2), dil * PE_LD * 2, kvo);
        read_v(vc, la);
        f32x16 s = qk32r(kc, qf);
        LDS_DRAIN_PINNED(); if (kt < tile) dma_v(wl, rsV, (unsigned)(kt + 1) * 4096u, 64, vvo);
        if (D0 >= 32 && D0 <= 96) sm_fast(s, kc, qf, true, m, l, o0, o1, pb);
        else sm_step(s, kc, qf, D0 + r - 128, D0 + r, hh, m, l, o0, o1, pb);
        pv32r(o0, o1, vc, pb);
        if (kt < tile) { DMA_WAIT(); read_k(kc, la); } }
    l = xsum32(l);
    const float rl = 1.f / l;
    { float ov[32];
#pragma unroll
      for (int reg = 0; reg < 16; ++reg) { ov[reg] = o0[reg]; ov[16 + reg] = o1[reg]; }
      store_row64(DOUT + ((size_t)G * cM + row) * 256 + hd * 64, hh, ov, rl); }
    if (hh == 0) DLSE[((size_t)G * cM + row) * 4 + hd] = m + __builtin_amdgcn_logf(l);
}
namespace pg8 {
#define PG8_LAS __attribute__((address_space(3)))
typedef unsigned short bf16_t;
typedef short bf16x8 __attribute__((ext_vector_type(8)));
typedef float f32x4 __attribute__((ext_vector_type(4)));
typedef unsigned u32x4 __attribute__((ext_vector_type(4)));
constexpr int BM = 256, BK = 64, HALF = 128, HTB = HALF * BK * 2  , STAGE_BYTES = 8 * HTB, NXCD = 8, WGM = 8;

__host__ __device__ __forceinline__ int lds_byte(int r, int c) { const int st = (r >> 4) * 2 + (c >> 5), rr = r & 15, cc = c & 31, ob = rr * 64 + cc * 2; return st * 1024 + (ob ^ (((ob >> 9) & 1) << 5)); }
__host__ __device__ __forceinline__ void stage_rc(int b, int& R, int& C) { const int st = b / 1024, sb = b % 1024, swz = sb ^ (((sb >> 9) & 1) << 5); R = (st >> 1) * 16 + swz / 64; C = (st & 1) * 32 + (swz % 64) / 2; }
__host__ __device__ __forceinline__ int perm32(int rho) { const int n = rho >> 4, i = rho & 15; return 8 * (i >> 2) + 4 * n + (i & 3); }

struct Unit { int pm, pn; };
struct Gemm { const bf16_t* A; const bf16_t* Bt; int M, N, K; };

struct StaticOrder {
    int nM, nN, nwg, G, c;
    __host__ __device__ void init(int M, int N, int G_, int c_) { nM = M / BM; nN = N / BM; nwg = nM * nN; G = G_; c = c_; }
    __host__ __device__ bool next(int i, Unit& u) const {
        const long L = (long)i * G + c; if (L >= nwg) return false;
        int wgid = (int)L; { const int q = nwg / NXCD, r = nwg % NXCD, xcd = wgid % NXCD, off = wgid / NXCD; wgid = (xcd < r ? xcd * (q + 1) : r * (q + 1) + (xcd - r) * q) + off; }
        const int nig = WGM * nN, gid = wgid / nig, fm = gid * WGM, gsz = (nM - fm) < WGM ? (nM - fm) : WGM;
        u.pm = fm + ((wgid % nig) % gsz); u.pn = (wgid % nig) / gsz; return true;
    }
    __device__ __forceinline__ void a_ready(const Unit&) const {}
    __device__ __forceinline__ void done(const Unit&) const {}
};

__device__ __forceinline__ unsigned cvt_pk_bf16(float lo, float hi) { unsigned r; asm volatile("v_cvt_pk_bf16_f32 %0, %1, %2" : "=v"(r) : "v"(lo), "v"(hi)); return r; }
typedef float f32x2 __attribute__((ext_vector_type(2)));
__device__ __forceinline__ f32x2 gelu_pk(f32x2 v) {
    const f32x2 av = __builtin_elementwise_abs(v), d = av * 0.2316418882f + 1.0f;
    f32x2 t; t.x = __builtin_amdgcn_rcpf(d.x); t.y = __builtin_amdgcn_rcpf(d.y);
    f32x2 q = t * 0.5307027145f + (-0.7265760135f); q = q * t + 0.7107068705f; q = q * t + (-0.142248368f); q = q * t + 0.127414796f; q = q * t;
    const f32x2 s = (v * v) * (-0.72134752044f);
    f32x2 e; e.x = __builtin_amdgcn_exp2f(s.x); e.y = __builtin_amdgcn_exp2f(s.y);
    const f32x2 m = v * (q * e), r = v - m;
    f32x2 o; o.x = v.x < 0.f ? m.x : r.x; o.y = v.y < 0.f ? m.y : r.y; return o;
}

template <int ACT  > struct EpiBf16 {
    static constexpr bool PERM = true, AFTER_DRAIN = false, TABLE = false; static_assert(ACT == 0 || ACT == 1, "EpiBf16: ACT is 0 (none) or 1 (gelu_pk)");
    bf16_t* O; int ldc; const float* bias; int split_cols; size_t split_stride; float scale0;
    __device__ __forceinline__ void operator()(const f32x4 (&acc)[2][2][4][2], const Unit& u, int wr, int wc, int fr, int fq) const {
        const int row0 = u.pm * BM + wr * 64 + fr; int colt = u.pn * BM; bf16_t* base = O;
        float sc = 1.f; if (split_cols) { const int t = colt / split_cols; base += (size_t)t * split_stride; colt -= t * split_cols; if (t == 0) sc = scale0; }
        const int col0 = colt + wc * 32 + 8 * fq, bcol0 = u.pn * BM + wc * 32 + 8 * fq;
        f32x4 bv[2][2];
#pragma unroll
        for (int bj = 0; bj < 2; ++bj)
#pragma unroll
            for (int n = 0; n < 2; ++n) bv[bj][n] = bias ? *(const f32x4*)(bias + bcol0 + bj * HALF + 4 * n) : (f32x4){0.f, 0.f, 0.f, 0.f};
#pragma unroll
        for (int ai = 0; ai < 2; ++ai)
#pragma unroll
            for (int m = 0; m < 4; ++m) { bf16_t* rowp = base + (size_t)(row0 + ai * HALF + m * 16) * ldc + col0;
#pragma unroll
                for (int bj = 0; bj < 2; ++bj) { f32x4 v0 = acc[ai][bj][m][0] + bv[bj][0], v1 = acc[ai][bj][m][1] + bv[bj][1];
                    if (ACT == 1) { f32x2 a = gelu_pk((f32x2){v0[0], v0[1]}), b = gelu_pk((f32x2){v0[2], v0[3]}), c = gelu_pk((f32x2){v1[0], v1[1]}), d = gelu_pk((f32x2){v1[2], v1[3]});
                        v0 = (f32x4){a.x, a.y, b.x, b.y}; v1 = (f32x4){c.x, c.y, d.x, d.y}; }
                    v0 = v0 * sc; v1 = v1 * sc; u32x4 w; w.x = cvt_pk_bf16(v0[0], v0[1]); w.y = cvt_pk_bf16(v0[2], v0[3]); w.z = cvt_pk_bf16(v1[0], v1[1]); w.w = cvt_pk_bf16(v1[2], v1[3]);
                    *(u32x4*)(rowp + bj * HALF) = w; } }
    }
};
template <class Epi, class Sched, bool ALIGN_EPI = false, bool SP2 = false>
__device__ __forceinline__ void gemm_phase(PG8_LAS unsigned char* lds, const Gemm g, const Sched& S, const Epi& E) {
    int tid_ = threadIdx.x; asm volatile("" : "+v"(tid_));
    const int tid = tid_, wid = __builtin_amdgcn_readfirstlane(tid >> 6), lane = tid & 63, wr = wid >> 2, wc = wid & 3, fr = lane & 15, fq = lane >> 4;
    const int K = g.K, nt = K / BK;
    unsigned voffA[2], voffB[2];
#pragma unroll
    for (int i = 0; i < 2; ++i) { int R, C; stage_rc(tid * 16 + i * 8192, R, C); const int Rb = Epi::PERM ? ((R & ~31) + perm32(R & 31)) : R;
        voffA[i] = (unsigned)(R * K + C) * 2u; voffB[i] = (unsigned)(Rb * K + C) * 2u; }
    const size_t kstep = (size_t)(BK * 2);
    const size_t hstep = (size_t)HALF * K * 2;
    const size_t tstep = 2 * hstep;
    const unsigned ldsw = (unsigned)wid * 1024u;
    const int aoff = lds_byte(wr * 64 + fr, fq * 8), boff = lds_byte(wc * 32 + fr, fq * 8);
#define PG8_SA(b, h) (((b) * 2 + (h)) * HTB)
#define PG8_SB(b, h) ((4 + (b) * 2 + (h)) * HTB)
#define PG8_STAGE(bufoff, gbase, voff) do { _Pragma("unroll") for (int _i = 0; _i < 2; ++_i) \
        __builtin_amdgcn_global_load_lds((const unsigned*)((const char*)(gbase) + (voff)[_i]), (PG8_LAS unsigned*)(lds + (bufoff) + ldsw + _i * 8192), 16, 0, 0); } while (0)
#define PG8_LDA(dst, b, h) do { _Pragma("unroll") for (int m = 0; m < 4; ++m) _Pragma("unroll") for (int k = 0; k < 2; ++k) dst[m][k] = *(const PG8_LAS bf16x8*)(lds + PG8_SA(b, h) + aoff + m * 2048 + k * 1024); } while (0)
#define PG8_LDB(dst, b, h) do { _Pragma("unroll") for (int n = 0; n < 2; ++n) _Pragma("unroll") for (int k = 0; k < 2; ++k) dst[n][k] = *(const PG8_LAS bf16x8*)(lds + PG8_SB(b, h) + boff + n * 2048 + k * 1024); } while (0)
#define PG8_MMA(ai, bj, At, Bt) do { __builtin_amdgcn_s_setprio(1); _Pragma("unroll") for (int m = 0; m < 4; ++m) _Pragma("unroll") for (int n = 0; n < 2; ++n) _Pragma("unroll") for (int k = 0; k < 2; ++k) \
        acc[ai][bj][m][n] = __builtin_amdgcn_mfma_f32_16x16x32_bf16(Bt[n][k], At[m][k], acc[ai][bj][m][n], 0, 0, 0); __builtin_amdgcn_s_setprio(0); } while (0)
#define PG8_WAIT_V(n) asm volatile("s_waitcnt vmcnt(" #n ")" ::: "memory")
#define PG8_WAIT_L(n) asm volatile("s_waitcnt lgkmcnt(" #n ")" ::: "memory")
#define PG8_BAR __builtin_amdgcn_s_barrier()
#define PG8_SCHED __builtin_amdgcn_sched_barrier(0)
    Unit cur, nxt; int ui = 0;
    if (!S.next(0, cur)) return;
    f32x4 acc[2][2][4][2];
#pragma unroll
    for (int a = 0; a < 2; ++a)
#pragma unroll
        for (int b = 0; b < 2; ++b)
#pragma unroll
            for (int m = 0; m < 4; ++m)
#pragma unroll
                for (int n = 0; n < 2; ++n) acc[a][b][m][n] = (f32x4){0.f, 0.f, 0.f, 0.f};
    bf16x8 At[4][2], B0[2][2], B1[2][2];
    const char* cA = (const char*)g.A + (size_t)cur.pm * tstep; const char* cB = (const char*)g.Bt + (size_t)cur.pn * tstep;
    S.a_ready(cur);
    if constexpr (SP2) {
        PG8_STAGE(PG8_SB(0, 0), cB, voffB); PG8_STAGE(PG8_SB(0, 1), cB + hstep, voffB); PG8_STAGE(PG8_SA(0, 0), cA, voffA); PG8_STAGE(PG8_SA(0, 1), cA + hstep, voffA);
        if (wr == 1) PG8_BAR;
        PG8_WAIT_V(2); PG8_BAR;
        PG8_STAGE(PG8_SB(1, 0), cB + kstep, voffB); PG8_STAGE(PG8_SA(1, 0), cA + kstep, voffA); PG8_STAGE(PG8_SB(1, 1), cB + hstep + kstep, voffB);
        PG8_WAIT_V(6); PG8_BAR;
    } else {
        PG8_STAGE(PG8_SB(0, 0), cB, voffB); PG8_STAGE(PG8_SA(0, 0), cA, voffA); PG8_STAGE(PG8_SB(0, 1), cB + hstep, voffB); PG8_STAGE(PG8_SA(0, 1), cA + hstep, voffA);
        if (wr == 1) PG8_BAR;
        PG8_WAIT_V(4); PG8_BAR;
        PG8_STAGE(PG8_SB(1, 0), cB + kstep, voffB); PG8_STAGE(PG8_SA(1, 0), cA + kstep, voffA); PG8_STAGE(PG8_SB(1, 1), cB + hstep + kstep, voffB);
        PG8_WAIT_V(6); PG8_BAR;
    }
    for (;;) {
        const bool has_next = S.next(ui + 1, nxt);
        if constexpr (Epi::TABLE) { if (tid < 256) E.stage_table(cur, lds + 131072 + (ui & 1) * 4096, tid); }
        const char* nA = has_next ? (const char*)g.A + (size_t)nxt.pm * tstep : cA; const char* nB = has_next ? (const char*)g.Bt + (size_t)nxt.pn * tstep : cB;
        for (int t = 0; t < nt; t += 2) {
            const bool last = (t == nt - 2);
            const char* a1 = cA + (size_t)(t + 1) * kstep;
            const char* a2 = last ? nA : cA + (size_t)(t + 2) * kstep; const char* b2 = last ? nB : cB + (size_t)(t + 2) * kstep;
            const char* a3 = a2 + kstep; const char* b3 = b2 + kstep;
            if (last && has_next) S.a_ready(nxt);
            if constexpr (SP2) {
            PG8_LDB(B0, 0, 0); PG8_LDB(B1, 0, 1); PG8_SCHED; PG8_LDA(At, 0, 0); PG8_STAGE(PG8_SA(1, 1), a1 + hstep, voffA);
            PG8_WAIT_V(8); PG8_WAIT_L(0); PG8_BAR; PG8_MMA(0, 0, At, B0); PG8_MMA(0, 1, At, B1); PG8_BAR; PG8_SCHED;
            PG8_LDA(At, 0, 1); PG8_STAGE(PG8_SB(0, 0), b2, voffB); PG8_STAGE(PG8_SB(0, 1), b2 + hstep, voffB); PG8_STAGE(PG8_SA(0, 0), a2, voffA);
            PG8_WAIT_V(8); PG8_WAIT_L(0); PG8_BAR; PG8_MMA(1, 0, At, B0); PG8_MMA(1, 1, At, B1); PG8_BAR; PG8_SCHED;
            PG8_LDB(B0, 1, 0); PG8_LDB(B1, 1, 1); PG8_SCHED; PG8_LDA(At, 1, 0); PG8_STAGE(PG8_SA(0, 1), a2 + hstep, voffA);
            PG8_WAIT_V(8); PG8_WAIT_L(0); PG8_BAR; PG8_MMA(0, 0, At, B0); PG8_MMA(0, 1, At, B1); PG8_BAR; PG8_SCHED;
            PG8_LDA(At, 1, 1); PG8_STAGE(PG8_SB(1, 0), b3, voffB); PG8_STAGE(PG8_SB(1, 1), b3 + hstep, voffB); PG8_STAGE(PG8_SA(1, 0), a3, voffA);
            PG8_WAIT_V(8); PG8_WAIT_L(0); PG8_BAR; PG8_MMA(1, 0, At, B0); PG8_MMA(1, 1, At, B1); PG8_BAR; PG8_SCHED;
            } else {
            PG8_LDB(B0, 0, 0); PG8_SCHED; PG8_LDA(At, 0, 0); PG8_STAGE(PG8_SA(1, 1), a1 + hstep, voffA);
            PG8_WAIT_L(8); PG8_BAR; PG8_WAIT_L(0); PG8_MMA(0, 0, At, B0); PG8_BAR; PG8_SCHED;
            PG8_LDB(B1, 0, 1); PG8_STAGE(PG8_SB(0, 0), b2, voffB);
            PG8_BAR; PG8_WAIT_L(0); PG8_MMA(0, 1, At, B1); PG8_BAR;
            PG8_LDA(At, 0, 1); PG8_STAGE(PG8_SA(0, 0), a2, voffA);
            PG8_BAR; PG8_WAIT_L(0); PG8_MMA(1, 0, At, B0); PG8_BAR; PG8_SCHED;
            PG8_STAGE(PG8_SB(0, 1), b2 + hstep, voffB);
            PG8_WAIT_V(6); PG8_BAR; PG8_MMA(1, 1, At, B1); PG8_BAR;
            PG8_LDB(B0, 1, 0); PG8_SCHED; PG8_LDA(At, 1, 0); PG8_STAGE(PG8_SA(0, 1), a2 + hstep, voffA);
            PG8_WAIT_L(8); PG8_BAR; PG8_WAIT_L(0); PG8_MMA(0, 0, At, B0); PG8_BAR; PG8_SCHED;
            PG8_LDB(B1, 1, 1); PG8_STAGE(PG8_SB(1, 0), b3, voffB);
            PG8_BAR; PG8_WAIT_L(0); PG8_MMA(0, 1, At, B1); PG8_BAR;
            PG8_LDA(At, 1, 1); PG8_STAGE(PG8_SA(1, 0), a3, voffA);
            PG8_BAR; PG8_WAIT_L(0); PG8_MMA(1, 0, At, B0); PG8_BAR; PG8_SCHED;
            PG8_STAGE(PG8_SB(1, 1), b3 + hstep, voffB);
            PG8_WAIT_V(6); PG8_BAR; PG8_MMA(1, 1, At, B1); PG8_BAR;
            }
        }
        if constexpr (ALIGN_EPI) { if (wr == 0) PG8_BAR; }
        if constexpr (!Epi::AFTER_DRAIN) { if constexpr (Epi::TABLE) E.run(acc, cur, wr, wc, fr, fq, lds + 131072 + (ui & 1) * 4096); else E(acc, cur, wr, wc, fr, fq); S.done(cur); }
        if (!has_next) break;
#pragma unroll
        for (int a = 0; a < 2; ++a)
#pragma unroll
            for (int b = 0; b < 2; ++b)
#pragma unroll
                for (int m = 0; m < 4; ++m)
#pragma unroll
                    for (int n = 0; n < 2; ++n) acc[a][b][m][n] = (f32x4){0.f, 0.f, 0.f, 0.f};
        cur = nxt; cA = nA; cB = nB; ++ui;
        if constexpr (ALIGN_EPI) { if (wr == 1) PG8_BAR; }
    }
    PG8_WAIT_V(0);
    if constexpr (!ALIGN_EPI) { if (wr == 0) PG8_BAR; }
    PG8_BAR;
    if constexpr (Epi::AFTER_DRAIN) { E.fused(acc, cur, wr, wc, fr, fq, lds, wid, lane); S.done(cur); }
#undef PG8_SA
#undef PG8_SB
#undef PG8_STAGE
#undef PG8_LDA
#undef PG8_LDB
#undef PG8_MMA
#undef PG8_WAIT_V
#undef PG8_WAIT_L
#undef PG8_BAR
#undef PG8_SCHED
}
}
namespace pg8 {
struct EpiRopeE {
    static constexpr bool PERM = true, AFTER_DRAIN = false, TABLE = false;
    bf16_t* O; int ldc; const float* rope;
    __device__ __forceinline__ void operator()(const f32x4 (&acc)[2][2][4][2], const Unit& u, int wr, int wc, int fr, int fq) const {
        const int row0 = u.pm * BM + wr * 64 + fr;
        if (u.pn == 2) {
            const int col0 = u.pn * BM + wc * 32 + 8 * fq;
#pragma unroll
            for (int ai = 0; ai < 2; ++ai)
#pragma unroll
                for (int m = 0; m < 4; ++m) { bf16_t* rowp = O + (size_t)(row0 + ai * HALF + m * 16) * ldc + col0;
#pragma unroll
                    for (int bj = 0; bj < 2; ++bj) { const f32x4 v0 = acc[ai][bj][m][0], v1 = acc[ai][bj][m][1]; u32x4 w;
                        w.x = cvt_pk_bf16(v0[0], v0[1]); w.y = cvt_pk_bf16(v0[2], v0[3]); w.z = cvt_pk_bf16(v1[0], v1[1]); w.w = cvt_pk_bf16(v1[2], v1[3]); *(u32x4*)(rowp + bj * HALF) = w; } }
        } else {
            const int kk = 4 * (wc & 1) + fq;
#pragma unroll
            for (int ai = 0; ai < 2; ++ai)
#pragma unroll
                for (int m = 0; m < 4; ++m) { const int row = row0 + ai * HALF + m * 16, pos = row & (cS - 1);
                    const f32x4 c0 = *(const f32x4*)(rope + (size_t)(pos * 32 + 4 * kk) * 2), c1 = *(const f32x4*)(rope + (size_t)(pos * 32 + 4 * kk) * 2 + 4);
#pragma unroll
                    for (int bj = 0; bj < 2; ++bj) { const f32x4 x1 = acc[ai][bj][m][0], x2 = acc[ai][bj][m][1];
                        bf16_t* op = O + (size_t)row * ldc + u.pn * BM + (2 * bj + (wc >> 1)) * 64 + 4 * kk;
                        typedef unsigned u32x2 __attribute__((ext_vector_type(2)));
                        u32x2 a, b;
                        a.x = cvt_pk_bf16(x1[0] * c0[0] - x2[0] * c0[1], x1[1] * c0[2] - x2[1] * c0[3]); a.y = cvt_pk_bf16(x1[2] * c1[0] - x2[2] * c1[1], x1[3] * c1[2] - x2[3] * c1[3]);
                        b.x = cvt_pk_bf16(x2[0] * c0[0] + x1[0] * c0[1], x2[1] * c0[2] + x1[1] * c0[3]); b.y = cvt_pk_bf16(x2[2] * c1[0] + x1[2] * c1[1], x2[3] * c1[2] + x1[3] * c1[3]);
                        *(u32x2*)op = a; *(u32x2*)(op + 32) = b; } }
        }
    }
};
struct EpiVT {
    static constexpr bool PERM = true, AFTER_DRAIN = false, TABLE = false;
    bf16_t* O;
    __device__ __forceinline__ void operator()(const f32x4 (&acc)[2][2][4][2], const Unit& u, int wr, int wc, int fr, int fq) const {
        const int row0 = u.pm * BM + wr * 64 + fr, col0 = u.pn * BM + wc * 32 + 8 * fq;
#pragma unroll
        for (int ai = 0; ai < 2; ++ai)
#pragma unroll
            for (int m = 0; m < 4; ++m) { const int dg = row0 + ai * HALF + m * 16;
#pragma unroll
                for (int bj = 0; bj < 2; ++bj) { const int col = col0 + bj * HALF, b = col / cS, tk = col & (cS - 1);
                    const f32x4 v0 = acc[ai][bj][m][0], v1 = acc[ai][bj][m][1]; u32x4 w;
                    w.x = cvt_pk_bf16(v0[0], v0[1]); w.y = cvt_pk_bf16(v0[2], v0[3]); w.z = cvt_pk_bf16(v1[0], v1[1]); w.w = cvt_pk_bf16(v1[2], v1[3]);
                    *(u32x4*)(O + vt_elem_off(16, b, dg, tk)) = w; } }
    }
};
__device__ __forceinline__ float ror1f(float x) { return __builtin_bit_cast(float, __builtin_amdgcn_mov_dpp(__builtin_bit_cast(int, x), 0x121, 0xF, 0xF, false)); }
__device__ __forceinline__ float ror2f(float x) { return __builtin_bit_cast(float, __builtin_amdgcn_mov_dpp(__builtin_bit_cast(int, x), 0x122, 0xF, 0xF, false)); }
__device__ __forceinline__ float gelu_fast(float x) { const float w = __builtin_fmaf(x * x, -2.3022081981f * 0.044715f, -2.3022081981f); return x * __builtin_amdgcn_rcpf(1.f + __builtin_amdgcn_exp2f(x * w)); }
struct EpiConvGelu {
    static constexpr bool PERM = true, AFTER_DRAIN = false, TABLE = true;
    bf16_t* ACT; const float* cw; const float* cb; float* SB;
    __device__ __forceinline__ void stage_table(const Unit& u, PG8_LAS unsigned char* tab, int tid) const {
        constexpr int LD2 = 2 * cDFF; const int v = tid >> 5, c4 = tid & 31, j = u.pn * 128 + 4 * c4;
        const float* src = ((v & 3) == 3 ? cb : cw + (v & 3) * LD2) + (v >> 2) * cDFF + j;
        *(PG8_LAS f32x4*)(tab + (v * 128 + 4 * c4) * 4) = *(const f32x4*)src; }
    __device__ __forceinline__ void run(const f32x4 (&acc)[2][2][4][2], const Unit& u, int wr, int wc, int fr, int fq, const PG8_LAS unsigned char* tab) const {
        constexpr int LD2 = 2 * cDFF;
        typedef unsigned u32x2 __attribute__((ext_vector_type(2)));
        u32x2 hold[2][4];
#pragma unroll
        for (int n = 0; n < 2; ++n) {
            const int ch0 = wc * 32 + 8 * fq + 4 * n, j0 = u.pn * 128 + ch0;
            const PG8_LAS f32x4* tv = (const PG8_LAS f32x4*)(tab + ch0 * 4);
            const f32x4 w0g = tv[0], w1g = tv[32], w2g = tv[64], bg = tv[96], w0v = tv[128], w1v = tv[160], w2v = tv[192], bv = tv[224];
#pragma unroll
            for (int ai = 0; ai < 2; ++ai) { const int rb = u.pm * BM + ai * HALF + wr * 64, blk = rb >> 6;
                f32x4 pg1, pg2, pv1, pv2;
#pragma unroll
                for (int m = 0; m < 4; ++m) { const f32x4 g = acc[ai][0][m][n], v = acc[ai][1][m][n]; const int row = rb + 16 * m + fr;
                    f32x4 g1, g2, v1, v2;
#pragma unroll
                    for (int e = 0; e < 4; ++e) { g1[e] = ror1f(g[e]); g2[e] = ror2f(g[e]); v1[e] = ror1f(v[e]); v2[e] = ror2f(v[e]); }
                    f32x4 a1g = g1, a2g = g2, a1v = v1, a2v = v2;
                    if (m > 0) { if (fr < 1) { a1g = pg1; a1v = pv1; } if (fr < 2) { a2g = pg2; a2v = pv2; } }
                    pg1 = g1; pg2 = g2; pv1 = v1; pv2 = v2;
                    if (m > 0 || fr >= 2) { float o[4];
#pragma unroll
                        for (int e = 0; e < 4; ++e) { const float cg = bg[e] + w0g[e] * a2g[e] + w1g[e] * a1g[e] + w2g[e] * g[e], cv = bv[e] + w0v[e] * a2v[e] + w1v[e] * a1v[e] + w2v[e] * v[e]; o[e] = gelu_fast(cg) * cv; }
                        u32x2 w; w.x = cvt_pk_bf16(o[0], o[1]); w.y = cvt_pk_bf16(o[2], o[3]);
                        if (n == 0) hold[ai][m] = w; else { u32x4 q; q.x = hold[ai][m].x; q.y = hold[ai][m].y; q.z = w.x; q.w = w.y; *(u32x4*)(ACT + (size_t)row * cDFF + j0 - 4) = q; } }
                    if (m == 0 && fr < 2) { float* sp = SB + ((size_t)blk * 4 + fr) * LD2; *(f32x4*)(sp + j0) = g; *(f32x4*)(sp + cDFF + j0) = v; }
                    if (m == 3 && fr >= 14) { float* sp = SB + ((size_t)blk * 4 + 2 + (fr - 14)) * LD2; *(f32x4*)(sp + j0) = g; *(f32x4*)(sp + cDFF + j0) = v; }
                } }
        }
    }
};
}
#define XB_TMO      128
#define XB_XCNT(j)  (256  + 64 * (j))
#define XB_XSUB(j)  (1280 + 64 * (j))
#define XB_XGEN(j)  (2304 + 64 * (j))
#define XB_TOP      3328
#define XB_TOPGEN   3392
#define XCD_BAR_WORDS 3456
#define XB_SPIN_CAP (1u << 18)

__device__ __forceinline__ unsigned xb_ld(unsigned* p)              { return __hip_atomic_load(p, __ATOMIC_RELAXED, __HIP_MEMORY_SCOPE_AGENT); }
__device__ __forceinline__ unsigned xb_add(unsigned* p, unsigned v) { return __hip_atomic_fetch_add(p, v, __ATOMIC_RELAXED, __HIP_MEMORY_SCOPE_AGENT); }
__device__ __forceinline__ unsigned xb_xcc_id() { return (unsigned)__builtin_amdgcn_s_getreg((3 << 11) | 20) & 0xFu; }
#define XB_SPIN(cond, bar) do { unsigned _sp = 0; while (cond) { __builtin_amdgcn_s_sleep(1); \
    if ((++_sp & 255u) == 0u) { if (xb_ld(&(bar)[XB_TMO])) break; if (_sp > XB_SPIN_CAP) { atomicAdd(&(bar)[XB_TMO], 1u); break; } } } } while (0)

struct XcdBarrier {
    unsigned* bar; unsigned x;
    volatile LAS unsigned* st;
};

__device__ __forceinline__ XcdBarrier xcd_barrier_post(unsigned* bar, volatile LAS unsigned* st) {
    XcdBarrier b; b.bar = bar; b.x = xb_xcc_id(); b.st = st;
    if (threadIdx.x == 0) (void)xb_add(&bar[XB_XCNT(b.x)], 1u);
    return b;
}
__device__ __forceinline__ void xcd_barrier_complete(unsigned* bar, unsigned x, unsigned& nloc, unsigned& nx) {
    const unsigned G = gridDim.x * gridDim.y * gridDim.z;
    unsigned sum, cnt, mine, sp = 0u;
    for (;;) {
        sum = 0u; cnt = 0u; mine = 0u;
#pragma unroll
        for (unsigned j = 0; j < 16; ++j) { const unsigned c = xb_ld(&bar[XB_XCNT(j)]); sum += c; cnt += (c > 0u) ? 1u : 0u; mine = (j == x) ? c : mine; }
        if (sum == G) break;
        __builtin_amdgcn_s_sleep(1);
        if ((++sp & 255u) == 0u) { if (xb_ld(&bar[XB_TMO])) break; if (sp > XB_SPIN_CAP) { atomicAdd(&bar[XB_TMO], 1u); break; } }
    }
    nloc = mine > 0u ? mine : 1u; nx = cnt > 0u ? cnt : 1u;
}

__device__ __forceinline__ void xcd_barrier(const XcdBarrier& b) {
    asm volatile("s_waitcnt vmcnt(0)" ::: "memory");
    __syncthreads();
    if (threadIdx.x == 0) {
        unsigned* bar = b.bar;
        __builtin_amdgcn_s_waitcnt(0);
        unsigned nloc = b.st[0], nx = b.st[1];
        if (nloc == 0u) { xcd_barrier_complete(bar, b.x, nloc, nx); b.st[0] = nloc; b.st[1] = nx; }
        const unsigned old = xb_add(&bar[XB_XSUB(b.x)], 1u);
        const unsigned gen = old / nloc;
        if (old + 1u == (gen + 1u) * nloc) {
            __builtin_amdgcn_fence(__ATOMIC_RELEASE, "agent");
            asm volatile("s_waitcnt vmcnt(0)" ::: "memory");
            const unsigned og = xb_add(&bar[XB_TOP], 1u);
            const unsigned tg = og / nx;
            if (og + 1u == (tg + 1u) * nx) xb_add(&bar[XB_TOPGEN], 1u);
            else XB_SPIN(xb_ld(&bar[XB_TOPGEN]) == tg, bar);
            __builtin_amdgcn_fence(__ATOMIC_ACQUIRE, "agent");
            xb_add(&bar[XB_XGEN(b.x)], 1u);
            asm volatile("s_waitcnt vmcnt(0)" ::: "memory");
        } else {
            XB_SPIN(xb_ld(&bar[XB_XGEN(b.x)]) == gen, bar);
            __builtin_amdgcn_fence(__ATOMIC_ACQUIRE, "agent");
            asm volatile("s_waitcnt vmcnt(0)" ::: "memory");
        }
    }
    __syncthreads();
}
constexpr int NWAVES = 8, NTHREADS = 512;
constexpr size_t MiB = 1u << 20;
constexpr size_t WS_CTL = 0, CTL_ZERO_BYTES = 65536;
constexpr size_t WS_WGT = 128 * 1024, WS_PEB = 256 * 1024;
constexpr size_t WS_WIN = 1 * MiB, WS_WV = 6 * MiB, WS_WOUT = 8 * MiB, WS_WUP = 10 * MiB, WS_WDN = 21 * MiB, WS_ROPE = 27 * MiB, WS_GATES = 29 * MiB, WS_KCMP = 32 * MiB,
                 WS_HID = 33 * MiB, WS_VCT = 41 * MiB, WS_W1T = 42 * MiB, WS_Y = 44 * MiB, WS_ATT = 44 * MiB  ,
                 WS_H16 = 108 * MiB  , WS_PROJ = 172 * MiB, WS_VT = 340 * MiB, WS_ACT = 172 * MiB  ,
                 WS_SB = 348 * MiB  , WS_Y2 = 406 * MiB,
                 WS_DOUT = 406 * MiB  , WS_DLSE = 454 * MiB, WS_VTP = 470 * MiB, WS_END = 504 * MiB;
static_assert((size_t)3 * cM * 256 * 2 <= WS_DLSE - WS_DOUT && WS_DLSE + (size_t)3 * cM * 4 * 4 <= WS_VTP && WS_VTP + (size_t)512 * VT_LD * 2 <= WS_END && (size_t)cM * PE_LD * 2 <= WS_VT - WS_PROJ && (size_t)1024 * VT_LD * 2 <= WS_Y2 - WS_VT
              && WS_ACT + (size_t)cM * cDFF * 2 <= WS_SB && WS_SB + (size_t)(cM / 64) * 4 * 2 * cDFF * 4 <= WS_Y2 && WS_H16 + (size_t)cM * cDM * 2 <= WS_PROJ, "workspace map");
constexpr int CW_BAR = 4096;
constexpr int RING_BYTES = 131072, LDSCTL_OFF = 8 * 17408  , MISC_OFF = LDSCTL_OFF + 320, LDS_BYTES = 147456;
typedef float f32x4 __attribute__((ext_vector_type(4)));

__device__ __forceinline__ int opaque(int x) { asm volatile("" : "+v"(x)); return x; }
__device__ __forceinline__ float wave_sum(float v) {
#pragma unroll
    for (int o = 1; o < 64; o <<= 1) v += __shfl_xor(v, o);
    return v;
}
__device__ __forceinline__ void n_row_dev(const float* xrow, const float* g, bf16* yrow, int lane) {
    float v[16]; float ss = 0.f;
#pragma unroll
    for (int j = 0; j < 2; ++j)
#pragma unroll
        for (int q = 0; q < 2; ++q) { const f32x4 t = *(const f32x4*)(xrow + 8 * lane + 512 * j + 4 * q);
            v[8 * j + 4 * q + 0] = t.x; v[8 * j + 4 * q + 1] = t.y; v[8 * j + 4 * q + 2] = t.z; v[8 * j + 4 * q + 3] = t.w; ss += t.x * t.x + t.y * t.y + t.z * t.z + t.w * t.w; }
    const float r = 1.f / sqrtf(wave_sum(ss) * (1.f / cDM) + 1e-6f);
#pragma unroll
    for (int j = 0; j < 2; ++j) { const float* gp = g + 8 * lane + 512 * j; U4 o;
        o.x = cvtpk(v[8 * j + 0] * r * gp[0], v[8 * j + 1] * r * gp[1]); o.y = cvtpk(v[8 * j + 2] * r * gp[2], v[8 * j + 3] * r * gp[3]);
        o.z = cvtpk(v[8 * j + 4] * r * gp[4], v[8 * j + 5] * r * gp[5]); o.w = cvtpk(v[8 * j + 6] * r * gp[6], v[8 * j + 7] * r * gp[7]);
        *(U4*)(yrow + 8 * lane + 512 * j) = o; }
}
template <bool HIN_F32, bool HOUT_F32>
__device__ __forceinline__ void nrn_row_dev(const void* hin_, const bf16* y2, const float* g1, const float* g2, void* hout_, bf16* yrow, int lane) {
    float v[16]; float ss = 0.f;
#pragma unroll
    for (int j = 0; j < 2; ++j) { const U4 t = *(const U4*)(y2 + 8 * lane + 512 * j);
        v[8 * j + 0] = bflo(t.x); v[8 * j + 1] = bfhi(t.x); v[8 * j + 2] = bflo(t.y); v[8 * j + 3] = bfhi(t.y); v[8 * j + 4] = bflo(t.z); v[8 * j + 5] = bfhi(t.z); v[8 * j + 6] = bflo(t.w); v[8 * j + 7] = bfhi(t.w); }
#pragma unroll
    for (int e = 0; e < 16; ++e) ss += v[e] * v[e];
    const float r = 1.f / sqrtf(wave_sum(ss) * (1.f / cDM) + 1e-6f);
    float s2 = 0.f;
#pragma unroll
    for (int j = 0; j < 2; ++j) { const int e0 = 8 * lane + 512 * j; float hv[8];
        if (HIN_F32) { const f32x4 a = *(const f32x4*)((const float*)hin_ + e0), b = *(const f32x4*)((const float*)hin_ + e0 + 4); hv[0] = a.x; hv[1] = a.y; hv[2] = a.z; hv[3] = a.w; hv[4] = b.x; hv[5] = b.y; hv[6] = b.z; hv[7] = b.w; }
        else { const U4 t = *(const U4*)((const bf16*)hin_ + e0); hv[0] = bflo(t.x); hv[1] = bfhi(t.x); hv[2] = bflo(t.y); hv[3] = bfhi(t.y); hv[4] = bflo(t.z); hv[5] = bfhi(t.z); hv[6] = bflo(t.w); hv[7] = bfhi(t.w); }
        const f32x4 ga = *(const f32x4*)(g1 + e0), gb = *(const f32x4*)(g1 + e0 + 4); const float gg[8] = {ga.x, ga.y, ga.z, ga.w, gb.x, gb.y, gb.z, gb.w};
#pragma unroll
        for (int e = 0; e < 8; ++e) { const float hn = hv[e] + v[8 * j + e] * r * gg[e]; v[8 * j + e] = hn; }
        if (HOUT_F32) { f32x4 a, b; a.x = v[8 * j]; a.y = v[8 * j + 1]; a.z = v[8 * j + 2]; a.w = v[8 * j + 3]; b.x = v[8 * j + 4]; b.y = v[8 * j + 5]; b.z = v[8 * j + 6]; b.w = v[8 * j + 7];
            *(f32x4*)((float*)hout_ + e0) = a; *(f32x4*)((float*)hout_ + e0 + 4) = b; }
        else { U4 o; o.x = cvtpk(v[8 * j], v[8 * j + 1]); o.y = cvtpk(v[8 * j + 2], v[8 * j + 3]);
            o.z = cvtpk(v[8 * j + 4], v[8 * j + 5]); o.w = cvtpk(v[8 * j + 6], v[8 * j + 7]);
            *(U4*)((bf16*)hout_ + e0) = o;
            v[8 * j + 0] = bflo(o.x); v[8 * j + 1] = bfhi(o.x); v[8 * j + 2] = bflo(o.y); v[8 * j + 3] = bfhi(o.y); v[8 * j + 4] = bflo(o.z); v[8 * j + 5] = bfhi(o.z); v[8 * j + 6] = bflo(o.w); v[8 * j + 7] = bfhi(o.w); }
#pragma unroll
        for (int e = 0; e < 8; ++e) s2 += v[8 * j + e] * v[8 * j + e]; }
    if (g2) { const float r2 = 1.f / sqrtf(wave_sum(s2) * (1.f / cDM) + 1e-6f);
#pragma unroll
        for (int j = 0; j < 2; ++j) { const float* gp = g2 + 8 * lane + 512 * j; U4 o;
            o.x = cvtpk(v[8 * j + 0] * r2 * gp[0], v[8 * j + 1] * r2 * gp[1]); o.y = cvtpk(v[8 * j + 2] * r2 * gp[2], v[8 * j + 3] * r2 * gp[3]);
            o.z = cvtpk(v[8 * j + 4] * r2 * gp[4], v[8 * j + 5] * r2 * gp[5]); o.w = cvtpk(v[8 * j + 6] * r2 * gp[6], v[8 * j + 7] * r2 * gp[7]);
            *(U4*)(yrow + 8 * lane + 512 * j) = o; } }
}

template <int K, int ldw, int N, int mode, int c0>
__device__ __forceinline__ void wprep_tile(const float* W, bf16* Bt, int tile, int lane, LAS float* scr) {
    constexpr int nblk = N / 32; const int kb = tile / nblk, nb = tile % nblk, k0 = 64 * kb, n0 = 32 * nb;
    const int c4 = 4 * (lane & 7), col = c0 + (mode ? wsrc_col(mode, n0 + c4) : n0 + c4);
#pragma unroll
    for (int i = 0; i < 8; ++i) { const int kk = 8 * i + (lane >> 3); const f32x4 t = *(const f32x4*)(W + (size_t)(k0 + kk) * ldw + col);
        scr[kk * 33 + c4] = t.x; scr[kk * 33 + c4 + 1] = t.y; scr[kk * 33 + c4 + 2] = t.z; scr[kk * 33 + c4 + 3] = t.w; }
    const int c = lane & 7;
#pragma unroll
    for (int j = 0; j < 4; ++j) { const int n = (lane >> 3) + 8 * j; const LAS float* s = scr + (8 * c) * 33 + n;
        U4 o; o.x = cvtpk(s[0], s[33]); o.y = cvtpk(s[2 * 33], s[3 * 33]);
        o.z = cvtpk(s[4 * 33], s[5 * 33]); o.w = cvtpk(s[6 * 33], s[7 * 33]);
        *(U4*)(Bt + (size_t)(n0 + n) * K + k0 + 8 * c) = o; }
    asm volatile("s_waitcnt lgkmcnt(0)" ::: "memory");
}
struct Args { const float* in[13]; float* out; unsigned char* ws; };

__global__ void __launch_bounds__(NTHREADS, 2) fwd(Args a) {
    extern __shared__ __attribute__((aligned(16))) unsigned char lds[];
    LAS unsigned char* L = (LAS unsigned char*)lds;
    const int tid = threadIdx.x, lane = tid & 63, wave = __builtin_amdgcn_readfirstlane(tid >> 6);
#define VCU() ((gridDim.x % 8 == 0) ? (int)((blockIdx.x % 8) * (gridDim.x / 8) + blockIdx.x / 8) : (int)blockIdx.x)
    for (int u = tid; u < (LDS_BYTES - LDSCTL_OFF) / 4; u += NTHREADS) ((LAS unsigned*)(L + LDSCTL_OFF))[u] = 0u;
    __syncthreads();
    XcdBarrier bar;
    { unsigned char* ws0 = a.ws; bar = xcd_barrier_post((unsigned*)(ws0 + WS_CTL) + CW_BAR, (volatile LAS unsigned*)(L + MISC_OFF) + 8); }
#define MKP() P p; unsigned char* wsb; { int z_ = 0; asm volatile("" : "+s"(z_)); unsigned char* ws = a.ws + z_; wsb = ws; const float* const* in_ = a.in + z_; \
    p.x = in_[0]; p.norm_g = in_[1]; p.even_w_in = in_[2]; p.even_w_out = in_[3]; p.cmp_pe = in_[4]; p.cmp_w1 = in_[5]; p.cmp_w2 = in_[6]; p.odd_w_in = in_[7]; p.odd_w_out = in_[8]; \
    p.ffn_w_up = in_[9]; p.ffn_conv_w = in_[10]; p.ffn_conv_b = in_[11]; p.ffn_w_down = in_[12]; p.out = (&a.out)[z_]; \
    p.Wt_in = (bf16*)(ws + WS_WIN); p.Wt_out = (bf16*)(ws + WS_WOUT); p.Wt_up = (bf16*)(ws + WS_WUP); p.Wt_dn = (bf16*)(ws + WS_WDN); \
    p.ROPE = (float*)(ws + WS_ROPE); p.GATES = (float*)(ws + WS_GATES); p.KCMP = (bf16*)(ws + WS_KCMP); \
    p.HID = (float*)(ws + WS_HID); p.Y = (bf16*)(ws + WS_Y); p.PROJ = (bf16*)(ws + WS_PROJ); p.ATT = (bf16*)(ws + WS_ATT); p.Y2 = (bf16*)(ws + WS_Y2); \
    p.ACT = (bf16*)(ws + WS_ACT); p.VT = (bf16*)(ws + WS_VT); p.VCT = (bf16*)(ws + WS_VCT); }

#define GRUN(N, call) do { const long _n = (long)(N); const long gthreads = (long)gridDim.x * NTHREADS; for (long i = (long)blockIdx.x * NTHREADS + opaque((int)threadIdx.x); i < _n; i += gthreads) { call; } } while (0)
#define GRID_BAR() xcd_barrier(bar)
#define GEMM_E(EpiT, Einit, Aptr, Btptr, Mrows, Ncols, Kdim) do { pg8::Gemm g{(const pg8::bf16_t*)(Aptr), (const pg8::bf16_t*)(Btptr), (int)(Mrows), (int)(Ncols), (int)(Kdim)}; \
        pg8::StaticOrder S; S.init((int)(Mrows), (int)(Ncols), (int)gridDim.x, (int)blockIdx.x); EpiT E Einit; \
        pg8::gemm_phase<EpiT, pg8::StaticOrder, true, true>(L, g, S, E); } while (0)
#define COMMA ,
#define GEMM(Aptr, Btptr, Mrows, Ncols, Kdim, Optr, ldo) GEMM_E(pg8::EpiBf16<0>, {(pg8::bf16_t*)(Optr) COMMA (int)(ldo) COMMA nullptr COMMA 0 COMMA 0 COMMA 1.f}, Aptr, Btptr, Mrows, Ncols, Kdim)
#define WT(Wp, K_, ldw_, N_, Btp, mode_, c0_) do { const int nt_ = ((N_) / 32) * ((K_) / 64); LAS float* scr_ = (LAS float*)(L + wave * 17408); \
        for (int t_ = blockIdx.x * NWAVES + wave; t_ < nt_; t_ += gridDim.x * NWAVES) wprep_tile<(K_), (ldw_), (N_), (mode_), (c0_)>((Wp), (Btp), t_, lane, scr_); } while (0)
#define WPREP(LL) do { const int _li = (LL) / 2; \
        if (((LL) & 1) == 0) { const float* W = p.even_w_in + (size_t)_li * cDM * EIN_W; \
            WT(W, cDM, EIN_W, LDE2, p.Wt_in, 1, 0); \
            WT(W, cDM, EIN_W, 1024, (bf16*)(wsb + WS_WV), 2, 0); \
            WT(p.even_w_out + (size_t)_li * 768 * cDM, 768, cDM, cDM, p.Wt_out, 0, 0); \
            WT(W, cDM, EIN_W, 32, (bf16*)(wsb + WS_WGT), 0, 1280); \
            WT(p.cmp_w1 + ((size_t)_li * 2 + 0) * 2048 * 256, 2048, 256, 256, (bf16*)(wsb + WS_W1T), 0, 0); \
            WT(p.cmp_w1 + ((size_t)_li * 2 + 1) * 2048 * 256, 2048, 256, 256, (bf16*)(wsb + WS_W1T) + (size_t)256 * 2048, 0, 0); \
            GRUN(512, peb_item(p.cmp_pe + (size_t)_li * 2 * 2048, p.cmp_w1 + (size_t)_li * 2 * 2048 * 256, (float*)(wsb + WS_PEB), i)); } \
        else { const float* W = p.odd_w_in + (size_t)_li * cDM * 3 * cDM; \
            WT(W, cDM, 3 * cDM, 2 * cDM, p.Wt_in, 0, 0); \
            WT(W, cDM, 3 * cDM, cDM, (bf16*)(wsb + WS_WV), 0, 2 * cDM); \
            WT(p.odd_w_out + (size_t)_li * cDM * cDM, cDM, cDM, cDM, p.Wt_out, 0, 0); } \
        WT(p.ffn_w_up + (size_t)(LL) * cDM * 2 * cDFF, cDM, 2 * cDFF, 2 * cDFF, p.Wt_up, 3, 0); \
        WT(p.ffn_w_down + (size_t)(LL) * cDFF * cDM, cDFF, cDM, cDM, p.Wt_dn, 0, 0); } while (0)
#define NRN(FIN, FOUT, hin_, hout_, g1_, g2_) do { for (long r = blockIdx.x * NWAVES + wave; r < cM; r += gridDim.x * NWAVES) nrn_row_dev<FIN, FOUT>((hin_) + r * cDM, p.Y2 + r * cDM, (g1_), (g2_), (hout_) + r * cDM, p.Y + r * cDM, lane); } while (0)
#define H16P ((bf16*)(wsb + WS_H16))
#define FFN(LL) do { \
        { MKP(); GEMM_E(pg8::EpiConvGelu, {(pg8::bf16_t*)p.ACT COMMA p.ffn_conv_w + (size_t)(LL) * 3 * 2 * cDFF COMMA p.ffn_conv_b + (size_t)(LL) * 2 * cDFF COMMA (float*)(wsb + WS_SB)}, p.Y, p.Wt_up, cM, 2 * cDFF, cDM); } GRID_BAR(); \
        { MKP(); GRUN((long)(cM / 64) * 2 * (cDFF / 4), convfix_item(p, (const float*)(wsb + WS_SB), p.ffn_conv_w + (size_t)(LL) * 3 * 2 * cDFF, p.ffn_conv_b + (size_t)(LL) * 2 * cDFF, i)); } GRID_BAR(); \
        { MKP(); GEMM(p.ACT, p.Wt_dn, cM, cDM, cDFF, p.Y2, cDM); } GRID_BAR(); \
        { MKP(); const float* ng = p.norm_g + (size_t)(LL) * 4 * cDM; if ((LL) + 1 < 4) NRN(false, false, H16P, H16P, ng + 3 * cDM, ng + 4 * cDM); else NRN(false, true, H16P, p.out, ng + 3 * cDM, (const float*)nullptr); \
          if ((LL) + 1 < 4) WPREP((LL) + 1); } GRID_BAR(); } while (0)
#define EVEN_LAYER(lp) do { const int LL = 2 * (lp); \
          { MKP(); GEMM_E(pg8::EpiRopeE, {(pg8::bf16_t*)p.PROJ COMMA PE_LD COMMA p.ROPE}, p.Y, p.Wt_in, cM, LDE2, cDM); } \
          { MKP(); GEMM_E(pg8::EpiVT, {(pg8::bf16_t*)p.VT}, (const bf16*)(wsb + WS_WV), p.Y, 1024, cM, cDM); } GRID_BAR();            \
          { MKP(); GRUN((long)512 * cB * (cS / 128), vtp_item(p.VT, (bf16*)(wsb + WS_VTP), i)); for (int u = blockIdx.x * NWAVES + wave; u < cM / 32; u += gridDim.x * NWAVES) gates_unit(p, (const bf16*)(wsb + WS_WGT), u, lane); \
            for (int u = blockIdx.x * NWAVES + wave; u < 2048; u += gridDim.x * NWAVES) cmp1_unit(p, (const bf16*)(wsb + WS_W1T), (const float*)(wsb + WS_PEB), u, lane); } GRID_BAR(); \
          { MKP(); GRUN((long)2 * cB * cNC * 2 * 32, cmp2_item(p, p.cmp_w2 + (size_t)(lp) * 2 * 256 * 64, i)); } GRID_BAR(); \
          { MKP(); const int ngw = gridDim.x * NWAVES; bf16* DO_ = (bf16*)(wsb + WS_DOUT); float* DL_ = (float*)(wsb + WS_DLSE); const bf16* VP_ = (const bf16*)(wsb + WS_VTP); \
              \
            for (int u = VCU() * NWAVES + wave; u < cB * 4 * 256; u += ngw) { const int bh = u >> 8, x = u & 255; \
                dil_unit<0>(p, p.VT, VP_, DO_, DL_, L + wave * 17408, bh >> 2, bh & 3, 0, x, lane); \
                dil_unit<1>(p, p.VT, VP_, DO_, DL_, L + wave * 17408, bh >> 2, bh & 3, x >> 6, x & 63, lane); \
                dil_unit<2>(p, p.VT, VP_, DO_, DL_, L + wave * 17408, bh >> 2, bh & 3, x >> 4, x & 15, lane); } } \
          { MKP(); const int ngw = gridDim.x * NWAVES, NT = cS / 8; LAS unsigned char* wl = L + wave * 17408; \
              \
            for (int u = VCU() * NWAVES + wave; u < cB * 2 * NT; u += ngw) { const int gw = u % ngw, k = u / ngw; int bg, tile; \
                if (ngw == 2048) { bg = gw >> 8; const int i = gw & 255; tile = 256 * k + ((k & 1) ? 255 - i : i); } else { bg = u / NT; tile = u % NT; } \
                nsa_unit(p, p.VCT, p.VT, wl, bg >> 1, bg & 1, tile * 8, lane); } } GRID_BAR(); \
          { MKP(); GRUN((long)cM * 32, dil_combine_item(p, (const bf16*)(wsb + WS_DOUT), (const float*)(wsb + WS_DLSE), i)); } GRID_BAR(); \
          { MKP(); GEMM(p.ATT, p.Wt_out, cM, cDM, 768, p.Y2, cDM); } GRID_BAR(); \
          { MKP(); const float* ng = p.norm_g + (size_t)LL * 4 * cDM; if ((lp) == 0) NRN(true, false, p.x, H16P, ng + cDM, ng + 2 * cDM); else NRN(false, false, H16P, H16P, ng + cDM, ng + 2 * cDM); } GRID_BAR(); \
          FFN(LL); } while (0)
#define ODD_LAYER(lp) do { const int LL = 2 * (lp) + 1; \
          { MKP(); GEMM(p.Y, p.Wt_in, cM, LDO2, cDM, p.PROJ, PO_LD); } \
          { MKP(); GEMM_E(pg8::EpiVT, {(pg8::bf16_t*)p.VT}, (const bf16*)(wsb + WS_WV), p.Y, 1024, cM, cDM); } GRID_BAR(); \
          { MKP(); const int NT = cS / 32; for (int u = VCU() * NWAVES + wave; u < cB * cNSB * NT; u += gridDim.x * NWAVES) { const int bh = u / NT; \
                sb_unit(p, p.VT, L + wave * 17408, bh / cNSB, bh % cNSB, (u % NT) * 32, lane); } } GRID_BAR(); \
          { MKP(); GEMM(p.ATT, p.Wt_out, cM, cDM, cDM, p.Y2, cDM); } GRID_BAR(); \
          { MKP(); const float* ng = p.norm_g + (size_t)LL * 4 * cDM; NRN(false, false, H16P, H16P, ng + cDM, ng + 2 * cDM); } GRID_BAR(); \
          FFN(LL); } while (0)

    { MKP();
      GRUN((long)cS * 32, rope_table_item(p, i));
      WPREP(0);
      for (long r = blockIdx.x * NWAVES + wave; r < cM; r += gridDim.x * NWAVES) n_row_dev(p.x + r * cDM, p.norm_g, p.Y + r * cDM, lane); }
    GRID_BAR();
    EVEN_LAYER(0); ODD_LAYER(0); EVEN_LAYER(1); ODD_LAYER(1);
}

extern "C" void kernel_launch(void* const* d_in, const int* in_sizes, int n_in, void* d_out, int out_size, void* d_ws, size_t ws_size, hipStream_t stream) {
    static int grid = 0;
    if (grid == 0) {
        if (n_in != 13 || out_size != cM * cDM || ws_size < WS_END) { fprintf(stderr, "kernel_launch: unexpected shapes (n_in %d out %d ws %zu)\n", n_in, out_size, ws_size); grid = -1; return; }
        int dev = 0, cus = 0;
        if (hipGetDevice(&dev) != hipSuccess || hipDeviceGetAttribute(&cus, hipDeviceAttributeMultiprocessorCount, dev) != hipSuccess) { grid = -1; return; }
        if (hipFuncSetAttribute((const void*)fwd, hipFuncAttributeMaxDynamicSharedMemorySize, LDS_BYTES) != hipSuccess) { grid = -1; return; }
        int per_cu = 0; (void)hipOccupancyMaxActiveBlocksPerMultiprocessor(&per_cu, (const void*)fwd, NTHREADS, LDS_BYTES); (void)hipGetLastError();
        grid = cus;
    }
    if (grid < 0) return;
    (void)hipMemsetAsync((char*)d_ws + WS_CTL, 0, CTL_ZERO_BYTES, stream);
    Args a{};
    for (int i = 0; i < 13; ++i) a.in[i] = (const float*)d_in[i];
    a.out = (float*)d_out; a.ws = (unsigned char*)d_ws;
    hipLaunchKernelGGL(fwd, dim3(grid), dim3(NTHREADS), LDS_BYTES, stream, a);
}
```

```cpp
#include <hip/hip_runtime.h>
#include <cstdio>
#include <cstdint>
#include <cmath>
#ifdef HOST_TEST
#include <cmath>
#include <cstring>
#include <cstdio>
#include <cstdlib>
#define HD
static int cB = 1, cS = 1024, cDM = 128, cDFF = 192;
#else
#define HD __device__ __forceinline__
constexpr int cB = 4, cS = 8192, cDM = 1024, cDFF = 2816;
#endif
typedef unsigned short bf16;
#define cM (cB * cS)
#define cNC ((cS - 32) / 16 + 1)
#define cNS (cS / 64)
#define cTOPN (cNS < 16 ? cNS : 16)
#define cNSB (cDM / 64)
#define LDE 3584
#define LDE2 2560
#define LDO2 2048
#define LDO (3 * cDM)
#define EIN_W 3608
#define KCMP_ROWS 512
#define PE_LD (LDE2 + 128)
#define PO_LD (LDO2 + 128)
#define VT_LD (cM + 128)
#define VCT_LD (KCMP_ROWS + 128)

struct alignas(16) U4 { unsigned x, y, z, w; };
HD float u2f(unsigned u) { float f; __builtin_memcpy(&f, &u, 4); return f; }
HD unsigned f2u(float f) { unsigned u; __builtin_memcpy(&u, &f, 4); return u; }
HD float bf2f(bf16 v) { return u2f((unsigned)v << 16); }
HD bf16 f2bf(float f) { unsigned u = f2u(f); return (bf16)((u + 0x7fffu + ((u >> 16) & 1u)) >> 16); }
HD unsigned pk2bf(float lo, float hi) {
#if defined(__HIP_DEVICE_COMPILE__)
    typedef float pk2f_t __attribute__((ext_vector_type(2))); typedef __bf16 pk2b_t __attribute__((ext_vector_type(2)));
    pk2f_t v = {lo, hi}; pk2b_t b = __builtin_convertvector(v, pk2b_t); return __builtin_bit_cast(unsigned, b);
#else
    return (unsigned)f2bf(lo) | ((unsigned)f2bf(hi) << 16);
#endif
}
HD float fast_exp2(float x) {
#if defined(__HIP_DEVICE_COMPILE__)
    return __builtin_amdgcn_exp2f(x);
#else
    return exp2f(x);
#endif
}
HD float fast_rcp(float x) {
#if defined(__HIP_DEVICE_COMPILE__)
    return __builtin_amdgcn_rcpf(x);
#else
    return 1.f / x;
#endif
}
HD float bflo(unsigned w) { return u2f(w << 16); }
HD float bfhi(unsigned w) { return u2f(w & 0xffff0000u); }

struct P {
    const float *x, *norm_g, *even_w_in, *even_w_out, *cmp_pe, *cmp_w1, *cmp_w2, *odd_w_in, *odd_w_out, *ffn_w_up, *ffn_conv_w, *ffn_conv_b, *ffn_w_down;
    float* out;
    bf16 *Wt_in, *Wt_out, *Wt_up, *Wt_dn;
    float* ROPE;
    float* GATES;
    bf16* KCMP;
    float* HID;
    bf16 *Y, *PROJ, *ATT, *Y2, *ACT;
    bf16* VT;
    bf16* VCT;
};

HD float gelu_tanh(float x) { return 0.5f * x * (1.f + tanhf(0.7978845608028654f * (x + 0.044715f * x * x * x))); }

HD void rope_table_item(const P& p, long idx) {
    const int pos = (int)(idx / 32), i = (int)(idx % 32);
    const double ang = (double)pos * pow(10000.0, -(double)i / 32.0);
    p.ROPE[idx * 2] = (float)cos(ang); p.ROPE[idx * 2 + 1] = (float)sin(ang);
}
HD void cmp2_item(const P& p, const float* w2, long idx) {
    const int i = (int)(idx % 32), g = (int)((idx / 32) % 2), n = (int)((idx / 64) % cNC), b = (int)((idx / (64L * cNC)) % cB), which = (int)(idx / (64L * cNC * cB));
    const float* hid = p.HID + ((((size_t)which * cB + b) * cNC + n) * 2 + g) * 256; const float* ww = w2 + (size_t)which * 256 * 64;
    float a1 = 0.f, a2 = 0.f;
    for (int j = 0; j < 256; ++j) { a1 += hid[j] * ww[j * 64 + i]; a2 += hid[j] * ww[j * 64 + i + 32]; }
    bf16* o = p.KCMP + (((size_t)b * KCMP_ROWS + n) * 2 + g) * 64;
    if (which == 0) { const int pos = 16 * n + 31; const float c = p.ROPE[(pos * 32 + i) * 2], s = p.ROPE[(pos * 32 + i) * 2 + 1];
        o[i] = f2bf(a1 * c - a2 * s); o[i + 32] = f2bf(a2 * c + a1 * s); }
    else { bf16* ot = p.VCT + ((size_t)(b * 2 + g) * 64 + i) * VCT_LD + n; ot[0] = f2bf(a1); ot[(size_t)32 * VCT_LD] = f2bf(a2);
        if (n == 0) { ot[511] = 0; ot[(size_t)32 * VCT_LD + 511] = 0; } }
    if (which == 0 && n == 0) { bf16* oz = p.KCMP + (((size_t)b * KCMP_ROWS + 511) * 2 + g) * 64; oz[i] = 0; oz[i + 32] = 0; }
}
HD void peb_item(const float* pe, const float* w1, float* PEB, long idx) {
    const int j = (int)(idx % 256), which = (int)(idx / 256);
    float acc = 0.f;
    for (int k = 0; k < 2048; ++k) acc += pe[(size_t)which * 2048 + k] * w1[((size_t)which * 2048 + k) * 256 + j];
    PEB[idx] = acc;
}
HD int wsrc_col(int mode, int n) {
    if (mode == 1) { const int u = n >> 8, c = n & 255, hiu = c >> 6, w = c & 63;
        if (u == 2) return 512 + c;
        const int d = (w & 7) < 4 ? 4 * (w >> 3) + (w & 7) : 32 + 4 * (w >> 3) + ((w & 7) - 4);
        int base;
        if (u < 2) base = 64 * (4 * u + hiu); else if (u == 3) base = hiu < 2 ? 768 + 64 * hiu : 1024 + 64 * (hiu - 2);
        else if (u < 7) base = 1304 + 64 * (4 * (u - 4) + hiu); else base = 1304 + 768 + 64 * (4 * (u - 7) + hiu);
        return base + d; }
    if (mode == 2) return n < 128 ? 896 + n : n < 256 ? 1152 + (n - 128) : 2840 + (n - 256);
    if (mode == 3) { const int pn = n >> 8, bj = (n >> 7) & 1, x = n & 127; return bj * cDFF + 128 * pn + x; }
    return n;
}
HD float gelu_fast_h(float x) { const float z = x + 0.044715f * x * x * x; return x * fast_rcp(1.f + fast_exp2(-2.3022081981f * z)); }
struct alignas(16) F4 { float v[4]; };
HD void convfix_item(const P& p, const float* SB, const float* cw, const float* cb, long idx) {
    constexpr int Q = cDFF / 4; const int j = 4 * (int)(idx % Q), rr = (int)((idx / Q) % 2); const long blk = idx / (2L * Q); const long row = blk * 64 + rr; const int t = (int)(row % cS), LD2 = 2 * cDFF;
    const float* s0 = SB + ((size_t)blk * 4 + rr) * LD2; const float* sp = SB + ((size_t)(blk - 1) * 4) * LD2;
    const float* sm = SB + ((size_t)blk * 4) * LD2;
#define LD4(ptr) (*(const F4*)(ptr))
    const F4 bg = LD4(cb + j), bv = LD4(cb + cDFF + j), w2g = LD4(cw + 2 * LD2 + j), w2v = LD4(cw + 2 * LD2 + cDFF + j), w1g = LD4(cw + LD2 + j), w1v = LD4(cw + LD2 + cDFF + j), w0g = LD4(cw + j), w0v = LD4(cw + cDFF + j);
    const F4 ug = LD4(s0 + j), uv = LD4(s0 + cDFF + j);
    F4 g1 = {{0.f, 0.f, 0.f, 0.f}}, v1 = g1, g2 = g1, v2 = g1;
    if (rr == 0) { if (t >= 1) { g1 = LD4(sp + 3 * LD2 + j); v1 = LD4(sp + 3 * LD2 + cDFF + j); g2 = LD4(sp + 2 * LD2 + j); v2 = LD4(sp + 2 * LD2 + cDFF + j); } }
    else { g1 = LD4(sm + j); v1 = LD4(sm + cDFF + j); if (t >= 2) { g2 = LD4(sp + 3 * LD2 + j); v2 = LD4(sp + 3 * LD2 + cDFF + j); } }
#undef LD4
    float o[4];
#pragma unroll
    for (int e = 0; e < 4; ++e) { const float cg = bg.v[e] + w2g.v[e] * ug.v[e] + w1g.v[e] * g1.v[e] + w0g.v[e] * g2.v[e], cv = bv.v[e] + w2v.v[e] * uv.v[e] + w1v.v[e] * v1.v[e] + w0v.v[e] * v2.v[e];
        o[e] = gelu_fast_h(cg) * cv; }
    uint2 w; w.x = pk2bf(o[0], o[1]); w.y = pk2bf(o[2], o[3]);
    *(uint2*)(p.ACT + (size_t)row * cDFF + j) = w;
}
HD size_t vt_tile_off(int ngrp, int b, int grp, int tile) { return (((size_t)b * ngrp + grp) * (cS / 32) + tile) * 2048; }
HD size_t vt_elem_off(int ngrp, int b, int dg, int tk) { return vt_tile_off(ngrp, b, dg >> 6, tk >> 5) + (size_t)(dg & 63) * 32 + (tk & 31); }
template <int dil> HD void vtp_run(const bf16* src, bf16* VTP, int b, int pr, int G) {
    unsigned in[64];
#pragma unroll
    for (int q = 0; q < 4; ++q)
#pragma unroll
        for (int c = 0; c < 4; ++c) { const U4 v = *(const U4*)(src + (size_t)q * 2048 + 8 * c); in[16 * q + 4 * c] = v.x; in[16 * q + 4 * c + 1] = v.y; in[16 * q + 4 * c + 2] = v.z; in[16 * q + 4 * c + 3] = v.w; }
    constexpr int per = cS / dil, nm = 128 / dil;
#pragma unroll
    for (int rc = 0; rc < dil; ++rc)
#pragma unroll
        for (int o8 = 0; o8 < nm / 8; ++o8) { unsigned w[4];
#pragma unroll
            for (int e = 0; e < 4; ++e) { const int t0_ = dil * (8 * o8 + 2 * e) + rc, t1_ = t0_ + dil;
                const unsigned lo = (t0_ & 1) ? (in[t0_ >> 1] >> 16) : (in[t0_ >> 1] & 0xFFFFu), hi = (t1_ & 1) ? (in[t1_ >> 1] & 0xFFFF0000u) : (in[t1_ >> 1] << 16);
                w[e] = lo | hi; }
            U4 v; v.x = w[0]; v.y = w[1]; v.z = w[2]; v.w = w[3];
            *(U4*)(VTP + vt_elem_off(8, b, pr, rc * per + nm * G + 8 * o8)) = v; }
}
HD void vtp_item(const bf16* VT, bf16* VTP, long idx) {
    const int ng = cS / 128; const int G = (int)(idx % ng), b = (int)((idx / ng) % cB), pr = (int)(idx / ((long)ng * cB));
    const bf16* src = VT + vt_elem_off(16, b, 512 + pr, 128 * G);
    if (pr < 256) vtp_run<4>(src, VTP, b, pr, G); else vtp_run<16>(src, VTP, b, pr, G);
}
HD void dil_combine_item(const P& p, const bf16* DOUT, const float* DLSE, long idx) {
    const int c8 = (int)(idx % 8), hd = (int)((idx / 8) % 4); const long row = idx / 32;
    const float l0 = DLSE[((size_t)0 * cM + row) * 4 + hd], l1 = DLSE[((size_t)1 * cM + row) * 4 + hd], l2 = DLSE[((size_t)2 * cM + row) * 4 + hd];
    const float mx = fmaxf(l0, fmaxf(l1, l2)), e0 = fast_exp2(l0 - mx), e1 = fast_exp2(l1 - mx), e2 = fast_exp2(l2 - mx), rs = fast_rcp(e0 + e1 + e2);
    const U4 a = *(const U4*)(DOUT + ((size_t)0 * cM + row) * 256 + hd * 64 + 8 * c8), bq = *(const U4*)(DOUT + ((size_t)1 * cM + row) * 256 + hd * 64 + 8 * c8), cq = *(const U4*)(DOUT + ((size_t)2 * cM + row) * 256 + hd * 64 + 8 * c8);
    const float w0 = e0 * rs, w1 = e1 * rs, w2 = e2 * rs;
    U4 o;
    o.x = pk2bf(w0 * bflo(a.x) + w1 * bflo(bq.x) + w2 * bflo(cq.x), w0 * bfhi(a.x) + w1 * bfhi(bq.x) + w2 * bfhi(cq.x));
    o.y = pk2bf(w0 * bflo(a.y) + w1 * bflo(bq.y) + w2 * bflo(cq.y), w0 * bfhi(a.y) + w1 * bfhi(bq.y) + w2 * bfhi(cq.y));
    o.z = pk2bf(w0 * bflo(a.z) + w1 * bflo(bq.z) + w2 * bflo(cq.z), w0 * bfhi(a.z) + w1 * bfhi(bq.z) + w2 * bfhi(cq.z));
    o.w = pk2bf(w0 * bflo(a.w) + w1 * bflo(bq.w) + w2 * bflo(cq.w), w0 * bfhi(a.w) + w1 * bfhi(bq.w) + w2 * bfhi(cq.w));
    *(U4*)(p.ATT + (size_t)row * 768 + 512 + hd * 64 + 8 * c8) = o;
}
#define LAS __attribute__((address_space(3)))
typedef short bf16x8v __attribute__((ext_vector_type(8)));
typedef short bf16x4v __attribute__((ext_vector_type(4)));
typedef float f32x16 __attribute__((ext_vector_type(16)));
typedef float f32x2_t __attribute__((ext_vector_type(2)));
typedef float f32x4v __attribute__((ext_vector_type(4)));
typedef __bf16 bf16x2_t __attribute__((ext_vector_type(2)));
__device__ __forceinline__ unsigned cvtpk(float lo, float hi) { f32x2_t v = {lo, hi}; bf16x2_t b = __builtin_convertvector(v, bf16x2_t); return __builtin_bit_cast(unsigned, b); }
__device__ __forceinline__ float fexp2(float x) { return __builtin_amdgcn_exp2f(x); }
#define ATT_C2 (0.125f * 1.4426950408889634f)
#define ATT_NEG (-1e30f)
#define ATT_THR 8.0f

typedef unsigned u32x2v __attribute__((ext_vector_type(2)));
__device__ __forceinline__ float vmax2(float a, float b) { float d; asm("v_max_f32 %0, %1, %2" : "=v"(d) : "v"(a), "v"(b)); return d; }
__device__ __forceinline__ float vmax3(float a, float b, float c) { float d; asm("v_max3_f32 %0, %1, %2, %3" : "=v"(d) : "v"(a), "v"(b), "v"(c)); return d; }
__device__ __forceinline__ float vmax16(const f32x16& s) {
    const float a = vmax3(s[0], s[1], s[2]), b = vmax3(s[3], s[4], s[5]), c = vmax3(s[6], s[7], s[8]), d = vmax3(s[9], s[10], s[11]), e = vmax3(s[12], s[13], s[14]);
    return vmax2(vmax3(vmax3(a, b, c), d, e), s[15]); }
__device__ __forceinline__ float vmax16_acc(const f32x16& s) { float d;
    asm("s_nop 11\n\tv_max3_f32 %0, %1, %2, %3\n\tv_max3_f32 %0, %0, %4, %5\n\tv_max3_f32 %0, %0, %6, %7\n\tv_max3_f32 %0, %0, %8, %9\n\t"
        "v_max3_f32 %0, %0, %10, %11\n\tv_max3_f32 %0, %0, %12, %13\n\tv_max3_f32 %0, %0, %14, %15\n\tv_max_f32 %0, %0, %16"
        : "=&v"(d) : "v"(s[0]), "v"(s[1]), "v"(s[2]), "v"(s[3]), "v"(s[4]), "v"(s[5]), "v"(s[6]), "v"(s[7]), "v"(s[8]), "v"(s[9]), "v"(s[10]), "v"(s[11]), "v"(s[12]), "v"(s[13]), "v"(s[14]), "v"(s[15]));
    return d; }
#define OPQ(x) asm("" : "+v"(x))
__device__ __forceinline__ float vsum16(const f32x16& s) {
    float a0 = s[0] + s[1], a1 = s[2] + s[3], a2 = s[4] + s[5], a3 = s[6] + s[7], a4 = s[8] + s[9], a5 = s[10] + s[11], a6 = s[12] + s[13], a7 = s[14] + s[15];
    OPQ(a0); OPQ(a1); OPQ(a2); OPQ(a3); OPQ(a4); OPQ(a5); OPQ(a6); OPQ(a7);
    float b0 = a0 + a1, b1 = a2 + a3, b2 = a4 + a5, b3 = a6 + a7; OPQ(b0); OPQ(b1); OPQ(b2); OPQ(b3);
    float c0 = b0 + b1, c1 = b2 + b3; OPQ(c0); OPQ(c1);
    return c0 + c1; }
__device__ __forceinline__ float xmax32(float x) { float y; asm volatile("v_mov_b32 %0, %1\n\ts_nop 1" : "=v"(y) : "v"(x));
    auto r = __builtin_amdgcn_permlane32_swap(__builtin_bit_cast(unsigned, x), __builtin_bit_cast(unsigned, y), false, false); const unsigned a = r[0], b = r[1];
    return vmax2(__builtin_bit_cast(float, a), __builtin_bit_cast(float, b)); }
__device__ __forceinline__ float xsum32(float x) { float y; asm volatile("v_mov_b32 %0, %1\n\ts_nop 1" : "=v"(y) : "v"(x));
    auto r = __builtin_amdgcn_permlane32_swap(__builtin_bit_cast(unsigned, x), __builtin_bit_cast(unsigned, y), false, false); const unsigned a = r[0], b = r[1];
    return __builtin_bit_cast(float, a) + __builtin_bit_cast(float, b); }
__device__ __forceinline__ void store_row64(bf16* rowp, int hh, const float (&o)[32], float sc) {
#pragma unroll
    for (int dt = 0; dt < 2; ++dt)
#pragma unroll
        for (int kp = 0; kp < 2; ++kp) { const float* q = o + 16 * dt + 8 * kp;
            const unsigned a0 = cvtpk(q[0] * sc, q[1] * sc), a1 = cvtpk(q[2] * sc, q[3] * sc), b0 = cvtpk(q[4] * sc, q[5] * sc), b1 = cvtpk(q[6] * sc, q[7] * sc);
            auto r0 = __builtin_amdgcn_permlane32_swap(a0, b0, false, false); auto r1 = __builtin_amdgcn_permlane32_swap(a1, b1, false, false);
            U4 w; w.x = r0[0]; w.y = r1[0]; w.z = r0[1]; w.w = r1[1];
            *(U4*)(rowp + 32 * dt + 16 * kp + 8 * hh) = w; }
}
__device__ __forceinline__ f32x16 zero16() { f32x16 z;
#pragma unroll
    for (int i = 0; i < 16; ++i) z[i] = 0.f;
    return z; }
__device__ __forceinline__ f32x16 qk32(const bf16* kp, const bf16x8v (&qf)[4]) {
    f32x16 acc = zero16();
#pragma unroll
    for (int ks = 0; ks < 4; ++ks) { const bf16x8v kf = *(const bf16x8v*)(kp + 16 * ks); acc = __builtin_amdgcn_mfma_f32_32x32x16_bf16(kf, qf[ks], acc, 0, 0, 0); }
    return acc;
}
__device__ __forceinline__ void pv32(f32x16& o0, f32x16& o1, const bf16* vt, size_t dstep, const unsigned (&pb)[8]) {
#pragma unroll
    for (int s = 0; s < 2; ++s) {
        const bf16x4v a00 = *(const bf16x4v*)(vt + 16 * s), a01 = *(const bf16x4v*)(vt + 16 * s + 8);
        const bf16x4v a10 = *(const bf16x4v*)(vt + dstep + 16 * s), a11 = *(const bf16x4v*)(vt + dstep + 16 * s + 8);
        bf16x8v A0, A1, B;
        A0 = __builtin_shufflevector(a00, a01, 0, 1, 2, 3, 4, 5, 6, 7); A1 = __builtin_shufflevector(a10, a11, 0, 1, 2, 3, 4, 5, 6, 7);
        typedef unsigned u32x4v __attribute__((ext_vector_type(4)));
        u32x4v bw = {pb[4 * s + 0], pb[4 * s + 1], pb[4 * s + 2], pb[4 * s + 3]};
        B = __builtin_bit_cast(bf16x8v, bw);
        o0 = __builtin_amdgcn_mfma_f32_32x32x16_bf16(A0, B, o0, 0, 0, 0);
        o1 = __builtin_amdgcn_mfma_f32_32x32x16_bf16(A1, B, o1, 0, 0, 0);
    }
}
struct KF { bf16x8v k[4]; };
struct VF { bf16x4v v[8]; };
__device__ __forceinline__ void load_k(KF& f, const bf16* kp) {
#pragma unroll
    for (int ks = 0; ks < 4; ++ks) f.k[ks] = *(const bf16x8v*)(kp + 16 * ks); }
__device__ __forceinline__ void load_v(VF& f, const bf16* vt, size_t dstep) {
#pragma unroll
    for (int s = 0; s < 2; ++s) { f.v[2 * s] = *(const bf16x4v*)(vt + 16 * s); f.v[2 * s + 1] = *(const bf16x4v*)(vt + 16 * s + 8);
        f.v[4 + 2 * s] = *(const bf16x4v*)(vt + dstep + 16 * s); f.v[4 + 2 * s + 1] = *(const bf16x4v*)(vt + dstep + 16 * s + 8); } }
__device__ __forceinline__ f32x16 qk32r(const KF& f, const bf16x8v (&qf)[4]) {
    f32x16 acc = zero16();
#pragma unroll
    for (int ks = 0; ks < 4; ++ks) acc = __builtin_amdgcn_mfma_f32_32x32x16_bf16(f.k[ks], qf[ks], acc, 0, 0, 0);
    return acc; }
__device__ __forceinline__ void pv32r(f32x16& o0, f32x16& o1, const VF& f, const unsigned (&pb)[8]) {
    typedef unsigned u32x4v __attribute__((ext_vector_type(4)));
#pragma unroll
    for (int s = 0; s < 2; ++s) {
        const bf16x8v A0 = __builtin_shufflevector(f.v[2 * s], f.v[2 * s + 1], 0, 1, 2, 3, 4, 5, 6, 7), A1 = __builtin_shufflevector(f.v[4 + 2 * s], f.v[4 + 2 * s + 1], 0, 1, 2, 3, 4, 5, 6, 7);
        const u32x4v bw = {pb[4 * s + 0], pb[4 * s + 1], pb[4 * s + 2], pb[4 * s + 3]}; const bf16x8v B = __builtin_bit_cast(bf16x8v, bw);
        o0 = __builtin_amdgcn_mfma_f32_32x32x16_bf16(A0, B, o0, 0, 0, 0); o1 = __builtin_amdgcn_mfma_f32_32x32x16_bf16(A1, B, o1, 0, 0, 0); } }
__device__ __forceinline__ unsigned long long wave_or64(unsigned long long x) {
    unsigned lo = (unsigned)x, hi = (unsigned)(x >> 32);
#pragma unroll
    for (int o = 1; o < 64; o <<= 1) { lo |= (unsigned)__shfl_xor((int)lo, o); hi |= (unsigned)__shfl_xor((int)hi, o); }
    return ((unsigned long long)(unsigned)__builtin_amdgcn_readfirstlane((int)hi) << 32) | (unsigned)__builtin_amdgcn_readfirstlane((int)lo); }
struct LaneAddr { unsigned ck, cv; unsigned rk[4], rv[4], rw[4]; };
__device__ __forceinline__ LaneAddr lane_addr(LAS unsigned char* slot, int lane) {
    LaneAddr a; const int r = lane & 31, hh = lane >> 5; const unsigned sb = (unsigned)(size_t)slot;
    a.ck = (unsigned)lane; a.cv = (unsigned)lane;
#pragma unroll
    for (int ks = 0; ks < 4; ++ks) a.rk[ks] = sb + r * 128 + (((2 * ks + hh) ^ (r & 7)) * 16);
#pragma unroll
    for (int c = 0; c < 4; ++c) { a.rv[c] = sb + 4096 + r * 64 + ((c ^ ((r >> 2) & 3)) * 16) + 8 * hh; unsigned w = a.rv[c] + 2048; asm volatile("" : "+v"(w)); a.rw[c] = w; }
    return a; }
__device__ __forceinline__ unsigned kvoff(int lane, size_t pitch) { const int row = lane >> 3, ch = (lane & 7) ^ (row & 7); return (unsigned)((row * pitch + ch * 8) * 2); }
__device__ __forceinline__ unsigned vvoff(int lane, size_t pitch) { const int row = lane >> 2, ch = (lane & 3) ^ ((row >> 2) & 3); return (unsigned)((row * pitch + ch * 8) * 2); }
typedef __amdgpu_buffer_rsrc_t rsrc_t;
__device__ __forceinline__ rsrc_t mkrsrc(const void* base) { return __builtin_amdgcn_make_buffer_rsrc((void*)base, 0, 0x7FFFFFF0, 0x00020000); }
__device__ __forceinline__ void dma_k(LAS unsigned char* slot, rsrc_t rs, unsigned tile_off, unsigned pitchB, unsigned voff) {
#pragma unroll
    for (int q = 0; q < 4; ++q) __builtin_amdgcn_raw_ptr_buffer_load_lds(rs, (LAS unsigned*)(slot + q * 1024), 16, voff, tile_off + q * 8 * pitchB, 0, 0); }
__device__ __forceinline__ void dma_v(LAS unsigned char* slot, rsrc_t rs, unsigned tile_off, unsigned pitchB, unsigned voff) {
#pragma unroll
    for (int q = 0; q < 4; ++q) __builtin_amdgcn_raw_ptr_buffer_load_lds(rs, (LAS unsigned*)(slot + 4096 + q * 1024), 16, voff, tile_off + q * 16 * pitchB, 0, 0); }
__device__ __forceinline__ void read_k(KF& f, const LaneAddr& a) {
#pragma unroll
    for (int ks = 0; ks < 4; ++ks) f.k[ks] = *(const LAS bf16x8v*)(size_t)a.rk[ks]; }
__device__ __forceinline__ void read_v(VF& f, const LaneAddr& a) {
#pragma unroll
    for (int dt = 0; dt < 2; ++dt)
#pragma unroll
        for (int s = 0; s < 2; ++s) { f.v[4 * dt + 2 * s] = *(const LAS bf16x4v*)(size_t)(dt ? a.rw[2 * s] : a.rv[2 * s]); f.v[4 * dt + 2 * s + 1] = *(const LAS bf16x4v*)(size_t)(dt ? a.rw[2 * s + 1] : a.rv[2 * s + 1]); } }
#define DMA_WAIT() asm volatile("s_waitcnt vmcnt(0)" ::: "memory")
#define LDS_DRAIN() asm volatile("s_waitcnt lgkmcnt(0)" ::: "memory")
#define LDS_DRAIN_PINNED() do { __builtin_amdgcn_sched_barrier(0); asm volatile("s_waitcnt lgkmcnt(0)" ::: "memory"); } while (0)
#define ATT_BIG 1.152921504606847e18f
__device__ __forceinline__ void sm_fast(f32x16& s, const KF& kc, const bf16x8v (&qf)[4], bool lane_on, float& m, float& l, f32x16& o0, f32x16& o1, unsigned (&pb)[8]) {
    float nb = lane_on ? -m : -INFINITY;
#pragma unroll
    for (int reg = 0; reg < 16; ++reg) s[reg] = fexp2(__builtin_fmaf(s[reg], ATT_C2, nb));
    float rs = vsum16(s);
    if (__any(!(rs < ATT_BIG))) {
        s = qk32r(kc, qf);
        float mx = vmax16_acc(s);
        mx = xmax32(lane_on ? mx * ATT_C2 : ATT_NEG);
        const float mn = (mx > m + ATT_THR) ? mx : m, alpha = fexp2(m - mn); m = mn; l *= alpha;
#pragma unroll
        for (int reg = 0; reg < 16; ++reg) { o0[reg] *= alpha; o1[reg] *= alpha; }
        nb = lane_on ? -m : -INFINITY;
#pragma unroll
        for (int reg = 0; reg < 16; ++reg) s[reg] = fexp2(__builtin_fmaf(s[reg], ATT_C2, nb));
        rs = vsum16(s); }
    l += rs;
#pragma unroll
    for (int i = 0; i < 8; ++i) pb[i] = cvtpk(s[2 * i], s[2 * i + 1]);
}
__device__ __forceinline__ void sm_step(f32x16& s, const KF& kc, const bf16x8v (&qf)[4], int lo, int hi, int hh, float& m, float& l, f32x16& o0, f32x16& o1, unsigned (&pb)[8]) {
    const float nb = -m;
#pragma unroll
    for (int reg = 0; reg < 16; ++reg) { const int ko = (reg & 3) + 8 * (reg >> 2) + 4 * hh; const bool v = (ko >= lo) && (ko <= hi);
        const float e = fexp2(__builtin_fmaf(s[reg], ATT_C2, nb)); s[reg] = v ? e : 0.f; }
    float rs = vsum16(s);
    if (__any(!(rs < ATT_BIG))) {
        s = qk32r(kc, qf);
#pragma unroll
        for (int reg = 0; reg < 16; ++reg) { const int ko = (reg & 3) + 8 * (reg >> 2) + 4 * hh; const bool v = (ko >= lo) && (ko <= hi);
            s[reg] = v ? s[reg] * ATT_C2 : ATT_NEG; }
        const float mx = xmax32(vmax16(s));
        const float mn = (mx > m + ATT_THR) ? mx : m, alpha = fexp2(m - mn); m = mn; l *= alpha;
#pragma unroll
        for (int reg = 0; reg < 16; ++reg) { o0[reg] *= alpha; o1[reg] *= alpha; }
#pragma unroll
        for (int reg = 0; reg < 16; ++reg) s[reg] = (s[reg] > -1e29f) ? fexp2(s[reg] - m) : 0.f;
        rs = vsum16(s); }
    l += rs;
#pragma unroll
    for (int i = 0; i < 8; ++i) pb[i] = cvtpk(s[2 * i], s[2 * i + 1]);
}

__device__ __forceinline__ float dpp_xor1(float x) { return __builtin_bit_cast(float, __builtin_amdgcn_update_dpp(0, __builtin_bit_cast(int, x), 0xB1, 0xF, 0xF, true)); }
__device__ __forceinline__ float dpp_xor2(float x) { return __builtin_bit_cast(float, __builtin_amdgcn_update_dpp(0, __builtin_bit_cast(int, x), 0x4E, 0xF, 0xF, true)); }
#define IMP_LD 132
__device__ __forceinline__ void nsa_unit(const P& p, const bf16* VCT, const bf16* VT, LAS unsigned char* wl, int b, int g, int t0, int lane) {
    const LaneAddr la = lane_addr(wl, lane);
    LAS float* imp = (LAS float*)(wl + 8192);
    const int r = lane & 31, hh = lane >> 5, tl = r >> 2, hg = r & 3, head = g * 4 + hg, t = t0 + tl;
    const long row = (long)b * cS + t;
    bf16x8v qf[4];
    { const bf16* qp = p.PROJ + (size_t)row * PE_LD + head * 64 + 8 * hh;
#pragma unroll
      for (int ks = 0; ks < 4; ++ks) qf[ks] = *(const bf16x8v*)(qp + 16 * ks); }
    float outacc[32];
    unsigned pb[8];
    unsigned long long m0 = 0ull, m1 = 0ull;
    {
        for (int i = lane; i < 8 * IMP_LD; i += 64) imp[i] = 0.f;
        const int nv = t >= 31 ? (t - 31) / 16 + 1 : 0, nvmax = (t0 + 7) >= 31 ? (t0 + 7 - 31) / 16 + 1 : 0, ntile = (nvmax + 31) >> 5;
        float m = ATT_NEG, l = 0.f;
        const bf16* kc0 = p.KCMP + ((size_t)b * KCMP_ROWS * 2 + g) * 64;
        const bf16* vc0 = VCT + (size_t)(b * 2 + g) * 64 * VCT_LD;
        const rsrc_t rsK = mkrsrc(kc0), rsV = mkrsrc(vc0); const unsigned kvo = kvoff(lane, 128), vvo = vvoff(lane, VCT_LD);
        KF kc; VF vc;
        if (ntile > 0) { dma_k(wl, rsK, 0u, 128 * 2, kvo); DMA_WAIT(); read_k(kc, la); }
        for (int kt = 0; kt < ntile; ++kt) { const int key0 = 32 * kt;
            LDS_DRAIN();
            if (kt + 1 < ntile) dma_k(wl, rsK, (unsigned)(key0 + 32) * (128 * 2), 128 * 2, kvo);
            f32x16 s = qk32r(kc, qf);
            float mx = ATT_NEG;
#pragma unroll
            for (int reg = 0; reg < 16; ++reg) { const int ko = (reg & 3) + 8 * (reg >> 2) + 4 * hh; const float x = (key0 + ko < nv) ? s[reg] * ATT_C2 : ATT_NEG; s[reg] = x; mx = fmaxf(mx, x); }
            mx = xmax32(mx);
            const float mn = fmaxf(m, mx); float rs = 0.f;
#pragma unroll
            for (int reg = 0; reg < 16; ++reg) rs += (s[reg] > -1e29f) ? fexp2(s[reg] - mn) : 0.f;
            rs = xsum32(rs);
            l = l * fexp2(m - mn) + rs; m = mn;
            if (kt + 1 < ntile) { DMA_WAIT(); read_k(kc, la); } }
        const float rl = l > 0.f ? 1.f / l : 0.f;
        f32x16 o0 = zero16(), o1 = zero16();
        if (ntile > 0) { dma_k(wl, rsK, 0u, 128 * 2, kvo); dma_v(wl, rsV, 0u, VCT_LD * 2, vvo); DMA_WAIT(); read_k(kc, la); }
        for (int kt = 0; kt < ntile; ++kt) { const int key0 = 32 * kt;
            LDS_DRAIN(); if (kt + 1 < ntile) dma_k(wl, rsK, (unsigned)(key0 + 32) * (128 * 2), 128 * 2, kvo);
            read_v(vc, la);
            f32x16 s = qk32r(kc, qf);
            LDS_DRAIN_PINNED(); if (kt + 1 < ntile) dma_v(wl, rsV, (unsigned)(key0 + 32) * 2, VCT_LD * 2, vvo);
#pragma unroll
            for (int reg = 0; reg < 16; ++reg) { const int ko = (reg & 3) + 8 * (reg >> 2) + 4 * hh; s[reg] = (key0 + ko < nv) ? fexp2(s[reg] * ATT_C2 - m) * rl : 0.f; }
#pragma unroll
            for (int i = 0; i < 8; ++i) pb[i] = cvtpk(s[2 * i], s[2 * i + 1]);
            pv32r(o0, o1, vc, pb);
#pragma unroll
            for (int k = 0; k < 4; ++k) { float a = s[4 * k] + s[4 * k + 1] + s[4 * k + 2] + 0.5f * s[4 * k + 3], c = 0.5f * s[4 * k + 3];
                a += dpp_xor1(a); a += dpp_xor2(a); c += dpp_xor1(c); c += dpp_xor2(c);
                if (hg == 0) { const int j = (key0 >> 2) + 2 * k + hh; (void)__hip_atomic_fetch_add(imp + tl * IMP_LD + j, a, __ATOMIC_RELAXED, __HIP_MEMORY_SCOPE_WORKGROUP); (void)__hip_atomic_fetch_add(imp + tl * IMP_LD + j + 1, c, __ATOMIC_RELAXED, __HIP_MEMORY_SCOPE_WORKGROUP); } }
            if (kt + 1 < ntile) { DMA_WAIT(); read_k(kc, la); } }
        const float g0 = p.GATES[row * 24 + head * 3 + 0];
#pragma unroll
        for (int reg = 0; reg < 16; ++reg) { outacc[reg] = o0[reg] * g0; outacc[16 + reg] = o1[reg] * g0; }
    }
    for (int tk = 0; tk < 8; ++tk) { const int tt = t0 + tk, cur = tt >> 6; LAS float* row = imp + tk * IMP_LD;
        float v0 = (64 * lane > tt) ? -1.f : row[lane], v1 = (64 * (lane + 64) > tt) ? -1.f : row[lane + 64];
        if (lane == 0 || lane == cur || lane == cur - 1) v0 += 1e4f;
        if (lane + 64 == cur || lane + 64 == cur - 1) v1 += 1e4f;
        row[lane] = v0; row[lane + 64] = v1;
        int r0 = 0, r1 = 0;
        const int nq4 = min(32, ((cur >> 2) + 4) & ~3);
#pragma unroll 4
        for (int q4 = 0; q4 < nq4; ++q4) { const f32x4v w = *(const LAS f32x4v*)(row + 4 * q4);
#pragma unroll
            for (int e = 0; e < 4; ++e) { const int jj = 4 * q4 + e; const float x = w[e];
                r0 += (x > v0 || (x == v0 && jj < lane)) ? 1 : 0; r1 += (x > v1 || (x == v1 && jj < lane + 64)) ? 1 : 0; } }
        const unsigned long long s0 = __ballot(r0 < 16), s1 = __ballot(r1 < 16);
        if (tl == tk) { m0 = s0; m1 = s1; } }
    {
        f32x16 o0 = zero16(), o1 = zero16(); float m = ATT_NEG, l = 0.f;
        const bf16* k0p = p.PROJ + (size_t)b * cS * PE_LD + 768 + g * 64;
        const bf16* v0p = VT + vt_tile_off(16, b, g, 0);
        const rsrc_t rsK = mkrsrc(k0p), rsV = mkrsrc(v0p); const unsigned kvo = kvoff(lane, PE_LD), vvo = vvoff(lane, 32);
        unsigned long long u0 = wave_or64(m0), u1 = wave_or64(m1);
        const int tmax = (t0 + 7) >> 5;
#define NSA_NEXT_TILE(tc) ({ int tt_ = (tc) + 1; if ((tt_ & 1) == 0) { const int j_ = tt_ >> 1; \
            const unsigned long long lo_ = j_ < 64 ? (u0 >> j_) : 0ull, hi_ = j_ < 64 ? u1 : (j_ < 128 ? (u1 >> (j_ - 64)) : 0ull); \
            tt_ = lo_ ? 2 * (j_ + __builtin_ctzll(lo_)) : (hi_ ? 2 * ((j_ < 64 ? 64 : j_) + __builtin_ctzll(hi_)) : 1 << 20); } tt_ <= tmax ? tt_ : -1; })
        int tn = NSA_NEXT_TILE(-1);
        KF kc; VF vc;
        if (tn >= 0) { dma_k(wl, rsK, (unsigned)(32 * tn) * (PE_LD * 2), PE_LD * 2, kvo); dma_v(wl, rsV, (unsigned)tn * 4096u, 64, vvo); DMA_WAIT(); read_k(kc, la); }
        while (tn >= 0 && 32 * tn + 31 <= t0) { const int tc = tn, key0 = 32 * tc, j = tc >> 1;
            tn = NSA_NEXT_TILE(tc);
            LDS_DRAIN(); if (tn >= 0) dma_k(wl, rsK, (unsigned)(32 * tn) * (PE_LD * 2), PE_LD * 2, kvo);
            read_v(vc, la);
            const bool selj = ((j < 64 ? m0 : m1) >> (j & 63)) & 1ull;
            f32x16 s = qk32r(kc, qf);
            LDS_DRAIN_PINNED(); if (tn >= 0) dma_v(wl, rsV, (unsigned)tn * 4096u, 64, vvo);
            sm_fast(s, kc, qf, selj, m, l, o0, o1, pb);
            pv32r(o0, o1, vc, pb);
            if (tn >= 0) { DMA_WAIT(); read_k(kc, la); } }
        while (tn >= 0) { const int tc = tn, key0 = 32 * tc, j = tc >> 1;
            tn = NSA_NEXT_TILE(tc);
            LDS_DRAIN(); if (tn >= 0) dma_k(wl, rsK, (unsigned)(32 * tn) * (PE_LD * 2), PE_LD * 2, kvo);
            read_v(vc, la);
            const bool selj = ((j < 64 ? m0 : m1) >> (j & 63)) & 1ull;
            f32x16 s = qk32r(kc, qf);
            LDS_DRAIN_PINNED(); if (tn >= 0) dma_v(wl, rsV, (unsigned)tn * 4096u, 64, vvo);
            sm_step(s, kc, qf, 0, selj ? t - key0 : -1, hh, m, l, o0, o1, pb);
            pv32r(o0, o1, vc, pb);
            if (tn >= 0) { DMA_WAIT(); read_k(kc, la); } }
        l = xsum32(l);
        const float sc = (l > 0.f ? 1.f / l : 0.f) * p.GATES[row * 24 + head * 3 + 1];
#pragma unroll
        for (int reg = 0; reg < 16; ++reg) { outacc[reg] += o0[reg] * sc; outacc[16 + reg] += o1[reg] * sc; }
    }
    {
        f32x16 o0 = zero16(), o1 = zero16(); float m = ATT_NEG, l = 0.f;
        const bf16* k0p = p.PROJ + (size_t)b * cS * PE_LD + 896 + g * 64;
        const bf16* v0p = VT + vt_tile_off(16, b, 2 + g, 0);
        const rsrc_t rsK = mkrsrc(k0p), rsV = mkrsrc(v0p); const unsigned kvo = kvoff(lane, PE_LD), vvo = vvoff(lane, 32);
        const int k_lo = t0 >= 511 ? (t0 - 511) >> 5 : 0, k_hi = (t0 + 7) >> 5;
        KF kc; VF vc;
        dma_k(wl, rsK, (unsigned)(32 * k_lo) * (PE_LD * 2), PE_LD * 2, kvo); dma_v(wl, rsV, (unsigned)k_lo * 4096u, 64, vvo); DMA_WAIT(); read_k(kc, la);
#define WIN_TILE(SM_) { const int key0 = 32 * kt; \
            LDS_DRAIN(); if (kt < k_hi) dma_k(wl, rsK, (unsigned)(key0 + 32) * (PE_LD * 2), PE_LD * 2, kvo); \
            read_v(vc, la); \
            f32x16 s = qk32r(kc, qf); \
            LDS_DRAIN_PINNED(); if (kt < k_hi) dma_v(wl, rsV, (unsigned)(kt + 1) * 4096u, 64, vvo); \
            SM_; \
            pv32r(o0, o1, vc, pb); \
            if (kt < k_hi) { DMA_WAIT(); read_k(kc, la); } }
        int kt = k_lo;
        for (; kt <= k_hi && 32 * kt < t0 + 7 - 511; ++kt) WIN_TILE(sm_step(s, kc, qf, t - 511 - key0, 31, hh, m, l, o0, o1, pb))
        for (; kt <= k_hi && 32 * kt + 31 <= t0; ++kt) WIN_TILE(sm_fast(s, kc, qf, true, m, l, o0, o1, pb))
        for (; kt <= k_hi; ++kt) WIN_TILE(sm_step(s, kc, qf, 0, t - key0, hh, m, l, o0, o1, pb))
#undef WIN_TILE
        l = xsum32(l);
        const float sc = (l > 0.f ? 1.f / l : 0.f) * p.GATES[row * 24 + head * 3 + 2];
#pragma unroll
        for (int reg = 0; reg < 16; ++reg) { outacc[reg] += o0[reg] * sc; outacc[16 + reg] += o1[reg] * sc; }
    }
    store_row64(p.ATT + (size_t)row * 768 + head * 64, hh, outacc, 1.f);
}

__device__ __forceinline__ void cmp1_unit(const P& p, const bf16* W1T, const float* PEB, int u, int lane) {
    const int r = lane & 31, hh = lane >> 5;
    const int ct = u & 7, rt = (u >> 3) & 127, which = u >> 10;
    const int NR = cB * cNC * 2;
    int i = rt * 32 + r; if (i >= NR) i = NR - 1;
    const int g = i & 1, n = (i >> 1) % cNC, b = (i >> 1) / cNC;
    const bf16* ap = p.PROJ + (size_t)(b * cS + 16 * n) * PE_LD + 512 + which * 128 + g * 64 + 8 * hh;
    const bf16* bp = W1T + ((size_t)which * 256 + ct * 32 + r) * 2048 + 8 * hh;
    f32x16 acc = zero16();
    for (int l = 0; l < 32; ++l) {
#pragma unroll
        for (int q = 0; q < 4; ++q) { const bf16x8v a = *(const bf16x8v*)(ap + (size_t)l * PE_LD + 16 * q), bb = *(const bf16x8v*)(bp + l * 64 + 16 * q);
            acc = __builtin_amdgcn_mfma_f32_32x32x16_bf16(a, bb, acc, 0, 0, 0); } }
    const int j = ct * 32 + r; const float bias = PEB[which * 256 + j];
#pragma unroll
    for (int reg = 0; reg < 16; ++reg) { const int io = rt * 32 + (reg & 3) + 8 * (reg >> 2) + 4 * hh;
        if (io < NR) p.HID[((size_t)which * NR + io) * 256 + j] = gelu_tanh(acc[reg] + bias); }
}
__device__ __forceinline__ void gates_unit(const P& p, const bf16* WGT, int u, int lane) {
    const int r = lane & 31, hh = lane >> 5;
    const bf16* ap = p.Y + (size_t)(u * 32 + r) * cDM + 8 * hh; const bf16* bp = WGT + (size_t)r * cDM + 8 * hh;
    f32x16 acc = zero16();
#pragma unroll 8
    for (int ks = 0; ks < cDM / 16; ++ks) { const bf16x8v a = *(const bf16x8v*)(ap + 16 * ks), bb = *(const bf16x8v*)(bp + 16 * ks);
        acc = __builtin_amdgcn_mfma_f32_32x32x16_bf16(a, bb, acc, 0, 0, 0); }
    if (r < 24) {
#pragma unroll
        for (int reg = 0; reg < 16; ++reg) { const int row = u * 32 + (reg & 3) + 8 * (reg >> 2) + 4 * hh; p.GATES[(size_t)row * 24 + r] = 1.f / (1.f + __expf(-acc[reg])); } }
}

__device__ __forceinline__ float xlo32(float x) { float y; asm volatile("v_mov_b32 %0, %1\n\ts_nop 1" : "=v"(y) : "v"(x));
    auto r = __builtin_amdgcn_permlane32_swap(__builtin_bit_cast(unsigned, x), __builtin_bit_cast(unsigned, y), false, false); const unsigned a = r[0]; return __builtin_bit_cast(float, a); }
template <bool DIAG>
__device__ __forceinline__ void sb_tile(const f32x16& z, const VF& vc, const bf16x8v (&TA)[2], int r, int hh, float& carry, f32x16& o0, f32x16& o1) {
    f32x16 l1; float lbv[16];
#pragma unroll
    for (int reg = 0; reg < 16; ++reg) { const int ko = (reg & 3) + 8 * (reg >> 2) + 4 * hh; float zr = z[reg]; OPQ(zr); const float zz = zr * 0.125f;
        const float e = fexp2(-fabsf(zz) * 1.4426950408889634f); const float sp = __builtin_amdgcn_logf(1.f + e) * 0.6931471805599453f;
        float lb = fminf(zz, 0.f) - sp; OPQ(lb); lbv[reg] = lb; float x = (!DIAG || ko < r) ? lb - zz : 0.f; OPQ(x); l1[reg] = x; }
    unsigned bh[8], bl[8];
#pragma unroll
    for (int i = 0; i < 8; ++i) { const float x0 = l1[2 * i], x1 = l1[2 * i + 1]; const unsigned hw = cvtpk(x0, x1); bh[i] = hw; float d0 = x0 - bflo(hw), d1 = x1 - bfhi(hw); OPQ(d0); OPQ(d1); bl[i] = cvtpk(d0, d1); }
    f32x16 af = zero16();
    typedef unsigned u32x4v __attribute__((ext_vector_type(4)));
#pragma unroll
    for (int s = 0; s < 2; ++s) { const u32x4v wh = {bh[4 * s], bh[4 * s + 1], bh[4 * s + 2], bh[4 * s + 3]}, wl = {bl[4 * s], bl[4 * s + 1], bl[4 * s + 2], bl[4 * s + 3]};
        af = __builtin_amdgcn_mfma_f32_32x32x16_bf16(TA[s], __builtin_bit_cast(bf16x8v, wh), af, 0, 0, 0);
        af = __builtin_amdgcn_mfma_f32_32x32x16_bf16(TA[s], __builtin_bit_cast(bf16x8v, wl), af, 0, 0, 0); }
    unsigned pb[8]; float av[16];
#pragma unroll
    for (int reg = 0; reg < 16; ++reg) { const int ko = (reg & 3) + 8 * (reg >> 2) + 4 * hh;
        float t = lbv[reg] + af[reg]; OPQ(t); av[reg] = (!DIAG || ko < r) ? fexp2((t + carry) * 1.4426950408889634f) : 0.f; }
#pragma unroll
    for (int i = 0; i < 8; ++i) pb[i] = cvtpk(av[2 * i], av[2 * i + 1]);
    pv32r(o0, o1, vc, pb);
    carry += xlo32(af[0] + l1[0]);
}
__device__ __forceinline__ void sb_unit(const P& p, const bf16* VT, LAS unsigned char* wl, int b, int h, int t0, int lane) {
    const int r = lane & 31, hh = lane >> 5; const long row = (long)b * cS + t0 + r; const LaneAddr la = lane_addr(wl, lane);
    bf16x8v qf[4];
    { const bf16* qp = p.PROJ + (size_t)row * PO_LD + h * 64 + 8 * hh;
#pragma unroll
      for (int ks = 0; ks < 4; ++ks) qf[ks] = *(const bf16x8v*)(qp + 16 * ks); }
    bf16x8v TA[2];
#pragma unroll
    for (int s = 0; s < 2; ++s)
#pragma unroll
        for (int j = 0; j < 8; ++j) { const int kk = 16 * s + 8 * (j >> 2) + 4 * hh + (j & 3); TA[s][j] = (short)(kk > r ? 0x3F80 : 0); }
    f32x16 o0 = zero16(), o1 = zero16(); float carry = 0.f;
    const bf16* k0p = p.PROJ + (size_t)b * cS * PO_LD + cDM + h * 64;
    const bf16* v0p = VT + vt_tile_off(16, b, h, 0);
    const rsrc_t rsK = mkrsrc(k0p), rsV = mkrsrc(v0p); const unsigned kvo = kvoff(lane, PO_LD), vvo = vvoff(lane, 32);
    KF kc; VF vc;
    dma_k(wl, rsK, (unsigned)t0 * (PO_LD * 2), PO_LD * 2, kvo); dma_v(wl, rsV, (unsigned)(t0 >> 5) * 4096u, 64, vvo); DMA_WAIT(); read_k(kc, la);
#define SB_TILE(DIAG_, key0_) do { LDS_DRAIN(); if ((key0_) > 0) dma_k(wl, rsK, (unsigned)((key0_) - 32) * (PO_LD * 2), PO_LD * 2, kvo); \
        read_v(vc, la); const f32x16 z_ = qk32r(kc, qf); \
        LDS_DRAIN_PINNED(); if ((key0_) > 0) dma_v(wl, rsV, (unsigned)(((key0_) - 32) >> 5) * 4096u, 64, vvo); \
        sb_tile<DIAG_>(z_, vc, TA, r, hh, carry, o0, o1); } while (0)
    int kt = t0 >> 5;
    SB_TILE(true, t0);
    for (--kt; kt >= 0; --kt) { const int key0 = 32 * kt;
        DMA_WAIT(); read_k(kc, la);
        SB_TILE(false, key0);
        if (__all(carry < -93.f)) break; }
#undef SB_TILE
    DMA_WAIT();
    { float ov[32];
#pragma unroll
      for (int reg = 0; reg < 16; ++reg) { ov[reg] = o0[reg]; ov[16 + reg] = o1[reg]; }
      store_row64(p.ATT + (size_t)row * cDM + h * 64, hh, ov, 1.f); }
}

template <int G>
__device__ __forceinline__ void dil_unit(const P& p, const bf16* VT, const bf16* VTP, bf16* DOUT, float* DLSE, LAS unsigned char* wl, int b, int hd, int rc, int tile, int lane) {
    constexpr int dil = G == 0 ? 1 : G == 1 ? 4 : 16; constexpr int slot0 = 4 * G;
    const int r = lane & 31, hh = lane >> 5, slot = slot0 + hd; const LaneAddr la = lane_addr(wl, lane);
    const long row = (long)b * cS + rc + (long)dil * (32 * tile + r);
    bf16x8v qf[4];
    { const bf16* qp = p.PROJ + (size_t)row * PE_LD + 1024 + slot * 64 + 8 * hh;
#pragma unroll
      for (int ks = 0; ks < 4; ++ks) qf[ks] = *(const bf16x8v*)(qp + 16 * ks); }
    f32x16 o0 = zero16(), o1 = zero16(); float m = ATT_NEG, l = 0.f; unsigned pb[8];
    const bf16* k0p = p.PROJ + ((size_t)b * cS + rc) * PE_LD + 1792 + slot * 64;
    const bf16* v0p = G == 0 ? VT + vt_tile_off(16, b, 4 + slot, 0)
                             : VTP + vt_tile_off(8, b, (G - 1) * 4 + hd, rc * (cS / dil / 32));
    const rsrc_t rsK = mkrsrc(k0p), rsV = mkrsrc(v0p); const unsigned kvo = kvoff(lane, (size_t)dil * PE_LD), vvo = vvoff(lane, 32);
    const int k_lo = tile >= 4 ? tile - 4 : 0;
    KF kc; VF vc;
    dma_k(wl, rsK, (unsigned)(32 * k_lo) * (dil * PE_LD * 2), dil * PE_LD * 2, kvo); dma_v(wl, rsV, (unsigned)k_lo * 4096u, 64, vvo); DMA_WAIT(); read_k(kc, la);
    for (int kt = k_lo; kt <= tile; ++kt) { const int D0 = 32 * (tile - kt);
        LDS_DRAIN(); if (kt < tile) dma_k(wl, rsK, (unsigned)(32 * kt + 32) * (dil * PE_LD * 2), dil * PE_LD * 2, kvo);
        read_v(vc, la);
        f32x16 s = qk32r(kc, qf);
        LDS_DRAIN_PINNED(); if (kt < tile) dma_v(wl, rsV, (unsigned)(kt + 1) * 4096u, 64, vvo);
        if (D0 >= 32 && D0 <= 96) sm_fast(s, kc, qf, true, m, l, o0, o1, pb);
        else sm_step(s, kc, qf, D0 + r - 128, D0 + r, hh, m, l, o0, o1, pb);
        pv32r(o0, o1, vc, pb);
        if (kt < tile) { DMA_WAIT(); read_k(kc, la); } }
    l = xsum32(l);
    const float rl = 1.f / l;
    { float ov[32];
#pragma unroll
      for (int reg = 0; reg < 16; ++reg) { ov[reg] = o0[reg]; ov[16 + reg] = o1[reg]; }
      store_row64(DOUT + ((size_t)G * cM + row) * 256 + hd * 64, hh, ov, rl); }
    if (hh == 0) DLSE[((size_t)G * cM + row) * 4 + hd] = m + __builtin_amdgcn_logf(l);
}
namespace pg8 {
#define PG8_LAS __attribute__((address_space(3)))
typedef unsigned short bf16_t;
typedef short bf16x8 __attribute__((ext_vector_type(8)));
typedef float f32x4 __attribute__((ext_vector_type(4)));
typedef unsigned u32x4 __attribute__((ext_vector_type(4)));
constexpr int BM = 256, BK = 64, HALF = 128, HTB = HALF * BK * 2  , STAGE_BYTES = 8 * HTB, NXCD = 8, WGM = 8;

__host__ __device__ __forceinline__ int lds_byte(int r, int c) { const int st = (r >> 4) * 2 + (c >> 5), rr = r & 15, cc = c & 31, ob = rr * 64 + cc * 2; return st * 1024 + (ob ^ (((ob >> 9) & 1) << 5)); }
__host__ __device__ __forceinline__ void stage_rc(int b, int& R, int& C) { const int st = b / 1024, sb = b % 1024, swz = sb ^ (((sb >> 9) & 1) << 5); R = (st >> 1) * 16 + swz / 64; C = (st & 1) * 32 + (swz % 64) / 2; }
__host__ __device__ __forceinline__ int perm32(int rho) { const int n = rho >> 4, i = rho & 15; return 8 * (i >> 2) + 4 * n + (i & 3); }

struct Unit { int pm, pn; };
struct Gemm { const bf16_t* A; const bf16_t* Bt; int M, N, K; };

struct StaticOrder {
    int nM, nN, nwg, G, c;
    __host__ __device__ void init(int M, int N, int G_, int c_) { nM = M / BM; nN = N / BM; nwg = nM * nN; G = G_; c = c_; }
    __host__ __device__ bool next(int i, Unit& u) const {
        const long L = (long)i * G + c; if (L >= nwg) return false;
        int wgid = (int)L; { const int q = nwg / NXCD, r = nwg % NXCD, xcd = wgid % NXCD, off = wgid / NXCD; wgid = (xcd < r ? xcd * (q + 1) : r * (q + 1) + (xcd - r) * q) + off; }
        const int nig = WGM * nN, gid = wgid / nig, fm = gid * WGM, gsz = (nM - fm) < WGM ? (nM - fm) : WGM;
        u.pm = fm + ((wgid % nig) % gsz); u.pn = (wgid % nig) / gsz; return true;
    }
    __device__ __forceinline__ void a_ready(const Unit&) const {}
    __device__ __forceinline__ void done(const Unit&) const {}
};

__device__ __forceinline__ unsigned cvt_pk_bf16(float lo, float hi) { unsigned r; asm volatile("v_cvt_pk_bf16_f32 %0, %1, %2" : "=v"(r) : "v"(lo), "v"(hi)); return r; }
typedef float f32x2 __attribute__((ext_vector_type(2)));
__device__ __forceinline__ f32x2 gelu_pk(f32x2 v) {
    const f32x2 av = __builtin_elementwise_abs(v), d = av * 0.2316418882f + 1.0f;
    f32x2 t; t.x = __builtin_amdgcn_rcpf(d.x); t.y = __builtin_amdgcn_rcpf(d.y);
    f32x2 q = t * 0.5307027145f + (-0.7265760135f); q = q * t + 0.7107068705f; q = q * t + (-0.142248368f); q = q * t + 0.127414796f; q = q * t;
    const f32x2 s = (v * v) * (-0.72134752044f);
    f32x2 e; e.x = __builtin_amdgcn_exp2f(s.x); e.y = __builtin_amdgcn_exp2f(s.y);
    const f32x2 m = v * (q * e), r = v - m;
    f32x2 o; o.x = v.x < 0.f ? m.x : r.x; o.y = v.y < 0.f ? m.y : r.y; return o;
}

template <int ACT  > struct EpiBf16 {
    static constexpr bool PERM = true, AFTER_DRAIN = false, TABLE = false; static_assert(ACT == 0 || ACT == 1, "EpiBf16: ACT is 0 (none) or 1 (gelu_pk)");
    bf16_t* O; int ldc; const float* bias; int split_cols; size_t split_stride; float scale0;
    __device__ __forceinline__ void operator()(const f32x4 (&acc)[2][2][4][2], const Unit& u, int wr, int wc, int fr, int fq) const {
        const int row0 = u.pm * BM + wr * 64 + fr; int colt = u.pn * BM; bf16_t* base = O;
        float sc = 1.f; if (split_cols) { const int t = colt / split_cols; base += (size_t)t * split_stride; colt -= t * split_cols; if (t == 0) sc = scale0; }
        const int col0 = colt + wc * 32 + 8 * fq, bcol0 = u.pn * BM + wc * 32 + 8 * fq;
        f32x4 bv[2][2];
#pragma unroll
        for (int bj = 0; bj < 2; ++bj)
#pragma unroll
            for (int n = 0; n < 2; ++n) bv[bj][n] = bias ? *(const f32x4*)(bias + bcol0 + bj * HALF + 4 * n) : (f32x4){0.f, 0.f, 0.f, 0.f};
#pragma unroll
        for (int ai = 0; ai < 2; ++ai)
#pragma unroll
            for (int m = 0; m < 4; ++m) { bf16_t* rowp = base + (size_t)(row0 + ai * HALF + m * 16) * ldc + col0;
#pragma unroll
                for (int bj = 0; bj < 2; ++bj) { f32x4 v0 = acc[ai][bj][m][0] + bv[bj][0], v1 = acc[ai][bj][m][1] + bv[bj][1];
                    if (ACT == 1) { f32x2 a = gelu_pk((f32x2){v0[0], v0[1]}), b = gelu_pk((f32x2){v0[2], v0[3]}), c = gelu_pk((f32x2){v1[0], v1[1]}), d = gelu_pk((f32x2){v1[2], v1[3]});
                        v0 = (f32x4){a.x, a.y, b.x, b.y}; v1 = (f32x4){c.x, c.y, d.x, d.y}; }
                    v0 = v0 * sc; v1 = v1 * sc; u32x4 w; w.x = cvt_pk_bf16(v0[0], v0[1]); w.y = cvt_pk_bf16(v0[2], v0[3]); w.z = cvt_pk_bf16(v1[0], v1[1]); w.w = cvt_pk_bf16(v1[2], v1[3]);
                    *(u32x4*)(rowp + bj * HALF) = w; } }
    }
};
template <class Epi, class Sched, bool ALIGN_EPI = false, bool SP2 = false>
__device__ __forceinline__ void gemm_phase(PG8_LAS unsigned char* lds, const Gemm g, const Sched& S, const Epi& E) {
    int tid_ = threadIdx.x; asm volatile("" : "+v"(tid_));
    const int tid = tid_, wid = __builtin_amdgcn_readfirstlane(tid >> 6), lane = tid & 63, wr = wid >> 2, wc = wid & 3, fr = lane & 15, fq = lane >> 4;
    const int K = g.K, nt = K / BK;
    unsigned voffA[2], voffB[2];
#pragma unroll
    for (int i = 0; i < 2; ++i) { int R, C; stage_rc(tid * 16 + i * 8192, R, C); const int Rb = Epi::PERM ? ((R & ~31) + perm32(R & 31)) : R;
        voffA[i] = (unsigned)(R * K + C) * 2u; voffB[i] = (unsigned)(Rb * K + C) * 2u; }
    const size_t kstep = (size_t)(BK * 2);
    const size_t hstep = (size_t)HALF * K * 2;
    const size_t tstep = 2 * hstep;
    const unsigned ldsw = (unsigned)wid * 1024u;
    const int aoff = lds_byte(wr * 64 + fr, fq * 8), boff = lds_byte(wc * 32 + fr, fq * 8);
#define PG8_SA(b, h) (((b) * 2 + (h)) * HTB)
#define PG8_SB(b, h) ((4 + (b) * 2 + (h)) * HTB)
#define PG8_STAGE(bufoff, gbase, voff) do { _Pragma("unroll") for (int _i = 0; _i < 2; ++_i) \
        __builtin_amdgcn_global_load_lds((const unsigned*)((const char*)(gbase) + (voff)[_i]), (PG8_LAS unsigned*)(lds + (bufoff) + ldsw + _i * 8192), 16, 0, 0); } while (0)
#define PG8_LDA(dst, b, h) do { _Pragma("unroll") for (int m = 0; m < 4; ++m) _Pragma("unroll") for (int k = 0; k < 2; ++k) dst[m][k] = *(const PG8_LAS bf16x8*)(lds + PG8_SA(b, h) + aoff + m * 2048 + k * 1024); } while (0)
#define PG8_LDB(dst, b, h) do { _Pragma("unroll") for (int n = 0; n < 2; ++n) _Pragma("unroll") for (int k = 0; k < 2; ++k) dst[n][k] = *(const PG8_LAS bf16x8*)(lds + PG8_SB(b, h) + boff + n * 2048 + k * 1024); } while (0)
#define PG8_MMA(ai, bj, At, Bt) do { __builtin_amdgcn_s_setprio(1); _Pragma("unroll") for (int m = 0; m < 4; ++m) _Pragma("unroll") for (int n = 0; n < 2; ++n) _Pragma("unroll") for (int k = 0; k < 2; ++k) \
        acc[ai][bj][m][n] = __builtin_amdgcn_mfma_f32_16x16x32_bf16(Bt[n][k], At[m][k], acc[ai][bj][m][n], 0, 0, 0); __builtin_amdgcn_s_setprio(0); } while (0)
#define PG8_WAIT_V(n) asm volatile("s_waitcnt vmcnt(" #n ")" ::: "memory")
#define PG8_WAIT_L(n) asm volatile("s_waitcnt lgkmcnt(" #n ")" ::: "memory")
#define PG8_BAR __builtin_amdgcn_s_barrier()
#define PG8_SCHED __builtin_amdgcn_sched_barrier(0)
    Unit cur, nxt; int ui = 0;
    if (!S.next(0, cur)) return;
    f32x4 acc[2][2][4][2];
#pragma unroll
    for (int a = 0; a < 2; ++a)
#pragma unroll
        for (int b = 0; b < 2; ++b)
#pragma unroll
            for (int m = 0; m < 4; ++m)
#pragma unroll
                for (int n = 0; n < 2; ++n) acc[a][b][m][n] = (f32x4){0.f, 0.f, 0.f, 0.f};
    bf16x8 At[4][2], B0[2][2], B1[2][2];
    const char* cA = (const char*)g.A + (size_t)cur.pm * tstep; const char* cB = (const char*)g.Bt + (size_t)cur.pn * tstep;
    S.a_ready(cur);
    if constexpr (SP2) {
        PG8_STAGE(PG8_SB(0, 0), cB, voffB); PG8_STAGE(PG8_SB(0, 1), cB + hstep, voffB); PG8_STAGE(PG8_SA(0, 0), cA, voffA); PG8_STAGE(PG8_SA(0, 1), cA + hstep, voffA);
        if (wr == 1) PG8_BAR;
        PG8_WAIT_V(2); PG8_BAR;
        PG8_STAGE(PG8_SB(1, 0), cB + kstep, voffB); PG8_STAGE(PG8_SA(1, 0), cA + kstep, voffA); PG8_STAGE(PG8_SB(1, 1), cB + hstep + kstep, voffB);
        PG8_WAIT_V(6); PG8_BAR;
    } else {
        PG8_STAGE(PG8_SB(0, 0), cB, voffB); PG8_STAGE(PG8_SA(0, 0), cA, voffA); PG8_STAGE(PG8_SB(0, 1), cB + hstep, voffB); PG8_STAGE(PG8_SA(0, 1), cA + hstep, voffA);
        if (wr == 1) PG8_BAR;
        PG8_WAIT_V(4); PG8_BAR;
        PG8_STAGE(PG8_SB(1, 0), cB + kstep, voffB); PG8_STAGE(PG8_SA(1, 0), cA + kstep, voffA); PG8_STAGE(PG8_SB(1, 1), cB + hstep + kstep, voffB);
        PG8_WAIT_V(6); PG8_BAR;
    }
    for (;;) {
        const bool has_next = S.next(ui + 1, nxt);
        if constexpr (Epi::TABLE) { if (tid < 256) E.stage_table(cur, lds + 131072 + (ui & 1) * 4096, tid); }
        const char* nA = has_next ? (const char*)g.A + (size_t)nxt.pm * tstep : cA; const char* nB = has_next ? (const char*)g.Bt + (size_t)nxt.pn * tstep : cB;
        for (int t = 0; t < nt; t += 2) {
            const bool last = (t == nt - 2);
            const char* a1 = cA + (size_t)(t + 1) * kstep;
            const char* a2 = last ? nA : cA + (size_t)(t + 2) * kstep; const char* b2 = last ? nB : cB + (size_t)(t + 2) * kstep;
            const char* a3 = a2 + kstep; const char* b3 = b2 + kstep;
            if (last && has_next) S.a_ready(nxt);
            if constexpr (SP2) {
            PG8_LDB(B0, 0, 0); PG8_LDB(B1, 0, 1); PG8_SCHED; PG8_LDA(At, 0, 0); PG8_STAGE(PG8_SA(1, 1), a1 + hstep, voffA);
            PG8_WAIT_V(8); PG8_WAIT_L(0); PG8_BAR; PG8_MMA(0, 0, At, B0); PG8_MMA(0, 1, At, B1); PG8_BAR; PG8_SCHED;
            PG8_LDA(At, 0, 1); PG8_STAGE(PG8_SB(0, 0), b2, voffB); PG8_STAGE(PG8_SB(0, 1), b2 + hstep, voffB); PG8_STAGE(PG8_SA(0, 0), a2, voffA);
            PG8_WAIT_V(8); PG8_WAIT_L(0); PG8_BAR; PG8_MMA(1, 0, At, B0); PG8_MMA(1, 1, At, B1); PG8_BAR; PG8_SCHED;
            PG8_LDB(B0, 1, 0); PG8_LDB(B1, 1, 1); PG8_SCHED; PG8_LDA(At, 1, 0); PG8_STAGE(PG8_SA(0, 1), a2 + hstep, voffA);
            PG8_WAIT_V(8); PG8_WAIT_L(0); PG8_BAR; PG8_MMA(0, 0, At, B0); PG8_MMA(0, 1, At, B1); PG8_BAR; PG8_SCHED;
            PG8_LDA(At, 1, 1); PG8_STAGE(PG8_SB(1, 0), b3, voffB); PG8_STAGE(PG8_SB(1, 1), b3 + hstep, voffB); PG8_STAGE(PG8_SA(1, 0), a3, voffA);
            PG8_WAIT_V(8); PG8_WAIT_L(0); PG8_BAR; PG8_MMA(1, 0, At, B0); PG8_MMA(1, 1, At, B1); PG8_BAR; PG8_SCHED;
            } else {
            PG8_LDB(B0, 0, 0); PG8_SCHED; PG8_LDA(At, 0, 0); PG8_STAGE(PG8_SA(1, 1), a1 + hstep, voffA);
            PG8_WAIT_L(8); PG8_BAR; PG8_WAIT_L(0); PG8_MMA(0, 0, At, B0); PG8_BAR; PG8_SCHED;
            PG8_LDB(B1, 0, 1); PG8_STAGE(PG8_SB(0, 0), b2, voffB);
            PG8_BAR; PG8_WAIT_L(0); PG8_MMA(0, 1, At, B1); PG8_BAR;
            PG8_LDA(At, 0, 1); PG8_STAGE(PG8_SA(0, 0), a2, voffA);
            PG8_BAR; PG8_WAIT_L(0); PG8_MMA(1, 0, At, B0); PG8_BAR; PG8_SCHED;
            PG8_STAGE(PG8_SB(0, 1), b2 + hstep, voffB);
            PG8_WAIT_V(6); PG8_BAR; PG8_MMA(1, 1, At, B1); PG8_BAR;
            PG8_LDB(B0, 1, 0); PG8_SCHED; PG8_LDA(At, 1, 0); PG8_STAGE(PG8_SA(0, 1), a2 + hstep, voffA);
            PG8_WAIT_L(8); PG8_BAR; PG8_WAIT_L(0); PG8_MMA(0, 0, At, B0); PG8_BAR; PG8_SCHED;
            PG8_LDB(B1, 1, 1); PG8_STAGE(PG8_SB(1, 0), b3, voffB);
            PG8_BAR; PG8_WAIT_L(0); PG8_MMA(0, 1, At, B1); PG8_BAR;
            PG8_LDA(At, 1, 1); PG8_STAGE(PG8_SA(1, 0), a3, voffA);
            PG8_BAR; PG8_WAIT_L(0); PG8_MMA(1, 0, At, B0); PG8_BAR; PG8_SCHED;
            PG8_STAGE(PG8_SB(1, 1), b3 + hstep, voffB);
            PG8_WAIT_V(6); PG8_BAR; PG8_MMA(1, 1, At, B1); PG8_BAR;
            }
        }
        if constexpr (ALIGN_EPI) { if (wr == 0) PG8_BAR; }
        if constexpr (!Epi::AFTER_DRAIN) { if constexpr (Epi::TABLE) E.run(acc, cur, wr, wc, fr, fq, lds + 131072 + (ui & 1) * 4096); else E(acc, cur, wr, wc, fr, fq); S.done(cur); }
        if (!has_next) break;
#pragma unroll
        for (int a = 0; a < 2; ++a)
#pragma unroll
            for (int b = 0; b < 2; ++b)
#pragma unroll
                for (int m = 0; m < 4; ++m)
#pragma unroll
                    for (int n = 0; n < 2; ++n) acc[a][b][m][n] = (f32x4){0.f, 0.f, 0.f, 0.f};
        cur = nxt; cA = nA; cB = nB; ++ui;
        if constexpr (ALIGN_EPI) { if (wr == 1) PG8_BAR; }
    }
    PG8_WAIT_V(0);
    if constexpr (!ALIGN_EPI) { if (wr == 0) PG8_BAR; }
    PG8_BAR;
    if constexpr (Epi::AFTER_DRAIN) { E.fused(acc, cur, wr, wc, fr, fq, lds, wid, lane); S.done(cur); }
#undef PG8_SA
#undef PG8_SB
#undef PG8_STAGE
#undef PG8_LDA
#undef PG8_LDB
#undef PG8_MMA
#undef PG8_WAIT_V
#undef PG8_WAIT_L
#undef PG8_BAR
#undef PG8_SCHED
}
}
namespace pg8 {
struct EpiRopeE {
    static constexpr bool PERM = true, AFTER_DRAIN = false, TABLE = false;
    bf16_t* O; int ldc; const float* rope;
    __device__ __forceinline__ void operator()(const f32x4 (&acc)[2][2][4][2], const Unit& u, int wr, int wc, int fr, int fq) const {
        const int row0 = u.pm * BM + wr * 64 + fr;
        if (u.pn == 2) {
            const int col0 = u.pn * BM + wc * 32 + 8 * fq;
#pragma unroll
            for (int ai = 0; ai < 2; ++ai)
#pragma unroll
                for (int m = 0; m < 4; ++m) { bf16_t* rowp = O + (size_t)(row0 + ai * HALF + m * 16) * ldc + col0;
#pragma unroll
                    for (int bj = 0; bj < 2; ++bj) { const f32x4 v0 = acc[ai][bj][m][0], v1 = acc[ai][bj][m][1]; u32x4 w;
                        w.x = cvt_pk_bf16(v0[0], v0[1]); w.y = cvt_pk_bf16(v0[2], v0[3]); w.z = cvt_pk_bf16(v1[0], v1[1]); w.w = cvt_pk_bf16(v1[2], v1[3]); *(u32x4*)(rowp + bj * HALF) = w; } }
        } else {
            const int kk = 4 * (wc & 1) + fq;
#pragma unroll
            for (int ai = 0; ai < 2; ++ai)
#pragma unroll
                for (int m = 0; m < 4; ++m) { const int row = row0 + ai * HALF + m * 16, pos = row & (cS - 1);
                    const f32x4 c0 = *(const f32x4*)(rope + (size_t)(pos * 32 + 4 * kk) * 2), c1 = *(const f32x4*)(rope + (size_t)(pos * 32 + 4 * kk) * 2 + 4);
#pragma unroll
                    for (int bj = 0; bj < 2; ++bj) { const f32x4 x1 = acc[ai][bj][m][0], x2 = acc[ai][bj][m][1];
                        bf16_t* op = O + (size_t)row * ldc + u.pn * BM + (2 * bj + (wc >> 1)) * 64 + 4 * kk;
                        const unsigned ax = cvt_pk_bf16(x1[0] * c0[0] - x2[0] * c0[1], x1[1] * c0[2] - x2[1] * c0[3]), ay = cvt_pk_bf16(x1[2] * c1[0] - x2[2] * c1[1], x1[3] * c1[2] - x2[3] * c1[3]);
                        const unsigned bx = cvt_pk_bf16(x2[0] * c0[0] + x1[0] * c0[1], x2[1] * c0[2] + x1[1] * c0[3]), by = cvt_pk_bf16(x2[2] * c1[0] + x1[2] * c1[1], x2[3] * c1[2] + x1[3] * c1[3]);
                        auto rx = __builtin_amdgcn_permlane16_swap(ax, bx, false, false); auto ry = __builtin_amdgcn_permlane16_swap(ay, by, false, false);
                        u32x4 w; w.x = rx[0]; w.y = ry[0]; w.z = rx[1]; w.w = ry[1];
                        *(u32x4*)((fq & 1) ? op + 32 - 4 : op) = w; } }
        }
    }
};
struct EpiVT {
    static constexpr bool PERM = true, AFTER_DRAIN = false, TABLE = false;
    bf16_t* O;
    __device__ __forceinline__ void operator()(const f32x4 (&acc)[2][2][4][2], const Unit& u, int wr, int wc, int fr, int fq) const {
        const int row0 = u.pm * BM + wr * 64 + fr, col0 = u.pn * BM + wc * 32 + 8 * fq;
#pragma unroll
        for (int ai = 0; ai < 2; ++ai)
#pragma unroll
            for (int m = 0; m < 4; ++m) { const int dg = row0 + ai * HALF + m * 16;
#pragma unroll
                for (int bj = 0; bj < 2; ++bj) { const int col = col0 + bj * HALF, b = col / cS, tk = col & (cS - 1);
                    const f32x4 v0 = acc[ai][bj][m][0], v1 = acc[ai][bj][m][1]; u32x4 w;
                    w.x = cvt_pk_bf16(v0[0], v0[1]); w.y = cvt_pk_bf16(v0[2], v0[3]); w.z = cvt_pk_bf16(v1[0], v1[1]); w.w = cvt_pk_bf16(v1[2], v1[3]);
                    *(u32x4*)(O + vt_elem_off(16, b, dg, tk)) = w; } }
    }
};
__device__ __forceinline__ float ror1f(float x) { return __builtin_bit_cast(float, __builtin_amdgcn_mov_dpp(__builtin_bit_cast(int, x), 0x121, 0xF, 0xF, false)); }
__device__ __forceinline__ float ror2f(float x) { return __builtin_bit_cast(float, __builtin_amdgcn_mov_dpp(__builtin_bit_cast(int, x), 0x122, 0xF, 0xF, false)); }
__device__ __forceinline__ float gelu_fast(float x) { const float w = __builtin_fmaf(x * x, -2.3022081981f * 0.044715f, -2.3022081981f); return x * __builtin_amdgcn_rcpf(1.f + __builtin_amdgcn_exp2f(x * w)); }
struct EpiConvGelu {
    static constexpr bool PERM = true, AFTER_DRAIN = false, TABLE = true;
    bf16_t* ACT; const float* cw; const float* cb; float* SB;
    __device__ __forceinline__ void stage_table(const Unit& u, PG8_LAS unsigned char* tab, int tid) const {
        constexpr int LD2 = 2 * cDFF; const int v = tid >> 5, c4 = tid & 31, j = u.pn * 128 + 4 * c4;
        const float* src = ((v & 3) == 3 ? cb : cw + (v & 3) * LD2) + (v >> 2) * cDFF + j;
        *(PG8_LAS f32x4*)(tab + (v * 128 + 4 * c4) * 4) = *(const f32x4*)src; }
    __device__ __forceinline__ void run(const f32x4 (&acc)[2][2][4][2], const Unit& u, int wr, int wc, int fr, int fq, const PG8_LAS unsigned char* tab) const {
        constexpr int LD2 = 2 * cDFF;
        typedef unsigned u32x2 __attribute__((ext_vector_type(2)));
        u32x2 hold[2][4];
#pragma unroll
        for (int n = 0; n < 2; ++n) {
            const int ch0 = wc * 32 + 8 * fq + 4 * n, j0 = u.pn * 128 + ch0;
            const PG8_LAS f32x4* tv = (const PG8_LAS f32x4*)(tab + ch0 * 4);
            const f32x4 w0g = tv[0], w1g = tv[32], w2g = tv[64], bg = tv[96], w0v = tv[128], w1v = tv[160], w2v = tv[192], bv = tv[224];
#pragma unroll
            for (int ai = 0; ai < 2; ++ai) { const int rb = u.pm * BM + ai * HALF + wr * 64, blk = rb >> 6;
                f32x4 pg1, pg2, pv1, pv2;
#pragma unroll
                for (int m = 0; m < 4; ++m) { const f32x4 g = acc[ai][0][m][n], v = acc[ai][1][m][n]; const int row = rb + 16 * m + fr;
                    f32x4 g1, g2, v1, v2;
#pragma unroll
                    for (int e = 0; e < 4; ++e) { g1[e] = ror1f(g[e]); g2[e] = ror2f(g[e]); v1[e] = ror1f(v[e]); v2[e] = ror2f(v[e]); }
                    f32x4 a1g = g1, a2g = g2, a1v = v1, a2v = v2;
                    if (m > 0) { if (fr < 1) { a1g = pg1; a1v = pv1; } if (fr < 2) { a2g = pg2; a2v = pv2; } }
                    pg1 = g1; pg2 = g2; pv1 = v1; pv2 = v2;
                    if (m > 0 || fr >= 2) { float o[4];
#pragma unroll
                        for (int e = 0; e < 4; ++e) { const float cg = bg[e] + w0g[e] * a2g[e] + w1g[e] * a1g[e] + w2g[e] * g[e], cv = bv[e] + w0v[e] * a2v[e] + w1v[e] * a1v[e] + w2v[e] * v[e]; o[e] = gelu_fast(cg) * cv; }
                        u32x2 w; w.x = cvt_pk_bf16(o[0], o[1]); w.y = cvt_pk_bf16(o[2], o[3]);
                        if (n == 0) hold[ai][m] = w; else { u32x4 q; q.x = hold[ai][m].x; q.y = hold[ai][m].y; q.z = w.x; q.w = w.y; *(u32x4*)(ACT + (size_t)row * cDFF + j0 - 4) = q; } }
                    if (m == 0 && fr < 2) { float* sp = SB + ((size_t)blk * 4 + fr) * LD2; *(f32x4*)(sp + j0) = g; *(f32x4*)(sp + cDFF + j0) = v; }
                    if (m == 3 && fr >= 14) { float* sp = SB + ((size_t)blk * 4 + 2 + (fr - 14)) * LD2; *(f32x4*)(sp + j0) = g; *(f32x4*)(sp + cDFF + j0) = v; }
                } }
        }
    }
};
}
#define XB_TMO      128
#define XB_XCNT(j)  (256  + 64 * (j))
#define XB_XSUB(j)  (1280 + 64 * (j))
#define XB_XGEN(j)  (2304 + 64 * (j))
#define XB_TOP      3328
#define XB_TOPGEN   3392
#define XCD_BAR_WORDS 3456
#define XB_SPIN_CAP (1u << 18)

__device__ __forceinline__ unsigned xb_ld(unsigned* p)              { return __hip_atomic_load(p, __ATOMIC_RELAXED, __HIP_MEMORY_SCOPE_AGENT); }
__device__ __forceinline__ unsigned xb_add(unsigned* p, unsigned v) { return __hip_atomic_fetch_add(p, v, __ATOMIC_RELAXED, __HIP_MEMORY_SCOPE_AGENT); }
__device__ __forceinline__ unsigned xb_xcc_id() { return (unsigned)__builtin_amdgcn_s_getreg((3 << 11) | 20) & 0xFu; }
#define XB_SPIN(cond, bar) do { unsigned _sp = 0; while (cond) { __builtin_amdgcn_s_sleep(1); \
    if ((++_sp & 255u) == 0u) { if (xb_ld(&(bar)[XB_TMO])) break; if (_sp > XB_SPIN_CAP) { atomicAdd(&(bar)[XB_TMO], 1u); break; } } } } while (0)

struct XcdBarrier {
    unsigned* bar; unsigned x;
    volatile LAS unsigned* st;
};

__device__ __forceinline__ XcdBarrier xcd_barrier_post(unsigned* bar, volatile LAS unsigned* st) {
    XcdBarrier b; b.bar = bar; b.x = xb_xcc_id(); b.st = st;
    if (threadIdx.x == 0) (void)xb_add(&bar[XB_XCNT(b.x)], 1u);
    return b;
}
__device__ __forceinline__ void xcd_barrier_complete(unsigned* bar, unsigned x, unsigned& nloc, unsigned& nx) {
    const unsigned G = gridDim.x * gridDim.y * gridDim.z;
    unsigned sum, cnt, mine, sp = 0u;
    for (;;) {
        sum = 0u; cnt = 0u; mine = 0u;
#pragma unroll
        for (unsigned j = 0; j < 16; ++j) { const unsigned c = xb_ld(&bar[XB_XCNT(j)]); sum += c; cnt += (c > 0u) ? 1u : 0u; mine = (j == x) ? c : mine; }
        if (sum == G) break;
        __builtin_amdgcn_s_sleep(1);
        if ((++sp & 255u) == 0u) { if (xb_ld(&bar[XB_TMO])) break; if (sp > XB_SPIN_CAP) { atomicAdd(&bar[XB_TMO], 1u); break; } }
    }
    nloc = mine > 0u ? mine : 1u; nx = cnt > 0u ? cnt : 1u;
}

__device__ __forceinline__ void xcd_barrier(const XcdBarrier& b) {
    asm volatile("s_waitcnt vmcnt(0)" ::: "memory");
    __syncthreads();
    if (threadIdx.x == 0) {
        unsigned* bar = b.bar;
        __builtin_amdgcn_s_waitcnt(0);
        unsigned nloc = b.st[0], nx = b.st[1];
        if (nloc == 0u) { xcd_barrier_complete(bar, b.x, nloc, nx); b.st[0] = nloc; b.st[1] = nx; }
        const unsigned old = xb_add(&bar[XB_XSUB(b.x)], 1u);
        const unsigned gen = old / nloc;
        if (old + 1u == (gen + 1u) * nloc) {
            __builtin_amdgcn_fence(__ATOMIC_RELEASE, "agent");
            asm volatile("s_waitcnt vmcnt(0)" ::: "memory");
            const unsigned og = xb_add(&bar[XB_TOP], 1u);
            const unsigned tg = og / nx;
            if (og + 1u == (tg + 1u) * nx) xb_add(&bar[XB_TOPGEN], 1u);
            else XB_SPIN(xb_ld(&bar[XB_TOPGEN]) == tg, bar);
            __builtin_amdgcn_fence(__ATOMIC_ACQUIRE, "agent");
            xb_add(&bar[XB_XGEN(b.x)], 1u);
            asm volatile("s_waitcnt vmcnt(0)" ::: "memory");
        } else {
            XB_SPIN(xb_ld(&bar[XB_XGEN(b.x)]) == gen, bar);
            __builtin_amdgcn_fence(__ATOMIC_ACQUIRE, "agent");
            asm volatile("s_waitcnt vmcnt(0)" ::: "memory");
        }
    }
    __syncthreads();
}
constexpr int NWAVES = 8, NTHREADS = 512;
constexpr size_t MiB = 1u << 20;
constexpr size_t WS_CTL = 0, CTL_ZERO_BYTES = 65536;
constexpr size_t WS_WGT = 128 * 1024, WS_PEB = 256 * 1024;
constexpr size_t WS_WIN = 1 * MiB, WS_WV = 6 * MiB, WS_WOUT = 8 * MiB, WS_WUP = 10 * MiB, WS_WDN = 21 * MiB, WS_ROPE = 27 * MiB, WS_GATES = 29 * MiB, WS_KCMP = 32 * MiB,
                 WS_HID = 33 * MiB, WS_VCT = 41 * MiB, WS_W1T = 42 * MiB, WS_Y = 44 * MiB, WS_ATT = 44 * MiB  ,
                 WS_H16 = 108 * MiB  , WS_PROJ = 172 * MiB, WS_VT = 340 * MiB, WS_ACT = 172 * MiB  ,
                 WS_SB = 348 * MiB  , WS_Y2 = 406 * MiB,
                 WS_DOUT = 406 * MiB  , WS_DLSE = 454 * MiB, WS_VTP = 470 * MiB, WS_END = 504 * MiB;
static_assert((size_t)3 * cM * 256 * 2 <= WS_DLSE - WS_DOUT && WS_DLSE + (size_t)3 * cM * 4 * 4 <= WS_VTP && WS_VTP + (size_t)512 * VT_LD * 2 <= WS_END && (size_t)cM * PE_LD * 2 <= WS_VT - WS_PROJ && (size_t)1024 * VT_LD * 2 <= WS_Y2 - WS_VT
              && WS_ACT + (size_t)cM * cDFF * 2 <= WS_SB && WS_SB + (size_t)(cM / 64) * 4 * 2 * cDFF * 4 <= WS_Y2 && WS_H16 + (size_t)cM * cDM * 2 <= WS_PROJ, "workspace map");
constexpr int CW_BAR = 4096;
constexpr int RING_BYTES = 131072, LDSCTL_OFF = 8 * 17408  , MISC_OFF = LDSCTL_OFF + 320, LDS_BYTES = 147456;
typedef float f32x4 __attribute__((ext_vector_type(4)));

__device__ __forceinline__ int opaque(int x) { asm volatile("" : "+v"(x)); return x; }
__device__ __forceinline__ float wave_sum(float v) {
#pragma unroll
    for (int o = 1; o < 64; o <<= 1) v += __shfl_xor(v, o);
    return v;
}
__device__ __forceinline__ void n_row_dev(const float* xrow, const float* g, bf16* yrow, int lane) {
    float v[16]; float ss = 0.f;
#pragma unroll
    for (int j = 0; j < 2; ++j)
#pragma unroll
        for (int q = 0; q < 2; ++q) { const f32x4 t = *(const f32x4*)(xrow + 8 * lane + 512 * j + 4 * q);
            v[8 * j + 4 * q + 0] = t.x; v[8 * j + 4 * q + 1] = t.y; v[8 * j + 4 * q + 2] = t.z; v[8 * j + 4 * q + 3] = t.w; ss += t.x * t.x + t.y * t.y + t.z * t.z + t.w * t.w; }
    const float r = 1.f / sqrtf(wave_sum(ss) * (1.f / cDM) + 1e-6f);
#pragma unroll
    for (int j = 0; j < 2; ++j) { const float* gp = g + 8 * lane + 512 * j; U4 o;
        o.x = cvtpk(v[8 * j + 0] * r * gp[0], v[8 * j + 1] * r * gp[1]); o.y = cvtpk(v[8 * j + 2] * r * gp[2], v[8 * j + 3] * r * gp[3]);
        o.z = cvtpk(v[8 * j + 4] * r * gp[4], v[8 * j + 5] * r * gp[5]); o.w = cvtpk(v[8 * j + 6] * r * gp[6], v[8 * j + 7] * r * gp[7]);
        *(U4*)(yrow + 8 * lane + 512 * j) = o; }
}
template <bool HIN_F32, bool HOUT_F32>
__device__ __forceinline__ void nrn_row_dev(const void* hin_, const bf16* y2, const float* g1, const float* g2, void* hout_, bf16* yrow, int lane) {
    float v[16]; float ss = 0.f;
#pragma unroll
    for (int j = 0; j < 2; ++j) { const U4 t = *(const U4*)(y2 + 8 * lane + 512 * j);
        v[8 * j + 0] = bflo(t.x); v[8 * j + 1] = bfhi(t.x); v[8 * j + 2] = bflo(t.y); v[8 * j + 3] = bfhi(t.y); v[8 * j + 4] = bflo(t.z); v[8 * j + 5] = bfhi(t.z); v[8 * j + 6] = bflo(t.w); v[8 * j + 7] = bfhi(t.w); }
#pragma unroll
    for (int e = 0; e < 16; ++e) ss += v[e] * v[e];
    const float r = 1.f / sqrtf(wave_sum(ss) * (1.f / cDM) + 1e-6f);
    float s2 = 0.f;
#pragma unroll
    for (int j = 0; j < 2; ++j) { const int e0 = 8 * lane + 512 * j; float hv[8];
        if (HIN_F32) { const f32x4 a = *(const f32x4*)((const float*)hin_ + e0), b = *(const f32x4*)((const float*)hin_ + e0 + 4); hv[0] = a.x; hv[1] = a.y; hv[2] = a.z; hv[3] = a.w; hv[4] = b.x; hv[5] = b.y; hv[6] = b.z; hv[7] = b.w; }
        else { const U4 t = *(const U4*)((const bf16*)hin_ + e0); hv[0] = bflo(t.x); hv[1] = bfhi(t.x); hv[2] = bflo(t.y); hv[3] = bfhi(t.y); hv[4] = bflo(t.z); hv[5] = bfhi(t.z); hv[6] = bflo(t.w); hv[7] = bfhi(t.w); }
        const f32x4 ga = *(const f32x4*)(g1 + e0), gb = *(const f32x4*)(g1 + e0 + 4); const float gg[8] = {ga.x, ga.y, ga.z, ga.w, gb.x, gb.y, gb.z, gb.w};
#pragma unroll
        for (int e = 0; e < 8; ++e) { const float hn = hv[e] + v[8 * j + e] * r * gg[e]; v[8 * j + e] = hn; }
        if (HOUT_F32) { f32x4 a, b; a.x = v[8 * j]; a.y = v[8 * j + 1]; a.z = v[8 * j + 2]; a.w = v[8 * j + 3]; b.x = v[8 * j + 4]; b.y = v[8 * j + 5]; b.z = v[8 * j + 6]; b.w = v[8 * j + 7];
            *(f32x4*)((float*)hout_ + e0) = a; *(f32x4*)((float*)hout_ + e0 + 4) = b; }
        else { U4 o; o.x = cvtpk(v[8 * j], v[8 * j + 1]); o.y = cvtpk(v[8 * j + 2], v[8 * j + 3]);
            o.z = cvtpk(v[8 * j + 4], v[8 * j + 5]); o.w = cvtpk(v[8 * j + 6], v[8 * j + 7]);
            *(U4*)((bf16*)hout_ + e0) = o;
            v[8 * j + 0] = bflo(o.x); v[8 * j + 1] = bfhi(o.x); v[8 * j + 2] = bflo(o.y); v[8 * j + 3] = bfhi(o.y); v[8 * j + 4] = bflo(o.z); v[8 * j + 5] = bfhi(o.z); v[8 * j + 6] = bflo(o.w); v[8 * j + 7] = bfhi(o.w); }
#pragma unroll
        for (int e = 0; e < 8; ++e) s2 += v[8 * j + e] * v[8 * j + e]; }
    if (g2) { const float r2 = 1.f / sqrtf(wave_sum(s2) * (1.f / cDM) + 1e-6f);
#pragma unroll
        for (int j = 0; j < 2; ++j) { const float* gp = g2 + 8 * lane + 512 * j; U4 o;
            o.x = cvtpk(v[8 * j + 0] * r2 * gp[0], v[8 * j + 1] * r2 * gp[1]); o.y = cvtpk(v[8 * j + 2] * r2 * gp[2], v[8 * j + 3] * r2 * gp[3]);
            o.z = cvtpk(v[8 * j + 4] * r2 * gp[4], v[8 * j + 5] * r2 * gp[5]); o.w = cvtpk(v[8 * j + 6] * r2 * gp[6], v[8 * j + 7] * r2 * gp[7]);
            *(U4*)(yrow + 8 * lane + 512 * j) = o; } }
}

template <int K, int ldw, int N, int mode, int c0>
__device__ __forceinline__ void wprep_tile(const float* W, bf16* Bt, int tile, int lane, LAS float* scr) {
    constexpr int nblk = N / 32; const int kb = tile / nblk, nb = tile % nblk, k0 = 64 * kb, n0 = 32 * nb;
    const int c4 = 4 * (lane & 7), col = c0 + (mode ? wsrc_col(mode, n0 + c4) : n0 + c4);
#pragma unroll
    for (int i = 0; i < 8; ++i) { const int kk = 8 * i + (lane >> 3); const f32x4 t = *(const f32x4*)(W + (size_t)(k0 + kk) * ldw + col);
        scr[kk * 33 + c4] = t.x; scr[kk * 33 + c4 + 1] = t.y; scr[kk * 33 + c4 + 2] = t.z; scr[kk * 33 + c4 + 3] = t.w; }
    const int c = lane & 7;
#pragma unroll
    for (int j = 0; j < 4; ++j) { const int n = (lane >> 3) + 8 * j; const LAS float* s = scr + (8 * c) * 33 + n;
        U4 o; o.x = cvtpk(s[0], s[33]); o.y = cvtpk(s[2 * 33], s[3 * 33]);
        o.z = cvtpk(s[4 * 33], s[5 * 33]); o.w = cvtpk(s[6 * 33], s[7 * 33]);
        *(U4*)(Bt + (size_t)(n0 + n) * K + k0 + 8 * c) = o; }
    asm volatile("s_waitcnt lgkmcnt(0)" ::: "memory");
}
struct Args { const float* in[13]; float* out; unsigned char* ws; };

__global__ void __launch_bounds__(NTHREADS, 2) fwd(Args a) {
    extern __shared__ __attribute__((aligned(16))) unsigned char lds[];
    LAS unsigned char* L = (LAS unsigned char*)lds;
    const int tid = threadIdx.x, lane = tid & 63, wave = __builtin_amdgcn_readfirstlane(tid >> 6);
#define VCU() ((gridDim.x % 8 == 0) ? (int)((blockIdx.x % 8) * (gridDim.x / 8) + blockIdx.x / 8) : (int)blockIdx.x)
    for (int u = tid; u < (LDS_BYTES - LDSCTL_OFF) / 4; u += NTHREADS) ((LAS unsigned*)(L + LDSCTL_OFF))[u] = 0u;
    __syncthreads();
    XcdBarrier bar;
    { unsigned char* ws0 = a.ws; bar = xcd_barrier_post((unsigned*)(ws0 + WS_CTL) + CW_BAR, (volatile LAS unsigned*)(L + MISC_OFF) + 8); }
#define MKP() P p; unsigned char* wsb; { int z_ = 0; asm volatile("" : "+s"(z_)); unsigned char* ws = a.ws + z_; wsb = ws; const float* const* in_ = a.in + z_; \
    p.x = in_[0]; p.norm_g = in_[1]; p.even_w_in = in_[2]; p.even_w_out = in_[3]; p.cmp_pe = in_[4]; p.cmp_w1 = in_[5]; p.cmp_w2 = in_[6]; p.odd_w_in = in_[7]; p.odd_w_out = in_[8]; \
    p.ffn_w_up = in_[9]; p.ffn_conv_w = in_[10]; p.ffn_conv_b = in_[11]; p.ffn_w_down = in_[12]; p.out = (&a.out)[z_]; \
    p.Wt_in = (bf16*)(ws + WS_WIN); p.Wt_out = (bf16*)(ws + WS_WOUT); p.Wt_up = (bf16*)(ws + WS_WUP); p.Wt_dn = (bf16*)(ws + WS_WDN); \
    p.ROPE = (float*)(ws + WS_ROPE); p.GATES = (float*)(ws + WS_GATES); p.KCMP = (bf16*)(ws + WS_KCMP); \
    p.HID = (float*)(ws + WS_HID); p.Y = (bf16*)(ws + WS_Y); p.PROJ = (bf16*)(ws + WS_PROJ); p.ATT = (bf16*)(ws + WS_ATT); p.Y2 = (bf16*)(ws + WS_Y2); \
    p.ACT = (bf16*)(ws + WS_ACT); p.VT = (bf16*)(ws + WS_VT); p.VCT = (bf16*)(ws + WS_VCT); }

#define GRUN(N, call) do { const long _n = (long)(N); const long gthreads = (long)gridDim.x * NTHREADS; for (long i = (long)blockIdx.x * NTHREADS + opaque((int)threadIdx.x); i < _n; i += gthreads) { call; } } while (0)
#define GRID_BAR() xcd_barrier(bar)
#define GEMM_E(EpiT, Einit, Aptr, Btptr, Mrows, Ncols, Kdim) do { pg8::Gemm g{(const pg8::bf16_t*)(Aptr), (const pg8::bf16_t*)(Btptr), (int)(Mrows), (int)(Ncols), (int)(Kdim)}; \
        pg8::StaticOrder S; S.init((int)(Mrows), (int)(Ncols), (int)gridDim.x, (int)blockIdx.x); EpiT E Einit; \
        pg8::gemm_phase<EpiT, pg8::StaticOrder, true, true>(L, g, S, E); } while (0)
#define COMMA ,
#define GEMM(Aptr, Btptr, Mrows, Ncols, Kdim, Optr, ldo) GEMM_E(pg8::EpiBf16<0>, {(pg8::bf16_t*)(Optr) COMMA (int)(ldo) COMMA nullptr COMMA 0 COMMA 0 COMMA 1.f}, Aptr, Btptr, Mrows, Ncols, Kdim)
#define WT(Wp, K_, ldw_, N_, Btp, mode_, c0_) do { const int nt_ = ((N_) / 32) * ((K_) / 64); LAS float* scr_ = (LAS float*)(L + wave * 17408); \
        for (int t_ = blockIdx.x * NWAVES + wave; t_ < nt_; t_ += gridDim.x * NWAVES) wprep_tile<(K_), (ldw_), (N_), (mode_), (c0_)>((Wp), (Btp), t_, lane, scr_); } while (0)
#define WPREP(LL) do { const int _li = (LL) / 2; \
        if (((LL) & 1) == 0) { const float* W = p.even_w_in + (size_t)_li * cDM * EIN_W; \
            WT(W, cDM, EIN_W, LDE2, p.Wt_in, 1, 0); \
            WT(W, cDM, EIN_W, 1024, (bf16*)(wsb + WS_WV), 2, 0); \
            WT(p.even_w_out + (size_t)_li * 768 * cDM, 768, cDM, cDM, p.Wt_out, 0, 0); \
            WT(W, cDM, EIN_W, 32, (bf16*)(wsb + WS_WGT), 0, 1280); \
            WT(p.cmp_w1 + ((size_t)_li * 2 + 0) * 2048 * 256, 2048, 256, 256, (bf16*)(wsb + WS_W1T), 0, 0); \
            WT(p.cmp_w1 + ((size_t)_li * 2 + 1) * 2048 * 256, 2048, 256, 256, (bf16*)(wsb + WS_W1T) + (size_t)256 * 2048, 0, 0); \
            GRUN(512, peb_item(p.cmp_pe + (size_t)_li * 2 * 2048, p.cmp_w1 + (size_t)_li * 2 * 2048 * 256, (float*)(wsb + WS_PEB), i)); } \
        else { const float* W = p.odd_w_in + (size_t)_li * cDM * 3 * cDM; \
            WT(W, cDM, 3 * cDM, 2 * cDM, p.Wt_in, 0, 0); \
            WT(W, cDM, 3 * cDM, cDM, (bf16*)(wsb + WS_WV), 0, 2 * cDM); \
            WT(p.odd_w_out + (size_t)_li * cDM * cDM, cDM, cDM, cDM, p.Wt_out, 0, 0); } \
        WT(p.ffn_w_up + (size_t)(LL) * cDM * 2 * cDFF, cDM, 2 * cDFF, 2 * cDFF, p.Wt_up, 3, 0); \
        WT(p.ffn_w_down + (size_t)(LL) * cDFF * cDM, cDFF, cDM, cDM, p.Wt_dn, 0, 0); } while (0)
#define NRN(FIN, FOUT, hin_, hout_, g1_, g2_) do { for (long r = blockIdx.x * NWAVES + wave; r < cM; r += gridDim.x * NWAVES) nrn_row_dev<FIN, FOUT>((hin_) + r * cDM, p.Y2 + r * cDM, (g1_), (g2_), (hout_) + r * cDM, p.Y + r * cDM, lane); } while (0)
#define H16P ((bf16*)(wsb + WS_H16))
#define FFN(LL) do { \
        { MKP(); GEMM_E(pg8::EpiConvGelu, {(pg8::bf16_t*)p.ACT COMMA p.ffn_conv_w + (size_t)(LL) * 3 * 2 * cDFF COMMA p.ffn_conv_b + (size_t)(LL) * 2 * cDFF COMMA (float*)(wsb + WS_SB)}, p.Y, p.Wt_up, cM, 2 * cDFF, cDM); } GRID_BAR(); \
        { MKP(); GRUN((long)(cM / 64) * 2 * (cDFF / 4), convfix_item(p, (const float*)(wsb + WS_SB), p.ffn_conv_w + (size_t)(LL) * 3 * 2 * cDFF, p.ffn_conv_b + (size_t)(LL) * 2 * cDFF, i)); } GRID_BAR(); \
        { MKP(); GEMM(p.ACT, p.Wt_dn, cM, cDM, cDFF, p.Y2, cDM); } GRID_BAR(); \
        { MKP(); const float* ng = p.norm_g + (size_t)(LL) * 4 * cDM; if ((LL) + 1 < 4) NRN(false, false, H16P, H16P, ng + 3 * cDM, ng + 4 * cDM); else NRN(false, true, H16P, p.out, ng + 3 * cDM, (const float*)nullptr); \
          if ((LL) + 1 < 4) WPREP((LL) + 1); } GRID_BAR(); } while (0)
#define EVEN_LAYER(lp) do { const int LL = 2 * (lp); \
          { MKP(); GEMM_E(pg8::EpiRopeE, {(pg8::bf16_t*)p.PROJ COMMA PE_LD COMMA p.ROPE}, p.Y, p.Wt_in, cM, LDE2, cDM); } \
          { MKP(); GEMM_E(pg8::EpiVT, {(pg8::bf16_t*)p.VT}, (const bf16*)(wsb + WS_WV), p.Y, 1024, cM, cDM); } GRID_BAR();            \
          { MKP(); GRUN((long)512 * cB * (cS / 128), vtp_item(p.VT, (bf16*)(wsb + WS_VTP), i)); for (int u = blockIdx.x * NWAVES + wave; u < cM / 32; u += gridDim.x * NWAVES) gates_unit(p, (const bf16*)(wsb + WS_WGT), u, lane); \
            for (int u = blockIdx.x * NWAVES + wave; u < 2048; u += gridDim.x * NWAVES) cmp1_unit(p, (const bf16*)(wsb + WS_W1T), (const float*)(wsb + WS_PEB), u, lane); } GRID_BAR(); \
          { MKP(); GRUN((long)2 * cB * cNC * 2 * 32, cmp2_item(p, p.cmp_w2 + (size_t)(lp) * 2 * 256 * 64, i)); } GRID_BAR(); \
          { MKP(); const int ngw = gridDim.x * NWAVES; bf16* DO_ = (bf16*)(wsb + WS_DOUT); float* DL_ = (float*)(wsb + WS_DLSE); const bf16* VP_ = (const bf16*)(wsb + WS_VTP); \
              \
            for (int u = VCU() * NWAVES + wave; u < cB * 4 * 256; u += ngw) { const int bh = u >> 8, x = u & 255; \
                dil_unit<0>(p, p.VT, VP_, DO_, DL_, L + wave * 17408, bh >> 2, bh & 3, 0, x, lane); \
                dil_unit<1>(p, p.VT, VP_, DO_, DL_, L + wave * 17408, bh >> 2, bh & 3, x >> 6, x & 63, lane); \
                dil_unit<2>(p, p.VT, VP_, DO_, DL_, L + wave * 17408, bh >> 2, bh & 3, x >> 4, x & 15, lane); } } \
          { MKP(); const int ngw = gridDim.x * NWAVES, NT = cS / 8; LAS unsigned char* wl = L + wave * 17408; \
              \
            for (int u = VCU() * NWAVES + wave; u < cB * 2 * NT; u += ngw) { const int gw = u % ngw, k = u / ngw; int bg, tile; \
                if (ngw == 2048) { bg = gw >> 8; const int i = gw & 255; tile = 256 * k + ((k & 1) ? 255 - i : i); } else { bg = u / NT; tile = u % NT; } \
                nsa_unit(p, p.VCT, p.VT, wl, bg >> 1, bg & 1, tile * 8, lane); } } GRID_BAR(); \
          { MKP(); GRUN((long)cM * 32, dil_combine_item(p, (const bf16*)(wsb + WS_DOUT), (const float*)(wsb + WS_DLSE), i)); } GRID_BAR(); \
          { MKP(); GEMM(p.ATT, p.Wt_out, cM, cDM, 768, p.Y2, cDM); } GRID_BAR(); \
          { MKP(); const float* ng = p.norm_g + (size_t)LL * 4 * cDM; if ((lp) == 0) NRN(true, false, p.x, H16P, ng + cDM, ng + 2 * cDM); else NRN(false, false, H16P, H16P, ng + cDM, ng + 2 * cDM); } GRID_BAR(); \
          FFN(LL); } while (0)
#define ODD_LAYER(lp) do { const int LL = 2 * (lp) + 1; \
          { MKP(); GEMM(p.Y, p.Wt_in, cM, LDO2, cDM, p.PROJ, PO_LD); } \
          { MKP(); GEMM_E(pg8::EpiVT, {(pg8::bf16_t*)p.VT}, (const bf16*)(wsb + WS_WV), p.Y, 1024, cM, cDM); } GRID_BAR(); \
          { MKP(); const int NT = cS / 32; for (int u = VCU() * NWAVES + wave; u < cB * cNSB * NT; u += gridDim.x * NWAVES) { const int bh = u / NT; \
                sb_unit(p, p.VT, L + wave * 17408, bh / cNSB, bh % cNSB, (u % NT) * 32, lane); } } GRID_BAR(); \
          { MKP(); GEMM(p.ATT, p.Wt_out, cM, cDM, cDM, p.Y2, cDM); } GRID_BAR(); \
          { MKP(); const float* ng = p.norm_g + (size_t)LL * 4 * cDM; NRN(false, false, H16P, H16P, ng + cDM, ng + 2 * cDM); } GRID_BAR(); \
          FFN(LL); } while (0)

    { MKP();
      GRUN((long)cS * 32, rope_table_item(p, i));
      WPREP(0);
      for (long r = blockIdx.x * NWAVES + wave; r < cM; r += gridDim.x * NWAVES) n_row_dev(p.x + r * cDM, p.norm_g, p.Y + r * cDM, lane); }
    GRID_BAR();
    EVEN_LAYER(0); ODD_LAYER(0); EVEN_LAYER(1); ODD_LAYER(1);
}

extern "C" void kernel_launch(void* const* d_in, const int* in_sizes, int n_in, void* d_out, int out_size, void* d_ws, size_t ws_size, hipStream_t stream) {
    static int grid = 0;
    if (grid == 0) {
        if (n_in != 13 || out_size != cM * cDM || ws_size < WS_END) { fprintf(stderr, "kernel_launch: unexpected shapes (n_in %d out %d ws %zu)\n", n_in, out_size, ws_size); grid = -1; return; }
        int dev = 0, cus = 0;
        if (hipGetDevice(&dev) != hipSuccess || hipDeviceGetAttribute(&cus, hipDeviceAttributeMultiprocessorCount, dev) != hipSuccess) { grid = -1; return; }
        if (hipFuncSetAttribute((const void*)fwd, hipFuncAttributeMaxDynamicSharedMemorySize, LDS_BYTES) != hipSuccess) { grid = -1; return; }
        int per_cu = 0; (void)hipOccupancyMaxActiveBlocksPerMultiprocessor(&per_cu, (const void*)fwd, NTHREADS, LDS_BYTES); (void)hipGetLastError();
        grid = cus;
    }
    if (grid < 0) return;
    (void)hipMemsetAsync((char*)d_ws + WS_CTL, 0, CTL_ZERO_BYTES, stream);
    Args a{};
    for (int i = 0; i < 13; ++i) a.in[i] = (const float*)d_in[i];
    a.out = (float*)d_out; a.ws = (unsigned char*)d_ws;
    hipLaunchKernelGGL(fwd, dim3(grid), dim3(NTHREADS), LDS_BYTES, stream, a);
}
```

```cpp
#include <hip/hip_runtime.h>
#include <cstdio>
#include <cstdint>
#include <cmath>
#ifdef HOST_TEST
#include <cmath>
#include <cstring>
#include <cstdio>
#include <cstdlib>
#define HD
static int cB = 1, cS = 1024, cDM = 128, cDFF = 192;
#else
#define HD __device__ __forceinline__
constexpr int cB = 4, cS = 8192, cDM = 1024, cDFF = 2816;
#endif
typedef unsigned short bf16;
#define cM (cB * cS)
#define cNC ((cS - 32) / 16 + 1)
#define cNS (cS / 64)
#define cTOPN (cNS < 16 ? cNS : 16)
#define cNSB (cDM / 64)
#define LDE 3584
#define LDE2 2560
#define LDO2 2048
#define LDO (3 * cDM)
#define EIN_W 3608
#define KCMP_ROWS 512
#define PE_LD (LDE2 + 128)
#define PO_LD (LDO2 + 128)
#define VT_LD (cM + 128)
#define VCT_LD (KCMP_ROWS + 128)

struct alignas(16) U4 { unsigned x, y, z, w; };
HD float u2f(unsigned u) { float f; __builtin_memcpy(&f, &u, 4); return f; }
HD unsigned f2u(float f) { unsigned u; __builtin_memcpy(&u, &f, 4); return u; }
HD float bf2f(bf16 v) { return u2f((unsigned)v << 16); }
HD bf16 f2bf(float f) { unsigned u = f2u(f); return (bf16)((u + 0x7fffu + ((u >> 16) & 1u)) >> 16); }
HD unsigned pk2bf(float lo, float hi) {
#if defined(__HIP_DEVICE_COMPILE__)
    typedef float pk2f_t __attribute__((ext_vector_type(2))); typedef __bf16 pk2b_t __attribute__((ext_vector_type(2)));
    pk2f_t v = {lo, hi}; pk2b_t b = __builtin_convertvector(v, pk2b_t); return __builtin_bit_cast(unsigned, b);
#else
    return (unsigned)f2bf(lo) | ((unsigned)f2bf(hi) << 16);
#endif
}
HD float fast_exp2(float x) {
#if defined(__HIP_DEVICE_COMPILE__)
    return __builtin_amdgcn_exp2f(x);
#else
    return exp2f(x);
#endif
}
HD float fast_rcp(float x) {
#if defined(__HIP_DEVICE_COMPILE__)
    return __builtin_amdgcn_rcpf(x);
#else
    return 1.f / x;
#endif
}
HD float bflo(unsigned w) { return u2f(w << 16); }
HD float bfhi(unsigned w) { return u2f(w & 0xffff0000u); }

struct P {
    const float *x, *norm_g, *even_w_in, *even_w_out, *cmp_pe, *cmp_w1, *cmp_w2, *odd_w_in, *odd_w_out, *ffn_w_up, *ffn_conv_w, *ffn_conv_b, *ffn_w_down;
    float* out;
    bf16 *Wt_in, *Wt_out, *Wt_up, *Wt_dn;
    float* ROPE;
    float* GATES;
    bf16* KCMP;
    float* HID;
    bf16 *Y, *PROJ, *ATT, *Y2, *ACT;
    bf16* VT;
    bf16* VCT;
};

HD float gelu_tanh(float x) { return 0.5f * x * (1.f + tanhf(0.7978845608028654f * (x + 0.044715f * x * x * x))); }

HD void rope_table_item(const P& p, long idx) {
    const int pos = (int)(idx / 32), i = (int)(idx % 32);
    const double ang = (double)pos * pow(10000.0, -(double)i / 32.0);
    p.ROPE[idx * 2] = (float)cos(ang); p.ROPE[idx * 2 + 1] = (float)sin(ang);
}
HD void cmp2_item(const P& p, const float* w2, long idx) {
    const int i = (int)(idx % 32), g = (int)((idx / 32) % 2), n = (int)((idx / 64) % cNC), b = (int)((idx / (64L * cNC)) % cB), which = (int)(idx / (64L * cNC * cB));
    const float* hid = p.HID + ((((size_t)which * cB + b) * cNC + n) * 2 + g) * 256; const float* ww = w2 + (size_t)which * 256 * 64;
    float a1 = 0.f, a2 = 0.f;
    for (int j = 0; j < 256; ++j) { a1 += hid[j] * ww[j * 64 + i]; a2 += hid[j] * ww[j * 64 + i + 32]; }
    bf16* o = p.KCMP + (((size_t)b * KCMP_ROWS + n) * 2 + g) * 64;
    if (which == 0) { const int pos = 16 * n + 31; const float c = p.ROPE[(pos * 32 + i) * 2], s = p.ROPE[(pos * 32 + i) * 2 + 1];
        o[i] = f2bf(a1 * c - a2 * s); o[i + 32] = f2bf(a2 * c + a1 * s); }
    else { bf16* ot = p.VCT + ((size_t)(b * 2 + g) * 64 + i) * VCT_LD + n; ot[0] = f2bf(a1); ot[(size_t)32 * VCT_LD] = f2bf(a2);
        if (n == 0) { ot[511] = 0; ot[(size_t)32 * VCT_LD + 511] = 0; } }
    if (which == 0 && n == 0) { bf16* oz = p.KCMP + (((size_t)b * KCMP_ROWS + 511) * 2 + g) * 64; oz[i] = 0; oz[i + 32] = 0; }
}
HD void peb_item(const float* pe, const float* w1, float* PEB, long idx) {
    const int j = (int)(idx % 256), which = (int)(idx / 256);
    float acc = 0.f;
    for (int k = 0; k < 2048; ++k) acc += pe[(size_t)which * 2048 + k] * w1[((size_t)which * 2048 + k) * 256 + j];
    PEB[idx] = acc;
}
HD int wsrc_col(int mode, int n) {
    if (mode == 1) { const int u = n >> 8, c = n & 255, hiu = c >> 6, w = c & 63;
        if (u == 2) return 512 + c;
        const int d = (w & 7) < 4 ? 4 * (w >> 3) + (w & 7) : 32 + 4 * (w >> 3) + ((w & 7) - 4);
        int base;
        if (u < 2) base = 64 * (4 * u + hiu); else if (u == 3) base = hiu < 2 ? 768 + 64 * hiu : 1024 + 64 * (hiu - 2);
        else if (u < 7) base = 1304 + 64 * (4 * (u - 4) + hiu); else base = 1304 + 768 + 64 * (4 * (u - 7) + hiu);
        return base + d; }
    if (mode == 2) return n < 128 ? 896 + n : n < 256 ? 1152 + (n - 128) : 2840 + (n - 256);
    if (mode == 3) { const int pn = n >> 8, bj = (n >> 7) & 1, x = n & 127; return bj * cDFF + 128 * pn + x; }
    return n;
}
HD float gelu_fast_h(float x) { const float z = x + 0.044715f * x * x * x; return x * fast_rcp(1.f + fast_exp2(-2.3022081981f * z)); }
struct alignas(16) F4 { float v[4]; };
HD void convfix_item(const P& p, const float* SB, const float* cw, const float* cb, long idx) {
    constexpr int Q = cDFF / 4; const int j = 4 * (int)(idx % Q), rr = (int)((idx / Q) % 2); const long blk = idx / (2L * Q); const long row = blk * 64 + rr; const int t = (int)(row % cS), LD2 = 2 * cDFF;
    const float* s0 = SB + ((size_t)blk * 4 + rr) * LD2; const float* sp = SB + ((size_t)(blk - 1) * 4) * LD2;
    const float* sm = SB + ((size_t)blk * 4) * LD2;
#define LD4(ptr) (*(const F4*)(ptr))
    const F4 bg = LD4(cb + j), bv = LD4(cb + cDFF + j), w2g = LD4(cw + 2 * LD2 + j), w2v = LD4(cw + 2 * LD2 + cDFF + j), w1g = LD4(cw + LD2 + j), w1v = LD4(cw + LD2 + cDFF + j), w0g = LD4(cw + j), w0v = LD4(cw + cDFF + j);
    const F4 ug = LD4(s0 + j), uv = LD4(s0 + cDFF + j);
    F4 g1 = {{0.f, 0.f, 0.f, 0.f}}, v1 = g1, g2 = g1, v2 = g1;
    if (rr == 0) { if (t >= 1) { g1 = LD4(sp + 3 * LD2 + j); v1 = LD4(sp + 3 * LD2 + cDFF + j); g2 = LD4(sp + 2 * LD2 + j); v2 = LD4(sp + 2 * LD2 + cDFF + j); } }
    else { g1 = LD4(sm + j); v1 = LD4(sm + cDFF + j); if (t >= 2) { g2 = LD4(sp + 3 * LD2 + j); v2 = LD4(sp + 3 * LD2 + cDFF + j); } }
#undef LD4
    float o[4];
#pragma unroll
    for (int e = 0; e < 4; ++e) { const float cg = bg.v[e] + w2g.v[e] * ug.v[e] + w1g.v[e] * g1.v[e] + w0g.v[e] * g2.v[e], cv = bv.v[e] + w2v.v[e] * uv.v[e] + w1v.v[e] * v1.v[e] + w0v.v[e] * v2.v[e];
        o[e] = gelu_fast_h(cg) * cv; }
    uint2 w; w.x = pk2bf(o[0], o[1]); w.y = pk2bf(o[2], o[3]);
    *(uint2*)(p.ACT + (size_t)row * cDFF + j) = w;
}
HD size_t vt_tile_off(int ngrp, int b, int grp, int tile) { return (((size_t)b * ngrp + grp) * (cS / 32) + tile) * 2048; }
HD size_t vt_elem_off(int ngrp, int b, int dg, int tk) { return vt_tile_off(ngrp, b, dg >> 6, tk >> 5) + (size_t)(dg & 63) * 32 + (tk & 31); }
template <int dil> HD void vtp_run(const bf16* src, bf16* VTP, int b, int pr, int G) {
    unsigned in[64];
#pragma unroll
    for (int q = 0; q < 4; ++q)
#pragma unroll
        for (int c = 0; c < 4; ++c) { const U4 v = *(const U4*)(src + (size_t)q * 2048 + 8 * c); in[16 * q + 4 * c] = v.x; in[16 * q + 4 * c + 1] = v.y; in[16 * q + 4 * c + 2] = v.z; in[16 * q + 4 * c + 3] = v.w; }
    constexpr int per = cS / dil, nm = 128 / dil;
#pragma unroll
    for (int rc = 0; rc < dil; ++rc)
#pragma unroll
        for (int o8 = 0; o8 < nm / 8; ++o8) { unsigned w[4];
#pragma unroll
            for (int e = 0; e < 4; ++e) { const int t0_ = dil * (8 * o8 + 2 * e) + rc, t1_ = t0_ + dil;
                const unsigned lo = (t0_ & 1) ? (in[t0_ >> 1] >> 16) : (in[t0_ >> 1] & 0xFFFFu), hi = (t1_ & 1) ? (in[t1_ >> 1] & 0xFFFF0000u) : (in[t1_ >> 1] << 16);
                w[e] = lo | hi; }
            U4 v; v.x = w[0]; v.y = w[1]; v.z = w[2]; v.w = w[3];
            *(U4*)(VTP + vt_elem_off(8, b, pr, rc * per + nm * G + 8 * o8)) = v; }
}
HD void vtp_item(const bf16* VT, bf16* VTP, long idx) {
    const int ng = cS / 128; const int G = (int)(idx % ng), b = (int)((idx / ng) % cB), pr = (int)(idx / ((long)ng * cB));
    const bf16* src = VT + vt_elem_off(16, b, 512 + pr, 128 * G);
    if (pr < 256) vtp_run<4>(src, VTP, b, pr, G); else vtp_run<16>(src, VTP, b, pr, G);
}
HD void dil_combine_item(const P& p, const bf16* DOUT, const float* DLSE, long idx) {
    const int c8 = (int)(idx % 8), hd = (int)((idx / 8) % 4); const long row = idx / 32;
    const float l0 = DLSE[((size_t)0 * cM + row) * 4 + hd], l1 = DLSE[((size_t)1 * cM + row) * 4 + hd], l2 = DLSE[((size_t)2 * cM + row) * 4 + hd];
    const float mx = fmaxf(l0, fmaxf(l1, l2)), e0 = fast_exp2(l0 - mx), e1 = fast_exp2(l1 - mx), e2 = fast_exp2(l2 - mx), rs = fast_rcp(e0 + e1 + e2);
    const U4 a = *(const U4*)(DOUT + ((size_t)0 * cM + row) * 256 + hd * 64 + 8 * c8), bq = *(const U4*)(DOUT + ((size_t)1 * cM + row) * 256 + hd * 64 + 8 * c8), cq = *(const U4*)(DOUT + ((size_t)2 * cM + row) * 256 + hd * 64 + 8 * c8);
    const float w0 = e0 * rs, w1 = e1 * rs, w2 = e2 * rs;
    U4 o;
    o.x = pk2bf(w0 * bflo(a.x) + w1 * bflo(bq.x) + w2 * bflo(cq.x), w0 * bfhi(a.x) + w1 * bfhi(bq.x) + w2 * bfhi(cq.x));
    o.y = pk2bf(w0 * bflo(a.y) + w1 * bflo(bq.y) + w2 * bflo(cq.y), w0 * bfhi(a.y) + w1 * bfhi(bq.y) + w2 * bfhi(cq.y));
    o.z = pk2bf(w0 * bflo(a.z) + w1 * bflo(bq.z) + w2 * bflo(cq.z), w0 * bfhi(a.z) + w1 * bfhi(bq.z) + w2 * bfhi(cq.z));
    o.w = pk2bf(w0 * bflo(a.w) + w1 * bflo(bq.w) + w2 * bflo(cq.w), w0 * bfhi(a.w) + w1 * bfhi(bq.w) + w2 * bfhi(cq.w));
    *(U4*)(p.ATT + (size_t)row * 768 + 512 + hd * 64 + 8 * c8) = o;
}
#define LAS __attribute__((address_space(3)))
typedef short bf16x8v __attribute__((ext_vector_type(8)));
typedef short bf16x4v __attribute__((ext_vector_type(4)));
typedef float f32x16 __attribute__((ext_vector_type(16)));
typedef float f32x2_t __attribute__((ext_vector_type(2)));
typedef float f32x4v __attribute__((ext_vector_type(4)));
typedef __bf16 bf16x2_t __attribute__((ext_vector_type(2)));
__device__ __forceinline__ unsigned cvtpk(float lo, float hi) { f32x2_t v = {lo, hi}; bf16x2_t b = __builtin_convertvector(v, bf16x2_t); return __builtin_bit_cast(unsigned, b); }
__device__ __forceinline__ float fexp2(float x) { return __builtin_amdgcn_exp2f(x); }
#define ATT_C2 (0.125f * 1.4426950408889634f)
#define ATT_NEG (-1e30f)
#define ATT_THR 8.0f

typedef unsigned u32x2v __attribute__((ext_vector_type(2)));
__device__ __forceinline__ float vmax2(float a, float b) { float d; asm("v_max_f32 %0, %1, %2" : "=v"(d) : "v"(a), "v"(b)); return d; }
__device__ __forceinline__ float vmax3(float a, float b, float c) { float d; asm("v_max3_f32 %0, %1, %2, %3" : "=v"(d) : "v"(a), "v"(b), "v"(c)); return d; }
__device__ __forceinline__ float vmax16(const f32x16& s) {
    const float a = vmax3(s[0], s[1], s[2]), b = vmax3(s[3], s[4], s[5]), c = vmax3(s[6], s[7], s[8]), d = vmax3(s[9], s[10], s[11]), e = vmax3(s[12], s[13], s[14]);
    return vmax2(vmax3(vmax3(a, b, c), d, e), s[15]); }
__device__ __forceinline__ float vmax16_acc(const f32x16& s) { float d;
    asm("s_nop 11\n\tv_max3_f32 %0, %1, %2, %3\n\tv_max3_f32 %0, %0, %4, %5\n\tv_max3_f32 %0, %0, %6, %7\n\tv_max3_f32 %0, %0, %8, %9\n\t"
        "v_max3_f32 %0, %0, %10, %11\n\tv_max3_f32 %0, %0, %12, %13\n\tv_max3_f32 %0, %0, %14, %15\n\tv_max_f32 %0, %0, %16"
        : "=&v"(d) : "v"(s[0]), "v"(s[1]), "v"(s[2]), "v"(s[3]), "v"(s[4]), "v"(s[5]), "v"(s[6]), "v"(s[7]), "v"(s[8]), "v"(s[9]), "v"(s[10]), "v"(s[11]), "v"(s[12]), "v"(s[13]), "v"(s[14]), "v"(s[15]));
    return d; }
#define OPQ(x) asm("" : "+v"(x))
__device__ __forceinline__ float vsum16(const f32x16& s) {
    float a0 = s[0] + s[1], a1 = s[2] + s[3], a2 = s[4] + s[5], a3 = s[6] + s[7], a4 = s[8] + s[9], a5 = s[10] + s[11], a6 = s[12] + s[13], a7 = s[14] + s[15];
    OPQ(a0); OPQ(a1); OPQ(a2); OPQ(a3); OPQ(a4); OPQ(a5); OPQ(a6); OPQ(a7);
    float b0 = a0 + a1, b1 = a2 + a3, b2 = a4 + a5, b3 = a6 + a7; OPQ(b0); OPQ(b1); OPQ(b2); OPQ(b3);
    float c0 = b0 + b1, c1 = b2 + b3; OPQ(c0); OPQ(c1);
    return c0 + c1; }
__device__ __forceinline__ float xmax32(float x) { float y; asm volatile("v_mov_b32 %0, %1\n\ts_nop 1" : "=v"(y) : "v"(x));
    auto r = __builtin_amdgcn_permlane32_swap(__builtin_bit_cast(unsigned, x), __builtin_bit_cast(unsigned, y), false, false); const unsigned a = r[0], b = r[1];
    return vmax2(__builtin_bit_cast(float, a), __builtin_bit_cast(float, b)); }
__device__ __forceinline__ float xsum32(float x) { float y; asm volatile("v_mov_b32 %0, %1\n\ts_nop 1" : "=v"(y) : "v"(x));
    auto r = __builtin_amdgcn_permlane32_swap(__builtin_bit_cast(unsigned, x), __builtin_bit_cast(unsigned, y), false, false); const unsigned a = r[0], b = r[1];
    return __builtin_bit_cast(float, a) + __builtin_bit_cast(float, b); }
__device__ __forceinline__ void store_row64(bf16* rowp, int hh, const float (&o)[32], float sc) {
#pragma unroll
    for (int dt = 0; dt < 2; ++dt)
#pragma unroll
        for (int kp = 0; kp < 2; ++kp) { const float* q = o + 16 * dt + 8 * kp;
            const unsigned a0 = cvtpk(q[0] * sc, q[1] * sc), a1 = cvtpk(q[2] * sc, q[3] * sc), b0 = cvtpk(q[4] * sc, q[5] * sc), b1 = cvtpk(q[6] * sc, q[7] * sc);
            auto r0 = __builtin_amdgcn_permlane32_swap(a0, b0, false, false); auto r1 = __builtin_amdgcn_permlane32_swap(a1, b1, false, false);
            U4 w; w.x = r0[0]; w.y = r1[0]; w.z = r0[1]; w.w = r1[1];
            *(U4*)(rowp + 32 * dt + 16 * kp + 8 * hh) = w; }
}
__device__ __forceinline__ f32x16 zero16() { f32x16 z;
#pragma unroll
    for (int i = 0; i < 16; ++i) z[i] = 0.f;
    return z; }
__device__ __forceinline__ f32x16 qk32(const bf16* kp, const bf16x8v (&qf)[4]) {
    f32x16 acc = zero16();
#pragma unroll
    for (int ks = 0; ks < 4; ++ks) { const bf16x8v kf = *(const bf16x8v*)(kp + 16 * ks); acc = __builtin_amdgcn_mfma_f32_32x32x16_bf16(kf, qf[ks], acc, 0, 0, 0); }
    return acc;
}
__device__ __forceinline__ void pv32(f32x16& o0, f32x16& o1, const bf16* vt, size_t dstep, const unsigned (&pb)[8]) {
#pragma unroll
    for (int s = 0; s < 2; ++s) {
        const bf16x4v a00 = *(const bf16x4v*)(vt + 16 * s), a01 = *(const bf16x4v*)(vt + 16 * s + 8);
        const bf16x4v a10 = *(const bf16x4v*)(vt + dstep + 16 * s), a11 = *(const bf16x4v*)(vt + dstep + 16 * s + 8);
        bf16x8v A0, A1, B;
        A0 = __builtin_shufflevector(a00, a01, 0, 1, 2, 3, 4, 5, 6, 7); A1 = __builtin_shufflevector(a10, a11, 0, 1, 2, 3, 4, 5, 6, 7);
        typedef unsigned u32x4v __attribute__((ext_vector_type(4)));
        u32x4v bw = {pb[4 * s + 0], pb[4 * s + 1], pb[4 * s + 2], pb[4 * s + 3]};
        B = __builtin_bit_cast(bf16x8v, bw);
        o0 = __builtin_amdgcn_mfma_f32_32x32x16_bf16(A0, B, o0, 0, 0, 0);
        o1 = __builtin_amdgcn_mfma_f32_32x32x16_bf16(A1, B, o1, 0, 0, 0);
    }
}
struct KF { bf16x8v k[4]; };
struct VF { bf16x4v v[8]; };
__device__ __forceinline__ void load_k(KF& f, const bf16* kp) {
#pragma unroll
    for (int ks = 0; ks < 4; ++ks) f.k[ks] = *(const bf16x8v*)(kp + 16 * ks); }
__device__ __forceinline__ void load_v(VF& f, const bf16* vt, size_t dstep) {
#pragma unroll
    for (int s = 0; s < 2; ++s) { f.v[2 * s] = *(const bf16x4v*)(vt + 16 * s); f.v[2 * s + 1] = *(const bf16x4v*)(vt + 16 * s + 8);
        f.v[4 + 2 * s] = *(const bf16x4v*)(vt + dstep + 16 * s); f.v[4 + 2 * s + 1] = *(const bf16x4v*)(vt + dstep + 16 * s + 8); } }
__device__ __forceinline__ f32x16 qk32r(const KF& f, const bf16x8v (&qf)[4]) {
    f32x16 acc = zero16();
#pragma unroll
    for (int ks = 0; ks < 4; ++ks) acc = __builtin_amdgcn_mfma_f32_32x32x16_bf16(f.k[ks], qf[ks], acc, 0, 0, 0);
    return acc; }
__device__ __forceinline__ void pv32r(f32x16& o0, f32x16& o1, const VF& f, const unsigned (&pb)[8]) {
    typedef unsigned u32x4v __attribute__((ext_vector_type(4)));
#pragma unroll
    for (int s = 0; s < 2; ++s) {
        const bf16x8v A0 = __builtin_shufflevector(f.v[2 * s], f.v[2 * s + 1], 0, 1, 2, 3, 4, 5, 6, 7), A1 = __builtin_shufflevector(f.v[4 + 2 * s], f.v[4 + 2 * s + 1], 0, 1, 2, 3, 4, 5, 6, 7);
        const u32x4v bw = {pb[4 * s + 0], pb[4 * s + 1], pb[4 * s + 2], pb[4 * s + 3]}; const bf16x8v B = __builtin_bit_cast(bf16x8v, bw);
        o0 = __builtin_amdgcn_mfma_f32_32x32x16_bf16(A0, B, o0, 0, 0, 0); o1 = __builtin_amdgcn_mfma_f32_32x32x16_bf16(A1, B, o1, 0, 0, 0); } }
__device__ __forceinline__ unsigned long long wave_or64(unsigned long long x) {
    unsigned lo = (unsigned)x, hi = (unsigned)(x >> 32);
#pragma unroll
    for (int o = 1; o < 64; o <<= 1) { lo |= (unsigned)__shfl_xor((int)lo, o); hi |= (unsigned)__shfl_xor((int)hi, o); }
    return ((unsigned long long)(unsigned)__builtin_amdgcn_readfirstlane((int)hi) << 32) | (unsigned)__builtin_amdgcn_readfirstlane((int)lo); }
struct LaneAddr { unsigned ck, cv; unsigned rk[4], rv[4], rw[4]; };
__device__ __forceinline__ LaneAddr lane_addr(LAS unsigned char* slot, int lane) {
    LaneAddr a; const int r = lane & 31, hh = lane >> 5; const unsigned sb = (unsigned)(size_t)slot;
    a.ck = (unsigned)lane; a.cv = (unsigned)lane;
#pragma unroll
    for (int ks = 0; ks < 4; ++ks) a.rk[ks] = sb + r * 128 + (((2 * ks + hh) ^ (r & 7)) * 16);
#pragma unroll
    for (int c = 0; c < 4; ++c) { a.rv[c] = sb + 4096 + r * 64 + ((c ^ ((r >> 2) & 3)) * 16) + 8 * hh; unsigned w = a.rv[c] + 2048; asm volatile("" : "+v"(w)); a.rw[c] = w; }
    return a; }
__device__ __forceinline__ unsigned kvoff(int lane, size_t pitch) { const int row = lane >> 3, ch = (lane & 7) ^ (row & 7); return (unsigned)((row * pitch + ch * 8) * 2); }
__device__ __forceinline__ unsigned vvoff(int lane, size_t pitch) { const int row = lane >> 2, ch = (lane & 3) ^ ((row >> 2) & 3); return (unsigned)((row * pitch + ch * 8) * 2); }
typedef __amdgpu_buffer_rsrc_t rsrc_t;
__device__ __forceinline__ rsrc_t mkrsrc(const void* base) { return __builtin_amdgcn_make_buffer_rsrc((void*)base, 0, 0x7FFFFFF0, 0x00020000); }
__device__ __forceinline__ void dma_k(LAS unsigned char* slot, rsrc_t rs, unsigned tile_off, unsigned pitchB, unsigned voff) {
#pragma unroll
    for (int q = 0; q < 4; ++q) __builtin_amdgcn_raw_ptr_buffer_load_lds(rs, (LAS unsigned*)(slot + q * 1024), 16, voff, tile_off + q * 8 * pitchB, 0, 0); }
__device__ __forceinline__ void dma_v(LAS unsigned char* slot, rsrc_t rs, unsigned tile_off, unsigned pitchB, unsigned voff) {
#pragma unroll
    for (int q = 0; q < 4; ++q) __builtin_amdgcn_raw_ptr_buffer_load_lds(rs, (LAS unsigned*)(slot + 4096 + q * 1024), 16, voff, tile_off + q * 16 * pitchB, 0, 0); }
__device__ __forceinline__ void read_k(KF& f, const LaneAddr& a) {
#pragma unroll
    for (int ks = 0; ks < 4; ++ks) f.k[ks] = *(const LAS bf16x8v*)(size_t)a.rk[ks]; }
__device__ __forceinline__ void read_v(VF& f, const LaneAddr& a) {
#pragma unroll
    for (int dt = 0; dt < 2; ++dt)
#pragma unroll
        for (int s = 0; s < 2; ++s) { f.v[4 * dt + 2 * s] = *(const LAS bf16x4v*)(size_t)(dt ? a.rw[2 * s] : a.rv[2 * s]); f.v[4 * dt + 2 * s + 1] = *(const LAS bf16x4v*)(size_t)(dt ? a.rw[2 * s + 1] : a.rv[2 * s + 1]); } }
#define DMA_WAIT() asm volatile("s_waitcnt vmcnt(0)" ::: "memory")
#define LDS_DRAIN() asm volatile("s_waitcnt lgkmcnt(0)" ::: "memory")
#define LDS_DRAIN_PINNED() do { __builtin_amdgcn_sched_barrier(0); asm volatile("s_waitcnt lgkmcnt(0)" ::: "memory"); } while (0)
#define ATT_BIG 1.152921504606847e18f
__device__ __forceinline__ void sm_fast(f32x16& s, const KF& kc, const bf16x8v (&qf)[4], bool lane_on, float& m, float& l, f32x16& o0, f32x16& o1, unsigned (&pb)[8]) {
    float nb = lane_on ? -m : -INFINITY;
#pragma unroll
    for (int reg = 0; reg < 16; ++reg) s[reg] = fexp2(__builtin_fmaf(s[reg], ATT_C2, nb));
    float rs = vsum16(s);
    if (__any(!(rs < ATT_BIG))) {
        s = qk32r(kc, qf);
        float mx = vmax16_acc(s);
        mx = xmax32(lane_on ? mx * ATT_C2 : ATT_NEG);
        const float mn = (mx > m + ATT_THR) ? mx : m, alpha = fexp2(m - mn); m = mn; l *= alpha;
#pragma unroll
        for (int reg = 0; reg < 16; ++reg) { o0[reg] *= alpha; o1[reg] *= alpha; }
        nb = lane_on ? -m : -INFINITY;
#pragma unroll
        for (int reg = 0; reg < 16; ++reg) s[reg] = fexp2(__builtin_fmaf(s[reg], ATT_C2, nb));
        rs = vsum16(s); }
    l += rs;
#pragma unroll
    for (int i = 0; i < 8; ++i) pb[i] = cvtpk(s[2 * i], s[2 * i + 1]);
}
__device__ __forceinline__ void sm_step(f32x16& s, const KF& kc, const bf16x8v (&qf)[4], int lo, int hi, int hh, float& m, float& l, f32x16& o0, f32x16& o1, unsigned (&pb)[8]) {
    const float nb = -m;
#pragma unroll
    for (int reg = 0; reg < 16; ++reg) { const int ko = (reg & 3) + 8 * (reg >> 2) + 4 * hh; const bool v = (ko >= lo) && (ko <= hi);
        const float e = fexp2(__builtin_fmaf(s[reg], ATT_C2, nb)); s[reg] = v ? e : 0.f; }
    float rs = vsum16(s);
    if (__any(!(rs < ATT_BIG))) {
        s = qk32r(kc, qf);
#pragma unroll
        for (int reg = 0; reg < 16; ++reg) { const int ko = (reg & 3) + 8 * (reg >> 2) + 4 * hh; const bool v = (ko >= lo) && (ko <= hi);
            s[reg] = v ? s[reg] * ATT_C2 : ATT_NEG; }
        const float mx = xmax32(vmax16(s));
        const float mn = (mx > m + ATT_THR) ? mx : m, alpha = fexp2(m - mn); m = mn; l *= alpha;
#pragma unroll
        for (int reg = 0; reg < 16; ++reg) { o0[reg] *= alpha; o1[reg] *= alpha; }
#pragma unroll
        for (int reg = 0; reg < 16; ++reg) s[reg] = (s[reg] > -1e29f) ? fexp2(s[reg] - m) : 0.f;
        rs = vsum16(s); }
    l += rs;
#pragma unroll
    for (int i = 0; i < 8; ++i) pb[i] = cvtpk(s[2 * i], s[2 * i + 1]);
}

__device__ __forceinline__ float dpp_xor1(float x) { return __builtin_bit_cast(float, __builtin_amdgcn_update_dpp(0, __builtin_bit_cast(int, x), 0xB1, 0xF, 0xF, true)); }
__device__ __forceinline__ float dpp_xor2(float x) { return __builtin_bit_cast(float, __builtin_amdgcn_update_dpp(0, __builtin_bit_cast(int, x), 0x4E, 0xF, 0xF, true)); }
#define IMP_LD 132
__device__ __forceinline__ void nsa_unit(const P& p, const bf16* VCT, const bf16* VT, LAS unsigned char* wl, int b, int g, int t0, int lane) {
    const LaneAddr la = lane_addr(wl, lane);
    LAS float* imp = (LAS float*)(wl + 8192);
    const int r = lane & 31, hh = lane >> 5, tl = r >> 2, hg = r & 3, head = g * 4 + hg, t = t0 + tl;
    const long row = (long)b * cS + t;
    bf16x8v qf[4];
    { const bf16* qp = p.PROJ + (size_t)row * PE_LD + head * 64 + 8 * hh;
#pragma unroll
      for (int ks = 0; ks < 4; ++ks) qf[ks] = *(const bf16x8v*)(qp + 16 * ks); }
    float outacc[32];
    unsigned pb[8];
    unsigned long long m0 = 0ull, m1 = 0ull;
    {
        for (int i = lane; i < 8 * IMP_LD; i += 64) imp[i] = 0.f;
        const int nv = t >= 31 ? (t - 31) / 16 + 1 : 0, nvmax = (t0 + 7) >= 31 ? (t0 + 7 - 31) / 16 + 1 : 0, ntile = (nvmax + 31) >> 5;
        float m = ATT_NEG, l = 0.f;
        const bf16* kc0 = p.KCMP + ((size_t)b * KCMP_ROWS * 2 + g) * 64;
        const bf16* vc0 = VCT + (size_t)(b * 2 + g) * 64 * VCT_LD;
        const rsrc_t rsK = mkrsrc(kc0), rsV = mkrsrc(vc0); const unsigned kvo = kvoff(lane, 128), vvo = vvoff(lane, VCT_LD);
        KF kc; VF vc;
        if (ntile > 0) { dma_k(wl, rsK, 0u, 128 * 2, kvo); DMA_WAIT(); read_k(kc, la); }
        for (int kt = 0; kt < ntile; ++kt) { const int key0 = 32 * kt;
            LDS_DRAIN();
            if (kt + 1 < ntile) dma_k(wl, rsK, (unsigned)(key0 + 32) * (128 * 2), 128 * 2, kvo);
            f32x16 s = qk32r(kc, qf);
            float mx = ATT_NEG;
#pragma unroll
            for (int reg = 0; reg < 16; ++reg) { const int ko = (reg & 3) + 8 * (reg >> 2) + 4 * hh; const float x = (key0 + ko < nv) ? s[reg] * ATT_C2 : ATT_NEG; s[reg] = x; mx = fmaxf(mx, x); }
            mx = xmax32(mx);
            const float mn = fmaxf(m, mx); float rs = 0.f;
#pragma unroll
            for (int reg = 0; reg < 16; ++reg) rs += (s[reg] > -1e29f) ? fexp2(s[reg] - mn) : 0.f;
            rs = xsum32(rs);
            l = l * fexp2(m - mn) + rs; m = mn;
            if (kt + 1 < ntile) { DMA_WAIT(); read_k(kc, la); } }
        const float rl = l > 0.f ? 1.f / l : 0.f;
        f32x16 o0 = zero16(), o1 = zero16();
        if (ntile > 0) { dma_k(wl, rsK, 0u, 128 * 2, kvo); dma_v(wl, rsV, 0u, VCT_LD * 2, vvo); DMA_WAIT(); read_k(kc, la); }
        for (int kt = 0; kt < ntile; ++kt) { const int key0 = 32 * kt;
            LDS_DRAIN(); if (kt + 1 < ntile) dma_k(wl, rsK, (unsigned)(key0 + 32) * (128 * 2), 128 * 2, kvo);
            read_v(vc, la);
            f32x16 s = qk32r(kc, qf);
            LDS_DRAIN_PINNED(); if (kt + 1 < ntile) dma_v(wl, rsV, (unsigned)(key0 + 32) * 2, VCT_LD * 2, vvo);
#pragma unroll
            for (int reg = 0; reg < 16; ++reg) { const int ko = (reg & 3) + 8 * (reg >> 2) + 4 * hh; s[reg] = (key0 + ko < nv) ? fexp2(s[reg] * ATT_C2 - m) * rl : 0.f; }
#pragma unroll
            for (int i = 0; i < 8; ++i) pb[i] = cvtpk(s[2 * i], s[2 * i + 1]);
            pv32r(o0, o1, vc, pb);
#pragma unroll
            for (int k = 0; k < 4; ++k) { float a = s[4 * k] + s[4 * k + 1] + s[4 * k + 2] + 0.5f * s[4 * k + 3], c = 0.5f * s[4 * k + 3];
                a += dpp_xor1(a); a += dpp_xor2(a); c += dpp_xor1(c); c += dpp_xor2(c);
                if (hg == 0) { const int j = (key0 >> 2) + 2 * k + hh; (void)__hip_atomic_fetch_add(imp + tl * IMP_LD + j, a, __ATOMIC_RELAXED, __HIP_MEMORY_SCOPE_WORKGROUP); (void)__hip_atomic_fetch_add(imp + tl * IMP_LD + j + 1, c, __ATOMIC_RELAXED, __HIP_MEMORY_SCOPE_WORKGROUP); } }
            if (kt + 1 < ntile) { DMA_WAIT(); read_k(kc, la); } }
        const float g0 = p.GATES[row * 24 + head * 3 + 0];
#pragma unroll
        for (int reg = 0; reg < 16; ++reg) { outacc[reg] = o0[reg] * g0; outacc[16 + reg] = o1[reg] * g0; }
    }
    for (int tk = 0; tk < 8; ++tk) { const int tt = t0 + tk, cur = tt >> 6; LAS float* row = imp + tk * IMP_LD;
        float v0 = (64 * lane > tt) ? -1.f : row[lane], v1 = (64 * (lane + 64) > tt) ? -1.f : row[lane + 64];
        if (lane == 0 || lane == cur || lane == cur - 1) v0 += 1e4f;
        if (lane + 64 == cur || lane + 64 == cur - 1) v1 += 1e4f;
        row[lane] = v0; row[lane + 64] = v1;
        int r0 = 0, r1 = 0;
        const int nq4 = min(32, ((cur >> 2) + 4) & ~3);
#pragma unroll 4
        for (int q4 = 0; q4 < nq4; ++q4) { const f32x4v w = *(const LAS f32x4v*)(row + 4 * q4);
#pragma unroll
            for (int e = 0; e < 4; ++e) { const int jj = 4 * q4 + e; const float x = w[e];
                r0 += (x > v0 || (x == v0 && jj < lane)) ? 1 : 0; r1 += (x > v1 || (x == v1 && jj < lane + 64)) ? 1 : 0; } }
        const unsigned long long s0 = __ballot(r0 < 16), s1 = __ballot(r1 < 16);
        if (tl == tk) { m0 = s0; m1 = s1; } }
    {
        f32x16 o0 = zero16(), o1 = zero16(); float m = ATT_NEG, l = 0.f;
        const bf16* k0p = p.PROJ + (size_t)b * cS * PE_LD + 768 + g * 64;
        const bf16* v0p = VT + vt_tile_off(16, b, g, 0);
        const rsrc_t rsK = mkrsrc(k0p), rsV = mkrsrc(v0p); const unsigned kvo = kvoff(lane, PE_LD), vvo = vvoff(lane, 32);
        unsigned long long u0 = wave_or64(m0), u1 = wave_or64(m1);
        const int tmax = (t0 + 7) >> 5;
#define NSA_NEXT_TILE(tc) ({ int tt_ = (tc) + 1; if ((tt_ & 1) == 0) { const int j_ = tt_ >> 1; \
            const unsigned long long lo_ = j_ < 64 ? (u0 >> j_) : 0ull, hi_ = j_ < 64 ? u1 : (j_ < 128 ? (u1 >> (j_ - 64)) : 0ull); \
            tt_ = lo_ ? 2 * (j_ + __builtin_ctzll(lo_)) : (hi_ ? 2 * ((j_ < 64 ? 64 : j_) + __builtin_ctzll(hi_)) : 1 << 20); } tt_ <= tmax ? tt_ : -1; })
        int tn = NSA_NEXT_TILE(-1);
        KF kc; VF vc;
        if (tn >= 0) { dma_k(wl, rsK, (unsigned)(32 * tn) * (PE_LD * 2), PE_LD * 2, kvo); dma_v(wl, rsV, (unsigned)tn * 4096u, 64, vvo); DMA_WAIT(); read_k(kc, la); }
        while (tn >= 0 && 32 * tn + 31 <= t0) { const int tc = tn, key0 = 32 * tc, j = tc >> 1;
            tn = NSA_NEXT_TILE(tc);
            LDS_DRAIN(); if (tn >= 0) dma_k(wl, rsK, (unsigned)(32 * tn) * (PE_LD * 2), PE_LD * 2, kvo);
            read_v(vc, la);
            const bool selj = ((j < 64 ? m0 : m1) >> (j & 63)) & 1ull;
            f32x16 s = qk32r(kc, qf);
            LDS_DRAIN_PINNED(); if (tn >= 0) dma_v(wl, rsV, (unsigned)tn * 4096u, 64, vvo);
            sm_fast(s, kc, qf, selj, m, l, o0, o1, pb);
            pv32r(o0, o1, vc, pb);
            if (tn >= 0) { DMA_WAIT(); read_k(kc, la); } }
        while (tn >= 0) { const int tc = tn, key0 = 32 * tc, j = tc >> 1;
            tn = NSA_NEXT_TILE(tc);
            LDS_DRAIN(); if (tn >= 0) dma_k(wl, rsK, (unsigned)(32 * tn) * (PE_LD * 2), PE_LD * 2, kvo);
            read_v(vc, la);
            const bool selj = ((j < 64 ? m0 : m1) >> (j & 63)) & 1ull;
            f32x16 s = qk32r(kc, qf);
            LDS_DRAIN_PINNED(); if (tn >= 0) dma_v(wl, rsV, (unsigned)tn * 4096u, 64, vvo);
            sm_step(s, kc, qf, 0, selj ? t - key0 : -1, hh, m, l, o0, o1, pb);
            pv32r(o0, o1, vc, pb);
            if (tn >= 0) { DMA_WAIT(); read_k(kc, la); } }
        l = xsum32(l);
        const float sc = (l > 0.f ? 1.f / l : 0.f) * p.GATES[row * 24 + head * 3 + 1];
#pragma unroll
        for (int reg = 0; reg < 16; ++reg) { outacc[reg] += o0[reg] * sc; outacc[16 + reg] += o1[reg] * sc; }
    }
    {
        f32x16 o0 = zero16(), o1 = zero16(); float m = ATT_NEG, l = 0.f;
        const bf16* k0p = p.PROJ + (size_t)b * cS * PE_LD + 896 + g * 64;
        const bf16* v0p = VT + vt_tile_off(16, b, 2 + g, 0);
        const rsrc_t rsK = mkrsrc(k0p), rsV = mkrsrc(v0p); const unsigned kvo = kvoff(lane, PE_LD), vvo = vvoff(lane, 32);
        const int k_lo = t0 >= 511 ? (t0 - 511) >> 5 : 0, k_hi = (t0 + 7) >> 5;
        KF kc; VF vc;
        dma_k(wl, rsK, (unsigned)(32 * k_lo) * (PE_LD * 2), PE_LD * 2, kvo); dma_v(wl, rsV, (unsigned)k_lo * 4096u, 64, vvo); DMA_WAIT(); read_k(kc, la);
#define WIN_TILE(SM_) { const int key0 = 32 * kt; \
            LDS_DRAIN(); if (kt < k_hi) dma_k(wl, rsK, (unsigned)(key0 + 32) * (PE_LD * 2), PE_LD * 2, kvo); \
            read_v(vc, la); \
            f32x16 s = qk32r(kc, qf); \
            LDS_DRAIN_PINNED(); if (kt < k_hi) dma_v(wl, rsV, (unsigned)(kt + 1) * 4096u, 64, vvo); \
            SM_; \
            pv32r(o0, o1, vc, pb); \
            if (kt < k_hi) { DMA_WAIT(); read_k(kc, la); } }
        int kt = k_lo;
        for (; kt <= k_hi && 32 * kt < t0 + 7 - 511; ++kt) WIN_TILE(sm_step(s, kc, qf, t - 511 - key0, 31, hh, m, l, o0, o1, pb))
        for (; kt <= k_hi && 32 * kt + 31 <= t0; ++kt) WIN_TILE(sm_fast(s, kc, qf, true, m, l, o0, o1, pb))
        for (; kt <= k_hi; ++kt) WIN_TILE(sm_step(s, kc, qf, 0, t - key0, hh, m, l, o0, o1, pb))
#undef WIN_TILE
        l = xsum32(l);
        const float sc = (l > 0.f ? 1.f / l : 0.f) * p.GATES[row * 24 + head * 3 + 2];
#pragma unroll
        for (int reg = 0; reg < 16; ++reg) { outacc[reg] += o0[reg] * sc; outacc[16 + reg] += o1[reg] * sc; }
    }
    store_row64(p.ATT + (size_t)row * 768 + head * 64, hh, outacc, 1.f);
}

__device__ __forceinline__ void cmp1_unit(const P& p, const bf16* W1T, const float* PEB, int u, int lane) {
    const int r = lane & 31, hh = lane >> 5;
    const int ct = u & 7, rt = (u >> 3) & 127, which = u >> 10;
    const int NR = cB * cNC * 2;
    int i = rt * 32 + r; if (i >= NR) i = NR - 1;
    const int g = i & 1, n = (i >> 1) % cNC, b = (i >> 1) / cNC;
    const bf16* ap = p.PROJ + (size_t)(b * cS + 16 * n) * PE_LD + 512 + which * 128 + g * 64 + 8 * hh;
    const bf16* bp = W1T + ((size_t)which * 256 + ct * 32 + r) * 2048 + 8 * hh;
    f32x16 acc = zero16();
    for (int l = 0; l < 32; ++l) {
#pragma unroll
        for (int q = 0; q < 4; ++q) { const bf16x8v a = *(const bf16x8v*)(ap + (size_t)l * PE_LD + 16 * q), bb = *(const bf16x8v*)(bp + l * 64 + 16 * q);
            acc = __builtin_amdgcn_mfma_f32_32x32x16_bf16(a, bb, acc, 0, 0, 0); } }
    const int j = ct * 32 + r; const float bias = PEB[which * 256 + j];
#pragma unroll
    for (int reg = 0; reg < 16; ++reg) { const int io = rt * 32 + (reg & 3) + 8 * (reg >> 2) + 4 * hh;
        if (io < NR) p.HID[((size_t)which * NR + io) * 256 + j] = gelu_tanh(acc[reg] + bias); }
}
__device__ __forceinline__ void gates_unit(const P& p, const bf16* WGT, int u, int lane) {
    const int r = lane & 31, hh = lane >> 5;
    const bf16* ap = p.Y + (size_t)(u * 32 + r) * cDM + 8 * hh; const bf16* bp = WGT + (size_t)r * cDM + 8 * hh;
    f32x16 acc = zero16();
#pragma unroll 8
    for (int ks = 0; ks < cDM / 16; ++ks) { const bf16x8v a = *(const bf16x8v*)(ap + 16 * ks), bb = *(const bf16x8v*)(bp + 16 * ks);
        acc = __builtin_amdgcn_mfma_f32_32x32x16_bf16(a, bb, acc, 0, 0, 0); }
    if (r < 24) {
#pragma unroll
        for (int reg = 0; reg < 16; ++reg) { const int row = u * 32 + (reg & 3) + 8 * (reg >> 2) + 4 * hh; p.GATES[(size_t)row * 24 + r] = 1.f / (1.f + __expf(-acc[reg])); } }
}

__device__ __forceinline__ float xlo32(float x) { float y; asm volatile("v_mov_b32 %0, %1\n\ts_nop 1" : "=v"(y) : "v"(x));
    auto r = __builtin_amdgcn_permlane32_swap(__builtin_bit_cast(unsigned, x), __builtin_bit_cast(unsigned, y), false, false); const unsigned a = r[0]; return __builtin_bit_cast(float, a); }
template <bool DIAG>
__device__ __forceinline__ void sb_tile(const f32x16& z, const VF& vc, const bf16x8v (&TA)[2], int r, int hh, float& carry, f32x16& o0, f32x16& o1) {
    f32x16 l1; float lbv[16];
#pragma unroll
    for (int reg = 0; reg < 16; ++reg) { const int ko = (reg & 3) + 8 * (reg >> 2) + 4 * hh; float zr = z[reg]; OPQ(zr); const float zz = zr * 0.125f;
        const float e = fexp2(-fabsf(zz) * 1.4426950408889634f); const float sp = __builtin_amdgcn_logf(1.f + e) * 0.6931471805599453f;
        float lb = fminf(zz, 0.f) - sp; OPQ(lb); lbv[reg] = lb; float x = (!DIAG || ko < r) ? lb - zz : 0.f; OPQ(x); l1[reg] = x; }
    unsigned bh[8], bl[8];
#pragma unroll
    for (int i = 0; i < 8; ++i) { const float x0 = l1[2 * i], x1 = l1[2 * i + 1]; const unsigned hw = cvtpk(x0, x1); bh[i] = hw; float d0 = x0 - bflo(hw), d1 = x1 - bfhi(hw); OPQ(d0); OPQ(d1); bl[i] = cvtpk(d0, d1); }
    f32x16 af = zero16();
    typedef unsigned u32x4v __attribute__((ext_vector_type(4)));
#pragma unroll
    for (int s = 0; s < 2; ++s) { const u32x4v wh = {bh[4 * s], bh[4 * s + 1], bh[4 * s + 2], bh[4 * s + 3]}, wl = {bl[4 * s], bl[4 * s + 1], bl[4 * s + 2], bl[4 * s + 3]};
        af = __builtin_amdgcn_mfma_f32_32x32x16_bf16(TA[s], __builtin_bit_cast(bf16x8v, wh), af, 0, 0, 0);
        af = __builtin_amdgcn_mfma_f32_32x32x16_bf16(TA[s], __builtin_bit_cast(bf16x8v, wl), af, 0, 0, 0); }
    unsigned pb[8]; float av[16];
#pragma unroll
    for (int reg = 0; reg < 16; ++reg) { const int ko = (reg & 3) + 8 * (reg >> 2) + 4 * hh;
        float t = lbv[reg] + af[reg]; OPQ(t); av[reg] = (!DIAG || ko < r) ? fexp2((t + carry) * 1.4426950408889634f) : 0.f; }
#pragma unroll
    for (int i = 0; i < 8; ++i) pb[i] = cvtpk(av[2 * i], av[2 * i + 1]);
    pv32r(o0, o1, vc, pb);
    carry += xlo32(af[0] + l1[0]);
}
__device__ __forceinline__ void sb_unit(const P& p, const bf16* VT, LAS unsigned char* wl, int b, int h, int t0, int lane) {
    const int r = lane & 31, hh = lane >> 5; const long row = (long)b * cS + t0 + r; const LaneAddr la = lane_addr(wl, lane);
    bf16x8v qf[4];
    { const bf16* qp = p.PROJ + (size_t)row * PO_LD + h * 64 + 8 * hh;
#pragma unroll
      for (int ks = 0; ks < 4; ++ks) qf[ks] = *(const bf16x8v*)(qp + 16 * ks); }
    bf16x8v TA[2];
#pragma unroll
    for (int s = 0; s < 2; ++s)
#pragma unroll
        for (int j = 0; j < 8; ++j) { const int kk = 16 * s + 8 * (j >> 2) + 4 * hh + (j & 3); TA[s][j] = (short)(kk > r ? 0x3F80 : 0); }
    f32x16 o0 = zero16(), o1 = zero16(); float carry = 0.f;
    const bf16* k0p = p.PROJ + (size_t)b * cS * PO_LD + cDM + h * 64;
    const bf16* v0p = VT + vt_tile_off(16, b, h, 0);
    const rsrc_t rsK = mkrsrc(k0p), rsV = mkrsrc(v0p); const unsigned kvo = kvoff(lane, PO_LD), vvo = vvoff(lane, 32);
    KF kc; VF vc;
    dma_k(wl, rsK, (unsigned)t0 * (PO_LD * 2), PO_LD * 2, kvo); dma_v(wl, rsV, (unsigned)(t0 >> 5) * 4096u, 64, vvo); DMA_WAIT(); read_k(kc, la);
#define SB_TILE(DIAG_, key0_) do { LDS_DRAIN(); if ((key0_) > 0) dma_k(wl, rsK, (unsigned)((key0_) - 32) * (PO_LD * 2), PO_LD * 2, kvo); \
        read_v(vc, la); const f32x16 z_ = qk32r(kc, qf); \
        LDS_DRAIN_PINNED(); if ((key0_) > 0) dma_v(wl, rsV, (unsigned)(((key0_) - 32) >> 5) * 4096u, 64, vvo); \
        sb_tile<DIAG_>(z_, vc, TA, r, hh, carry, o0, o1); } while (0)
    int kt = t0 >> 5;
    SB_TILE(true, t0);
    for (--kt; kt >= 0; --kt) { const int key0 = 32 * kt;
        DMA_WAIT(); read_k(kc, la);
        SB_TILE(false, key0);
        if (__all(carry < -93.f)) break; }
#undef SB_TILE
    DMA_WAIT();
    { float ov[32];
#pragma unroll
      for (int reg = 0; reg < 16; ++reg) { ov[reg] = o0[reg]; ov[16 + reg] = o1[reg]; }
      store_row64(p.ATT + (size_t)row * cDM + h * 64, hh, ov, 1.f); }
}

template <int G>
__device__ __forceinline__ void dil_unit(const P& p, const bf16* VT, const bf16* VTP, bf16* DOUT, float* DLSE, LAS unsigned char* wl, int b, int hd, int rc, int tile, int lane) {
    constexpr int dil = G == 0 ? 1 : G == 1 ? 4 : 16; constexpr int slot0 = 4 * G;
    const int r = lane & 31, hh = lane >> 5, slot = slot0 + hd; const LaneAddr la = lane_addr(wl, lane);
    const long row = (long)b * cS + rc + (long)dil * (32 * tile + r);
    bf16x8v qf[4];
    { const bf16* qp = p.PROJ + (size_t)row * PE_LD + 1024 + slot * 64 + 8 * hh;
#pragma unroll
      for (int ks = 0; ks < 4; ++ks) qf[ks] = *(const bf16x8v*)(qp + 16 * ks); }
    f32x16 o0 = zero16(), o1 = zero16(); float m = ATT_NEG, l = 0.f; unsigned pb[8];
    const bf16* k0p = p.PROJ + ((size_t)b * cS + rc) * PE_LD + 1792 + slot * 64;
    const bf16* v0p = G == 0 ? VT + vt_tile_off(16, b, 4 + slot, 0)
                             : VTP + vt_tile_off(8, b, (G - 1) * 4 + hd, rc * (cS / dil / 32));
    const rsrc_t rsK = mkrsrc(k0p), rsV = mkrsrc(v0p); const unsigned kvo = kvoff(lane, (size_t)dil * PE_LD), vvo = vvoff(lane, 32);
    const int k_lo = tile >= 4 ? tile - 4 : 0;
    KF kc; VF vc;
    dma_k(wl, rsK, (unsigned)(32 * k_lo) * (dil * PE_LD * 2), dil * PE_LD * 2, kvo); dma_v(wl, rsV, (unsigned)k_lo * 4096u, 64, vvo); DMA_WAIT(); read_k(kc, la);
    for (int kt = k_lo; kt <= tile; ++kt) { const int D0 = 32 * (tile - kt);
        LDS_DRAIN(); if (kt < tile) dma_k(wl, rsK, (unsigned)(32 * kt + 32) * (dil * PE_LD * 2), dil * PE_LD * 2, kvo);
        read_v(vc, la);
        f32x16 s = qk32r(kc, qf);
        LDS_DRAIN_PINNED(); if (kt < tile) dma_v(wl, rsV, (unsigned)(kt + 1) * 4096u, 64, vvo);
        if (D0 >= 32 && D0 <= 96) sm_fast(s, kc, qf, true, m, l, o0, o1, pb);
        else sm_step(s, kc, qf, D0 + r - 128, D0 + r, hh, m, l, o0, o1, pb);
        pv32r(o0, o1, vc, pb);
        if (kt < tile) { DMA_WAIT(); read_k(kc, la); } }
    l = xsum32(l);
    const float rl = 1.f / l;
    { float ov[32];
#pragma unroll
      for (int reg = 0; reg < 16; ++reg) { ov[reg] = o0[reg]; ov[16 + reg] = o1[reg]; }
      store_row64(DOUT + ((size_t)G * cM + row) * 256 + hd * 64, hh, ov, rl); }
    if (hh == 0) DLSE[((size_t)G * cM + row) * 4 + hd] = m + __builtin_amdgcn_logf(l);
}
namespace pg8 {
#define PG8_LAS __attribute__((address_space(3)))
typedef unsigned short bf16_t;
typedef short bf16x8 __attribute__((ext_vector_type(8)));
typedef float f32x4 __attribute__((ext_vector_type(4)));
typedef unsigned u32x4 __attribute__((ext_vector_type(4)));
constexpr int BM = 256, BK = 64, HALF = 128, HTB = HALF * BK * 2  , STAGE_BYTES = 8 * HTB, NXCD = 8, WGM = 8;

__host__ __device__ __forceinline__ int lds_byte(int r, int c) { const int st = (r >> 4) * 2 + (c >> 5), rr = r & 15, cc = c & 31, ob = rr * 64 + cc * 2; return st * 1024 + (ob ^ (((ob >> 9) & 1) << 5)); }
__host__ __device__ __forceinline__ void stage_rc(int b, int& R, int& C) { const int st = b / 1024, sb = b % 1024, swz = sb ^ (((sb >> 9) & 1) << 5); R = (st >> 1) * 16 + swz / 64; C = (st & 1) * 32 + (swz % 64) / 2; }
__host__ __device__ __forceinline__ int perm32(int rho) { const int n = rho >> 4, i = rho & 15; return 8 * (i >> 2) + 4 * n + (i & 3); }

struct Unit { int pm, pn; };
struct Gemm { const bf16_t* A; const bf16_t* Bt; int M, N, K; };

struct StaticOrder {
    int nM, nN, nwg, G, c;
    __host__ __device__ void init(int M, int N, int G_, int c_) { nM = M / BM; nN = N / BM; nwg = nM * nN; G = G_; c = c_; }
    __host__ __device__ bool next(int i, Unit& u) const {
        const long L = (long)i * G + c; if (L >= nwg) return false;
        int wgid = (int)L; { const int q = nwg / NXCD, r = nwg % NXCD, xcd = wgid % NXCD, off = wgid / NXCD; wgid = (xcd < r ? xcd * (q + 1) : r * (q + 1) + (xcd - r) * q) + off; }
        const int nig = WGM * nN, gid = wgid / nig, fm = gid * WGM, gsz = (nM - fm) < WGM ? (nM - fm) : WGM;
        u.pm = fm + ((wgid % nig) % gsz); u.pn = (wgid % nig) / gsz; return true;
    }
    __device__ __forceinline__ void a_ready(const Unit&) const {}
    __device__ __forceinline__ void done(const Unit&) const {}
};

__device__ __forceinline__ unsigned cvt_pk_bf16(float lo, float hi) { unsigned r; asm volatile("v_cvt_pk_bf16_f32 %0, %1, %2" : "=v"(r) : "v"(lo), "v"(hi)); return r; }
typedef float f32x2 __attribute__((ext_vector_type(2)));
__device__ __forceinline__ f32x2 gelu_pk(f32x2 v) {
    const f32x2 av = __builtin_elementwise_abs(v), d = av * 0.2316418882f + 1.0f;
    f32x2 t; t.x = __builtin_amdgcn_rcpf(d.x); t.y = __builtin_amdgcn_rcpf(d.y);
    f32x2 q = t * 0.5307027145f + (-0.7265760135f); q = q * t + 0.7107068705f; q = q * t + (-0.142248368f); q = q * t + 0.127414796f; q = q * t;
    const f32x2 s = (v * v) * (-0.72134752044f);
    f32x2 e; e.x = __builtin_amdgcn_exp2f(s.x); e.y = __builtin_amdgcn_exp2f(s.y);
    const f32x2 m = v * (q * e), r = v - m;
    f32x2 o; o.x = v.x < 0.f ? m.x : r.x; o.y = v.y < 0.f ? m.y : r.y; return o;
}

template <int ACT  > struct EpiBf16 {
    static constexpr bool PERM = true, AFTER_DRAIN = false, TABLE = false; static_assert(ACT == 0 || ACT == 1, "EpiBf16: ACT is 0 (none) or 1 (gelu_pk)");
    bf16_t* O; int ldc; const float* bias; int split_cols; size_t split_stride; float scale0;
    __device__ __forceinline__ void operator()(const f32x4 (&acc)[2][2][4][2], const Unit& u, int wr, int wc, int fr, int fq) const {
        const int row0 = u.pm * BM + wr * 64 + fr; int colt = u.pn * BM; bf16_t* base = O;
        float sc = 1.f; if (split_cols) { const int t = colt / split_cols; base += (size_t)t * split_stride; colt -= t * split_cols; if (t == 0) sc = scale0; }
        const int col0 = colt + wc * 32 + 8 * fq, bcol0 = u.pn * BM + wc * 32 + 8 * fq;
        f32x4 bv[2][2];
#pragma unroll
        for (int bj = 0; bj < 2; ++bj)
#pragma unroll
            for (int n = 0; n < 2; ++n) bv[bj][n] = bias ? *(const f32x4*)(bias + bcol0 + bj * HALF + 4 * n) : (f32x4){0.f, 0.f, 0.f, 0.f};
#pragma unroll
        for (int ai = 0; ai < 2; ++ai)
#pragma unroll
            for (int m = 0; m < 4; ++m) { bf16_t* rowp = base + (size_t)(row0 + ai * HALF + m * 16) * ldc + col0;
#pragma unroll
                for (int bj = 0; bj < 2; ++bj) { f32x4 v0 = acc[ai][bj][m][0] + bv[bj][0], v1 = acc[ai][bj][m][1] + bv[bj][1];
                    if (ACT == 1) { f32x2 a = gelu_pk((f32x2){v0[0], v0[1]}), b = gelu_pk((f32x2){v0[2], v0[3]}), c = gelu_pk((f32x2){v1[0], v1[1]}), d = gelu_pk((f32x2){v1[2], v1[3]});
                        v0 = (f32x4){a.x, a.y, b.x, b.y}; v1 = (f32x4){c.x, c.y, d.x, d.y}; }
                    v0 = v0 * sc; v1 = v1 * sc; u32x4 w; w.x = cvt_pk_bf16(v0[0], v0[1]); w.y = cvt_pk_bf16(v0[2], v0[3]); w.z = cvt_pk_bf16(v1[0], v1[1]); w.w = cvt_pk_bf16(v1[2], v1[3]);
                    *(u32x4*)(rowp + bj * HALF) = w; } }
    }
};
template <class Epi, class Sched, bool ALIGN_EPI = false, bool SP2 = false>
__device__ __forceinline__ void gemm_phase(PG8_LAS unsigned char* lds, const Gemm g, const Sched& S, const Epi& E) {
    int tid_ = threadIdx.x; asm volatile("" : "+v"(tid_));
    const int tid = tid_, wid = __builtin_amdgcn_readfirstlane(tid >> 6), lane = tid & 63, wr = wid >> 2, wc = wid & 3, fr = lane & 15, fq = lane >> 4;
    const int K = g.K, nt = K / BK;
    unsigned voffA[2], voffB[2];
#pragma unroll
    for (int i = 0; i < 2; ++i) { int R, C; stage_rc(tid * 16 + i * 8192, R, C); const int Rb = Epi::PERM ? ((R & ~31) + perm32(R & 31)) : R;
        voffA[i] = (unsigned)(R * K + C) * 2u; voffB[i] = (unsigned)(Rb * K + C) * 2u; }
    const size_t kstep = (size_t)(BK * 2);
    const size_t hstep = (size_t)HALF * K * 2;
    const size_t tstep = 2 * hstep;
    const unsigned ldsw = (unsigned)wid * 1024u;
    const int aoff = lds_byte(wr * 64 + fr, fq * 8), boff = lds_byte(wc * 32 + fr, fq * 8);
#define PG8_SA(b, h) (((b) * 2 + (h)) * HTB)
#define PG8_SB(b, h) ((4 + (b) * 2 + (h)) * HTB)
#define PG8_STAGE(bufoff, gbase, voff) do { _Pragma("unroll") for (int _i = 0; _i < 2; ++_i) \
        __builtin_amdgcn_global_load_lds((const unsigned*)((const char*)(gbase) + (voff)[_i]), (PG8_LAS unsigned*)(lds + (bufoff) + ldsw + _i * 8192), 16, 0, 0); } while (0)
#define PG8_LDA(dst, b, h) do { _Pragma("unroll") for (int m = 0; m < 4; ++m) _Pragma("unroll") for (int k = 0; k < 2; ++k) dst[m][k] = *(const PG8_LAS bf16x8*)(lds + PG8_SA(b, h) + aoff + m * 2048 + k * 1024); } while (0)
#define PG8_LDB(dst, b, h) do { _Pragma("unroll") for (int n = 0; n < 2; ++n) _Pragma("unroll") for (int k = 0; k < 2; ++k) dst[n][k] = *(const PG8_LAS bf16x8*)(lds + PG8_SB(b, h) + boff + n * 2048 + k * 1024); } while (0)
#define PG8_MMA(ai, bj, At, Bt) do { __builtin_amdgcn_s_setprio(1); _Pragma("unroll") for (int m = 0; m < 4; ++m) _Pragma("unroll") for (int n = 0; n < 2; ++n) _Pragma("unroll") for (int k = 0; k < 2; ++k) \
        acc[ai][bj][m][n] = __builtin_amdgcn_mfma_f32_16x16x32_bf16(Bt[n][k], At[m][k], acc[ai][bj][m][n], 0, 0, 0); __builtin_amdgcn_s_setprio(0); } while (0)
#define PG8_WAIT_V(n) asm volatile("s_waitcnt vmcnt(" #n ")" ::: "memory")
#define PG8_WAIT_L(n) asm volatile("s_waitcnt lgkmcnt(" #n ")" ::: "memory")
#define PG8_BAR __builtin_amdgcn_s_barrier()
#define PG8_SCHED __builtin_amdgcn_sched_barrier(0)
    Unit cur, nxt; int ui = 0;
    if (!S.next(0, cur)) return;
    f32x4 acc[2][2][4][2];
#pragma unroll
    for (int a = 0; a < 2; ++a)
#pragma unroll
        for (int b = 0; b < 2; ++b)
#pragma unroll
            for (int m = 0; m < 4; ++m)
#pragma unroll
                for (int n = 0; n < 2; ++n) acc[a][b][m][n] = (f32x4){0.f, 0.f, 0.f, 0.f};
    bf16x8 At[4][2], B0[2][2], B1[2][2];
    const char* cA = (const char*)g.A + (size_t)cur.pm * tstep; const char* cB = (const char*)g.Bt + (size_t)cur.pn * tstep;
    S.a_ready(cur);
    if constexpr (SP2) {
        PG8_STAGE(PG8_SB(0, 0), cB, voffB); PG8_STAGE(PG8_SB(0, 1), cB + hstep, voffB); PG8_STAGE(PG8_SA(0, 0), cA, voffA); PG8_STAGE(PG8_SA(0, 1), cA + hstep, voffA);
        if (wr == 1) PG8_BAR;
        PG8_WAIT_V(2); PG8_BAR;
        PG8_STAGE(PG8_SB(1, 0), cB + kstep, voffB); PG8_STAGE(PG8_SA(1, 0), cA + kstep, voffA); PG8_STAGE(PG8_SB(1, 1), cB + hstep + kstep, voffB);
        PG8_WAIT_V(6); PG8_BAR;
    } else {
        PG8_STAGE(PG8_SB(0, 0), cB, voffB); PG8_STAGE(PG8_SA(0, 0), cA, voffA); PG8_STAGE(PG8_SB(0, 1), cB + hstep, voffB); PG8_STAGE(PG8_SA(0, 1), cA + hstep, voffA);
        if (wr == 1) PG8_BAR;
        PG8_WAIT_V(4); PG8_BAR;
        PG8_STAGE(PG8_SB(1, 0), cB + kstep, voffB); PG8_STAGE(PG8_SA(1, 0), cA + kstep, voffA); PG8_STAGE(PG8_SB(1, 1), cB + hstep + kstep, voffB);
        PG8_WAIT_V(6); PG8_BAR;
    }
    for (;;) {
        const bool has_next = S.next(ui + 1, nxt);
        if constexpr (Epi::TABLE) { if (tid < 256) E.stage_table(cur, lds + 131072 + (ui & 1) * 4096, tid); }
        const char* nA = has_next ? (const char*)g.A + (size_t)nxt.pm * tstep : cA; const char* nB = has_next ? (const char*)g.Bt + (size_t)nxt.pn * tstep : cB;
        for (int t = 0; t < nt; t += 2) {
            const bool last = (t == nt - 2);
            const char* a1 = cA + (size_t)(t + 1) * kstep;
            const char* a2 = last ? nA : cA + (size_t)(t + 2) * kstep; const char* b2 = last ? nB : cB + (size_t)(t + 2) * kstep;
            const char* a3 = a2 + kstep; const char* b3 = b2 + kstep;
            if (last && has_next) S.a_ready(nxt);
            if constexpr (SP2) {
            PG8_LDB(B0, 0, 0); PG8_LDB(B1, 0, 1); PG8_SCHED; PG8_LDA(At, 0, 0); PG8_STAGE(PG8_SA(1, 1), a1 + hstep, voffA);
            PG8_WAIT_V(8); PG8_WAIT_L(0); PG8_BAR; PG8_MMA(0, 0, At, B0); PG8_MMA(0, 1, At, B1); PG8_BAR; PG8_SCHED;
            PG8_LDA(At, 0, 1); PG8_STAGE(PG8_SB(0, 0), b2, voffB); PG8_STAGE(PG8_SB(0, 1), b2 + hstep, voffB); PG8_STAGE(PG8_SA(0, 0), a2, voffA);
            PG8_WAIT_V(8); PG8_WAIT_L(0); PG8_BAR; PG8_MMA(1, 0, At, B0); PG8_MMA(1, 1, At, B1); PG8_BAR; PG8_SCHED;
            PG8_LDB(B0, 1, 0); PG8_LDB(B1, 1, 1); PG8_SCHED; PG8_LDA(At, 1, 0); PG8_STAGE(PG8_SA(0, 1), a2 + hstep, voffA);
            PG8_WAIT_V(8); PG8_WAIT_L(0); PG8_BAR; PG8_MMA(0, 0, At, B0); PG8_MMA(0, 1, At, B1); PG8_BAR; PG8_SCHED;
            PG8_LDA(At, 1, 1); PG8_STAGE(PG8_SB(1, 0), b3, voffB); PG8_STAGE(PG8_SB(1, 1), b3 + hstep, voffB); PG8_STAGE(PG8_SA(1, 0), a3, voffA);
            PG8_WAIT_V(8); PG8_WAIT_L(0); PG8_BAR; PG8_MMA(1, 0, At, B0); PG8_MMA(1, 1, At, B1); PG8_BAR; PG8_SCHED;
            } else {
            PG8_LDB(B0, 0, 0); PG8_SCHED; PG8_LDA(At, 0, 0); PG8_STAGE(PG8_SA(1, 1), a1 + hstep, voffA);
            PG8_WAIT_L(8); PG8_BAR; PG8_WAIT_L(0); PG8_MMA(0, 0, At, B0); PG8_BAR; PG8_SCHED;
            PG8_LDB(B1, 0, 1); PG8_STAGE(PG8_SB(0, 0), b2, voffB);
            PG8_BAR; PG8_WAIT_L(0); PG8_MMA(0, 1, At, B1); PG8_BAR;
            PG8_LDA(At, 0, 1); PG8_STAGE(PG8_SA(0, 0), a2, voffA);
            PG8_BAR; PG8_WAIT_L(0); PG8_MMA(1, 0, At, B0); PG8_BAR; PG8_SCHED;
            PG8_STAGE(PG8_SB(0, 1), b2 + hstep, voffB);
            PG8_WAIT_V(6); PG8_BAR; PG8_MMA(1, 1, At, B1); PG8_BAR;
            PG8_LDB(B0, 1, 0); PG8_SCHED; PG8_LDA(At, 1, 0); PG8_STAGE(PG8_SA(0, 1), a2 + hstep, voffA);
            PG8_WAIT_L(8); PG8_BAR; PG8_WAIT_L(0); PG8_MMA(0, 0, At, B0); PG8_BAR; PG8_SCHED;
            PG8_LDB(B1, 1, 1); PG8_STAGE(PG8_SB(1, 0), b3, voffB);
            PG8_BAR; PG8_WAIT_L(0); PG8_MMA(0, 1, At, B1); PG8_BAR;
            PG8_LDA(At, 1, 1); PG8_STAGE(PG8_SA(1, 0), a3, voffA);
            PG8_BAR; PG8_WAIT_L(0); PG8_MMA(1, 0, At, B0); PG8_BAR; PG8_SCHED;
            PG8_STAGE(PG8_SB(1, 1), b3 + hstep, voffB);
            PG8_WAIT_V(6); PG8_BAR; PG8_MMA(1, 1, At, B1); PG8_BAR;
            }
        }
        if constexpr (ALIGN_EPI) { if (wr == 0) PG8_BAR; }
        if constexpr (!Epi::AFTER_DRAIN) { if constexpr (Epi::TABLE) E.run(acc, cur, wr, wc, fr, fq, lds + 131072 + (ui & 1) * 4096); else E(acc, cur, wr, wc, fr, fq); S.done(cur); }
        if (!has_next) break;
#pragma unroll
        for (int a = 0; a < 2; ++a)
#pragma unroll
            for (int b = 0; b < 2; ++b)
#pragma unroll
                for (int m = 0; m < 4; ++m)
#pragma unroll
                    for (int n = 0; n < 2; ++n) acc[a][b][m][n] = (f32x4){0.f, 0.f, 0.f, 0.f};
        cur = nxt; cA = nA; cB = nB; ++ui;
        if constexpr (ALIGN_EPI) { if (wr == 1) PG8_BAR; }
    }
    PG8_WAIT_V(0);
    if constexpr (!ALIGN_EPI) { if (wr == 0) PG8_BAR; }
    PG8_BAR;
    if constexpr (Epi::AFTER_DRAIN) { E.fused(acc, cur, wr, wc, fr, fq, lds, wid, lane); S.done(cur); }
#undef PG8_SA
#undef PG8_SB
#undef PG8_STAGE
#undef PG8_LDA
#undef PG8_LDB
#undef PG8_MMA
#undef PG8_WAIT_V
#undef PG8_WAIT_L
#undef PG8_BAR
#undef PG8_SCHED
}
}
namespace pg8 {
struct EpiRopeE {
    static constexpr bool PERM = true, AFTER_DRAIN = false, TABLE = false;
    bf16_t* O; int ldc; const float* rope;
    __device__ __forceinline__ void operator()(const f32x4 (&acc)[2][2][4][2], const Unit& u, int wr, int wc, int fr, int fq) const {
        const int row0 = u.pm * BM + wr * 64 + fr;
        if (u.pn == 2) {
            const int col0 = u.pn * BM + wc * 32 + 8 * fq;
#pragma unroll
            for (int ai = 0; ai < 2; ++ai)
#pragma unroll
                for (int m = 0; m < 4; ++m) { bf16_t* rowp = O + (size_t)(row0 + ai * HALF + m * 16) * ldc + col0;
#pragma unroll
                    for (int bj = 0; bj < 2; ++bj) { const f32x4 v0 = acc[ai][bj][m][0], v1 = acc[ai][bj][m][1]; u32x4 w;
                        w.x = cvt_pk_bf16(v0[0], v0[1]); w.y = cvt_pk_bf16(v0[2], v0[3]); w.z = cvt_pk_bf16(v1[0], v1[1]); w.w = cvt_pk_bf16(v1[2], v1[3]); *(u32x4*)(rowp + bj * HALF) = w; } }
        } else {
            const int kk = 4 * (wc & 1) + fq;
#pragma unroll
            for (int ai = 0; ai < 2; ++ai)
#pragma unroll
                for (int m = 0; m < 4; ++m) { const int row = row0 + ai * HALF + m * 16, pos = row & (cS - 1);
                    const f32x4 c0 = *(const f32x4*)(rope + (size_t)(pos * 32 + 4 * kk) * 2), c1 = *(const f32x4*)(rope + (size_t)(pos * 32 + 4 * kk) * 2 + 4);
#pragma unroll
                    for (int bj = 0; bj < 2; ++bj) { const f32x4 x1 = acc[ai][bj][m][0], x2 = acc[ai][bj][m][1];
                        bf16_t* op = O + (size_t)row * ldc + u.pn * BM + (2 * bj + (wc >> 1)) * 64 + 4 * kk;
                        const unsigned ax = cvt_pk_bf16(x1[0] * c0[0] - x2[0] * c0[1], x1[1] * c0[2] - x2[1] * c0[3]), ay = cvt_pk_bf16(x1[2] * c1[0] - x2[2] * c1[1], x1[3] * c1[2] - x2[3] * c1[3]);
                        const unsigned bx = cvt_pk_bf16(x2[0] * c0[0] + x1[0] * c0[1], x2[1] * c0[2] + x1[1] * c0[3]), by = cvt_pk_bf16(x2[2] * c1[0] + x1[2] * c1[1], x2[3] * c1[2] + x1[3] * c1[3]);
                        auto rx = __builtin_amdgcn_permlane16_swap(ax, bx, false, false); auto ry = __builtin_amdgcn_permlane16_swap(ay, by, false, false);
                        u32x4 w; w.x = rx[0]; w.y = ry[0]; w.z = rx[1]; w.w = ry[1];
                        *(u32x4*)((fq & 1) ? op + 32 - 4 : op) = w; } }
        }
    }
};
struct EpiVT {
    static constexpr bool PERM = true, AFTER_DRAIN = false, TABLE = false;
    bf16_t* O;
    __device__ __forceinline__ void operator()(const f32x4 (&acc)[2][2][4][2], const Unit& u, int wr, int wc, int fr, int fq) const {
        const int row0 = u.pm * BM + wr * 64 + fr, col0 = u.pn * BM + wc * 32 + 8 * fq;
#pragma unroll
        for (int ai = 0; ai < 2; ++ai)
#pragma unroll
            for (int m = 0; m < 4; ++m) { const int dg = row0 + ai * HALF + m * 16;
#pragma unroll
                for (int bj = 0; bj < 2; ++bj) { const int col = col0 + bj * HALF, b = col / cS, tk = col & (cS - 1);
                    const f32x4 v0 = acc[ai][bj][m][0], v1 = acc[ai][bj][m][1]; u32x4 w;
                    w.x = cvt_pk_bf16(v0[0], v0[1]); w.y = cvt_pk_bf16(v0[2], v0[3]); w.z = cvt_pk_bf16(v1[0], v1[1]); w.w = cvt_pk_bf16(v1[2], v1[3]);
                    *(u32x4*)(O + vt_elem_off(16, b, dg, tk)) = w; } }
    }
};
__device__ __forceinline__ float ror1f(float x) { return __builtin_bit_cast(float, __builtin_amdgcn_mov_dpp(__builtin_bit_cast(int, x), 0x121, 0xF, 0xF, false)); }
__device__ __forceinline__ float ror2f(float x) { return __builtin_bit_cast(float, __builtin_amdgcn_mov_dpp(__builtin_bit_cast(int, x), 0x122, 0xF, 0xF, false)); }
__device__ __forceinline__ float gelu_fast(float x) { const float w = __builtin_fmaf(x * x, -2.3022081981f * 0.044715f, -2.3022081981f); return x * __builtin_amdgcn_rcpf(1.f + __builtin_amdgcn_exp2f(x * w)); }
struct EpiConvGelu {
    static constexpr bool PERM = true, AFTER_DRAIN = false, TABLE = true;
    bf16_t* ACT; const float* cw; const float* cb; float* SB;
    __device__ __forceinline__ void stage_table(const Unit& u, PG8_LAS unsigned char* tab, int tid) const {
        constexpr int LD2 = 2 * cDFF; const int v = tid >> 5, c4 = tid & 31, j = u.pn * 128 + 4 * c4;
        const float* src = ((v & 3) == 3 ? cb : cw + (v & 3) * LD2) + (v >> 2) * cDFF + j;
        *(PG8_LAS f32x4*)(tab + (v * 128 + 4 * c4) * 4) = *(const f32x4*)src; }
    __device__ __forceinline__ void run(const f32x4 (&acc)[2][2][4][2], const Unit& u, int wr, int wc, int fr, int fq, const PG8_LAS unsigned char* tab) const {
        constexpr int LD2 = 2 * cDFF;
        typedef unsigned u32x2 __attribute__((ext_vector_type(2)));
        u32x2 hold[2][4];
#pragma unroll
        for (int n = 0; n < 2; ++n) {
            const int ch0 = wc * 32 + 8 * fq + 4 * n, j0 = u.pn * 128 + ch0;
            const PG8_LAS f32x4* tv = (const PG8_LAS f32x4*)(tab + ch0 * 4);
            const f32x4 w0g = tv[0], w1g = tv[32], w2g = tv[64], bg = tv[96], w0v = tv[128], w1v = tv[160], w2v = tv[192], bv = tv[224];
#pragma unroll
            for (int ai = 0; ai < 2; ++ai) { const int rb = u.pm * BM + ai * HALF + wr * 64, blk = rb >> 6;
                f32x4 pg1, pg2, pv1, pv2;
#pragma unroll
                for (int m = 0; m < 4; ++m) { const f32x4 g = acc[ai][0][m][n], v = acc[ai][1][m][n]; const int row = rb + 16 * m + fr;
                    f32x4 g1, g2, v1, v2;
#pragma unroll
                    for (int e = 0; e < 4; ++e) { g1[e] = ror1f(g[e]); g2[e] = ror2f(g[e]); v1[e] = ror1f(v[e]); v2[e] = ror2f(v[e]); }
                    f32x4 a1g = g1, a2g = g2, a1v = v1, a2v = v2;
                    if (m > 0) { if (fr < 1) { a1g = pg1; a1v = pv1; } if (fr < 2) { a2g = pg2; a2v = pv2; } }
                    pg1 = g1; pg2 = g2; pv1 = v1; pv2 = v2;
                    if (m > 0 || fr >= 2) { float o[4];
#pragma unroll
                        for (int e = 0; e < 4; ++e) { const float cg = bg[e] + w0g[e] * a2g[e] + w1g[e] * a1g[e] + w2g[e] * g[e], cv = bv[e] + w0v[e] * a2v[e] + w1v[e] * a1v[e] + w2v[e] * v[e]; o[e] = gelu_fast(cg) * cv; }
                        u32x2 w; w.x = cvt_pk_bf16(o[0], o[1]); w.y = cvt_pk_bf16(o[2], o[3]);
                        if (n == 0) hold[ai][m] = w; else { u32x4 q; q.x = hold[ai][m].x; q.y = hold[ai][m].y; q.z = w.x; q.w = w.y; *(u32x4*)(ACT + (size_t)row * cDFF + j0 - 4) = q; } }
                    if (m == 0 && fr < 2) { float* sp = SB + ((size_t)blk * 4 + fr) * LD2; *(f32x4*)(sp + j0) = g; *(f32x4*)(sp + cDFF + j0) = v; }
                    if (m == 3 && fr >= 14) { float* sp = SB + ((size_t)blk * 4 + 2 + (fr - 14)) * LD2; *(f32x4*)(sp + j0) = g; *(f32x4*)(sp + cDFF + j0) = v; }
                } }
        }
    }
};
}
#define XB_TMO      128
#define XB_XCNT(j)  (256  + 64 * (j))
#define XB_XSUB(j)  (1280 + 64 * (j))
#define XB_XGEN(j)  (2304 + 64 * (j))
#define XB_TOP      3328
#define XB_TOPGEN   3392
#define XCD_BAR_WORDS 3456
#define XB_SPIN_CAP (1u << 18)

__device__ __forceinline__ unsigned xb_ld(unsigned* p)              { return __hip_atomic_load(p, __ATOMIC_RELAXED, __HIP_MEMORY_SCOPE_AGENT); }
__device__ __forceinline__ unsigned xb_add(unsigned* p, unsigned v) { return __hip_atomic_fetch_add(p, v, __ATOMIC_RELAXED, __HIP_MEMORY_SCOPE_AGENT); }
__device__ __forceinline__ unsigned xb_xcc_id() { return (unsigned)__builtin_amdgcn_s_getreg((3 << 11) | 20) & 0xFu; }
#define XB_SPIN(cond, bar) do { unsigned _sp = 0; while (cond) { __builtin_amdgcn_s_sleep(1); \
    if ((++_sp & 255u) == 0u) { if (xb_ld(&(bar)[XB_TMO])) break; if (_sp > XB_SPIN_CAP) { atomicAdd(&(bar)[XB_TMO], 1u); break; } } } } while (0)

struct XcdBarrier {
    unsigned* bar; unsigned x;
    volatile LAS unsigned* st;
};

__device__ __forceinline__ XcdBarrier xcd_barrier_post(unsigned* bar, volatile LAS unsigned* st) {
    XcdBarrier b; b.bar = bar; b.x = xb_xcc_id(); b.st = st;
    if (threadIdx.x == 0) (void)xb_add(&bar[XB_XCNT(b.x)], 1u);
    return b;
}
__device__ __forceinline__ void xcd_barrier_complete(unsigned* bar, unsigned x, unsigned& nloc, unsigned& nx) {
    const unsigned G = gridDim.x * gridDim.y * gridDim.z;
    unsigned sum, cnt, mine, sp = 0u;
    for (;;) {
        sum = 0u; cnt = 0u; mine = 0u;
#pragma unroll
        for (unsigned j = 0; j < 16; ++j) { const unsigned c = xb_ld(&bar[XB_XCNT(j)]); sum += c; cnt += (c > 0u) ? 1u : 0u; mine = (j == x) ? c : mine; }
        if (sum == G) break;
        __builtin_amdgcn_s_sleep(1);
        if ((++sp & 255u) == 0u) { if (xb_ld(&bar[XB_TMO])) break; if (sp > XB_SPIN_CAP) { atomicAdd(&bar[XB_TMO], 1u); break; } }
    }
    nloc = mine > 0u ? mine : 1u; nx = cnt > 0u ? cnt : 1u;
}

__device__ __forceinline__ void xcd_barrier(const XcdBarrier& b) {
    asm volatile("s_waitcnt vmcnt(0)" ::: "memory");
    __syncthreads();
    if (threadIdx.x == 0) {
        unsigned* bar = b.bar;
        __builtin_amdgcn_s_waitcnt(0);
        unsigned nloc = b.st[0], nx = b.st[1];
        if (nloc == 0u) { xcd_barrier_complete(bar, b.x, nloc, nx); b.st[0] = nloc; b.st[1] = nx; }
        const unsigned old = xb_add(&bar[XB_XSUB(b.x)], 1u);
        const unsigned gen = old / nloc;
        if (old + 1u == (gen + 1u) * nloc) {
            __builtin_amdgcn_fence(__ATOMIC_RELEASE, "agent");
            asm volatile("s_waitcnt vmcnt(0)" ::: "memory");
            const unsigned og = xb_add(&bar[XB_TOP], 1u);
            const unsigned tg = og / nx;
            if (og + 1u == (tg + 1u) * nx) xb_add(&bar[XB_TOPGEN], 1u);
            else XB_SPIN(xb_ld(&bar[XB_TOPGEN]) == tg, bar);
            __builtin_amdgcn_fence(__ATOMIC_ACQUIRE, "agent");
            xb_add(&bar[XB_XGEN(b.x)], 1u);
            asm volatile("s_waitcnt vmcnt(0)" ::: "memory");
        } else {
            XB_SPIN(xb_ld(&bar[XB_XGEN(b.x)]) == gen, bar);
            __builtin_amdgcn_fence(__ATOMIC_ACQUIRE, "agent");
            asm volatile("s_waitcnt vmcnt(0)" ::: "memory");
        }
    }
    __syncthreads();
}
constexpr int NWAVES = 8, NTHREADS = 512;
constexpr size_t MiB = 1u << 20;
constexpr size_t WS_CTL = 0, CTL_ZERO_BYTES = 65536;
constexpr size_t WS_WGT = 128 * 1024, WS_PEB = 256 * 1024;
constexpr size_t WS_WIN = 1 * MiB, WS_WV = 6 * MiB, WS_WOUT = 8 * MiB, WS_WUP = 10 * MiB, WS_WDN = 21 * MiB, WS_ROPE = 27 * MiB, WS_GATES = 29 * MiB, WS_KCMP = 32 * MiB,
                 WS_HID = 33 * MiB, WS_VCT = 41 * MiB, WS_W1T = 42 * MiB, WS_Y = 44 * MiB, WS_ATT = 44 * MiB  ,
                 WS_H16 = 108 * MiB  , WS_PROJ = 172 * MiB, WS_VT = 340 * MiB, WS_ACT = 172 * MiB  ,
                 WS_SB = 348 * MiB  , WS_Y2 = 406 * MiB,
                 WS_DOUT = 406 * MiB  , WS_DLSE = 454 * MiB, WS_VTP = 470 * MiB, WS_END = 504 * MiB;
static_assert((size_t)3 * cM * 256 * 2 <= WS_DLSE - WS_DOUT && WS_DLSE + (size_t)3 * cM * 4 * 4 <= WS_VTP && WS_VTP + (size_t)512 * VT_LD * 2 <= WS_END && (size_t)cM * PE_LD * 2 <= WS_VT - WS_PROJ && (size_t)1024 * VT_LD * 2 <= WS_Y2 - WS_VT
              && WS_ACT + (size_t)cM * cDFF * 2 <= WS_SB && WS_SB + (size_t)(cM / 64) * 4 * 2 * cDFF * 4 <= WS_Y2 && WS_H16 + (size_t)cM * cDM * 2 <= WS_PROJ, "workspace map");
constexpr int CW_BAR = 4096;
constexpr int RING_BYTES = 131072, LDSCTL_OFF = 8 * 17408  , MISC_OFF = LDSCTL_OFF + 320, LDS_BYTES = 147456;
typedef float f32x4 __attribute__((ext_vector_type(4)));

__device__ __forceinline__ int opaque(int x) { asm volatile("" : "+v"(x)); return x; }
__device__ __forceinline__ float wave_sum(float v) {
#pragma unroll
    for (int o = 1; o < 64; o <<= 1) v += __shfl_xor(v, o);
    return v;
}
__device__ __forceinline__ void n_row_dev(const float* xrow, const float* g, bf16* yrow, int lane) {
    float v[16]; float ss = 0.f;
#pragma unroll
    for (int j = 0; j < 2; ++j)
#pragma unroll
        for (int q = 0; q < 2; ++q) { const f32x4 t = *(const f32x4*)(xrow + 8 * lane + 512 * j + 4 * q);
            v[8 * j + 4 * q + 0] = t.x; v[8 * j + 4 * q + 1] = t.y; v[8 * j + 4 * q + 2] = t.z; v[8 * j + 4 * q + 3] = t.w; ss += t.x * t.x + t.y * t.y + t.z * t.z + t.w * t.w; }
    const float r = 1.f / sqrtf(wave_sum(ss) * (1.f / cDM) + 1e-6f);
#pragma unroll
    for (int j = 0; j < 2; ++j) { const float* gp = g + 8 * lane + 512 * j; U4 o;
        o.x = cvtpk(v[8 * j + 0] * r * gp[0], v[8 * j + 1] * r * gp[1]); o.y = cvtpk(v[8 * j + 2] * r * gp[2], v[8 * j + 3] * r * gp[3]);
        o.z = cvtpk(v[8 * j + 4] * r * gp[4], v[8 * j + 5] * r * gp[5]); o.w = cvtpk(v[8 * j + 6] * r * gp[6], v[8 * j + 7] * r * gp[7]);
        *(U4*)(yrow + 8 * lane + 512 * j) = o; }
}
template <bool HIN_F32, bool HOUT_F32>
__device__ __forceinline__ void nrn_row_dev(const void* hin_, const bf16* y2, const float* g1, const float* g2, void* hout_, bf16* yrow, int lane) {
    float v[16]; float ss = 0.f;
#pragma unroll
    for (int j = 0; j < 2; ++j) { const U4 t = *(const U4*)(y2 + 8 * lane + 512 * j);
        v[8 * j + 0] = bflo(t.x); v[8 * j + 1] = bfhi(t.x); v[8 * j + 2] = bflo(t.y); v[8 * j + 3] = bfhi(t.y); v[8 * j + 4] = bflo(t.z); v[8 * j + 5] = bfhi(t.z); v[8 * j + 6] = bflo(t.w); v[8 * j + 7] = bfhi(t.w); }
#pragma unroll
    for (int e = 0; e < 16; ++e) ss += v[e] * v[e];
    const float r = 1.f / sqrtf(wave_sum(ss) * (1.f / cDM) + 1e-6f);
    float s2 = 0.f;
#pragma unroll
    for (int j = 0; j < 2; ++j) { const int e0 = 8 * lane + 512 * j; float hv[8];
        if (HIN_F32) { const f32x4 a = *(const f32x4*)((const float*)hin_ + e0), b = *(const f32x4*)((const float*)hin_ + e0 + 4); hv[0] = a.x; hv[1] = a.y; hv[2] = a.z; hv[3] = a.w; hv[4] = b.x; hv[5] = b.y; hv[6] = b.z; hv[7] = b.w; }
        else { const U4 t = *(const U4*)((const bf16*)hin_ + e0); hv[0] = bflo(t.x); hv[1] = bfhi(t.x); hv[2] = bflo(t.y); hv[3] = bfhi(t.y); hv[4] = bflo(t.z); hv[5] = bfhi(t.z); hv[6] = bflo(t.w); hv[7] = bfhi(t.w); }
        const f32x4 ga = *(const f32x4*)(g1 + e0), gb = *(const f32x4*)(g1 + e0 + 4); const float gg[8] = {ga.x, ga.y, ga.z, ga.w, gb.x, gb.y, gb.z, gb.w};
#pragma unroll
        for (int e = 0; e < 8; ++e) { const float hn = hv[e] + v[8 * j + e] * r * gg[e]; v[8 * j + e] = hn; }
        if (HOUT_F32) { f32x4 a, b; a.x = v[8 * j]; a.y = v[8 * j + 1]; a.z = v[8 * j + 2]; a.w = v[8 * j + 3]; b.x = v[8 * j + 4]; b.y = v[8 * j + 5]; b.z = v[8 * j + 6]; b.w = v[8 * j + 7];
            *(f32x4*)((float*)hout_ + e0) = a; *(f32x4*)((float*)hout_ + e0 + 4) = b; }
        else { U4 o; o.x = cvtpk(v[8 * j], v[8 * j + 1]); o.y = cvtpk(v[8 * j + 2], v[8 * j + 3]);
            o.z = cvtpk(v[8 * j + 4], v[8 * j + 5]); o.w = cvtpk(v[8 * j + 6], v[8 * j + 7]);
            *(U4*)((bf16*)hout_ + e0) = o;
            v[8 * j + 0] = bflo(o.x); v[8 * j + 1] = bfhi(o.x); v[8 * j + 2] = bflo(o.y); v[8 * j + 3] = bfhi(o.y); v[8 * j + 4] = bflo(o.z); v[8 * j + 5] = bfhi(o.z); v[8 * j + 6] = bflo(o.w); v[8 * j + 7] = bfhi(o.w); }
#pragma unroll
        for (int e = 0; e < 8; ++e) s2 += v[8 * j + e] * v[8 * j + e]; }
    if (g2) { const float r2 = 1.f / sqrtf(wave_sum(s2) * (1.f / cDM) + 1e-6f);
#pragma unroll
        for (int j = 0; j < 2; ++j) { const float* gp = g2 + 8 * lane + 512 * j; U4 o;
            o.x = cvtpk(v[8 * j + 0] * r2 * gp[0], v[8 * j + 1] * r2 * gp[1]); o.y = cvtpk(v[8 * j + 2] * r2 * gp[2], v[8 * j + 3] * r2 * gp[3]);
            o.z = cvtpk(v[8 * j + 4] * r2 * gp[4], v[8 * j + 5] * r2 * gp[5]); o.w = cvtpk(v[8 * j + 6] * r2 * gp[6], v[8 * j + 7] * r2 * gp[7]);
            *(U4*)(yrow + 8 * lane + 512 * j) = o; } }
}

template <int K, int ldw, int N, int mode, int c0>
__device__ __forceinline__ void wprep_tile(const float* W, bf16* Bt, int tile, int lane, LAS float* scr) {
    constexpr int nblk = N / 32; const int kb = tile / nblk, nb = tile % nblk, k0 = 64 * kb, n0 = 32 * nb;
    const int c4 = 4 * (lane & 7), col = c0 + (mode ? wsrc_col(mode, n0 + c4) : n0 + c4);
#pragma unroll
    for (int i = 0; i < 8; ++i) { const int kk = 8 * i + (lane >> 3); const f32x4 t = *(const f32x4*)(W + (size_t)(k0 + kk) * ldw + col);
        scr[kk * 33 + c4] = t.x; scr[kk * 33 + c4 + 1] = t.y; scr[kk * 33 + c4 + 2] = t.z; scr[kk * 33 + c4 + 3] = t.w; }
    const int c = lane & 7;
#pragma unroll
    for (int j = 0; j < 4; ++j) { const int n = (lane >> 3) + 8 * j; const LAS float* s = scr + (8 * c) * 33 + n;
        U4 o; o.x = cvtpk(s[0], s[33]); o.y = cvtpk(s[2 * 33], s[3 * 33]);
        o.z = cvtpk(s[4 * 33], s[5 * 33]); o.w = cvtpk(s[6 * 33], s[7 * 33]);
        *(U4*)(Bt + (size_t)(n0 + n) * K + k0 + 8 * c) = o; }
    asm volatile("s_waitcnt lgkmcnt(0)" ::: "memory");
}
struct Args { const float* in[13]; float* out; unsigned char* ws; };

__global__ void __launch_bounds__(NTHREADS, 2) fwd(Args a) {
    extern __shared__ __attribute__((aligned(16))) unsigned char lds[];
    LAS unsigned char* L = (LAS unsigned char*)lds;
    const int tid = threadIdx.x, lane = tid & 63, wave = __builtin_amdgcn_readfirstlane(tid >> 6);
#define VCU() ((gridDim.x % 8 == 0) ? (int)((blockIdx.x % 8) * (gridDim.x / 8) + blockIdx.x / 8) : (int)blockIdx.x)
    for (int u = tid; u < (LDS_BYTES - LDSCTL_OFF) / 4; u += NTHREADS) ((LAS unsigned*)(L + LDSCTL_OFF))[u] = 0u;
    __syncthreads();
    XcdBarrier bar;
    { unsigned char* ws0 = a.ws; bar = xcd_barrier_post((unsigned*)(ws0 + WS_CTL) + CW_BAR, (volatile LAS unsigned*)(L + MISC_OFF) + 8); }
#define MKP() P p; unsigned char* wsb; { int z_ = 0; asm volatile("" : "+s"(z_)); unsigned char* ws = a.ws + z_; wsb = ws; const float* const* in_ = a.in + z_; \
    p.x = in_[0]; p.norm_g = in_[1]; p.even_w_in = in_[2]; p.even_w_out = in_[3]; p.cmp_pe = in_[4]; p.cmp_w1 = in_[5]; p.cmp_w2 = in_[6]; p.odd_w_in = in_[7]; p.odd_w_out = in_[8]; \
    p.ffn_w_up = in_[9]; p.ffn_conv_w = in_[10]; p.ffn_conv_b = in_[11]; p.ffn_w_down = in_[12]; p.out = (&a.out)[z_]; \
    p.Wt_in = (bf16*)(ws + WS_WIN); p.Wt_out = (bf16*)(ws + WS_WOUT); p.Wt_up = (bf16*)(ws + WS_WUP); p.Wt_dn = (bf16*)(ws + WS_WDN); \
    p.ROPE = (float*)(ws + WS_ROPE); p.GATES = (float*)(ws + WS_GATES); p.KCMP = (bf16*)(ws + WS_KCMP); \
    p.HID = (float*)(ws + WS_HID); p.Y = (bf16*)(ws + WS_Y); p.PROJ = (bf16*)(ws + WS_PROJ); p.ATT = (bf16*)(ws + WS_ATT); p.Y2 = (bf16*)(ws + WS_Y2); \
    p.ACT = (bf16*)(ws + WS_ACT); p.VT = (bf16*)(ws + WS_VT); p.VCT = (bf16*)(ws + WS_VCT); }

#define GRUN(N, call) do { const long _n = (long)(N); const long gthreads = (long)gridDim.x * NTHREADS; for (long i = (long)blockIdx.x * NTHREADS + opaque((int)threadIdx.x); i < _n; i += gthreads) { call; } } while (0)
#define GRID_BAR() xcd_barrier(bar)
#define GEMM_E(EpiT, Einit, Aptr, Btptr, Mrows, Ncols, Kdim) do { pg8::Gemm g{(const pg8::bf16_t*)(Aptr), (const pg8::bf16_t*)(Btptr), (int)(Mrows), (int)(Ncols), (int)(Kdim)}; \
        pg8::StaticOrder S; S.init((int)(Mrows), (int)(Ncols), (int)gridDim.x, (int)blockIdx.x); EpiT E Einit; \
        pg8::gemm_phase<EpiT, pg8::StaticOrder, true, true>(L, g, S, E); } while (0)
#define COMMA ,
#define GEMM(Aptr, Btptr, Mrows, Ncols, Kdim, Optr, ldo) GEMM_E(pg8::EpiBf16<0>, {(pg8::bf16_t*)(Optr) COMMA (int)(ldo) COMMA nullptr COMMA 0 COMMA 0 COMMA 1.f}, Aptr, Btptr, Mrows, Ncols, Kdim)
#define WT(Wp, K_, ldw_, N_, Btp, mode_, c0_) do { const int nt_ = ((N_) / 32) * ((K_) / 64); LAS float* scr_ = (LAS float*)(L + wave * 17408); \
        for (int t_ = blockIdx.x * NWAVES + wave; t_ < nt_; t_ += gridDim.x * NWAVES) wprep_tile<(K_), (ldw_), (N_), (mode_), (c0_)>((Wp), (Btp), t_, lane, scr_); } while (0)
#define WPREP(LL) do { const int _li = (LL) / 2; \
        if (((LL) & 1) == 0) { const float* W = p.even_w_in + (size_t)_li * cDM * EIN_W; \
            WT(W, cDM, EIN_W, LDE2, p.Wt_in, 1, 0); \
            WT(W, cDM, EIN_W, 1024, (bf16*)(wsb + WS_WV), 2, 0); \
            WT(p.even_w_out + (size_t)_li * 768 * cDM, 768, cDM, cDM, p.Wt_out, 0, 0); \
            WT(W, cDM, EIN_W, 32, (bf16*)(wsb + WS_WGT), 0, 1280); \
            WT(p.cmp_w1 + ((size_t)_li * 2 + 0) * 2048 * 256, 2048, 256, 256, (bf16*)(wsb + WS_W1T), 0, 0); \
            WT(p.cmp_w1 + ((size_t)_li * 2 + 1) * 2048 * 256, 2048, 256, 256, (bf16*)(wsb + WS_W1T) + (size_t)256 * 2048, 0, 0); \
            GRUN(512, peb_item(p.cmp_pe + (size_t)_li * 2 * 2048, p.cmp_w1 + (size_t)_li * 2 * 2048 * 256, (float*)(wsb + WS_PEB), i)); } \
        else { const float* W = p.odd_w_in + (size_t)_li * cDM * 3 * cDM; \
            WT(W, cDM, 3 * cDM, 2 * cDM, p.Wt_in, 0, 0); \
            WT(W, cDM, 3 * cDM, cDM, (bf16*)(wsb + WS_WV), 0, 2 * cDM); \
            WT(p.odd_w_out + (size_t)_li * cDM * cDM, cDM, cDM, cDM, p.Wt_out, 0, 0); } \
        WT(p.ffn_w_up + (size_t)(LL) * cDM * 2 * cDFF, cDM, 2 * cDFF, 2 * cDFF, p.Wt_up, 3, 0); \
        WT(p.ffn_w_down + (size_t)(LL) * cDFF * cDM, cDFF, cDM, cDM, p.Wt_dn, 0, 0); } while (0)
#define NRN(FIN, FOUT, hin_, hout_, g1_, g2_) do { for (long r = blockIdx.x * NWAVES + wave; r < cM; r += gridDim.x * NWAVES) nrn_row_dev<FIN, FOUT>((hin_) + r * cDM, p.Y2 + r * cDM, (g1_), (g2_), (hout_) + r * cDM, p.Y + r * cDM, lane); } while (0)
#define H16P ((bf16*)(wsb + WS_H16))
#define FFN(LL) do { \
        { MKP(); GEMM_E(pg8::EpiConvGelu, {(pg8::bf16_t*)p.ACT COMMA p.ffn_conv_w + (size_t)(LL) * 3 * 2 * cDFF COMMA p.ffn_conv_b + (size_t)(LL) * 2 * cDFF COMMA (float*)(wsb + WS_SB)}, p.Y, p.Wt_up, cM, 2 * cDFF, cDM); } GRID_BAR(); \
        { MKP(); GRUN((long)(cM / 64) * 2 * (cDFF / 4), convfix_item(p, (const float*)(wsb + WS_SB), p.ffn_conv_w + (size_t)(LL) * 3 * 2 * cDFF, p.ffn_conv_b + (size_t)(LL) * 2 * cDFF, i)); } GRID_BAR(); \
        { MKP(); GEMM(p.ACT, p.Wt_dn, cM, cDM, cDFF, p.Y2, cDM); } GRID_BAR(); \
        { MKP(); const float* ng = p.norm_g + (size_t)(LL) * 4 * cDM; if ((LL) + 1 < 4) NRN(false, false, H16P, H16P, ng + 3 * cDM, ng + 4 * cDM); else NRN(false, true, H16P, p.out, ng + 3 * cDM, (const float*)nullptr); \
          if ((LL) + 1 < 4) WPREP((LL) + 1); } GRID_BAR(); } while (0)
#define EVEN_LAYER(lp) do { const int LL = 2 * (lp); \
          { MKP(); GEMM_E(pg8::EpiRopeE, {(pg8::bf16_t*)p.PROJ COMMA PE_LD COMMA p.ROPE}, p.Y, p.Wt_in, cM, LDE2, cDM); } \
          { MKP(); GEMM_E(pg8::EpiVT, {(pg8::bf16_t*)p.VT}, (const bf16*)(wsb + WS_WV), p.Y, 1024, cM, cDM); } GRID_BAR();            \
          { MKP(); GRUN((long)512 * cB * (cS / 128), vtp_item(p.VT, (bf16*)(wsb + WS_VTP), i)); if (wave < 4) for (int u = blockIdx.x * 4 + wave; u < cM / 32; u += gridDim.x * 4) gates_unit(p, (const bf16*)(wsb + WS_WGT), u, lane);     \
            for (int u = blockIdx.x * NWAVES + wave; u < 2048; u += gridDim.x * NWAVES) cmp1_unit(p, (const bf16*)(wsb + WS_W1T), (const float*)(wsb + WS_PEB), u, lane); } GRID_BAR(); \
          { MKP(); GRUN((long)2 * cB * cNC * 2 * 32, cmp2_item(p, p.cmp_w2 + (size_t)(lp) * 2 * 256 * 64, i)); } GRID_BAR(); \
          { MKP(); const int ngw = gridDim.x * NWAVES; bf16* DO_ = (bf16*)(wsb + WS_DOUT); float* DL_ = (float*)(wsb + WS_DLSE); const bf16* VP_ = (const bf16*)(wsb + WS_VTP); \
              \
            for (int u = VCU() * NWAVES + wave; u < cB * 4 * 256; u += ngw) { const int bh = u >> 8, x = u & 255; \
                dil_unit<0>(p, p.VT, VP_, DO_, DL_, L + wave * 17408, bh >> 2, bh & 3, 0, x, lane); \
                dil_unit<1>(p, p.VT, VP_, DO_, DL_, L + wave * 17408, bh >> 2, bh & 3, x >> 6, x & 63, lane); \
                dil_unit<2>(p, p.VT, VP_, DO_, DL_, L + wave * 17408, bh >> 2, bh & 3, x >> 4, x & 15, lane); } } \
          { MKP(); const int ngw = gridDim.x * NWAVES, NT = cS / 8; LAS unsigned char* wl = L + wave * 17408; \
              \
            for (int u = VCU() * NWAVES + wave; u < cB * 2 * NT; u += ngw) { const int gw = u % ngw, k = u / ngw; int bg, tile; \
                if (ngw == 2048) { bg = gw >> 8; const int i = gw & 255; tile = 256 * k + ((k & 1) ? 255 - i : i); } else { bg = u / NT; tile = u % NT; } \
                nsa_unit(p, p.VCT, p.VT, wl, bg >> 1, bg & 1, tile * 8, lane); } } GRID_BAR(); \
          { MKP(); GRUN((long)cM * 32, dil_combine_item(p, (const bf16*)(wsb + WS_DOUT), (const float*)(wsb + WS_DLSE), i)); } GRID_BAR(); \
          { MKP(); GEMM(p.ATT, p.Wt_out, cM, cDM, 768, p.Y2, cDM); } GRID_BAR(); \
          { MKP(); const float* ng = p.norm_g + (size_t)LL * 4 * cDM; if ((lp) == 0) NRN(true, false, p.x, H16P, ng + cDM, ng + 2 * cDM); else NRN(false, false, H16P, H16P, ng + cDM, ng + 2 * cDM); } GRID_BAR(); \
          FFN(LL); } while (0)
#define ODD_LAYER(lp) do { const int LL = 2 * (lp) + 1; \
          { MKP(); GEMM(p.Y, p.Wt_in, cM, LDO2, cDM, p.PROJ, PO_LD); } \
          { MKP(); GEMM_E(pg8::EpiVT, {(pg8::bf16_t*)p.VT}, (const bf16*)(wsb + WS_WV), p.Y, 1024, cM, cDM); } GRID_BAR(); \
          { MKP(); const int NT = cS / 32; for (int u = VCU() * NWAVES + wave; u < cB * cNSB * NT; u += gridDim.x * NWAVES) { const int bh = u / NT; \
                sb_unit(p, p.VT, L + wave * 17408, bh / cNSB, bh % cNSB, (u % NT) * 32, lane); } } GRID_BAR(); \
          { MKP(); GEMM(p.ATT, p.Wt_out, cM, cDM, cDM, p.Y2, cDM); } GRID_BAR(); \
          { MKP(); const float* ng = p.norm_g + (size_t)LL * 4 * cDM; NRN(false, false, H16P, H16P, ng + cDM, ng + 2 * cDM); } GRID_BAR(); \
          FFN(LL); } while (0)

    { MKP();
      GRUN((long)cS * 32, rope_table_item(p, i));
      WPREP(0);
      for (long r = blockIdx.x * NWAVES + wave; r < cM; r += gridDim.x * NWAVES) n_row_dev(p.x + r * cDM, p.norm_g, p.Y + r * cDM, lane); }
    GRID_BAR();
    EVEN_LAYER(0); ODD_LAYER(0); EVEN_LAYER(1); ODD_LAYER(1);
}

extern "C" void kernel_launch(void* const* d_in, const int* in_sizes, int n_in, void* d_out, int out_size, void* d_ws, size_t ws_size, hipStream_t stream) {
    static int grid = 0;
    if (grid == 0) {
        if (n_in != 13 || out_size != cM * cDM || ws_size < WS_END) { fprintf(stderr, "kernel_launch: unexpected shapes (n_in %d out %d ws %zu)\n", n_in, out_size, ws_size); grid = -1; return; }
        int dev = 0, cus = 0;
        if (hipGetDevice(&dev) != hipSuccess || hipDeviceGetAttribute(&cus, hipDeviceAttributeMultiprocessorCount, dev) != hipSuccess) { grid = -1; return; }
        if (hipFuncSetAttribute((const void*)fwd, hipFuncAttributeMaxDynamicSharedMemorySize, LDS_BYTES) != hipSuccess) { grid = -1; return; }
        int per_cu = 0; (void)hipOccupancyMaxActiveBlocksPerMultiprocessor(&per_cu, (const void*)fwd, NTHREADS, LDS_BYTES); (void)hipGetLastError();
        grid = cus;
    }
    if (grid < 0) return;
    (void)hipMemsetAsync((char*)d_ws + WS_CTL, 0, CTL_ZERO_BYTES, stream);
    Args a{};
    for (int i = 0; i < 13; ++i) a.in[i] = (const float*)d_in[i];
    a.out = (float*)d_out; a.ws = (unsigned char*)d_ws;
    hipLaunchKernelGGL(fwd, dim3(grid), dim3(NTHREADS), LDS_BYTES, stream, a);
}
```

```cpp
#include <hip/hip_runtime.h>
#include <cstdio>
#include <cstdint>
#include <cmath>
#ifdef HOST_TEST
#include <cmath>
#include <cstring>
#include <cstdio>
#include <cstdlib>
#define HD
static int cB = 1, cS = 1024, cDM = 128, cDFF = 192;
#else
#define HD __device__ __forceinline__
constexpr int cB = 4, cS = 8192, cDM = 1024, cDFF = 2816;
#endif
typedef unsigned short bf16;
#define cM (cB * cS)
#define cNC ((cS - 32) / 16 + 1)
#define cNS (cS / 64)
#define cTOPN (cNS < 16 ? cNS : 16)
#define cNSB (cDM / 64)
#define LDE 3584
#define LDE2 2560
#define LDO2 2048
#define LDO (3 * cDM)
#define EIN_W 3608
#define KCMP_ROWS 512
#define PE_LD (LDE2 + 128)
#define PO_LD (LDO2 + 128)
#define VT_LD (cM + 128)
#define VCT_LD (KCMP_ROWS + 128)

struct alignas(16) U4 { unsigned x, y, z, w; };
HD float u2f(unsigned u) { float f; __builtin_memcpy(&f, &u, 4); return f; }
HD unsigned f2u(float f) { unsigned u; __builtin_memcpy(&u, &f, 4); return u; }
HD float bf2f(bf16 v) { return u2f((unsigned)v << 16); }
HD bf16 f2bf(float f) { unsigned u = f2u(f); return (bf16)((u + 0x7fffu + ((u >> 16) & 1u)) >> 16); }
HD unsigned pk2bf(float lo, float hi) {
#if defined(__HIP_DEVICE_COMPILE__)
    typedef float pk2f_t __attribute__((ext_vector_type(2))); typedef __bf16 pk2b_t __attribute__((ext_vector_type(2)));
    pk2f_t v = {lo, hi}; pk2b_t b = __builtin_convertvector(v, pk2b_t); return __builtin_bit_cast(unsigned, b);
#else
    return (unsigned)f2bf(lo) | ((unsigned)f2bf(hi) << 16);
#endif
}
HD float fast_exp2(float x) {
#if defined(__HIP_DEVICE_COMPILE__)
    return __builtin_amdgcn_exp2f(x);
#else
    return exp2f(x);
#endif
}
HD float fast_rcp(float x) {
#if defined(__HIP_DEVICE_COMPILE__)
    return __builtin_amdgcn_rcpf(x);
#else
    return 1.f / x;
#endif
}
HD float bflo(unsigned w) { return u2f(w << 16); }
HD float bfhi(unsigned w) { return u2f(w & 0xffff0000u); }

struct P {
    const float *x, *norm_g, *even_w_in, *even_w_out, *cmp_pe, *cmp_w1, *cmp_w2, *odd_w_in, *odd_w_out, *ffn_w_up, *ffn_conv_w, *ffn_conv_b, *ffn_w_down;
    float* out;
    bf16 *Wt_in, *Wt_out, *Wt_up, *Wt_dn;
    float* ROPE;
    float* GATES;
    bf16* KCMP;
    float* HID;
    bf16 *Y, *PROJ, *ATT, *Y2, *ACT;
    bf16* VT;
    bf16* VCT;
};

HD float gelu_tanh(float x) { return 0.5f * x * (1.f + tanhf(0.7978845608028654f * (x + 0.044715f * x * x * x))); }

HD void rope_table_item(const P& p, long idx) {
    const int pos = (int)(idx / 32), i = (int)(idx % 32);
    const double ang = (double)pos * pow(10000.0, -(double)i / 32.0);
    p.ROPE[idx * 2] = (float)cos(ang); p.ROPE[idx * 2 + 1] = (float)sin(ang);
}
HD void cmp2_item(const P& p, const float* w2, long idx) {
    const int i = (int)(idx % 32), g = (int)((idx / 32) % 2), n = (int)((idx / 64) % cNC), b = (int)((idx / (64L * cNC)) % cB), which = (int)(idx / (64L * cNC * cB));
    const float* hid = p.HID + ((((size_t)which * cB + b) * cNC + n) * 2 + g) * 256; const float* ww = w2 + (size_t)which * 256 * 64;
    float a1 = 0.f, a2 = 0.f;
    for (int j = 0; j < 256; ++j) { a1 += hid[j] * ww[j * 64 + i]; a2 += hid[j] * ww[j * 64 + i + 32]; }
    bf16* o = p.KCMP + (((size_t)b * KCMP_ROWS + n) * 2 + g) * 64;
    if (which == 0) { const int pos = 16 * n + 31; const float c = p.ROPE[(pos * 32 + i) * 2], s = p.ROPE[(pos * 32 + i) * 2 + 1];
        o[i] = f2bf(a1 * c - a2 * s); o[i + 32] = f2bf(a2 * c + a1 * s); }
    else { bf16* ot = p.VCT + ((size_t)(b * 2 + g) * 64 + i) * VCT_LD + n; ot[0] = f2bf(a1); ot[(size_t)32 * VCT_LD] = f2bf(a2);
        if (n == 0) { ot[511] = 0; ot[(size_t)32 * VCT_LD + 511] = 0; } }
    if (which == 0 && n == 0) { bf16* oz = p.KCMP + (((size_t)b * KCMP_ROWS + 511) * 2 + g) * 64; oz[i] = 0; oz[i + 32] = 0; }
}
HD void peb_item(const float* pe, const float* w1, float* PEB, long idx) {
    const int j = (int)(idx % 256), which = (int)(idx / 256);
    float acc = 0.f;
    for (int k = 0; k < 2048; ++k) acc += pe[(size_t)which * 2048 + k] * w1[((size_t)which * 2048 + k) * 256 + j];
    PEB[idx] = acc;
}
HD int wsrc_col(int mode, int n) {
    if (mode == 1) { const int u = n >> 8, c = n & 255, hiu = c >> 6, w = c & 63;
        if (u == 2) return 512 + c;
        const int d = (w & 7) < 4 ? 4 * (w >> 3) + (w & 7) : 32 + 4 * (w >> 3) + ((w & 7) - 4);
        int base;
        if (u < 2) base = 64 * (4 * u + hiu); else if (u == 3) base = hiu < 2 ? 768 + 64 * hiu : 1024 + 64 * (hiu - 2);
        else if (u < 7) base = 1304 + 64 * (4 * (u - 4) + hiu); else base = 1304 + 768 + 64 * (4 * (u - 7) + hiu);
        return base + d; }
    if (mode == 2) return n < 128 ? 896 + n : n < 256 ? 1152 + (n - 128) : 2840 + (n - 256);
    if (mode == 3) { const int pn = n >> 8, bj = (n >> 7) & 1, x = n & 127; return bj * cDFF + 128 * pn + x; }
    return n;
}
HD float gelu_fast_h(float x) { const float z = x + 0.044715f * x * x * x; return x * fast_rcp(1.f + fast_exp2(-2.3022081981f * z)); }
struct alignas(16) F4 { float v[4]; };
HD void convfix_item(const P& p, const float* SB, const float* cw, const float* cb, long idx) {
    constexpr int Q = cDFF / 4; const int j = 4 * (int)(idx % Q), rr = (int)((idx / Q) % 2); const long blk = idx / (2L * Q); const long row = blk * 64 + rr; const int t = (int)(row % cS), LD2 = 2 * cDFF;
    const float* s0 = SB + ((size_t)blk * 4 + rr) * LD2; const float* sp = SB + ((size_t)(blk - 1) * 4) * LD2;
    const float* sm = SB + ((size_t)blk * 4) * LD2;
#define LD4(ptr) (*(const F4*)(ptr))
    const F4 bg = LD4(cb + j), bv = LD4(cb + cDFF + j), w2g = LD4(cw + 2 * LD2 + j), w2v = LD4(cw + 2 * LD2 + cDFF + j), w1g = LD4(cw + LD2 + j), w1v = LD4(cw + LD2 + cDFF + j), w0g = LD4(cw + j), w0v = LD4(cw + cDFF + j);
    const F4 ug = LD4(s0 + j), uv = LD4(s0 + cDFF + j);
    F4 g1 = {{0.f, 0.f, 0.f, 0.f}}, v1 = g1, g2 = g1, v2 = g1;
    if (rr == 0) { if (t >= 1) { g1 = LD4(sp + 3 * LD2 + j); v1 = LD4(sp + 3 * LD2 + cDFF + j); g2 = LD4(sp + 2 * LD2 + j); v2 = LD4(sp + 2 * LD2 + cDFF + j); } }
    else { g1 = LD4(sm + j); v1 = LD4(sm + cDFF + j); if (t >= 2) { g2 = LD4(sp + 3 * LD2 + j); v2 = LD4(sp + 3 * LD2 + cDFF + j); } }
#undef LD4
    float o[4];
#pragma unroll
    for (int e = 0; e < 4; ++e) { const float cg = bg.v[e] + w2g.v[e] * ug.v[e] + w1g.v[e] * g1.v[e] + w0g.v[e] * g2.v[e], cv = bv.v[e] + w2v.v[e] * uv.v[e] + w1v.v[e] * v1.v[e] + w0v.v[e] * v2.v[e];
        o[e] = gelu_fast_h(cg) * cv; }
    uint2 w; w.x = pk2bf(o[0], o[1]); w.y = pk2bf(o[2], o[3]);
    *(uint2*)(p.ACT + (size_t)row * cDFF + j) = w;
}
HD size_t vt_tile_off(int ngrp, int b, int grp, int tile) { return (((size_t)b * ngrp + grp) * (cS / 32) + tile) * 2048; }
HD size_t vt_elem_off(int ngrp, int b, int dg, int tk) { return vt_tile_off(ngrp, b, dg >> 6, tk >> 5) + (size_t)(dg & 63) * 32 + (tk & 31); }
template <int dil> HD void vtp_run(const bf16* src, bf16* VTP, int b, int pr, int G) {
    unsigned in[64];
#pragma unroll
    for (int q = 0; q < 4; ++q)
#pragma unroll
        for (int c = 0; c < 4; ++c) { const U4 v = *(const U4*)(src + (size_t)q * 2048 + 8 * c); in[16 * q + 4 * c] = v.x; in[16 * q + 4 * c + 1] = v.y; in[16 * q + 4 * c + 2] = v.z; in[16 * q + 4 * c + 3] = v.w; }
    constexpr int per = cS / dil, nm = 128 / dil;
#pragma unroll
    for (int rc = 0; rc < dil; ++rc)
#pragma unroll
        for (int o8 = 0; o8 < nm / 8; ++o8) { unsigned w[4];
#pragma unroll
            for (int e = 0; e < 4; ++e) { const int t0_ = dil * (8 * o8 + 2 * e) + rc, t1_ = t0_ + dil;
                const unsigned lo = (t0_ & 1) ? (in[t0_ >> 1] >> 16) : (in[t0_ >> 1] & 0xFFFFu), hi = (t1_ & 1) ? (in[t1_ >> 1] & 0xFFFF0000u) : (in[t1_ >> 1] << 16);
                w[e] = lo | hi; }
            U4 v; v.x = w[0]; v.y = w[1]; v.z = w[2]; v.w = w[3];
            *(U4*)(VTP + vt_elem_off(8, b, pr, rc * per + nm * G + 8 * o8)) = v; }
}
HD void vtp_item(const bf16* VT, bf16* VTP, long idx) {
    const int ng = cS / 128; const int G = (int)(idx % ng), b = (int)((idx / ng) % cB), pr = (int)(idx / ((long)ng * cB));
    const bf16* src = VT + vt_elem_off(16, b, 512 + pr, 128 * G);
    if (pr < 256) vtp_run<4>(src, VTP, b, pr, G); else vtp_run<16>(src, VTP, b, pr, G);
}
HD void dil_combine_item(const P& p, const bf16* DOUT, const float* DLSE, long idx) {
    const int c8 = (int)(idx % 8), hd = (int)((idx / 8) % 4); const long row = idx / 32;
    const float l0 = DLSE[((size_t)0 * cM + row) * 4 + hd], l1 = DLSE[((size_t)1 * cM + row) * 4 + hd], l2 = DLSE[((size_t)2 * cM + row) * 4 + hd];
    const float mx = fmaxf(l0, fmaxf(l1, l2)), e0 = fast_exp2(l0 - mx), e1 = fast_exp2(l1 - mx), e2 = fast_exp2(l2 - mx), rs = fast_rcp(e0 + e1 + e2);
    const U4 a = *(const U4*)(DOUT + ((size_t)0 * cM + row) * 256 + hd * 64 + 8 * c8), bq = *(const U4*)(DOUT + ((size_t)1 * cM + row) * 256 + hd * 64 + 8 * c8), cq = *(const U4*)(DOUT + ((size_t)2 * cM + row) * 256 + hd * 64 + 8 * c8);
    const float w0 = e0 * rs, w1 = e1 * rs, w2 = e2 * rs;
    U4 o;
    o.x = pk2bf(w0 * bflo(a.x) + w1 * bflo(bq.x) + w2 * bflo(cq.x), w0 * bfhi(a.x) + w1 * bfhi(bq.x) + w2 * bfhi(cq.x));
    o.y = pk2bf(w0 * bflo(a.y) + w1 * bflo(bq.y) + w2 * bflo(cq.y), w0 * bfhi(a.y) + w1 * bfhi(bq.y) + w2 * bfhi(cq.y));
    o.z = pk2bf(w0 * bflo(a.z) + w1 * bflo(bq.z) + w2 * bflo(cq.z), w0 * bfhi(a.z) + w1 * bfhi(bq.z) + w2 * bfhi(cq.z));
    o.w = pk2bf(w0 * bflo(a.w) + w1 * bflo(bq.w) + w2 * bflo(cq.w), w0 * bfhi(a.w) + w1 * bfhi(bq.w) + w2 * bfhi(cq.w));
    *(U4*)(p.ATT + (size_t)row * 768 + 512 + hd * 64 + 8 * c8) = o;
}
#define LAS __attribute__((address_space(3)))
typedef short bf16x8v __attribute__((ext_vector_type(8)));
typedef short bf16x4v __attribute__((ext_vector_type(4)));
typedef float f32x16 __attribute__((ext_vector_type(16)));
typedef float f32x2_t __attribute__((ext_vector_type(2)));
typedef float f32x4v __attribute__((ext_vector_type(4)));
typedef __bf16 bf16x2_t __attribute__((ext_vector_type(2)));
__device__ __forceinline__ unsigned cvtpk(float lo, float hi) { f32x2_t v = {lo, hi}; bf16x2_t b = __builtin_convertvector(v, bf16x2_t); return __builtin_bit_cast(unsigned, b); }
__device__ __forceinline__ float fexp2(float x) { return __builtin_amdgcn_exp2f(x); }
#define ATT_C2 (0.125f * 1.4426950408889634f)
#define ATT_NEG (-1e30f)
#define ATT_THR 8.0f

typedef unsigned u32x2v __attribute__((ext_vector_type(2)));
__device__ __forceinline__ float vmax2(float a, float b) { float d; asm("v_max_f32 %0, %1, %2" : "=v"(d) : "v"(a), "v"(b)); return d; }
__device__ __forceinline__ float vmax3(float a, float b, float c) { float d; asm("v_max3_f32 %0, %1, %2, %3" : "=v"(d) : "v"(a), "v"(b), "v"(c)); return d; }
__device__ __forceinline__ float vmax16(const f32x16& s) {
    const float a = vmax3(s[0], s[1], s[2]), b = vmax3(s[3], s[4], s[5]), c = vmax3(s[6], s[7], s[8]), d = vmax3(s[9], s[10], s[11]), e = vmax3(s[12], s[13], s[14]);
    return vmax2(vmax3(vmax3(a, b, c), d, e), s[15]); }
__device__ __forceinline__ float vmax16_acc(const f32x16& s) { float d;
    asm("s_nop 11\n\tv_max3_f32 %0, %1, %2, %3\n\tv_max3_f32 %0, %0, %4, %5\n\tv_max3_f32 %0, %0, %6, %7\n\tv_max3_f32 %0, %0, %8, %9\n\t"
        "v_max3_f32 %0, %0, %10, %11\n\tv_max3_f32 %0, %0, %12, %13\n\tv_max3_f32 %0, %0, %14, %15\n\tv_max_f32 %0, %0, %16"
        : "=&v"(d) : "v"(s[0]), "v"(s[1]), "v"(s[2]), "v"(s[3]), "v"(s[4]), "v"(s[5]), "v"(s[6]), "v"(s[7]), "v"(s[8]), "v"(s[9]), "v"(s[10]), "v"(s[11]), "v"(s[12]), "v"(s[13]), "v"(s[14]), "v"(s[15]));
    return d; }
#define OPQ(x) asm("" : "+v"(x))
__device__ __forceinline__ float vsum16(const f32x16& s) {
    float a0 = s[0] + s[1], a1 = s[2] + s[3], a2 = s[4] + s[5], a3 = s[6] + s[7], a4 = s[8] + s[9], a5 = s[10] + s[11], a6 = s[12] + s[13], a7 = s[14] + s[15];
    OPQ(a0); OPQ(a1); OPQ(a2); OPQ(a3); OPQ(a4); OPQ(a5); OPQ(a6); OPQ(a7);
    float b0 = a0 + a1, b1 = a2 + a3, b2 = a4 + a5, b3 = a6 + a7; OPQ(b0); OPQ(b1); OPQ(b2); OPQ(b3);
    float c0 = b0 + b1, c1 = b2 + b3; OPQ(c0); OPQ(c1);
    return c0 + c1; }
__device__ __forceinline__ float xmax32(float x) { float y; asm volatile("v_mov_b32 %0, %1\n\ts_nop 1" : "=v"(y) : "v"(x));
    auto r = __builtin_amdgcn_permlane32_swap(__builtin_bit_cast(unsigned, x), __builtin_bit_cast(unsigned, y), false, false); const unsigned a = r[0], b = r[1];
    return vmax2(__builtin_bit_cast(float, a), __builtin_bit_cast(float, b)); }
__device__ __forceinline__ float xsum32(float x) { float y; asm volatile("v_mov_b32 %0, %1\n\ts_nop 1" : "=v"(y) : "v"(x));
    auto r = __builtin_amdgcn_permlane32_swap(__builtin_bit_cast(unsigned, x), __builtin_bit_cast(unsigned, y), false, false); const unsigned a = r[0], b = r[1];
    return __builtin_bit_cast(float, a) + __builtin_bit_cast(float, b); }
__device__ __forceinline__ void store_row64(bf16* rowp, int hh, const float (&o)[32], float sc) {
#pragma unroll
    for (int dt = 0; dt < 2; ++dt)
#pragma unroll
        for (int kp = 0; kp < 2; ++kp) { const float* q = o + 16 * dt + 8 * kp;
            const unsigned a0 = cvtpk(q[0] * sc, q[1] * sc), a1 = cvtpk(q[2] * sc, q[3] * sc), b0 = cvtpk(q[4] * sc, q[5] * sc), b1 = cvtpk(q[6] * sc, q[7] * sc);
            auto r0 = __builtin_amdgcn_permlane32_swap(a0, b0, false, false); auto r1 = __builtin_amdgcn_permlane32_swap(a1, b1, false, false);
            U4 w; w.x = r0[0]; w.y = r1[0]; w.z = r0[1]; w.w = r1[1];
            *(U4*)(rowp + 32 * dt + 16 * kp + 8 * hh) = w; }
}
__device__ __forceinline__ f32x16 zero16() { f32x16 z;
#pragma unroll
    for (int i = 0; i < 16; ++i) z[i] = 0.f;
    return z; }
__device__ __forceinline__ f32x16 qk32(const bf16* kp, const bf16x8v (&qf)[4]) {
    f32x16 acc = zero16();
#pragma unroll
    for (int ks = 0; ks < 4; ++ks) { const bf16x8v kf = *(const bf16x8v*)(kp + 16 * ks); acc = __builtin_amdgcn_mfma_f32_32x32x16_bf16(kf, qf[ks], acc, 0, 0, 0); }
    return acc;
}
__device__ __forceinline__ void pv32(f32x16& o0, f32x16& o1, const bf16* vt, size_t dstep, const unsigned (&pb)[8]) {
#pragma unroll
    for (int s = 0; s < 2; ++s) {
        const bf16x4v a00 = *(const bf16x4v*)(vt + 16 * s), a01 = *(const bf16x4v*)(vt + 16 * s + 8);
        const bf16x4v a10 = *(const bf16x4v*)(vt + dstep + 16 * s), a11 = *(const bf16x4v*)(vt + dstep + 16 * s + 8);
        bf16x8v A0, A1, B;
        A0 = __builtin_shufflevector(a00, a01, 0, 1, 2, 3, 4, 5, 6, 7); A1 = __builtin_shufflevector(a10, a11, 0, 1, 2, 3, 4, 5, 6, 7);
        typedef unsigned u32x4v __attribute__((ext_vector_type(4)));
        u32x4v bw = {pb[4 * s + 0], pb[4 * s + 1], pb[4 * s + 2], pb[4 * s + 3]};
        B = __builtin_bit_cast(bf16x8v, bw);
        o0 = __builtin_amdgcn_mfma_f32_32x32x16_bf16(A0, B, o0, 0, 0, 0);
        o1 = __builtin_amdgcn_mfma_f32_32x32x16_bf16(A1, B, o1, 0, 0, 0);
    }
}
struct KF { bf16x8v k[4]; };
struct VF { bf16x4v v[8]; };
__device__ __forceinline__ void load_k(KF& f, const bf16* kp) {
#pragma unroll
    for (int ks = 0; ks < 4; ++ks) f.k[ks] = *(const bf16x8v*)(kp + 16 * ks); }
__device__ __forceinline__ void load_v(VF& f, const bf16* vt, size_t dstep) {
#pragma unroll
    for (int s = 0; s < 2; ++s) { f.v[2 * s] = *(const bf16x4v*)(vt + 16 * s); f.v[2 * s + 1] = *(const bf16x4v*)(vt + 16 * s + 8);
        f.v[4 + 2 * s] = *(const bf16x4v*)(vt + dstep + 16 * s); f.v[4 + 2 * s + 1] = *(const bf16x4v*)(vt + dstep + 16 * s + 8); } }
__device__ __forceinline__ f32x16 qk32r(const KF& f, const bf16x8v (&qf)[4]) {
    f32x16 acc = zero16();
#pragma unroll
    for (int ks = 0; ks < 4; ++ks) acc = __builtin_amdgcn_mfma_f32_32x32x16_bf16(f.k[ks], qf[ks], acc, 0, 0, 0);
    return acc; }
__device__ __forceinline__ void pv32r(f32x16& o0, f32x16& o1, const VF& f, const unsigned (&pb)[8]) {
    typedef unsigned u32x4v __attribute__((ext_vector_type(4)));
#pragma unroll
    for (int s = 0; s < 2; ++s) {
        const bf16x8v A0 = __builtin_shufflevector(f.v[2 * s], f.v[2 * s + 1], 0, 1, 2, 3, 4, 5, 6, 7), A1 = __builtin_shufflevector(f.v[4 + 2 * s], f.v[4 + 2 * s + 1], 0, 1, 2, 3, 4, 5, 6, 7);
        const u32x4v bw = {pb[4 * s + 0], pb[4 * s + 1], pb[4 * s + 2], pb[4 * s + 3]}; const bf16x8v B = __builtin_bit_cast(bf16x8v, bw);
        o0 = __builtin_amdgcn_mfma_f32_32x32x16_bf16(A0, B, o0, 0, 0, 0); o1 = __builtin_amdgcn_mfma_f32_32x32x16_bf16(A1, B, o1, 0, 0, 0); } }
__device__ __forceinline__ unsigned long long wave_or64(unsigned long long x) {
    unsigned lo = (unsigned)x, hi = (unsigned)(x >> 32);
#pragma unroll
    for (int o = 1; o < 64; o <<= 1) { lo |= (unsigned)__shfl_xor((int)lo, o); hi |= (unsigned)__shfl_xor((int)hi, o); }
    return ((unsigned long long)(unsigned)__builtin_amdgcn_readfirstlane((int)hi) << 32) | (unsigned)__builtin_amdgcn_readfirstlane((int)lo); }
struct LaneAddr { unsigned ck, cv; unsigned rk[4], rv[4], rw[4]; };
__device__ __forceinline__ LaneAddr lane_addr(LAS unsigned char* slot, int lane) {
    LaneAddr a; const int r = lane & 31, hh = lane >> 5; const unsigned sb = (unsigned)(size_t)slot;
    a.ck = (unsigned)lane; a.cv = (unsigned)lane;
#pragma unroll
    for (int ks = 0; ks < 4; ++ks) a.rk[ks] = sb + r * 128 + (((2 * ks + hh) ^ (r & 7)) * 16);
#pragma unroll
    for (int c = 0; c < 4; ++c) { a.rv[c] = sb + 4096 + r * 64 + ((c ^ ((r >> 2) & 3)) * 16) + 8 * hh; unsigned w = a.rv[c] + 2048; asm volatile("" : "+v"(w)); a.rw[c] = w; }
    return a; }
__device__ __forceinline__ unsigned kvoff(int lane, size_t pitch) { const int row = lane >> 3, ch = (lane & 7) ^ (row & 7); return (unsigned)((row * pitch + ch * 8) * 2); }
__device__ __forceinline__ unsigned vvoff(int lane, size_t pitch) { const int row = lane >> 2, ch = (lane & 3) ^ ((row >> 2) & 3); return (unsigned)((row * pitch + ch * 8) * 2); }
typedef __amdgpu_buffer_rsrc_t rsrc_t;
__device__ __forceinline__ rsrc_t mkrsrc(const void* base) { return __builtin_amdgcn_make_buffer_rsrc((void*)base, 0, 0x7FFFFFF0, 0x00020000); }
__device__ __forceinline__ void dma_k(LAS unsigned char* slot, rsrc_t rs, unsigned tile_off, unsigned pitchB, unsigned voff) {
#pragma unroll
    for (int q = 0; q < 4; ++q) __builtin_amdgcn_raw_ptr_buffer_load_lds(rs, (LAS unsigned*)(slot + q * 1024), 16, voff, tile_off + q * 8 * pitchB, 0, 0); }
__device__ __forceinline__ void dma_v(LAS unsigned char* slot, rsrc_t rs, unsigned tile_off, unsigned pitchB, unsigned voff) {
#pragma unroll
    for (int q = 0; q < 4; ++q) __builtin_amdgcn_raw_ptr_buffer_load_lds(rs, (LAS unsigned*)(slot + 4096 + q * 1024), 16, voff, tile_off + q * 16 * pitchB, 0, 0); }
__device__ __forceinline__ void read_k(KF& f, const LaneAddr& a) {
#pragma unroll
    for (int ks = 0; ks < 4; ++ks) f.k[ks] = *(const LAS bf16x8v*)(size_t)a.rk[ks]; }
__device__ __forceinline__ void read_v(VF& f, const LaneAddr& a) {
#pragma unroll
    for (int dt = 0; dt < 2; ++dt)
#pragma unroll
        for (int s = 0; s < 2; ++s) { f.v[4 * dt + 2 * s] = *(const LAS bf16x4v*)(size_t)(dt ? a.rw[2 * s] : a.rv[2 * s]); f.v[4 * dt + 2 * s + 1] = *(const LAS bf16x4v*)(size_t)(dt ? a.rw[2 * s + 1] : a.rv[2 * s + 1]); } }
#define DMA_WAIT() asm volatile("s_waitcnt vmcnt(0)" ::: "memory")
#define LDS_DRAIN() asm volatile("s_waitcnt lgkmcnt(0)" ::: "memory")
#define LDS_DRAIN_PINNED() do { __builtin_amdgcn_sched_barrier(0); asm volatile("s_waitcnt lgkmcnt(0)" ::: "memory"); } while (0)
#define ATT_BIG 1.152921504606847e18f
__device__ __forceinline__ void sm_fast(f32x16& s, const KF& kc, const bf16x8v (&qf)[4], bool lane_on, float& m, float& l, f32x16& o0, f32x16& o1, unsigned (&pb)[8]) {
    float nb = lane_on ? -m : -INFINITY;
#pragma unroll
    for (int reg = 0; reg < 16; ++reg) s[reg] = fexp2(__builtin_fmaf(s[reg], ATT_C2, nb));
    float rs = vsum16(s);
    if (__any(!(rs < ATT_BIG))) {
        s = qk32r(kc, qf);
        float mx = vmax16_acc(s);
        mx = xmax32(lane_on ? mx * ATT_C2 : ATT_NEG);
        const float mn = (mx > m + ATT_THR) ? mx : m, alpha = fexp2(m - mn); m = mn; l *= alpha;
#pragma unroll
        for (int reg = 0; reg < 16; ++reg) { o0[reg] *= alpha; o1[reg] *= alpha; }
        nb = lane_on ? -m : -INFINITY;
#pragma unroll
        for (int reg = 0; reg < 16; ++reg) s[reg] = fexp2(__builtin_fmaf(s[reg], ATT_C2, nb));
        rs = vsum16(s); }
    l += rs;
#pragma unroll
    for (int i = 0; i < 8; ++i) pb[i] = cvtpk(s[2 * i], s[2 * i + 1]);
}
__device__ __forceinline__ void sm_step(f32x16& s, const KF& kc, const bf16x8v (&qf)[4], int lo, int hi, int hh, float& m, float& l, f32x16& o0, f32x16& o1, unsigned (&pb)[8]) {
    const float nb = -m;
#pragma unroll
    for (int reg = 0; reg < 16; ++reg) { const int ko = (reg & 3) + 8 * (reg >> 2) + 4 * hh; const bool v = (ko >= lo) && (ko <= hi);
        const float e = fexp2(__builtin_fmaf(s[reg], ATT_C2, nb)); s[reg] = v ? e : 0.f; }
    float rs = vsum16(s);
    if (__any(!(rs < ATT_BIG))) {
        s = qk32r(kc, qf);
#pragma unroll
        for (int reg = 0; reg < 16; ++reg) { const int ko = (reg & 3) + 8 * (reg >> 2) + 4 * hh; const bool v = (ko >= lo) && (ko <= hi);
            s[reg] = v ? s[reg] * ATT_C2 : ATT_NEG; }
        const float mx = xmax32(vmax16(s));
        const float mn = (mx > m + ATT_THR) ? mx : m, alpha = fexp2(m - mn); m = mn; l *= alpha;
#pragma unroll
        for (int reg = 0; reg < 16; ++reg) { o0[reg] *= alpha; o1[reg] *= alpha; }
#pragma unroll
        for (int reg = 0; reg < 16; ++reg) s[reg] = (s[reg] > -1e29f) ? fexp2(s[reg] - m) : 0.f;
        rs = vsum16(s); }
    l += rs;
#pragma unroll
    for (int i = 0; i < 8; ++i) pb[i] = cvtpk(s[2 * i], s[2 * i + 1]);
}

__device__ __forceinline__ float dpp_xor1(float x) { return __builtin_bit_cast(float, __builtin_amdgcn_update_dpp(0, __builtin_bit_cast(int, x), 0xB1, 0xF, 0xF, true)); }
__device__ __forceinline__ float dpp_xor2(float x) { return __builtin_bit_cast(float, __builtin_amdgcn_update_dpp(0, __builtin_bit_cast(int, x), 0x4E, 0xF, 0xF, true)); }
#define IMP_LD 132
__device__ __forceinline__ void nsa_unit(const P& p, const bf16* VCT, const bf16* VT, LAS unsigned char* wl, int b, int g, int t0, int lane) {
    const LaneAddr la = lane_addr(wl, lane);
    LAS float* imp = (LAS float*)(wl + 8192);
    const int r = lane & 31, hh = lane >> 5, tl = r >> 2, hg = r & 3, head = g * 4 + hg, t = t0 + tl;
    const long row = (long)b * cS + t;
    bf16x8v qf[4];
    { const bf16* qp = p.PROJ + (size_t)row * PE_LD + head * 64 + 8 * hh;
#pragma unroll
      for (int ks = 0; ks < 4; ++ks) qf[ks] = *(const bf16x8v*)(qp + 16 * ks); }
    float outacc[32];
    unsigned pb[8];
    unsigned long long m0 = 0ull, m1 = 0ull;
    {
        for (int i = lane; i < 8 * IMP_LD; i += 64) imp[i] = 0.f;
        const int nv = t >= 31 ? (t - 31) / 16 + 1 : 0, nvmax = (t0 + 7) >= 31 ? (t0 + 7 - 31) / 16 + 1 : 0, ntile = (nvmax + 31) >> 5;
        float m = ATT_NEG, l = 0.f;
        const bf16* kc0 = p.KCMP + ((size_t)b * KCMP_ROWS * 2 + g) * 64;
        const bf16* vc0 = VCT + (size_t)(b * 2 + g) * 64 * VCT_LD;
        const rsrc_t rsK = mkrsrc(kc0), rsV = mkrsrc(vc0); const unsigned kvo = kvoff(lane, 128), vvo = vvoff(lane, VCT_LD);
        KF kc; VF vc;
        if (ntile > 0) { dma_k(wl, rsK, 0u, 128 * 2, kvo); DMA_WAIT(); read_k(kc, la); }
        for (int kt = 0; kt < ntile; ++kt) { const int key0 = 32 * kt;
            LDS_DRAIN();
            if (kt + 1 < ntile) dma_k(wl, rsK, (unsigned)(key0 + 32) * (128 * 2), 128 * 2, kvo);
            f32x16 s = qk32r(kc, qf);
            float mx = ATT_NEG;
#pragma unroll
            for (int reg = 0; reg < 16; ++reg) { const int ko = (reg & 3) + 8 * (reg >> 2) + 4 * hh; const float x = (key0 + ko < nv) ? s[reg] * ATT_C2 : ATT_NEG; s[reg] = x; mx = fmaxf(mx, x); }
            mx = xmax32(mx);
            const float mn = fmaxf(m, mx); float rs = 0.f;
#pragma unroll
            for (int reg = 0; reg < 16; ++reg) rs += (s[reg] > -1e29f) ? fexp2(s[reg] - mn) : 0.f;
            rs = xsum32(rs);
            l = l * fexp2(m - mn) + rs; m = mn;
            if (kt + 1 < ntile) { DMA_WAIT(); read_k(kc, la); } }
        const float rl = l > 0.f ? 1.f / l : 0.f;
        f32x16 o0 = zero16(), o1 = zero16();
        if (ntile > 0) { dma_k(wl, rsK, 0u, 128 * 2, kvo); dma_v(wl, rsV, 0u, VCT_LD * 2, vvo); DMA_WAIT(); read_k(kc, la); }
        for (int kt = 0; kt < ntile; ++kt) { const int key0 = 32 * kt;
            LDS_DRAIN(); if (kt + 1 < ntile) dma_k(wl, rsK, (unsigned)(key0 + 32) * (128 * 2), 128 * 2, kvo);
            read_v(vc, la);
            f32x16 s = qk32r(kc, qf);
            LDS_DRAIN_PINNED(); if (kt + 1 < ntile) dma_v(wl, rsV, (unsigned)(key0 + 32) * 2, VCT_LD * 2, vvo);
#pragma unroll
            for (int reg = 0; reg < 16; ++reg) { const int ko = (reg & 3) + 8 * (reg >> 2) + 4 * hh; s[reg] = (key0 + ko < nv) ? fexp2(s[reg] * ATT_C2 - m) * rl : 0.f; }
#pragma unroll
            for (int i = 0; i < 8; ++i) pb[i] = cvtpk(s[2 * i], s[2 * i + 1]);
            pv32r(o0, o1, vc, pb);
#pragma unroll
            for (int k = 0; k < 4; ++k) { float a = s[4 * k] + s[4 * k + 1] + s[4 * k + 2] + 0.5f * s[4 * k + 3], c = 0.5f * s[4 * k + 3];
                a += dpp_xor1(a); a += dpp_xor2(a); c += dpp_xor1(c); c += dpp_xor2(c);
                if (hg == 0) { const int j = (key0 >> 2) + 2 * k + hh; (void)__hip_atomic_fetch_add(imp + tl * IMP_LD + j, a, __ATOMIC_RELAXED, __HIP_MEMORY_SCOPE_WORKGROUP); (void)__hip_atomic_fetch_add(imp + tl * IMP_LD + j + 1, c, __ATOMIC_RELAXED, __HIP_MEMORY_SCOPE_WORKGROUP); } }
            if (kt + 1 < ntile) { DMA_WAIT(); read_k(kc, la); } }
        const float g0 = p.GATES[row * 24 + head * 3 + 0];
#pragma unroll
        for (int reg = 0; reg < 16; ++reg) { outacc[reg] = o0[reg] * g0; outacc[16 + reg] = o1[reg] * g0; }
    }
    for (int tk = 0; tk < 8; ++tk) { const int tt = t0 + tk, cur = tt >> 6; LAS float* row = imp + tk * IMP_LD;
        float v0 = (64 * lane > tt) ? -1.f : row[lane], v1 = (64 * (lane + 64) > tt) ? -1.f : row[lane + 64];
        if (lane == 0 || lane == cur || lane == cur - 1) v0 += 1e4f;
        if (lane + 64 == cur || lane + 64 == cur - 1) v1 += 1e4f;
        row[lane] = v0; row[lane + 64] = v1;
        int r0 = 0, r1 = 0;
        const int nq4 = min(32, ((cur >> 2) + 4) & ~3);
        if (cur >= 64) {
#pragma unroll 4
            for (int q4 = 0; q4 < nq4; ++q4) { const f32x4v w = *(const LAS f32x4v*)(row + 4 * q4);
#pragma unroll
                for (int e = 0; e < 4; ++e) { const int jj = 4 * q4 + e; const float x = w[e];
                    r0 += (x > v0 || (x == v0 && jj < lane)) ? 1 : 0; r1 += (x > v1 || (x == v1 && jj < lane + 64)) ? 1 : 0; } }
        } else {
#pragma unroll 4
            for (int q4 = 0; q4 < nq4; ++q4) { const f32x4v w = *(const LAS f32x4v*)(row + 4 * q4);
#pragma unroll
                for (int e = 0; e < 4; ++e) { const int jj = 4 * q4 + e; const float x = w[e];
                    r0 += (x > v0 || (x == v0 && jj < lane)) ? 1 : 0; } }
            r1 = 16; }
        const unsigned long long s0 = __ballot(r0 < 16), s1 = __ballot(r1 < 16);
        if (tl == tk) { m0 = s0; m1 = s1; } }
    {
        f32x16 o0 = zero16(), o1 = zero16(); float m = ATT_NEG, l = 0.f;
        const bf16* k0p = p.PROJ + (size_t)b * cS * PE_LD + 768 + g * 64;
        const bf16* v0p = VT + vt_tile_off(16, b, g, 0);
        const rsrc_t rsK = mkrsrc(k0p), rsV = mkrsrc(v0p); const unsigned kvo = kvoff(lane, PE_LD), vvo = vvoff(lane, 32);
        unsigned long long u0 = wave_or64(m0), u1 = wave_or64(m1);
        const int tmax = (t0 + 7) >> 5;
#define NSA_NEXT_TILE(tc) ({ int tt_ = (tc) + 1; if ((tt_ & 1) == 0) { const int j_ = tt_ >> 1; \
            const unsigned long long lo_ = j_ < 64 ? (u0 >> j_) : 0ull, hi_ = j_ < 64 ? u1 : (j_ < 128 ? (u1 >> (j_ - 64)) : 0ull); \
            tt_ = lo_ ? 2 * (j_ + __builtin_ctzll(lo_)) : (hi_ ? 2 * ((j_ < 64 ? 64 : j_) + __builtin_ctzll(hi_)) : 1 << 20); } tt_ <= tmax ? tt_ : -1; })
        int tn = NSA_NEXT_TILE(-1);
        KF kc; VF vc;
        if (tn >= 0) { dma_k(wl, rsK, (unsigned)(32 * tn) * (PE_LD * 2), PE_LD * 2, kvo); dma_v(wl, rsV, (unsigned)tn * 4096u, 64, vvo); DMA_WAIT(); read_k(kc, la); }
        while (tn >= 0 && 32 * tn + 31 <= t0) { const int tc = tn, key0 = 32 * tc, j = tc >> 1;
            tn = NSA_NEXT_TILE(tc);
            LDS_DRAIN(); if (tn >= 0) dma_k(wl, rsK, (unsigned)(32 * tn) * (PE_LD * 2), PE_LD * 2, kvo);
            read_v(vc, la);
            const bool selj = ((j < 64 ? m0 : m1) >> (j & 63)) & 1ull;
            f32x16 s = qk32r(kc, qf);
            LDS_DRAIN_PINNED(); if (tn >= 0) dma_v(wl, rsV, (unsigned)tn * 4096u, 64, vvo);
            sm_fast(s, kc, qf, selj, m, l, o0, o1, pb);
            pv32r(o0, o1, vc, pb);
            if (tn >= 0) { DMA_WAIT(); read_k(kc, la); } }
        while (tn >= 0) { const int tc = tn, key0 = 32 * tc, j = tc >> 1;
            tn = NSA_NEXT_TILE(tc);
            LDS_DRAIN(); if (tn >= 0) dma_k(wl, rsK, (unsigned)(32 * tn) * (PE_LD * 2), PE_LD * 2, kvo);
            read_v(vc, la);
            const bool selj = ((j < 64 ? m0 : m1) >> (j & 63)) & 1ull;
            f32x16 s = qk32r(kc, qf);
            LDS_DRAIN_PINNED(); if (tn >= 0) dma_v(wl, rsV, (unsigned)tn * 4096u, 64, vvo);
            sm_step(s, kc, qf, 0, selj ? t - key0 : -1, hh, m, l, o0, o1, pb);
            pv32r(o0, o1, vc, pb);
            if (tn >= 0) { DMA_WAIT(); read_k(kc, la); } }
        l = xsum32(l);
        const float sc = (l > 0.f ? 1.f / l : 0.f) * p.GATES[row * 24 + head * 3 + 1];
#pragma unroll
        for (int reg = 0; reg < 16; ++reg) { outacc[reg] += o0[reg] * sc; outacc[16 + reg] += o1[reg] * sc; }
    }
    {
        f32x16 o0 = zero16(), o1 = zero16(); float m = ATT_NEG, l = 0.f;
        const bf16* k0p = p.PROJ + (size_t)b * cS * PE_LD + 896 + g * 64;
        const bf16* v0p = VT + vt_tile_off(16, b, 2 + g, 0);
        const rsrc_t rsK = mkrsrc(k0p), rsV = mkrsrc(v0p); const unsigned kvo = kvoff(lane, PE_LD), vvo = vvoff(lane, 32);
        const int k_lo = t0 >= 511 ? (t0 - 511) >> 5 : 0, k_hi = (t0 + 7) >> 5;
        KF kc; VF vc;
        dma_k(wl, rsK, (unsigned)(32 * k_lo) * (PE_LD * 2), PE_LD * 2, kvo); dma_v(wl, rsV, (unsigned)k_lo * 4096u, 64, vvo); DMA_WAIT(); read_k(kc, la);
#define WIN_TILE(SM_) { const int key0 = 32 * kt; \
            LDS_DRAIN(); if (kt < k_hi) dma_k(wl, rsK, (unsigned)(key0 + 32) * (PE_LD * 2), PE_LD * 2, kvo); \
            read_v(vc, la); \
            f32x16 s = qk32r(kc, qf); \
            LDS_DRAIN_PINNED(); if (kt < k_hi) dma_v(wl, rsV, (unsigned)(kt + 1) * 4096u, 64, vvo); \
            SM_; \
            pv32r(o0, o1, vc, pb); \
            if (kt < k_hi) { DMA_WAIT(); read_k(kc, la); } }
        int kt = k_lo;
        for (; kt <= k_hi && 32 * kt < t0 + 7 - 511; ++kt) WIN_TILE(sm_step(s, kc, qf, t - 511 - key0, 31, hh, m, l, o0, o1, pb))
        for (; kt <= k_hi && 32 * kt + 31 <= t0; ++kt) WIN_TILE(sm_fast(s, kc, qf, true, m, l, o0, o1, pb))
        for (; kt <= k_hi; ++kt) WIN_TILE(sm_step(s, kc, qf, 0, t - key0, hh, m, l, o0, o1, pb))
#undef WIN_TILE
        l = xsum32(l);
        const float sc = (l > 0.f ? 1.f / l : 0.f) * p.GATES[row * 24 + head * 3 + 2];
#pragma unroll
        for (int reg = 0; reg < 16; ++reg) { outacc[reg] += o0[reg] * sc; outacc[16 + reg] += o1[reg] * sc; }
    }
    store_row64(p.ATT + (size_t)row * 768 + head * 64, hh, outacc, 1.f);
}

__device__ __forceinline__ void cmp1_unit(const P& p, const bf16* W1T, const float* PEB, int u, int lane) {
    const int r = lane & 31, hh = lane >> 5;
    const int ct = u & 7, rt = (u >> 3) & 127, which = u >> 10;
    const int NR = cB * cNC * 2;
    int i = rt * 32 + r; if (i >= NR) i = NR - 1;
    const int g = i & 1, n = (i >> 1) % cNC, b = (i >> 1) / cNC;
    const bf16* ap = p.PROJ + (size_t)(b * cS + 16 * n) * PE_LD + 512 + which * 128 + g * 64 + 8 * hh;
    const bf16* bp = W1T + ((size_t)which * 256 + ct * 32 + r) * 2048 + 8 * hh;
    f32x16 acc = zero16();
    for (int l = 0; l < 32; ++l) {
#pragma unroll
        for (int q = 0; q < 4; ++q) { const bf16x8v a = *(const bf16x8v*)(ap + (size_t)l * PE_LD + 16 * q), bb = *(const bf16x8v*)(bp + l * 64 + 16 * q);
            acc = __builtin_amdgcn_mfma_f32_32x32x16_bf16(a, bb, acc, 0, 0, 0); } }
    const int j = ct * 32 + r; const float bias = PEB[which * 256 + j];
#pragma unroll
    for (int reg = 0; reg < 16; ++reg) { const int io = rt * 32 + (reg & 3) + 8 * (reg >> 2) + 4 * hh;
        if (io < NR) p.HID[((size_t)which * NR + io) * 256 + j] = gelu_tanh(acc[reg] + bias); }
}
__device__ __forceinline__ void gates_unit(const P& p, const bf16* WGT, int u, int lane) {
    const int r = lane & 31, hh = lane >> 5;
    const bf16* ap = p.Y + (size_t)(u * 32 + r) * cDM + 8 * hh; const bf16* bp = WGT + (size_t)r * cDM + 8 * hh;
    f32x16 acc = zero16();
#pragma unroll 8
    for (int ks = 0; ks < cDM / 16; ++ks) { const bf16x8v a = *(const bf16x8v*)(ap + 16 * ks), bb = *(const bf16x8v*)(bp + 16 * ks);
        acc = __builtin_amdgcn_mfma_f32_32x32x16_bf16(a, bb, acc, 0, 0, 0); }
    if (r < 24) {
#pragma unroll
        for (int reg = 0; reg < 16; ++reg) { const int row = u * 32 + (reg & 3) + 8 * (reg >> 2) + 4 * hh; p.GATES[(size_t)row * 24 + r] = 1.f / (1.f + __expf(-acc[reg])); } }
}

__device__ __forceinline__ float xlo32(float x) { float y; asm volatile("v_mov_b32 %0, %1\n\ts_nop 1" : "=v"(y) : "v"(x));
    auto r = __builtin_amdgcn_permlane32_swap(__builtin_bit_cast(unsigned, x), __builtin_bit_cast(unsigned, y), false, false); const unsigned a = r[0]; return __builtin_bit_cast(float, a); }
template <bool DIAG>
__device__ __forceinline__ void sb_tile(const f32x16& z, const VF& vc, const bf16x8v (&TA)[2], int r, int hh, float& carry, f32x16& o0, f32x16& o1) {
    f32x16 l1; float lbv[16];
#pragma unroll
    for (int reg = 0; reg < 16; ++reg) { const int ko = (reg & 3) + 8 * (reg >> 2) + 4 * hh; float zr = z[reg]; OPQ(zr); const float zz = zr * 0.125f;
        const float e = fexp2(-fabsf(zz) * 1.4426950408889634f); const float sp = __builtin_amdgcn_logf(1.f + e) * 0.6931471805599453f;
        float lb = fminf(zz, 0.f) - sp; OPQ(lb); lbv[reg] = lb; float x = (!DIAG || ko < r) ? lb - zz : 0.f; OPQ(x); l1[reg] = x; }
    unsigned bh[8], bl[8];
#pragma unroll
    for (int i = 0; i < 8; ++i) { const float x0 = l1[2 * i], x1 = l1[2 * i + 1]; const unsigned hw = cvtpk(x0, x1); bh[i] = hw; float d0 = x0 - bflo(hw), d1 = x1 - bfhi(hw); OPQ(d0); OPQ(d1); bl[i] = cvtpk(d0, d1); }
    f32x16 af = zero16();
    typedef unsigned u32x4v __attribute__((ext_vector_type(4)));
#pragma unroll
    for (int s = 0; s < 2; ++s) { const u32x4v wh = {bh[4 * s], bh[4 * s + 1], bh[4 * s + 2], bh[4 * s + 3]}, wl = {bl[4 * s], bl[4 * s + 1], bl[4 * s + 2], bl[4 * s + 3]};
        af = __builtin_amdgcn_mfma_f32_32x32x16_bf16(TA[s], __builtin_bit_cast(bf16x8v, wh), af, 0, 0, 0);
        af = __builtin_amdgcn_mfma_f32_32x32x16_bf16(TA[s], __builtin_bit_cast(bf16x8v, wl), af, 0, 0, 0); }
    unsigned pb[8]; float av[16];
#pragma unroll
    for (int reg = 0; reg < 16; ++reg) { const int ko = (reg & 3) + 8 * (reg >> 2) + 4 * hh;
        float t = lbv[reg] + af[reg]; OPQ(t); av[reg] = (!DIAG || ko < r) ? fexp2((t + carry) * 1.4426950408889634f) : 0.f; }
#pragma unroll
    for (int i = 0; i < 8; ++i) pb[i] = cvtpk(av[2 * i], av[2 * i + 1]);
    pv32r(o0, o1, vc, pb);
    carry += xlo32(af[0] + l1[0]);
}
__device__ __forceinline__ void sb_unit(const P& p, const bf16* VT, LAS unsigned char* wl, int b, int h, int t0, int lane) {
    const int r = lane & 31, hh = lane >> 5; const long row = (long)b * cS + t0 + r; const LaneAddr la = lane_addr(wl, lane);
    bf16x8v qf[4];
    { const bf16* qp = p.PROJ + (size_t)row * PO_LD + h * 64 + 8 * hh;
#pragma unroll
      for (int ks = 0; ks < 4; ++ks) qf[ks] = *(const bf16x8v*)(qp + 16 * ks); }
    bf16x8v TA[2];
#pragma unroll
    for (int s = 0; s < 2; ++s)
#pragma unroll
        for (int j = 0; j < 8; ++j) { const int kk = 16 * s + 8 * (j >> 2) + 4 * hh + (j & 3); TA[s][j] = (short)(kk > r ? 0x3F80 : 0); }
    f32x16 o0 = zero16(), o1 = zero16(); float carry = 0.f;
    const bf16* k0p = p.PROJ + (size_t)b * cS * PO_LD + cDM + h * 64;
    const bf16* v0p = VT + vt_tile_off(16, b, h, 0);
    const rsrc_t rsK = mkrsrc(k0p), rsV = mkrsrc(v0p); const unsigned kvo = kvoff(lane, PO_LD), vvo = vvoff(lane, 32);
    KF kc; VF vc;
    dma_k(wl, rsK, (unsigned)t0 * (PO_LD * 2), PO_LD * 2, kvo); dma_v(wl, rsV, (unsigned)(t0 >> 5) * 4096u, 64, vvo); DMA_WAIT(); read_k(kc, la);
#define SB_TILE(DIAG_, key0_) do { LDS_DRAIN(); if ((key0_) > 0) dma_k(wl, rsK, (unsigned)((key0_) - 32) * (PO_LD * 2), PO_LD * 2, kvo); \
        read_v(vc, la); const f32x16 z_ = qk32r(kc, qf); \
        LDS_DRAIN_PINNED(); if ((key0_) > 0) dma_v(wl, rsV, (unsigned)(((key0_) - 32) >> 5) * 4096u, 64, vvo); \
        sb_tile<DIAG_>(z_, vc, TA, r, hh, carry, o0, o1); } while (0)
    int kt = t0 >> 5;
    SB_TILE(true, t0);
    for (--kt; kt >= 0; --kt) { const int key0 = 32 * kt;
        DMA_WAIT(); read_k(kc, la);
        SB_TILE(false, key0);
        if (__all(carry < -93.f)) break; }
#undef SB_TILE
    DMA_WAIT();
    { float ov[32];
#pragma unroll
      for (int reg = 0; reg < 16; ++reg) { ov[reg] = o0[reg]; ov[16 + reg] = o1[reg]; }
      store_row64(p.ATT + (size_t)row * cDM + h * 64, hh, ov, 1.f); }
}

template <int G>
__device__ __forceinline__ void dil_unit(const P& p, const bf16* VT, const bf16* VTP, bf16* DOUT, float* DLSE, LAS unsigned char* wl, int b, int hd, int rc, int tile, int lane) {
    constexpr int dil = G == 0 ? 1 : G == 1 ? 4 : 16; constexpr int slot0 = 4 * G;
    const int r = lane & 31, hh = lane >> 5, slot = slot0 + hd; const LaneAddr la = lane_addr(wl, lane);
    const long row = (long)b * cS + rc + (long)dil * (32 * tile + r);
    bf16x8v qf[4];
    { const bf16* qp = p.PROJ + (size_t)row * PE_LD + 1024 + slot * 64 + 8 * hh;
#pragma unroll
      for (int ks = 0; ks < 4; ++ks) qf[ks] = *(const bf16x8v*)(qp + 16 * ks); }
    f32x16 o0 = zero16(), o1 = zero16(); float m = ATT_NEG, l = 0.f; unsigned pb[8];
    const bf16* k0p = p.PROJ + ((size_t)b * cS + rc) * PE_LD + 1792 + slot * 64;
    const bf16* v0p = G == 0 ? VT + vt_tile_off(16, b, 4 + slot, 0)
                             : VTP + vt_tile_off(8, b, (G - 1) * 4 + hd, rc * (cS / dil / 32));
    const rsrc_t rsK = mkrsrc(k0p), rsV = mkrsrc(v0p); const unsigned kvo = kvoff(lane, (size_t)dil * PE_LD), vvo = vvoff(lane, 32);
    const int k_lo = tile >= 4 ? tile - 4 : 0;
    KF kc; VF vc;
    dma_k(wl, rsK, (unsigned)(32 * k_lo) * (dil * PE_LD * 2), dil * PE_LD * 2, kvo); dma_v(wl, rsV, (unsigned)k_lo * 4096u, 64, vvo); DMA_WAIT(); read_k(kc, la);
    for (int kt = k_lo; kt <= tile; ++kt) { const int D0 = 32 * (tile - kt);
        LDS_DRAIN(); if (kt < tile) dma_k(wl, rsK, (unsigned)(32 * kt + 32) * (dil * PE_LD * 2), dil * PE_LD * 2, kvo);
        read_v(vc, la);
        f32x16 s = qk32r(kc, qf);
        LDS_DRAIN_PINNED(); if (kt < tile) dma_v(wl, rsV, (unsigned)(kt + 1) * 4096u, 64, vvo);
        if (D0 >= 32 && D0 <= 96) sm_fast(s, kc, qf, true, m, l, o0, o1, pb);
        else sm_step(s, kc, qf, D0 + r - 128, D0 + r, hh, m, l, o0, o1, pb);
        pv32r(o0, o1, vc, pb);
        if (kt < tile) { DMA_WAIT(); read_k(kc, la); } }
    l = xsum32(l);
    const float rl = 1.f / l;
    { float ov[32];
#pragma unroll
      for (int reg = 0; reg < 16; ++reg) { ov[reg] = o0[reg]; ov[16 + reg] = o1[reg]; }
      store_row64(DOUT + ((size_t)G * cM + row) * 256 + hd * 64, hh, ov, rl); }
    if (hh == 0) DLSE[((size_t)G * cM + row) * 4 + hd] = m + __builtin_amdgcn_logf(l);
}
namespace pg8 {
#define PG8_LAS __attribute__((address_space(3)))
typedef unsigned short bf16_t;
typedef short bf16x8 __attribute__((ext_vector_type(8)));
typedef float f32x4 __attribute__((ext_vector_type(4)));
typedef unsigned u32x4 __attribute__((ext_vector_type(4)));
constexpr int BM = 256, BK = 64, HALF = 128, HTB = HALF * BK * 2  , STAGE_BYTES = 8 * HTB, NXCD = 8, WGM = 8;

__host__ __device__ __forceinline__ int lds_byte(int r, int c) { const int st = (r >> 4) * 2 + (c >> 5), rr = r & 15, cc = c & 31, ob = rr * 64 + cc * 2; return st * 1024 + (ob ^ (((ob >> 9) & 1) << 5)); }
__host__ __device__ __forceinline__ void stage_rc(int b, int& R, int& C) { const int st = b / 1024, sb = b % 1024, swz = sb ^ (((sb >> 9) & 1) << 5); R = (st >> 1) * 16 + swz / 64; C = (st & 1) * 32 + (swz % 64) / 2; }
__host__ __device__ __forceinline__ int perm32(int rho) { const int n = rho >> 4, i = rho & 15; return 8 * (i >> 2) + 4 * n + (i & 3); }

struct Unit { int pm, pn; };
struct Gemm { const bf16_t* A; const bf16_t* Bt; int M, N, K; };

struct StaticOrder {
    int nM, nN, nwg, G, c;
    __host__ __device__ void init(int M, int N, int G_, int c_) { nM = M / BM; nN = N / BM; nwg = nM * nN; G = G_; c = c_; }
    __host__ __device__ bool next(int i, Unit& u) const {
        const long L = (long)i * G + c; if (L >= nwg) return false;
        int wgid = (int)L; { const int q = nwg / NXCD, r = nwg % NXCD, xcd = wgid % NXCD, off = wgid / NXCD; wgid = (xcd < r ? xcd * (q + 1) : r * (q + 1) + (xcd - r) * q) + off; }
        const int nig = WGM * nN, gid = wgid / nig, fm = gid * WGM, gsz = (nM - fm) < WGM ? (nM - fm) : WGM;
        u.pm = fm + ((wgid % nig) % gsz); u.pn = (wgid % nig) / gsz; return true;
    }
    __device__ __forceinline__ void a_ready(const Unit&) const {}
    __device__ __forceinline__ void done(const Unit&) const {}
};

__device__ __forceinline__ unsigned cvt_pk_bf16(float lo, float hi) { unsigned r; asm volatile("v_cvt_pk_bf16_f32 %0, %1, %2" : "=v"(r) : "v"(lo), "v"(hi)); return r; }
typedef float f32x2 __attribute__((ext_vector_type(2)));
__device__ __forceinline__ f32x2 gelu_pk(f32x2 v) {
    const f32x2 av = __builtin_elementwise_abs(v), d = av * 0.2316418882f + 1.0f;
    f32x2 t; t.x = __builtin_amdgcn_rcpf(d.x); t.y = __builtin_amdgcn_rcpf(d.y);
    f32x2 q = t * 0.5307027145f + (-0.7265760135f); q = q * t + 0.7107068705f; q = q * t + (-0.142248368f); q = q * t + 0.127414796f; q = q * t;
    const f32x2 s = (v * v) * (-0.72134752044f);
    f32x2 e; e.x = __builtin_amdgcn_exp2f(s.x); e.y = __builtin_amdgcn_exp2f(s.y);
    const f32x2 m = v * (q * e), r = v - m;
    f32x2 o; o.x = v.x < 0.f ? m.x : r.x; o.y = v.y < 0.f ? m.y : r.y; return o;
}

template <int ACT  > struct EpiBf16 {
    static constexpr bool PERM = true, AFTER_DRAIN = false, TABLE = false; static_assert(ACT == 0 || ACT == 1, "EpiBf16: ACT is 0 (none) or 1 (gelu_pk)");
    bf16_t* O; int ldc; const float* bias; int split_cols; size_t split_stride; float scale0;
    __device__ __forceinline__ void operator()(const f32x4 (&acc)[2][2][4][2], const Unit& u, int wr, int wc, int fr, int fq) const {
        const int row0 = u.pm * BM + wr * 64 + fr; int colt = u.pn * BM; bf16_t* base = O;
        float sc = 1.f; if (split_cols) { const int t = colt / split_cols; base += (size_t)t * split_stride; colt -= t * split_cols; if (t == 0) sc = scale0; }
        const int col0 = colt + wc * 32 + 8 * fq, bcol0 = u.pn * BM + wc * 32 + 8 * fq;
        f32x4 bv[2][2];
#pragma unroll
        for (int bj = 0; bj < 2; ++bj)
#pragma unroll
            for (int n = 0; n < 2; ++n) bv[bj][n] = bias ? *(const f32x4*)(bias + bcol0 + bj * HALF + 4 * n) : (f32x4){0.f, 0.f, 0.f, 0.f};
#pragma unroll
        for (int ai = 0; ai < 2; ++ai)
#pragma unroll
            for (int m = 0; m < 4; ++m) { bf16_t* rowp = base + (size_t)(row0 + ai * HALF + m * 16) * ldc + col0;
#pragma unroll
                for (int bj = 0; bj < 2; ++bj) { f32x4 v0 = acc[ai][bj][m][0] + bv[bj][0], v1 = acc[ai][bj][m][1] + bv[bj][1];
                    if (ACT == 1) { f32x2 a = gelu_pk((f32x2){v0[0], v0[1]}), b = gelu_pk((f32x2){v0[2], v0[3]}), c = gelu_pk((f32x2){v1[0], v1[1]}), d = gelu_pk((f32x2){v1[2], v1[3]});
                        v0 = (f32x4){a.x, a.y, b.x, b.y}; v1 = (f32x4){c.x, c.y, d.x, d.y}; }
                    v0 = v0 * sc; v1 = v1 * sc; u32x4 w; w.x = cvt_pk_bf16(v0[0], v0[1]); w.y = cvt_pk_bf16(v0[2], v0[3]); w.z = cvt_pk_bf16(v1[0], v1[1]); w.w = cvt_pk_bf16(v1[2], v1[3]);
                    *(u32x4*)(rowp + bj * HALF) = w; } }
    }
};
template <class Epi, class Sched, bool ALIGN_EPI = false, bool SP2 = false>
__device__ __forceinline__ void gemm_phase(PG8_LAS unsigned char* lds, const Gemm g, const Sched& S, const Epi& E) {
    int tid_ = threadIdx.x; asm volatile("" : "+v"(tid_));
    const int tid = tid_, wid = __builtin_amdgcn_readfirstlane(tid >> 6), lane = tid & 63, wr = wid >> 2, wc = wid & 3, fr = lane & 15, fq = lane >> 4;
    const int K = g.K, nt = K / BK;
    unsigned voffA[2], voffB[2];
#pragma unroll
    for (int i = 0; i < 2; ++i) { int R, C; stage_rc(tid * 16 + i * 8192, R, C); const int Rb = Epi::PERM ? ((R & ~31) + perm32(R & 31)) : R;
        voffA[i] = (unsigned)(R * K + C) * 2u; voffB[i] = (unsigned)(Rb * K + C) * 2u; }
    const size_t kstep = (size_t)(BK * 2);
    const size_t hstep = (size_t)HALF * K * 2;
    const size_t tstep = 2 * hstep;
    const unsigned ldsw = (unsigned)wid * 1024u;
    const int aoff = lds_byte(wr * 64 + fr, fq * 8), boff = lds_byte(wc * 32 + fr, fq * 8);
#define PG8_SA(b, h) (((b) * 2 + (h)) * HTB)
#define PG8_SB(b, h) ((4 + (b) * 2 + (h)) * HTB)
#define PG8_STAGE(bufoff, gbase, voff) do { _Pragma("unroll") for (int _i = 0; _i < 2; ++_i) \
        __builtin_amdgcn_global_load_lds((const unsigned*)((const char*)(gbase) + (voff)[_i]), (PG8_LAS unsigned*)(lds + (bufoff) + ldsw + _i * 8192), 16, 0, 0); } while (0)
#define PG8_LDA(dst, b, h) do { _Pragma("unroll") for (int m = 0; m < 4; ++m) _Pragma("unroll") for (int k = 0; k < 2; ++k) dst[m][k] = *(const PG8_LAS bf16x8*)(lds + PG8_SA(b, h) + aoff + m * 2048 + k * 1024); } while (0)
#define PG8_LDB(dst, b, h) do { _Pragma("unroll") for (int n = 0; n < 2; ++n) _Pragma("unroll") for (int k = 0; k < 2; ++k) dst[n][k] = *(const PG8_LAS bf16x8*)(lds + PG8_SB(b, h) + boff + n * 2048 + k * 1024); } while (0)
#define PG8_MMA(ai, bj, At, Bt) do { __builtin_amdgcn_s_setprio(1); _Pragma("unroll") for (int m = 0; m < 4; ++m) _Pragma("unroll") for (int n = 0; n < 2; ++n) _Pragma("unroll") for (int k = 0; k < 2; ++k) \
        acc[ai][bj][m][n] = __builtin_amdgcn_mfma_f32_16x16x32_bf16(Bt[n][k], At[m][k], acc[ai][bj][m][n], 0, 0, 0); __builtin_amdgcn_s_setprio(0); } while (0)
#define PG8_WAIT_V(n) asm volatile("s_waitcnt vmcnt(" #n ")" ::: "memory")
#define PG8_WAIT_L(n) asm volatile("s_waitcnt lgkmcnt(" #n ")" ::: "memory")
#define PG8_BAR __builtin_amdgcn_s_barrier()
#define PG8_SCHED __builtin_amdgcn_sched_barrier(0)
    Unit cur, nxt; int ui = 0;
    if (!S.next(0, cur)) return;
    f32x4 acc[2][2][4][2];
#pragma unroll
    for (int a = 0; a < 2; ++a)
#pragma unroll
        for (int b = 0; b < 2; ++b)
#pragma unroll
            for (int m = 0; m < 4; ++m)
#pragma unroll
                for (int n = 0; n < 2; ++n) acc[a][b][m][n] = (f32x4){0.f, 0.f, 0.f, 0.f};
    bf16x8 At[4][2], B0[2][2], B1[2][2];
    const char* cA = (const char*)g.A + (size_t)cur.pm * tstep; const char* cB = (const char*)g.Bt + (size_t)cur.pn * tstep;
    S.a_ready(cur);
    if constexpr (SP2) {
        PG8_STAGE(PG8_SB(0, 0), cB, voffB); PG8_STAGE(PG8_SB(0, 1), cB + hstep, voffB); PG8_STAGE(PG8_SA(0, 0), cA, voffA); PG8_STAGE(PG8_SA(0, 1), cA + hstep, voffA);
        if (wr == 1) PG8_BAR;
        PG8_WAIT_V(2); PG8_BAR;
        PG8_STAGE(PG8_SB(1, 0), cB + kstep, voffB); PG8_STAGE(PG8_SA(1, 0), cA + kstep, voffA); PG8_STAGE(PG8_SB(1, 1), cB + hstep + kstep, voffB);
        PG8_WAIT_V(6); PG8_BAR;
    } else {
        PG8_STAGE(PG8_SB(0, 0), cB, voffB); PG8_STAGE(PG8_SA(0, 0), cA, voffA); PG8_STAGE(PG8_SB(0, 1), cB + hstep, voffB); PG8_STAGE(PG8_SA(0, 1), cA + hstep, voffA);
        if (wr == 1) PG8_BAR;
        PG8_WAIT_V(4); PG8_BAR;
        PG8_STAGE(PG8_SB(1, 0), cB + kstep, voffB); PG8_STAGE(PG8_SA(1, 0), cA + kstep, voffA); PG8_STAGE(PG8_SB(1, 1), cB + hstep + kstep, voffB);
        PG8_WAIT_V(6); PG8_BAR;
    }
    for (;;) {
        const bool has_next = S.next(ui + 1, nxt);
        if constexpr (Epi::TABLE) { if (tid < 256) E.stage_table(cur, lds + 131072 + (ui & 1) * 4096, tid); }
        const char* nA = has_next ? (const char*)g.A + (size_t)nxt.pm * tstep : cA; const char* nB = has_next ? (const char*)g.Bt + (size_t)nxt.pn * tstep : cB;
        for (int t = 0; t < nt; t += 2) {
            const bool last = (t == nt - 2);
            const char* a1 = cA + (size_t)(t + 1) * kstep;
            const char* a2 = last ? nA : cA + (size_t)(t + 2) * kstep; const char* b2 = last ? nB : cB + (size_t)(t + 2) * kstep;
            const char* a3 = a2 + kstep; const char* b3 = b2 + kstep;
            if (last && has_next) S.a_ready(nxt);
            if constexpr (SP2) {
            PG8_LDB(B0, 0, 0); PG8_LDB(B1, 0, 1); PG8_SCHED; PG8_LDA(At, 0, 0); PG8_STAGE(PG8_SA(1, 1), a1 + hstep, voffA);
            PG8_WAIT_V(8); PG8_WAIT_L(0); PG8_BAR; PG8_MMA(0, 0, At, B0); PG8_MMA(0, 1, At, B1); PG8_BAR; PG8_SCHED;
            PG8_LDA(At, 0, 1); PG8_STAGE(PG8_SB(0, 0), b2, voffB); PG8_STAGE(PG8_SB(0, 1), b2 + hstep, voffB); PG8_STAGE(PG8_SA(0, 0), a2, voffA);
            PG8_WAIT_V(8); PG8_WAIT_L(0); PG8_BAR; PG8_MMA(1, 0, At, B0); PG8_MMA(1, 1, At, B1); PG8_BAR; PG8_SCHED;
            PG8_LDB(B0, 1, 0); PG8_LDB(B1, 1, 1); PG8_SCHED; PG8_LDA(At, 1, 0); PG8_STAGE(PG8_SA(0, 1), a2 + hstep, voffA);
            PG8_WAIT_V(8); PG8_WAIT_L(0); PG8_BAR; PG8_MMA(0, 0, At, B0); PG8_MMA(0, 1, At, B1); PG8_BAR; PG8_SCHED;
            PG8_LDA(At, 1, 1); PG8_STAGE(PG8_SB(1, 0), b3, voffB); PG8_STAGE(PG8_SB(1, 1), b3 + hstep, voffB); PG8_STAGE(PG8_SA(1, 0), a3, voffA);
            PG8_WAIT_V(8); PG8_WAIT_L(0); PG8_BAR; PG8_MMA(1, 0, At, B0); PG8_MMA(1, 1, At, B1); PG8_BAR; PG8_SCHED;
            } else {
            PG8_LDB(B0, 0, 0); PG8_SCHED; PG8_LDA(At, 0, 0); PG8_STAGE(PG8_SA(1, 1), a1 + hstep, voffA);
            PG8_WAIT_L(8); PG8_BAR; PG8_WAIT_L(0); PG8_MMA(0, 0, At, B0); PG8_BAR; PG8_SCHED;
            PG8_LDB(B1, 0, 1); PG8_STAGE(PG8_SB(0, 0), b2, voffB);
            PG8_BAR; PG8_WAIT_L(0); PG8_MMA(0, 1, At, B1); PG8_BAR;
            PG8_LDA(At, 0, 1); PG8_STAGE(PG8_SA(0, 0), a2, voffA);
            PG8_BAR; PG8_WAIT_L(0); PG8_MMA(1, 0, At, B0); PG8_BAR; PG8_SCHED;
            PG8_STAGE(PG8_SB(0, 1), b2 + hstep, voffB);
            PG8_WAIT_V(6); PG8_BAR; PG8_MMA(1, 1, At, B1); PG8_BAR;
            PG8_LDB(B0, 1, 0); PG8_SCHED; PG8_LDA(At, 1, 0); PG8_STAGE(PG8_SA(0, 1), a2 + hstep, voffA);
            PG8_WAIT_L(8); PG8_BAR; PG8_WAIT_L(0); PG8_MMA(0, 0, At, B0); PG8_BAR; PG8_SCHED;
            PG8_LDB(B1, 1, 1); PG8_STAGE(PG8_SB(1, 0), b3, voffB);
            PG8_BAR; PG8_WAIT_L(0); PG8_MMA(0, 1, At, B1); PG8_BAR;
            PG8_LDA(At, 1, 1); PG8_STAGE(PG8_SA(1, 0), a3, voffA);
            PG8_BAR; PG8_WAIT_L(0); PG8_MMA(1, 0, At, B0); PG8_BAR; PG8_SCHED;
            PG8_STAGE(PG8_SB(1, 1), b3 + hstep, voffB);
            PG8_WAIT_V(6); PG8_BAR; PG8_MMA(1, 1, At, B1); PG8_BAR;
            }
        }
        if constexpr (ALIGN_EPI) { if (wr == 0) PG8_BAR; }
        if constexpr (!Epi::AFTER_DRAIN) { if constexpr (Epi::TABLE) E.run(acc, cur, wr, wc, fr, fq, lds + 131072 + (ui & 1) * 4096); else E(acc, cur, wr, wc, fr, fq); S.done(cur); }
        if (!has_next) break;
#pragma unroll
        for (int a = 0; a < 2; ++a)
#pragma unroll
            for (int b = 0; b < 2; ++b)
#pragma unroll
                for (int m = 0; m < 4; ++m)
#pragma unroll
                    for (int n = 0; n < 2; ++n) acc[a][b][m][n] = (f32x4){0.f, 0.f, 0.f, 0.f};
        cur = nxt; cA = nA; cB = nB; ++ui;
        if constexpr (ALIGN_EPI) { if (wr == 1) PG8_BAR; }
    }
    PG8_WAIT_V(0);
    if constexpr (!ALIGN_EPI) { if (wr == 0) PG8_BAR; }
    PG8_BAR;
    if constexpr (Epi::AFTER_DRAIN) { E.fused(acc, cur, wr, wc, fr, fq, lds, wid, lane); S.done(cur); }
#undef PG8_SA
#undef PG8_SB
#undef PG8_STAGE
#undef PG8_LDA
#undef PG8_LDB
#undef PG8_MMA
#undef PG8_WAIT_V
#undef PG8_WAIT_L
#undef PG8_BAR
#undef PG8_SCHED
}
}
namespace pg8 {
struct EpiRopeE {
    static constexpr bool PERM = true, AFTER_DRAIN = false, TABLE = false;
    bf16_t* O; int ldc; const float* rope;
    __device__ __forceinline__ void operator()(const f32x4 (&acc)[2][2][4][2], const Unit& u, int wr, int wc, int fr, int fq) const {
        const int row0 = u.pm * BM + wr * 64 + fr;
        if (u.pn == 2) {
            const int col0 = u.pn * BM + wc * 32 + 8 * fq;
#pragma unroll
            for (int ai = 0; ai < 2; ++ai)
#pragma unroll
                for (int m = 0; m < 4; ++m) { bf16_t* rowp = O + (size_t)(row0 + ai * HALF + m * 16) * ldc + col0;
#pragma unroll
                    for (int bj = 0; bj < 2; ++bj) { const f32x4 v0 = acc[ai][bj][m][0], v1 = acc[ai][bj][m][1]; u32x4 w;
                        w.x = cvt_pk_bf16(v0[0], v0[1]); w.y = cvt_pk_bf16(v0[2], v0[3]); w.z = cvt_pk_bf16(v1[0], v1[1]); w.w = cvt_pk_bf16(v1[2], v1[3]); *(u32x4*)(rowp + bj * HALF) = w; } }
        } else {
            const int kk = 4 * (wc & 1) + fq;
#pragma unroll
            for (int ai = 0; ai < 2; ++ai)
#pragma unroll
                for (int m = 0; m < 4; ++m) { const int row = row0 + ai * HALF + m * 16, pos = row & (cS - 1);
                    const f32x4 c0 = *(const f32x4*)(rope + (size_t)(pos * 32 + 4 * kk) * 2), c1 = *(const f32x4*)(rope + (size_t)(pos * 32 + 4 * kk) * 2 + 4);
#pragma unroll
                    for (int bj = 0; bj < 2; ++bj) { const f32x4 x1 = acc[ai][bj][m][0], x2 = acc[ai][bj][m][1];
                        bf16_t* op = O + (size_t)row * ldc + u.pn * BM + (2 * bj + (wc >> 1)) * 64 + 4 * kk;
                        const unsigned ax = cvt_pk_bf16(x1[0] * c0[0] - x2[0] * c0[1], x1[1] * c0[2] - x2[1] * c0[3]), ay = cvt_pk_bf16(x1[2] * c1[0] - x2[2] * c1[1], x1[3] * c1[2] - x2[3] * c1[3]);
                        const unsigned bx = cvt_pk_bf16(x2[0] * c0[0] + x1[0] * c0[1], x2[1] * c0[2] + x1[1] * c0[3]), by = cvt_pk_bf16(x2[2] * c1[0] + x1[2] * c1[1], x2[3] * c1[2] + x1[3] * c1[3]);
                        auto rx = __builtin_amdgcn_permlane16_swap(ax, bx, false, false); auto ry = __builtin_amdgcn_permlane16_swap(ay, by, false, false);
                        u32x4 w; w.x = rx[0]; w.y = ry[0]; w.z = rx[1]; w.w = ry[1];
                        *(u32x4*)((fq & 1) ? op + 32 - 4 : op) = w; } }
        }
    }
};
struct EpiVT {
    static constexpr bool PERM = true, AFTER_DRAIN = false, TABLE = false;
    bf16_t* O;
    __device__ __forceinline__ void operator()(const f32x4 (&acc)[2][2][4][2], const Unit& u, int wr, int wc, int fr, int fq) const {
        const int row0 = u.pm * BM + wr * 64 + fr, col0 = u.pn * BM + wc * 32 + 8 * fq;
#pragma unroll
        for (int ai = 0; ai < 2; ++ai)
#pragma unroll
            for (int m = 0; m < 4; ++m) { const int dg = row0 + ai * HALF + m * 16;
#pragma unroll
                for (int bj = 0; bj < 2; ++bj) { const int col = col0 + bj * HALF, b = col / cS, tk = col & (cS - 1);
                    const f32x4 v0 = acc[ai][bj][m][0], v1 = acc[ai][bj][m][1]; u32x4 w;
                    w.x = cvt_pk_bf16(v0[0], v0[1]); w.y = cvt_pk_bf16(v0[2], v0[3]); w.z = cvt_pk_bf16(v1[0], v1[1]); w.w = cvt_pk_bf16(v1[2], v1[3]);
                    *(u32x4*)(O + vt_elem_off(16, b, dg, tk)) = w; } }
    }
};
__device__ __forceinline__ float ror1f(float x) { return __builtin_bit_cast(float, __builtin_amdgcn_mov_dpp(__builtin_bit_cast(int, x), 0x121, 0xF, 0xF, false)); }
__device__ __forceinline__ float ror2f(float x) { return __builtin_bit_cast(float, __builtin_amdgcn_mov_dpp(__builtin_bit_cast(int, x), 0x122, 0xF, 0xF, false)); }
__device__ __forceinline__ float gelu_fast(float x) { const float w = __builtin_fmaf(x * x, -2.3022081981f * 0.044715f, -2.3022081981f); return x * __builtin_amdgcn_rcpf(1.f + __builtin_amdgcn_exp2f(x * w)); }
struct EpiConvGelu {
    static constexpr bool PERM = true, AFTER_DRAIN = false, TABLE = true;
    bf16_t* ACT; const float* cw; const float* cb; float* SB;
    __device__ __forceinline__ void stage_table(const Unit& u, PG8_LAS unsigned char* tab, int tid) const {
        constexpr int LD2 = 2 * cDFF; const int v = tid >> 5, c4 = tid & 31, j = u.pn * 128 + 4 * c4;
        const float* src = ((v & 3) == 3 ? cb : cw + (v & 3) * LD2) + (v >> 2) * cDFF + j;
        *(PG8_LAS f32x4*)(tab + (v * 128 + 4 * c4) * 4) = *(const f32x4*)src; }
    __device__ __forceinline__ void run(const f32x4 (&acc)[2][2][4][2], const Unit& u, int wr, int wc, int fr, int fq, const PG8_LAS unsigned char* tab) const {
        constexpr int LD2 = 2 * cDFF;
        typedef unsigned u32x2 __attribute__((ext_vector_type(2)));
        u32x2 hold[2][4];
#pragma unroll
        for (int n = 0; n < 2; ++n) {
            const int ch0 = wc * 32 + 8 * fq + 4 * n, j0 = u.pn * 128 + ch0;
            const PG8_LAS f32x4* tv = (const PG8_LAS f32x4*)(tab + ch0 * 4);
            const f32x4 w0g = tv[0], w1g = tv[32], w2g = tv[64], bg = tv[96], w0v = tv[128], w1v = tv[160], w2v = tv[192], bv = tv[224];
#pragma unroll
            for (int ai = 0; ai < 2; ++ai) { const int rb = u.pm * BM + ai * HALF + wr * 64, blk = rb >> 6;
                f32x4 pg1, pg2, pv1, pv2;
#pragma unroll
                for (int m = 0; m < 4; ++m) { const f32x4 g = acc[ai][0][m][n], v = acc[ai][1][m][n]; const int row = rb + 16 * m + fr;
                    f32x4 g1, g2, v1, v2;
#pragma unroll
                    for (int e = 0; e < 4; ++e) { g1[e] = ror1f(g[e]); g2[e] = ror2f(g[e]); v1[e] = ror1f(v[e]); v2[e] = ror2f(v[e]); }
                    f32x4 a1g = g1, a2g = g2, a1v = v1, a2v = v2;
                    if (m > 0) { if (fr < 1) { a1g = pg1; a1v = pv1; } if (fr < 2) { a2g = pg2; a2v = pv2; } }
                    pg1 = g1; pg2 = g2; pv1 = v1; pv2 = v2;
                    if (m > 0 || fr >= 2) { float o[4];
#pragma unroll
                        for (int e = 0; e < 4; ++e) { const float cg = bg[e] + w0g[e] * a2g[e] + w1g[e] * a1g[e] + w2g[e] * g[e], cv = bv[e] + w0v[e] * a2v[e] + w1v[e] * a1v[e] + w2v[e] * v[e]; o[e] = gelu_fast(cg) * cv; }
                        u32x2 w; w.x = cvt_pk_bf16(o[0], o[1]); w.y = cvt_pk_bf16(o[2], o[3]);
                        if (n == 0) hold[ai][m] = w; else { u32x4 q; q.x = hold[ai][m].x; q.y = hold[ai][m].y; q.z = w.x; q.w = w.y; *(u32x4*)(ACT + (size_t)row * cDFF + j0 - 4) = q; } }
                    if (m == 0 && fr < 2) { float* sp = SB + ((size_t)blk * 4 + fr) * LD2; *(f32x4*)(sp + j0) = g; *(f32x4*)(sp + cDFF + j0) = v; }
                    if (m == 3 && fr >= 14) { float* sp = SB + ((size_t)blk * 4 + 2 + (fr - 14)) * LD2; *(f32x4*)(sp + j0) = g; *(f32x4*)(sp + cDFF + j0) = v; }
                } }
        }
    }
};
}
#define XB_TMO      128
#define XB_XCNT(j)  (256  + 64 * (j))
#define XB_XSUB(j)  (1280 + 64 * (j))
#define XB_XGEN(j)  (2304 + 64 * (j))
#define XB_TOP      3328
#define XB_TOPGEN   3392
#define XCD_BAR_WORDS 3456
#define XB_SPIN_CAP (1u << 18)

__device__ __forceinline__ unsigned xb_ld(unsigned* p)              { return __hip_atomic_load(p, __ATOMIC_RELAXED, __HIP_MEMORY_SCOPE_AGENT); }
__device__ __forceinline__ unsigned xb_add(unsigned* p, unsigned v) { return __hip_atomic_fetch_add(p, v, __ATOMIC_RELAXED, __HIP_MEMORY_SCOPE_AGENT); }
__device__ __forceinline__ unsigned xb_xcc_id() { return (unsigned)__builtin_amdgcn_s_getreg((3 << 11) | 20) & 0xFu; }
#define XB_SPIN(cond, bar) do { unsigned _sp = 0; while (cond) { __builtin_amdgcn_s_sleep(1); \
    if ((++_sp & 255u) == 0u) { if (xb_ld(&(bar)[XB_TMO])) break; if (_sp > XB_SPIN_CAP) { atomicAdd(&(bar)[XB_TMO], 1u); break; } } } } while (0)

struct XcdBarrier {
    unsigned* bar; unsigned x;
    volatile LAS unsigned* st;
};

__device__ __forceinline__ XcdBarrier xcd_barrier_post(unsigned* bar, volatile LAS unsigned* st) {
    XcdBarrier b; b.bar = bar; b.x = xb_xcc_id(); b.st = st;
    if (threadIdx.x == 0) (void)xb_add(&bar[XB_XCNT(b.x)], 1u);
    return b;
}
__device__ __forceinline__ void xcd_barrier_complete(unsigned* bar, unsigned x, unsigned& nloc, unsigned& nx) {
    const unsigned G = gridDim.x * gridDim.y * gridDim.z;
    unsigned sum, cnt, mine, sp = 0u;
    for (;;) {
        sum = 0u; cnt = 0u; mine = 0u;
#pragma unroll
        for (unsigned j = 0; j < 16; ++j) { const unsigned c = xb_ld(&bar[XB_XCNT(j)]); sum += c; cnt += (c > 0u) ? 1u : 0u; mine = (j == x) ? c : mine; }
        if (sum == G) break;
        __builtin_amdgcn_s_sleep(1);
        if ((++sp & 255u) == 0u) { if (xb_ld(&bar[XB_TMO])) break; if (sp > XB_SPIN_CAP) { atomicAdd(&bar[XB_TMO], 1u); break; } }
    }
    nloc = mine > 0u ? mine : 1u; nx = cnt > 0u ? cnt : 1u;
}

__device__ __forceinline__ void xcd_barrier(const XcdBarrier& b) {
    asm volatile("s_waitcnt vmcnt(0)" ::: "memory");
    __syncthreads();
    if (threadIdx.x == 0) {
        unsigned* bar = b.bar;
        __builtin_amdgcn_s_waitcnt(0);
        unsigned nloc = b.st[0], nx = b.st[1];
        if (nloc == 0u) { xcd_barrier_complete(bar, b.x, nloc, nx); b.st[0] = nloc; b.st[1] = nx; }
        const unsigned old = xb_add(&bar[XB_XSUB(b.x)], 1u);
        const unsigned gen = old / nloc;
        if (old + 1u == (gen + 1u) * nloc) {
            __builtin_amdgcn_fence(__ATOMIC_RELEASE, "agent");
            asm volatile("s_waitcnt vmcnt(0)" ::: "memory");
            const unsigned og = xb_add(&bar[XB_TOP], 1u);
            const unsigned tg = og / nx;
            if (og + 1u == (tg + 1u) * nx) xb_add(&bar[XB_TOPGEN], 1u);
            else XB_SPIN(xb_ld(&bar[XB_TOPGEN]) == tg, bar);
            __builtin_amdgcn_fence(__ATOMIC_ACQUIRE, "agent");
            xb_add(&bar[XB_XGEN(b.x)], 1u);
            asm volatile("s_waitcnt vmcnt(0)" ::: "memory");
        } else {
            XB_SPIN(xb_ld(&bar[XB_XGEN(b.x)]) == gen, bar);
            __builtin_amdgcn_fence(__ATOMIC_ACQUIRE, "agent");
            asm volatile("s_waitcnt vmcnt(0)" ::: "memory");
        }
    }
    __syncthreads();
}
constexpr int NWAVES = 8, NTHREADS = 512;
constexpr size_t MiB = 1u << 20;
constexpr size_t WS_CTL = 0, CTL_ZERO_BYTES = 65536;
constexpr size_t WS_WGT = 128 * 1024, WS_PEB = 256 * 1024;
constexpr size_t WS_WIN = 1 * MiB, WS_WV = 6 * MiB, WS_WOUT = 8 * MiB, WS_WUP = 10 * MiB, WS_WDN = 21 * MiB, WS_ROPE = 27 * MiB, WS_GATES = 29 * MiB, WS_KCMP = 32 * MiB,
                 WS_HID = 33 * MiB, WS_VCT = 41 * MiB, WS_W1T = 42 * MiB, WS_Y = 44 * MiB, WS_ATT = 44 * MiB  ,
                 WS_H16 = 108 * MiB  , WS_PROJ = 172 * MiB, WS_VT = 340 * MiB, WS_ACT = 172 * MiB  ,
                 WS_SB = 348 * MiB  , WS_Y2 = 406 * MiB,
                 WS_DOUT = 406 * MiB  , WS_DLSE = 454 * MiB, WS_VTP = 470 * MiB, WS_END = 504 * MiB;
static_assert((size_t)3 * cM * 256 * 2 <= WS_DLSE - WS_DOUT && WS_DLSE + (size_t)3 * cM * 4 * 4 <= WS_VTP && WS_VTP + (size_t)512 * VT_LD * 2 <= WS_END && (size_t)cM * PE_LD * 2 <= WS_VT - WS_PROJ && (size_t)1024 * VT_LD * 2 <= WS_Y2 - WS_VT
              && WS_ACT + (size_t)cM * cDFF * 2 <= WS_SB && WS_SB + (size_t)(cM / 64) * 4 * 2 * cDFF * 4 <= WS_Y2 && WS_H16 + (size_t)cM * cDM * 2 <= WS_PROJ, "workspace map");
constexpr int CW_BAR = 4096;
constexpr int RING_BYTES = 131072, LDSCTL_OFF = 8 * 17408  , MISC_OFF = LDSCTL_OFF + 320, LDS_BYTES = 147456;
typedef float f32x4 __attribute__((ext_vector_type(4)));

__device__ __forceinline__ int opaque(int x) { asm volatile("" : "+v"(x)); return x; }
__device__ __forceinline__ float wave_sum(float v) {
#pragma unroll
    for (int o = 1; o < 64; o <<= 1) v += __shfl_xor(v, o);
    return v;
}
__device__ __forceinline__ void n_row_dev(const float* xrow, const float* g, bf16* yrow, int lane) {
    float v[16]; float ss = 0.f;
#pragma unroll
    for (int j = 0; j < 2; ++j)
#pragma unroll
        for (int q = 0; q < 2; ++q) { const f32x4 t = *(const f32x4*)(xrow + 8 * lane + 512 * j + 4 * q);
            v[8 * j + 4 * q + 0] = t.x; v[8 * j + 4 * q + 1] = t.y; v[8 * j + 4 * q + 2] = t.z; v[8 * j + 4 * q + 3] = t.w; ss += t.x * t.x + t.y * t.y + t.z * t.z + t.w * t.w; }
    const float r = 1.f / sqrtf(wave_sum(ss) * (1.f / cDM) + 1e-6f);
#pragma unroll
    for (int j = 0; j < 2; ++j) { const float* gp = g + 8 * lane + 512 * j; U4 o;
        o.x = cvtpk(v[8 * j + 0] * r * gp[0], v[8 * j + 1] * r * gp[1]); o.y = cvtpk(v[8 * j + 2] * r * gp[2], v[8 * j + 3] * r * gp[3]);
        o.z = cvtpk(v[8 * j + 4] * r * gp[4], v[8 * j + 5] * r * gp[5]); o.w = cvtpk(v[8 * j + 6] * r * gp[6], v[8 * j + 7] * r * gp[7]);
        *(U4*)(yrow + 8 * lane + 512 * j) = o; }
}
template <bool HIN_F32, bool HOUT_F32>
__device__ __forceinline__ void nrn_row_dev(const void* hin_, const bf16* y2, const float* g1, const float* g2, void* hout_, bf16* yrow, int lane) {
    float v[16]; float ss = 0.f;
#pragma unroll
    for (int j = 0; j < 2; ++j) { const U4 t = *(const U4*)(y2 + 8 * lane + 512 * j);
        v[8 * j + 0] = bflo(t.x); v[8 * j + 1] = bfhi(t.x); v[8 * j + 2] = bflo(t.y); v[8 * j + 3] = bfhi(t.y); v[8 * j + 4] = bflo(t.z); v[8 * j + 5] = bfhi(t.z); v[8 * j + 6] = bflo(t.w); v[8 * j + 7] = bfhi(t.w); }
#pragma unroll
    for (int e = 0; e < 16; ++e) ss += v[e] * v[e];
    const float r = 1.f / sqrtf(wave_sum(ss) * (1.f / cDM) + 1e-6f);
    float s2 = 0.f;
#pragma unroll
    for (int j = 0; j < 2; ++j) { const int e0 = 8 * lane + 512 * j; float hv[8];
        if (HIN_F32) { const f32x4 a = *(const f32x4*)((const float*)hin_ + e0), b = *(const f32x4*)((const float*)hin_ + e0 + 4); hv[0] = a.x; hv[1] = a.y; hv[2] = a.z; hv[3] = a.w; hv[4] = b.x; hv[5] = b.y; hv[6] = b.z; hv[7] = b.w; }
        else { const U4 t = *(const U4*)((const bf16*)hin_ + e0); hv[0] = bflo(t.x); hv[1] = bfhi(t.x); hv[2] = bflo(t.y); hv[3] = bfhi(t.y); hv[4] = bflo(t.z); hv[5] = bfhi(t.z); hv[6] = bflo(t.w); hv[7] = bfhi(t.w); }
        const f32x4 ga = *(const f32x4*)(g1 + e0), gb = *(const f32x4*)(g1 + e0 + 4); const float gg[8] = {ga.x, ga.y, ga.z, ga.w, gb.x, gb.y, gb.z, gb.w};
#pragma unroll
        for (int e = 0; e < 8; ++e) { const float hn = hv[e] + v[8 * j + e] * r * gg[e]; v[8 * j + e] = hn; }
        if (HOUT_F32) { f32x4 a, b; a.x = v[8 * j]; a.y = v[8 * j + 1]; a.z = v[8 * j + 2]; a.w = v[8 * j + 3]; b.x = v[8 * j + 4]; b.y = v[8 * j + 5]; b.z = v[8 * j + 6]; b.w = v[8 * j + 7];
            *(f32x4*)((float*)hout_ + e0) = a; *(f32x4*)((float*)hout_ + e0 + 4) = b; }
        else { U4 o; o.x = cvtpk(v[8 * j], v[8 * j + 1]); o.y = cvtpk(v[8 * j + 2], v[8 * j + 3]);
            o.z = cvtpk(v[8 * j + 4], v[8 * j + 5]); o.w = cvtpk(v[8 * j + 6], v[8 * j + 7]);
            *(U4*)((bf16*)hout_ + e0) = o;
            v[8 * j + 0] = bflo(o.x); v[8 * j + 1] = bfhi(o.x); v[8 * j + 2] = bflo(o.y); v[8 * j + 3] = bfhi(o.y); v[8 * j + 4] = bflo(o.z); v[8 * j + 5] = bfhi(o.z); v[8 * j + 6] = bflo(o.w); v[8 * j + 7] = bfhi(o.w); }
#pragma unroll
        for (int e = 0; e < 8; ++e) s2 += v[8 * j + e] * v[8 * j + e]; }
    if (g2) { const float r2 = 1.f / sqrtf(wave_sum(s2) * (1.f / cDM) + 1e-6f);
#pragma unroll
        for (int j = 0; j < 2; ++j) { const float* gp = g2 + 8 * lane + 512 * j; U4 o;
            o.x = cvtpk(v[8 * j + 0] * r2 * gp[0], v[8 * j + 1] * r2 * gp[1]); o.y = cvtpk(v[8 * j + 2] * r2 * gp[2], v[8 * j + 3] * r2 * gp[3]);
            o.z = cvtpk(v[8 * j + 4] * r2 * gp[4], v[8 * j + 5] * r2 * gp[5]); o.w = cvtpk(v[8 * j + 6] * r2 * gp[6], v[8 * j + 7] * r2 * gp[7]);
            *(U4*)(yrow + 8 * lane + 512 * j) = o; } }
}

template <int K, int ldw, int N, int mode, int c0>
__device__ __forceinline__ void wprep_tile(const float* W, bf16* Bt, int tile, int lane, LAS float* scr) {
    constexpr int nblk = N / 32; const int kb = tile / nblk, nb = tile % nblk, k0 = 64 * kb, n0 = 32 * nb;
    const int c4 = 4 * (lane & 7), col = c0 + (mode ? wsrc_col(mode, n0 + c4) : n0 + c4);
#pragma unroll
    for (int i = 0; i < 8; ++i) { const int kk = 8 * i + (lane >> 3); const f32x4 t = *(const f32x4*)(W + (size_t)(k0 + kk) * ldw + col);
        scr[kk * 33 + c4] = t.x; scr[kk * 33 + c4 + 1] = t.y; scr[kk * 33 + c4 + 2] = t.z; scr[kk * 33 + c4 + 3] = t.w; }
    const int c = lane & 7;
#pragma unroll
    for (int j = 0; j < 4; ++j) { const int n = (lane >> 3) + 8 * j; const LAS float* s = scr + (8 * c) * 33 + n;
        U4 o; o.x = cvtpk(s[0], s[33]); o.y = cvtpk(s[2 * 33], s[3 * 33]);
        o.z = cvtpk(s[4 * 33], s[5 * 33]); o.w = cvtpk(s[6 * 33], s[7 * 33]);
        *(U4*)(Bt + (size_t)(n0 + n) * K + k0 + 8 * c) = o; }
    asm volatile("s_waitcnt lgkmcnt(0)" ::: "memory");
}
struct Args { const float* in[13]; float* out; unsigned char* ws; };

__global__ void __launch_bounds__(NTHREADS, 2) fwd(Args a) {
    extern __shared__ __attribute__((aligned(16))) unsigned char lds[];
    LAS unsigned char* L = (LAS unsigned char*)lds;
    const int tid = threadIdx.x, lane = tid & 63, wave = __builtin_amdgcn_readfirstlane(tid >> 6);
#define VCU() ((gridDim.x % 8 == 0) ? (int)((blockIdx.x % 8) * (gridDim.x / 8) + blockIdx.x / 8) : (int)blockIdx.x)
    for (int u = tid; u < (LDS_BYTES - LDSCTL_OFF) / 4; u += NTHREADS) ((LAS unsigned*)(L + LDSCTL_OFF))[u] = 0u;
    __syncthreads();
    XcdBarrier bar;
    { unsigned char* ws0 = a.ws; bar = xcd_barrier_post((unsigned*)(ws0 + WS_CTL) + CW_BAR, (volatile LAS unsigned*)(L + MISC_OFF) + 8); }
#define MKP() P p; unsigned char* wsb; { int z_ = 0; asm volatile("" : "+s"(z_)); unsigned char* ws = a.ws + z_; wsb = ws; const float* const* in_ = a.in + z_; \
    p.x = in_[0]; p.norm_g = in_[1]; p.even_w_in = in_[2]; p.even_w_out = in_[3]; p.cmp_pe = in_[4]; p.cmp_w1 = in_[5]; p.cmp_w2 = in_[6]; p.odd_w_in = in_[7]; p.odd_w_out = in_[8]; \
    p.ffn_w_up = in_[9]; p.ffn_conv_w = in_[10]; p.ffn_conv_b = in_[11]; p.ffn_w_down = in_[12]; p.out = (&a.out)[z_]; \
    p.Wt_in = (bf16*)(ws + WS_WIN); p.Wt_out = (bf16*)(ws + WS_WOUT); p.Wt_up = (bf16*)(ws + WS_WUP); p.Wt_dn = (bf16*)(ws + WS_WDN); \
    p.ROPE = (float*)(ws + WS_ROPE); p.GATES = (float*)(ws + WS_GATES); p.KCMP = (bf16*)(ws + WS_KCMP); \
    p.HID = (float*)(ws + WS_HID); p.Y = (bf16*)(ws + WS_Y); p.PROJ = (bf16*)(ws + WS_PROJ); p.ATT = (bf16*)(ws + WS_ATT); p.Y2 = (bf16*)(ws + WS_Y2); \
    p.ACT = (bf16*)(ws + WS_ACT); p.VT = (bf16*)(ws + WS_VT); p.VCT = (bf16*)(ws + WS_VCT); }

#define GRUN(N, call) do { const long _n = (long)(N); const long gthreads = (long)gridDim.x * NTHREADS; for (long i = (long)blockIdx.x * NTHREADS + opaque((int)threadIdx.x); i < _n; i += gthreads) { call; } } while (0)
#define GRID_BAR() xcd_barrier(bar)
#define GEMM_E(EpiT, Einit, Aptr, Btptr, Mrows, Ncols, Kdim) do { pg8::Gemm g{(const pg8::bf16_t*)(Aptr), (const pg8::bf16_t*)(Btptr), (int)(Mrows), (int)(Ncols), (int)(Kdim)}; \
        pg8::StaticOrder S; S.init((int)(Mrows), (int)(Ncols), (int)gridDim.x, (int)blockIdx.x); EpiT E Einit; \
        pg8::gemm_phase<EpiT, pg8::StaticOrder, true, true>(L, g, S, E); } while (0)
#define COMMA ,
#define GEMM(Aptr, Btptr, Mrows, Ncols, Kdim, Optr, ldo) GEMM_E(pg8::EpiBf16<0>, {(pg8::bf16_t*)(Optr) COMMA (int)(ldo) COMMA nullptr COMMA 0 COMMA 0 COMMA 1.f}, Aptr, Btptr, Mrows, Ncols, Kdim)
#define WT(Wp, K_, ldw_, N_, Btp, mode_, c0_) do { const int nt_ = ((N_) / 32) * ((K_) / 64); LAS float* scr_ = (LAS float*)(L + wave * 17408); \
        for (int t_ = blockIdx.x * NWAVES + wave; t_ < nt_; t_ += gridDim.x * NWAVES) wprep_tile<(K_), (ldw_), (N_), (mode_), (c0_)>((Wp), (Btp), t_, lane, scr_); } while (0)
#define WPREP(LL) do { const int _li = (LL) / 2; \
        if (((LL) & 1) == 0) { const float* W = p.even_w_in + (size_t)_li * cDM * EIN_W; \
            WT(W, cDM, EIN_W, LDE2, p.Wt_in, 1, 0); \
            WT(W, cDM, EIN_W, 1024, (bf16*)(wsb + WS_WV), 2, 0); \
            WT(p.even_w_out + (size_t)_li * 768 * cDM, 768, cDM, cDM, p.Wt_out, 0, 0); \
            WT(W, cDM, EIN_W, 32, (bf16*)(wsb + WS_WGT), 0, 1280); \
            WT(p.cmp_w1 + ((size_t)_li * 2 + 0) * 2048 * 256, 2048, 256, 256, (bf16*)(wsb + WS_W1T), 0, 0); \
            WT(p.cmp_w1 + ((size_t)_li * 2 + 1) * 2048 * 256, 2048, 256, 256, (bf16*)(wsb + WS_W1T) + (size_t)256 * 2048, 0, 0); \
            GRUN(512, peb_item(p.cmp_pe + (size_t)_li * 2 * 2048, p.cmp_w1 + (size_t)_li * 2 * 2048 * 256, (float*)(wsb + WS_PEB), i)); } \
        else { const float* W = p.odd_w_in + (size_t)_li * cDM * 3 * cDM; \
            WT(W, cDM, 3 * cDM, 2 * cDM, p.Wt_in, 0, 0); \
            WT(W, cDM, 3 * cDM, cDM, (bf16*)(wsb + WS_WV), 0, 2 * cDM); \
            WT(p.odd_w_out + (size_t)_li * cDM * cDM, cDM, cDM, cDM, p.Wt_out, 0, 0); } \
        WT(p.ffn_w_up + (size_t)(LL) * cDM * 2 * cDFF, cDM, 2 * cDFF, 2 * cDFF, p.Wt_up, 3, 0); \
        WT(p.ffn_w_down + (size_t)(LL) * cDFF * cDM, cDFF, cDM, cDM, p.Wt_dn, 0, 0); } while (0)
#define NRN(FIN, FOUT, hin_, hout_, g1_, g2_) do { for (long r = blockIdx.x * NWAVES + wave; r < cM; r += gridDim.x * NWAVES) nrn_row_dev<FIN, FOUT>((hin_) + r * cDM, p.Y2 + r * cDM, (g1_), (g2_), (hout_) + r * cDM, p.Y + r * cDM, lane); } while (0)
#define H16P ((bf16*)(wsb + WS_H16))
#define FFN(LL) do { \
        { MKP(); GEMM_E(pg8::EpiConvGelu, {(pg8::bf16_t*)p.ACT COMMA p.ffn_conv_w + (size_t)(LL) * 3 * 2 * cDFF COMMA p.ffn_conv_b + (size_t)(LL) * 2 * cDFF COMMA (float*)(wsb + WS_SB)}, p.Y, p.Wt_up, cM, 2 * cDFF, cDM); } GRID_BAR(); \
        { MKP(); GRUN((long)(cM / 64) * 2 * (cDFF / 4), convfix_item(p, (const float*)(wsb + WS_SB), p.ffn_conv_w + (size_t)(LL) * 3 * 2 * cDFF, p.ffn_conv_b + (size_t)(LL) * 2 * cDFF, i)); } GRID_BAR(); \
        { MKP(); GEMM(p.ACT, p.Wt_dn, cM, cDM, cDFF, p.Y2, cDM); } GRID_BAR(); \
        { MKP(); const float* ng = p.norm_g + (size_t)(LL) * 4 * cDM; if ((LL) + 1 < 4) NRN(false, false, H16P, H16P, ng + 3 * cDM, ng + 4 * cDM); else NRN(false, true, H16P, p.out, ng + 3 * cDM, (const float*)nullptr); \
          if ((LL) + 1 < 4) WPREP((LL) + 1); } GRID_BAR(); } while (0)
#define EVEN_LAYER(lp) do { const int LL = 2 * (lp); \
          { MKP(); GEMM_E(pg8::EpiRopeE, {(pg8::bf16_t*)p.PROJ COMMA PE_LD COMMA p.ROPE}, p.Y, p.Wt_in, cM, LDE2, cDM); } \
          { MKP(); GEMM_E(pg8::EpiVT, {(pg8::bf16_t*)p.VT}, (const bf16*)(wsb + WS_WV), p.Y, 1024, cM, cDM); } GRID_BAR();            \
          { MKP(); GRUN((long)512 * cB * (cS / 128), vtp_item(p.VT, (bf16*)(wsb + WS_VTP), i)); if (wave < 4) for (int u = blockIdx.x * 4 + wave; u < cM / 32; u += gridDim.x * 4) gates_unit(p, (const bf16*)(wsb + WS_WGT), u, lane);     \
            for (int u = blockIdx.x * NWAVES + wave; u < 2048; u += gridDim.x * NWAVES) cmp1_unit(p, (const bf16*)(wsb + WS_W1T), (const float*)(wsb + WS_PEB), u, lane); } GRID_BAR(); \
          { MKP(); GRUN((long)2 * cB * cNC * 2 * 32, cmp2_item(p, p.cmp_w2 + (size_t)(lp) * 2 * 256 * 64, i)); } GRID_BAR(); \
          { MKP(); const int ngw = gridDim.x * NWAVES; bf16* DO_ = (bf16*)(wsb + WS_DOUT); float* DL_ = (float*)(wsb + WS_DLSE); const bf16* VP_ = (const bf16*)(wsb + WS_VTP); \
              \
            for (int u = VCU() * NWAVES + wave; u < cB * 4 * 256; u += ngw) { const int bh = u >> 8, x = u & 255; \
                dil_unit<0>(p, p.VT, VP_, DO_, DL_, L + wave * 17408, bh >> 2, bh & 3, 0, x, lane); \
                dil_unit<1>(p, p.VT, VP_, DO_, DL_, L + wave * 17408, bh >> 2, bh & 3, x >> 6, x & 63, lane); \
                dil_unit<2>(p, p.VT, VP_, DO_, DL_, L + wave * 17408, bh >> 2, bh & 3, x >> 4, x & 15, lane); } } \
          { MKP(); const int ngw = gridDim.x * NWAVES, NT = cS / 8; LAS unsigned char* wl = L + wave * 17408; \
              \
            for (int u = VCU() * NWAVES + wave; u < cB * 2 * NT; u += ngw) { const int gw = u % ngw, k = u / ngw; int bg, tile; \
                if (ngw == 2048) { bg = gw >> 8; const int i = gw & 255; tile = 256 * k + ((k & 1) ? 255 - i : i); } else { bg = u / NT; tile = u % NT; } \
                nsa_unit(p, p.VCT, p.VT, wl, bg >> 1, bg & 1, tile * 8, lane); } } GRID_BAR(); \
          { MKP(); GRUN((long)cM * 32, dil_combine_item(p, (const bf16*)(wsb + WS_DOUT), (const float*)(wsb + WS_DLSE), i)); } GRID_BAR(); \
          { MKP(); GEMM(p.ATT, p.Wt_out, cM, cDM, 768, p.Y2, cDM); } GRID_BAR(); \
          { MKP(); const float* ng = p.norm_g + (size_t)LL * 4 * cDM; if ((lp) == 0) NRN(true, false, p.x, H16P, ng + cDM, ng + 2 * cDM); else NRN(false, false, H16P, H16P, ng + cDM, ng + 2 * cDM); } GRID_BAR(); \
          FFN(LL); } while (0)
#define ODD_LAYER(lp) do { const int LL = 2 * (lp) + 1; \
          { MKP(); GEMM(p.Y, p.Wt_in, cM, LDO2, cDM, p.PROJ, PO_LD); } \
          { MKP(); GEMM_E(pg8::EpiVT, {(pg8::bf16_t*)p.VT}, (const bf16*)(wsb + WS_WV), p.Y, 1024, cM, cDM); } GRID_BAR(); \
          { MKP(); const int NT = cS / 32; for (int u = VCU() * NWAVES + wave; u < cB * cNSB * NT; u += gridDim.x * NWAVES) { const int bh = u / NT; \
                sb_unit(p, p.VT, L + wave * 17408, bh / cNSB, bh % cNSB, (u % NT) * 32, lane); } } GRID_BAR(); \
          { MKP(); GEMM(p.ATT, p.Wt_out, cM, cDM, cDM, p.Y2, cDM); } GRID_BAR(); \
          { MKP(); const float* ng = p.norm_g + (size_t)LL * 4 * cDM; NRN(false, false, H16P, H16P, ng + cDM, ng + 2 * cDM); } GRID_BAR(); \
          FFN(LL); } while (0)

    { MKP();
      GRUN((long)cS * 32, rope_table_item(p, i));
      WPREP(0);
      for (long r = blockIdx.x * NWAVES + wave; r < cM; r += gridDim.x * NWAVES) n_row_dev(p.x + r * cDM, p.norm_g, p.Y + r * cDM, lane); }
    GRID_BAR();
    EVEN_LAYER(0); ODD_LAYER(0); EVEN_LAYER(1); ODD_LAYER(1);
}

extern "C" void kernel_launch(void* const* d_in, const int* in_sizes, int n_in, void* d_out, int out_size, void* d_ws, size_t ws_size, hipStream_t stream) {
    static int grid = 0;
    if (grid == 0) {
        if (n_in != 13 || out_size != cM * cDM || ws_size < WS_END) { fprintf(stderr, "kernel_launch: unexpected shapes (n_in %d out %d ws %zu)\n", n_in, out_size, ws_size); grid = -1; return; }
        int dev = 0, cus = 0;
        if (hipGetDevice(&dev) != hipSuccess || hipDeviceGetAttribute(&cus, hipDeviceAttributeMultiprocessorCount, dev) != hipSuccess) { grid = -1; return; }
        if (hipFuncSetAttribute((const void*)fwd, hipFuncAttributeMaxDynamicSharedMemorySize, LDS_BYTES) != hipSuccess) { grid = -1; return; }
        int per_cu = 0; (void)hipOccupancyMaxActiveBlocksPerMultiprocessor(&per_cu, (const void*)fwd, NTHREADS, LDS_BYTES); (void)hipGetLastError();
        grid = cus;
    }
    if (grid < 0) return;
    (void)hipMemsetAsync((char*)d_ws + WS_CTL, 0, CTL_ZERO_BYTES, stream);
    Args a{};
    for (int i = 0; i < 13; ++i) a.in[i] = (const float*)d_in[i];
    a.out = (float*)d_out; a.ws = (unsigned char*)d_ws;
    hipLaunchKernelGGL(fwd, dim3(grid), dim3(NTHREADS), LDS_BYTES, stream, a);
}
```

```cpp
#include <hip/hip_runtime.h>
#include <cstdio>
#include <cstdint>
#include <cmath>
#ifdef HOST_TEST
#include <cmath>
#include <cstring>
#include <cstdio>
#include <cstdlib>
#define HD
static int cB = 1, cS = 1024, cDM = 128, cDFF = 192;
#else
#define HD __device__ __forceinline__
constexpr int cB = 4, cS = 8192, cDM = 1024, cDFF = 2816;
#endif
typedef unsigned short bf16;
#define cM (cB * cS)
#define cNC ((cS - 32) / 16 + 1)
#define cNS (cS / 64)
#define cTOPN (cNS < 16 ? cNS : 16)
#define cNSB (cDM / 64)
#define LDE 3584
#define LDE2 2560
#define LDO2 2048
#define LDO (3 * cDM)
#define EIN_W 3608
#define KCMP_ROWS 512
#define PE_LD (LDE2 + 128)
#define PO_LD (LDO2 + 128)
#define VT_LD (cM + 128)
#define VCT_LD (KCMP_ROWS + 128)

struct alignas(16) U4 { unsigned x, y, z, w; };
HD float u2f(unsigned u) { float f; __builtin_memcpy(&f, &u, 4); return f; }
HD unsigned f2u(float f) { unsigned u; __builtin_memcpy(&u, &f, 4); return u; }
HD float bf2f(bf16 v) { return u2f((unsigned)v << 16); }
HD bf16 f2bf(float f) { unsigned u = f2u(f); return (bf16)((u + 0x7fffu + ((u >> 16) & 1u)) >> 16); }
HD unsigned pk2bf(float lo, float hi) {
#if defined(__HIP_DEVICE_COMPILE__)
    typedef float pk2f_t __attribute__((ext_vector_type(2))); typedef __bf16 pk2b_t __attribute__((ext_vector_type(2)));
    pk2f_t v = {lo, hi}; pk2b_t b = __builtin_convertvector(v, pk2b_t); return __builtin_bit_cast(unsigned, b);
#else
    return (unsigned)f2bf(lo) | ((unsigned)f2bf(hi) << 16);
#endif
}
HD float fast_exp2(float x) {
#if defined(__HIP_DEVICE_COMPILE__)
    return __builtin_amdgcn_exp2f(x);
#else
    return exp2f(x);
#endif
}
HD float fast_rcp(float x) {
#if defined(__HIP_DEVICE_COMPILE__)
    return __builtin_amdgcn_rcpf(x);
#else
    return 1.f / x;
#endif
}
HD float bflo(unsigned w) { return u2f(w << 16); }
HD float bfhi(unsigned w) { return u2f(w & 0xffff0000u); }

struct P {
    const float *x, *norm_g, *even_w_in, *even_w_out, *cmp_pe, *cmp_w1, *cmp_w2, *odd_w_in, *odd_w_out, *ffn_w_up, *ffn_conv_w, *ffn_conv_b, *ffn_w_down;
    float* out;
    bf16 *Wt_in, *Wt_out, *Wt_up, *Wt_dn;
    float* ROPE;
    float* GATES;
    bf16* KCMP;
    float* HID;
    bf16 *Y, *PROJ, *ATT, *Y2, *ACT;
    bf16* VT;
    bf16* VCT;
};

HD float gelu_tanh(float x) { return 0.5f * x * (1.f + tanhf(0.7978845608028654f * (x + 0.044715f * x * x * x))); }

HD void rope_table_item(const P& p, long idx) {
    const int pos = (int)(idx / 32), i = (int)(idx % 32);
    const double ang = (double)pos * pow(10000.0, -(double)i / 32.0);
    p.ROPE[idx * 2] = (float)cos(ang); p.ROPE[idx * 2 + 1] = (float)sin(ang);
}
HD void cmp2_item(const P& p, const float* w2, long idx) {
    const int i = (int)(idx % 32), g = (int)((idx / 32) % 2), n = (int)((idx / 64) % cNC), b = (int)((idx / (64L * cNC)) % cB), which = (int)(idx / (64L * cNC * cB));
    const float* hid = p.HID + ((((size_t)which * cB + b) * cNC + n) * 2 + g) * 256; const float* ww = w2 + (size_t)which * 256 * 64;
    float a1 = 0.f, a2 = 0.f;
    for (int j = 0; j < 256; ++j) { a1 += hid[j] * ww[j * 64 + i]; a2 += hid[j] * ww[j * 64 + i + 32]; }
    bf16* o = p.KCMP + (((size_t)b * KCMP_ROWS + n) * 2 + g) * 64;
    if (which == 0) { const int pos = 16 * n + 31; const float c = p.ROPE[(pos * 32 + i) * 2], s = p.ROPE[(pos * 32 + i) * 2 + 1];
        o[i] = f2bf(a1 * c - a2 * s); o[i + 32] = f2bf(a2 * c + a1 * s); }
    else { bf16* ot = p.VCT + ((size_t)(b * 2 + g) * 64 + i) * VCT_LD + n; ot[0] = f2bf(a1); ot[(size_t)32 * VCT_LD] = f2bf(a2);
        if (n == 0) { ot[511] = 0; ot[(size_t)32 * VCT_LD + 511] = 0; } }
    if (which == 0 && n == 0) { bf16* oz = p.KCMP + (((size_t)b * KCMP_ROWS + 511) * 2 + g) * 64; oz[i] = 0; oz[i + 32] = 0; }
}
HD void peb_item(const float* pe, const float* w1, float* PEB, long idx) {
    const int j = (int)(idx % 256), which = (int)(idx / 256);
    float acc = 0.f;
    for (int k = 0; k < 2048; ++k) acc += pe[(size_t)which * 2048 + k] * w1[((size_t)which * 2048 + k) * 256 + j];
    PEB[idx] = acc;
}
HD int wsrc_col(int mode, int n) {
    if (mode == 1) { const int u = n >> 8, c = n & 255, hiu = c >> 6, w = c & 63;
        if (u == 2) return 512 + c;
        const int d = (w & 7) < 4 ? 4 * (w >> 3) + (w & 7) : 32 + 4 * (w >> 3) + ((w & 7) - 4);
        int base;
        if (u < 2) base = 64 * (4 * u + hiu); else if (u == 3) base = hiu < 2 ? 768 + 64 * hiu : 1024 + 64 * (hiu - 2);
        else if (u < 7) base = 1304 + 64 * (4 * (u - 4) + hiu); else base = 1304 + 768 + 64 * (4 * (u - 7) + hiu);
        return base + d; }
    if (mode == 2) return n < 128 ? 896 + n : n < 256 ? 1152 + (n - 128) : 2840 + (n - 256);
    if (mode == 3) { const int pn = n >> 8, bj = (n >> 7) & 1, x = n & 127; return bj * cDFF + 128 * pn + x; }
    return n;
}
HD float gelu_fast_h(float x) { const float z = x + 0.044715f * x * x * x; return x * fast_rcp(1.f + fast_exp2(-2.3022081981f * z)); }
struct alignas(16) F4 { float v[4]; };
HD void convfix_item(const P& p, const float* SB, const float* cw, const float* cb, long idx) {
    constexpr int Q = cDFF / 4; const int j = 4 * (int)(idx % Q), rr = (int)((idx / Q) % 2); const long blk = idx / (2L * Q); const long row = blk * 64 + rr; const int t = (int)(row % cS), LD2 = 2 * cDFF;
    const float* s0 = SB + ((size_t)blk * 4 + rr) * LD2; const float* sp = SB + ((size_t)(blk - 1) * 4) * LD2;
    const float* sm = SB + ((size_t)blk * 4) * LD2;
#define LD4(ptr) (*(const F4*)(ptr))
    const F4 bg = LD4(cb + j), bv = LD4(cb + cDFF + j), w2g = LD4(cw + 2 * LD2 + j), w2v = LD4(cw + 2 * LD2 + cDFF + j), w1g = LD4(cw + LD2 + j), w1v = LD4(cw + LD2 + cDFF + j), w0g = LD4(cw + j), w0v = LD4(cw + cDFF + j);
    const F4 ug = LD4(s0 + j), uv = LD4(s0 + cDFF + j);
    F4 g1 = {{0.f, 0.f, 0.f, 0.f}}, v1 = g1, g2 = g1, v2 = g1;
    if (rr == 0) { if (t >= 1) { g1 = LD4(sp + 3 * LD2 + j); v1 = LD4(sp + 3 * LD2 + cDFF + j); g2 = LD4(sp + 2 * LD2 + j); v2 = LD4(sp + 2 * LD2 + cDFF + j); } }
    else { g1 = LD4(sm + j); v1 = LD4(sm + cDFF + j); if (t >= 2) { g2 = LD4(sp + 3 * LD2 + j); v2 = LD4(sp + 3 * LD2 + cDFF + j); } }
#undef LD4
    float o[4];
#pragma unroll
    for (int e = 0; e < 4; ++e) { const float cg = bg.v[e] + w2g.v[e] * ug.v[e] + w1g.v[e] * g1.v[e] + w0g.v[e] * g2.v[e], cv = bv.v[e] + w2v.v[e] * uv.v[e] + w1v.v[e] * v1.v[e] + w0v.v[e] * v2.v[e];
        o[e] = gelu_fast_h(cg) * cv; }
    uint2 w; w.x = pk2bf(o[0], o[1]); w.y = pk2bf(o[2], o[3]);
    *(uint2*)(p.ACT + (size_t)row * cDFF + j) = w;
}
HD size_t vt_tile_off(int ngrp, int b, int grp, int tile) { return (((size_t)b * ngrp + grp) * (cS / 32) + tile) * 2048; }
HD size_t vt_elem_off(int ngrp, int b, int dg, int tk) { return vt_tile_off(ngrp, b, dg >> 6, tk >> 5) + (size_t)(dg & 63) * 32 + (tk & 31); }
template <int dil> HD void vtp_run(const bf16* src, bf16* VTP, int b, int pr, int G) {
    unsigned in[64];
#pragma unroll
    for (int q = 0; q < 4; ++q)
#pragma unroll
        for (int c = 0; c < 4; ++c) { const U4 v = *(const U4*)(src + (size_t)q * 2048 + 8 * c); in[16 * q + 4 * c] = v.x; in[16 * q + 4 * c + 1] = v.y; in[16 * q + 4 * c + 2] = v.z; in[16 * q + 4 * c + 3] = v.w; }
    constexpr int per = cS / dil, nm = 128 / dil;
#pragma unroll
    for (int rc = 0; rc < dil; ++rc)
#pragma unroll
        for (int o8 = 0; o8 < nm / 8; ++o8) { unsigned w[4];
#pragma unroll
            for (int e = 0; e < 4; ++e) { const int t0_ = dil * (8 * o8 + 2 * e) + rc, t1_ = t0_ + dil;
                const unsigned lo = (t0_ & 1) ? (in[t0_ >> 1] >> 16) : (in[t0_ >> 1] & 0xFFFFu), hi = (t1_ & 1) ? (in[t1_ >> 1] & 0xFFFF0000u) : (in[t1_ >> 1] << 16);
                w[e] = lo | hi; }
            U4 v; v.x = w[0]; v.y = w[1]; v.z = w[2]; v.w = w[3];
            *(U4*)(VTP + vt_elem_off(8, b, pr, rc * per + nm * G + 8 * o8)) = v; }
}
HD void vtp_item(const bf16* VT, bf16* VTP, long idx) {
    const int ng = cS / 128; const int G = (int)(idx % ng), b = (int)((idx / ng) % cB), pr = (int)(idx / ((long)ng * cB));
    const bf16* src = VT + vt_elem_off(16, b, 512 + pr, 128 * G);
    if (pr < 256) vtp_run<4>(src, VTP, b, pr, G); else vtp_run<16>(src, VTP, b, pr, G);
}
HD void dil_combine_item(const P& p, const bf16* DOUT, const float* DLSE, long idx) {
    const int c8 = (int)(idx % 8), hd = (int)((idx / 8) % 4); const long row = idx / 32;
    const float l0 = DLSE[((size_t)0 * cM + row) * 4 + hd], l1 = DLSE[((size_t)1 * cM + row) * 4 + hd], l2 = DLSE[((size_t)2 * cM + row) * 4 + hd];
    const float mx = fmaxf(l0, fmaxf(l1, l2)), e0 = fast_exp2(l0 - mx), e1 = fast_exp2(l1 - mx), e2 = fast_exp2(l2 - mx), rs = fast_rcp(e0 + e1 + e2);
    const U4 a = *(const U4*)(DOUT + ((size_t)0 * cM + row) * 256 + hd * 64 + 8 * c8), bq = *(const U4*)(DOUT + ((size_t)1 * cM + row) * 256 + hd * 64 + 8 * c8), cq = *(const U4*)(DOUT + ((size_t)2 * cM + row) * 256 + hd * 64 + 8 * c8);
    const float w0 = e0 * rs, w1 = e1 * rs, w2 = e2 * rs;
    U4 o;
    o.x = pk2bf(w0 * bflo(a.x) + w1 * bflo(bq.x) + w2 * bflo(cq.x), w0 * bfhi(a.x) + w1 * bfhi(bq.x) + w2 * bfhi(cq.x));
    o.y = pk2bf(w0 * bflo(a.y) + w1 * bflo(bq.y) + w2 * bflo(cq.y), w0 * bfhi(a.y) + w1 * bfhi(bq.y) + w2 * bfhi(cq.y));
    o.z = pk2bf(w0 * bflo(a.z) + w1 * bflo(bq.z) + w2 * bflo(cq.z), w0 * bfhi(a.z) + w1 * bfhi(bq.z) + w2 * bfhi(cq.z));
    o.w = pk2bf(w0 * bflo(a.w) + w1 * bflo(bq.w) + w2 * bflo(cq.w), w0 * bfhi(a.w) + w1 * bfhi(bq.w) + w2 * bfhi(cq.w));
    *(U4*)(p.ATT + (size_t)row * 768 + 512 + hd * 64 + 8 * c8) = o;
}
#define LAS __attribute__((address_space(3)))
typedef short bf16x8v __attribute__((ext_vector_type(8)));
typedef short bf16x4v __attribute__((ext_vector_type(4)));
typedef float f32x16 __attribute__((ext_vector_type(16)));
typedef float f32x2_t __attribute__((ext_vector_type(2)));
typedef float f32x4v __attribute__((ext_vector_type(4)));
typedef __bf16 bf16x2_t __attribute__((ext_vector_type(2)));
__device__ __forceinline__ unsigned cvtpk(float lo, float hi) { f32x2_t v = {lo, hi}; bf16x2_t b = __builtin_convertvector(v, bf16x2_t); return __builtin_bit_cast(unsigned, b); }
__device__ __forceinline__ float fexp2(float x) { return __builtin_amdgcn_exp2f(x); }
#define ATT_C2 (0.125f * 1.4426950408889634f)
#define ATT_NEG (-1e30f)
#define ATT_THR 8.0f

typedef unsigned u32x2v __attribute__((ext_vector_type(2)));
__device__ __forceinline__ float vmax2(float a, float b) { float d; asm("v_max_f32 %0, %1, %2" : "=v"(d) : "v"(a), "v"(b)); return d; }
__device__ __forceinline__ float vmax3(float a, float b, float c) { float d; asm("v_max3_f32 %0, %1, %2, %3" : "=v"(d) : "v"(a), "v"(b), "v"(c)); return d; }
__device__ __forceinline__ float vmax16(const f32x16& s) {
    const float a = vmax3(s[0], s[1], s[2]), b = vmax3(s[3], s[4], s[5]), c = vmax3(s[6], s[7], s[8]), d = vmax3(s[9], s[10], s[11]), e = vmax3(s[12], s[13], s[14]);
    return vmax2(vmax3(vmax3(a, b, c), d, e), s[15]); }
__device__ __forceinline__ float vmax16_acc(const f32x16& s) { float d;
    asm("s_nop 11\n\tv_max3_f32 %0, %1, %2, %3\n\tv_max3_f32 %0, %0, %4, %5\n\tv_max3_f32 %0, %0, %6, %7\n\tv_max3_f32 %0, %0, %8, %9\n\t"
        "v_max3_f32 %0, %0, %10, %11\n\tv_max3_f32 %0, %0, %12, %13\n\tv_max3_f32 %0, %0, %14, %15\n\tv_max_f32 %0, %0, %16"
        : "=&v"(d) : "v"(s[0]), "v"(s[1]), "v"(s[2]), "v"(s[3]), "v"(s[4]), "v"(s[5]), "v"(s[6]), "v"(s[7]), "v"(s[8]), "v"(s[9]), "v"(s[10]), "v"(s[11]), "v"(s[12]), "v"(s[13]), "v"(s[14]), "v"(s[15]));
    return d; }
#define OPQ(x) asm("" : "+v"(x))
__device__ __forceinline__ float vsum16(const f32x16& s) {
    float a0 = s[0] + s[1], a1 = s[2] + s[3], a2 = s[4] + s[5], a3 = s[6] + s[7], a4 = s[8] + s[9], a5 = s[10] + s[11], a6 = s[12] + s[13], a7 = s[14] + s[15];
    OPQ(a0); OPQ(a1); OPQ(a2); OPQ(a3); OPQ(a4); OPQ(a5); OPQ(a6); OPQ(a7);
    float b0 = a0 + a1, b1 = a2 + a3, b2 = a4 + a5, b3 = a6 + a7; OPQ(b0); OPQ(b1); OPQ(b2); OPQ(b3);
    float c0 = b0 + b1, c1 = b2 + b3; OPQ(c0); OPQ(c1);
    return c0 + c1; }
__device__ __forceinline__ float xmax32(float x) { float y; asm volatile("v_mov_b32 %0, %1\n\ts_nop 1" : "=v"(y) : "v"(x));
    auto r = __builtin_amdgcn_permlane32_swap(__builtin_bit_cast(unsigned, x), __builtin_bit_cast(unsigned, y), false, false); const unsigned a = r[0], b = r[1];
    return vmax2(__builtin_bit_cast(float, a), __builtin_bit_cast(float, b)); }
__device__ __forceinline__ float xsum32(float x) { float y; asm volatile("v_mov_b32 %0, %1\n\ts_nop 1" : "=v"(y) : "v"(x));
    auto r = __builtin_amdgcn_permlane32_swap(__builtin_bit_cast(unsigned, x), __builtin_bit_cast(unsigned, y), false, false); const unsigned a = r[0], b = r[1];
    return __builtin_bit_cast(float, a) + __builtin_bit_cast(float, b); }
__device__ __forceinline__ void store_row64(bf16* rowp, int hh, const float (&o)[32], float sc) {
#pragma unroll
    for (int dt = 0; dt < 2; ++dt)
#pragma unroll
        for (int kp = 0; kp < 2; ++kp) { const float* q = o + 16 * dt + 8 * kp;
            const unsigned a0 = cvtpk(q[0] * sc, q[1] * sc), a1 = cvtpk(q[2] * sc, q[3] * sc), b0 = cvtpk(q[4] * sc, q[5] * sc), b1 = cvtpk(q[6] * sc, q[7] * sc);
            auto r0 = __builtin_amdgcn_permlane32_swap(a0, b0, false, false); auto r1 = __builtin_amdgcn_permlane32_swap(a1, b1, false, false);
            U4 w; w.x = r0[0]; w.y = r1[0]; w.z = r0[1]; w.w = r1[1];
            *(U4*)(rowp + 32 * dt + 16 * kp + 8 * hh) = w; }
}
__device__ __forceinline__ f32x16 zero16() { f32x16 z;
#pragma unroll
    for (int i = 0; i < 16; ++i) z[i] = 0.f;
    return z; }
__device__ __forceinline__ f32x16 qk32(const bf16* kp, const bf16x8v (&qf)[4]) {
    f32x16 acc = zero16();
#pragma unroll
    for (int ks = 0; ks < 4; ++ks) { const bf16x8v kf = *(const bf16x8v*)(kp + 16 * ks); acc = __builtin_amdgcn_mfma_f32_32x32x16_bf16(kf, qf[ks], acc, 0, 0, 0); }
    return acc;
}
__device__ __forceinline__ void pv32(f32x16& o0, f32x16& o1, const bf16* vt, size_t dstep, const unsigned (&pb)[8]) {
#pragma unroll
    for (int s = 0; s < 2; ++s) {
        const bf16x4v a00 = *(const bf16x4v*)(vt + 16 * s), a01 = *(const bf16x4v*)(vt + 16 * s + 8);
        const bf16x4v a10 = *(const bf16x4v*)(vt + dstep + 16 * s), a11 = *(const bf16x4v*)(vt + dstep + 16 * s + 8);
        bf16x8v A0, A1, B;
        A0 = __builtin_shufflevector(a00, a01, 0, 1, 2, 3, 4, 5, 6, 7); A1 = __builtin_shufflevector(a10, a11, 0, 1, 2, 3, 4, 5, 6, 7);
        typedef unsigned u32x4v __attribute__((ext_vector_type(4)));
        u32x4v bw = {pb[4 * s + 0], pb[4 * s + 1], pb[4 * s + 2], pb[4 * s + 3]};
        B = __builtin_bit_cast(bf16x8v, bw);
        o0 = __builtin_amdgcn_mfma_f32_32x32x16_bf16(A0, B, o0, 0, 0, 0);
        o1 = __builtin_amdgcn_mfma_f32_32x32x16_bf16(A1, B, o1, 0, 0, 0);
    }
}
struct KF { bf16x8v k[4]; };
struct VF { bf16x4v v[8]; };
__device__ __forceinline__ void load_k(KF& f, const bf16* kp) {
#pragma unroll
    for (int ks = 0; ks < 4; ++ks) f.k[ks] = *(const bf16x8v*)(kp + 16 * ks); }
__device__ __forceinline__ void load_v(VF& f, const bf16* vt, size_t dstep) {
#pragma unroll
    for (int s = 0; s < 2; ++s) { f.v[2 * s] = *(const bf16x4v*)(vt + 16 * s); f.v[2 * s + 1] = *(const bf16x4v*)(vt + 16 * s + 8);
        f.v[4 + 2 * s] = *(const bf16x4v*)(vt + dstep + 16 * s); f.v[4 + 2 * s + 1] = *(const bf16x4v*)(vt + dstep + 16 * s + 8); } }
__device__ __forceinline__ f32x16 qk32r(const KF& f, const bf16x8v (&qf)[4]) {
    f32x16 acc = zero16();
#pragma unroll
    for (int ks = 0; ks < 4; ++ks) acc = __builtin_amdgcn_mfma_f32_32x32x16_bf16(f.k[ks], qf[ks], acc, 0, 0, 0);
    return acc; }
__device__ __forceinline__ void pv32r(f32x16& o0, f32x16& o1, const VF& f, const unsigned (&pb)[8]) {
    typedef unsigned u32x4v __attribute__((ext_vector_type(4)));
#pragma unroll
    for (int s = 0; s < 2; ++s) {
        const bf16x8v A0 = __builtin_shufflevector(f.v[2 * s], f.v[2 * s + 1], 0, 1, 2, 3, 4, 5, 6, 7), A1 = __builtin_shufflevector(f.v[4 + 2 * s], f.v[4 + 2 * s + 1], 0, 1, 2, 3, 4, 5, 6, 7);
        const u32x4v bw = {pb[4 * s + 0], pb[4 * s + 1], pb[4 * s + 2], pb[4 * s + 3]}; const bf16x8v B = __builtin_bit_cast(bf16x8v, bw);
        o0 = __builtin_amdgcn_mfma_f32_32x32x16_bf16(A0, B, o0, 0, 0, 0); o1 = __builtin_amdgcn_mfma_f32_32x32x16_bf16(A1, B, o1, 0, 0, 0); } }
__device__ __forceinline__ unsigned long long wave_or64(unsigned long long x) {
    unsigned lo = (unsigned)x, hi = (unsigned)(x >> 32);
#pragma unroll
    for (int o = 1; o < 64; o <<= 1) { lo |= (unsigned)__shfl_xor((int)lo, o); hi |= (unsigned)__shfl_xor((int)hi, o); }
    return ((unsigned long long)(unsigned)__builtin_amdgcn_readfirstlane((int)hi) << 32) | (unsigned)__builtin_amdgcn_readfirstlane((int)lo); }
struct LaneAddr { unsigned ck, cv; unsigned rk[4], rv[4], rw[4]; };
__device__ __forceinline__ LaneAddr lane_addr(LAS unsigned char* slot, int lane) {
    LaneAddr a; const int r = lane & 31, hh = lane >> 5; const unsigned sb = (unsigned)(size_t)slot;
    a.ck = (unsigned)lane; a.cv = (unsigned)lane;
#pragma unroll
    for (int ks = 0; ks < 4; ++ks) a.rk[ks] = sb + r * 128 + (((2 * ks + hh) ^ (r & 7)) * 16);
#pragma unroll
    for (int c = 0; c < 4; ++c) { a.rv[c] = sb + 4096 + r * 64 + ((c ^ ((r >> 2) & 3)) * 16) + 8 * hh; unsigned w = a.rv[c] + 2048; asm volatile("" : "+v"(w)); a.rw[c] = w; }
    return a; }
__device__ __forceinline__ unsigned kvoff(int lane, size_t pitch) { const int row = lane >> 3, ch = (lane & 7) ^ (row & 7); return (unsigned)((row * pitch + ch * 8) * 2); }
__device__ __forceinline__ unsigned vvoff(int lane, size_t pitch) { const int row = lane >> 2, ch = (lane & 3) ^ ((row >> 2) & 3); return (unsigned)((row * pitch + ch * 8) * 2); }
typedef __amdgpu_buffer_rsrc_t rsrc_t;
__device__ __forceinline__ rsrc_t mkrsrc(const void* base) { return __builtin_amdgcn_make_buffer_rsrc((void*)base, 0, 0x7FFFFFF0, 0x00020000); }
__device__ __forceinline__ void dma_k(LAS unsigned char* slot, rsrc_t rs, unsigned tile_off, unsigned pitchB, unsigned voff) {
#pragma unroll
    for (int q = 0; q < 4; ++q) __builtin_amdgcn_raw_ptr_buffer_load_lds(rs, (LAS unsigned*)(slot + q * 1024), 16, voff, tile_off + q * 8 * pitchB, 0, 0); }
__device__ __forceinline__ void dma_v(LAS unsigned char* slot, rsrc_t rs, unsigned tile_off, unsigned pitchB, unsigned voff) {
#pragma unroll
    for (int q = 0; q < 4; ++q) __builtin_amdgcn_raw_ptr_buffer_load_lds(rs, (LAS unsigned*)(slot + 4096 + q * 1024), 16, voff, tile_off + q * 16 * pitchB, 0, 0); }
__device__ __forceinline__ void read_k(KF& f, const LaneAddr& a) {
#pragma unroll
    for (int ks = 0; ks < 4; ++ks) f.k[ks] = *(const LAS bf16x8v*)(size_t)a.rk[ks]; }
__device__ __forceinline__ void read_v(VF& f, const LaneAddr& a) {
#pragma unroll
    for (int dt = 0; dt < 2; ++dt)
#pragma unroll
        for (int s = 0; s < 2; ++s) { f.v[4 * dt + 2 * s] = *(const LAS bf16x4v*)(size_t)(dt ? a.rw[2 * s] : a.rv[2 * s]); f.v[4 * dt + 2 * s + 1] = *(const LAS bf16x4v*)(size_t)(dt ? a.rw[2 * s + 1] : a.rv[2 * s + 1]); } }
#define DMA_WAIT() asm volatile("s_waitcnt vmcnt(0)" ::: "memory")
#define LDS_DRAIN() asm volatile("s_waitcnt lgkmcnt(0)" ::: "memory")
#define LDS_DRAIN_PINNED() do { __builtin_amdgcn_sched_barrier(0); asm volatile("s_waitcnt lgkmcnt(0)" ::: "memory"); } while (0)
#define ATT_BIG 1.152921504606847e18f
__device__ __forceinline__ void sm_fast(f32x16& s, const KF& kc, const bf16x8v (&qf)[4], bool lane_on, float& m, float& l, f32x16& o0, f32x16& o1, unsigned (&pb)[8]) {
    float nb = lane_on ? -m : -INFINITY;
#pragma unroll
    for (int reg = 0; reg < 16; ++reg) s[reg] = fexp2(__builtin_fmaf(s[reg], ATT_C2, nb));
    float rs = vsum16(s);
    if (__any(!(rs < ATT_BIG))) {
        s = qk32r(kc, qf);
        float mx = vmax16_acc(s);
        mx = xmax32(lane_on ? mx * ATT_C2 : ATT_NEG);
        const float mn = (mx > m + ATT_THR) ? mx : m, alpha = fexp2(m - mn); m = mn; l *= alpha;
#pragma unroll
        for (int reg = 0; reg < 16; ++reg) { o0[reg] *= alpha; o1[reg] *= alpha; }
        nb = lane_on ? -m : -INFINITY;
#pragma unroll
        for (int reg = 0; reg < 16; ++reg) s[reg] = fexp2(__builtin_fmaf(s[reg], ATT_C2, nb));
        rs = vsum16(s); }
    l += rs;
#pragma unroll
    for (int i = 0; i < 8; ++i) pb[i] = cvtpk(s[2 * i], s[2 * i + 1]);
}
__device__ __forceinline__ void sm_step(f32x16& s, const KF& kc, const bf16x8v (&qf)[4], int lo, int hi, int hh, float& m, float& l, f32x16& o0, f32x16& o1, unsigned (&pb)[8]) {
    const float nb = -m;
#pragma unroll
    for (int reg = 0; reg < 16; ++reg) { const int ko = (reg & 3) + 8 * (reg >> 2) + 4 * hh; const bool v = (ko >= lo) && (ko <= hi);
        const float e = fexp2(__builtin_fmaf(s[reg], ATT_C2, nb)); s[reg] = v ? e : 0.f; }
    float rs = vsum16(s);
    if (__any(!(rs < ATT_BIG))) {
        s = qk32r(kc, qf);
#pragma unroll
        for (int reg = 0; reg < 16; ++reg) { const int ko = (reg & 3) + 8 * (reg >> 2) + 4 * hh; const bool v = (ko >= lo) && (ko <= hi);
            s[reg] = v ? s[reg] * ATT_C2 : ATT_NEG; }
        const float mx = xmax32(vmax16(s));
        const float mn = (mx > m + ATT_THR) ? mx : m, alpha = fexp2(m - mn); m = mn; l *= alpha;
#pragma unroll
        for (int reg = 0; reg < 16; ++reg) { o0[reg] *= alpha; o1[reg] *= alpha; }
#pragma unroll
        for (int reg = 0; reg < 16; ++reg) s[reg] = (s[reg] > -1e29f) ? fexp2(s[reg] - m) : 0.f;
        rs = vsum16(s); }
    l += rs;
#pragma unroll
    for (int i = 0; i < 8; ++i) pb[i] = cvtpk(s[2 * i], s[2 * i + 1]);
}

__device__ __forceinline__ float dpp_xor1(float x) { return __builtin_bit_cast(float, __builtin_amdgcn_update_dpp(0, __builtin_bit_cast(int, x), 0xB1, 0xF, 0xF, true)); }
__device__ __forceinline__ float dpp_xor2(float x) { return __builtin_bit_cast(float, __builtin_amdgcn_update_dpp(0, __builtin_bit_cast(int, x), 0x4E, 0xF, 0xF, true)); }
#define IMP_LD 132
__device__ __forceinline__ void nsa_unit(const P& p, const bf16* VCT, const bf16* VT, LAS unsigned char* wl, int b, int g, int t0, int lane) {
    const LaneAddr la = lane_addr(wl, lane);
    LAS float* imp = (LAS float*)(wl + 8192);
    const int r = lane & 31, hh = lane >> 5, tl = r >> 2, hg = r & 3, head = g * 4 + hg, t = t0 + tl;
    const long row = (long)b * cS + t;
    bf16x8v qf[4];
    { const bf16* qp = p.PROJ + (size_t)row * PE_LD + head * 64 + 8 * hh;
#pragma unroll
      for (int ks = 0; ks < 4; ++ks) qf[ks] = *(const bf16x8v*)(qp + 16 * ks); }
    float outacc[32];
    unsigned pb[8];
    unsigned long long m0 = 0ull, m1 = 0ull;
    {
        for (int i = lane; i < 8 * IMP_LD; i += 64) imp[i] = 0.f;
        const int nv = t >= 31 ? (t - 31) / 16 + 1 : 0, nvmax = (t0 + 7) >= 31 ? (t0 + 7 - 31) / 16 + 1 : 0, ntile = (nvmax + 31) >> 5;
        float m = ATT_NEG, l = 0.f;
        const bf16* kc0 = p.KCMP + ((size_t)b * KCMP_ROWS * 2 + g) * 64;
        const bf16* vc0 = VCT + (size_t)(b * 2 + g) * 64 * VCT_LD;
        const rsrc_t rsK = mkrsrc(kc0), rsV = mkrsrc(vc0); const unsigned kvo = kvoff(lane, 128), vvo = vvoff(lane, VCT_LD);
        KF kc; VF vc;
        if (ntile > 0) { dma_k(wl, rsK, 0u, 128 * 2, kvo); DMA_WAIT(); read_k(kc, la); }
        for (int kt = 0; kt < ntile; ++kt) { const int key0 = 32 * kt;
            LDS_DRAIN();
            if (kt + 1 < ntile) dma_k(wl, rsK, (unsigned)(key0 + 32) * (128 * 2), 128 * 2, kvo);
            f32x16 s = qk32r(kc, qf);
            float mx = ATT_NEG;
#pragma unroll
            for (int reg = 0; reg < 16; ++reg) { const int ko = (reg & 3) + 8 * (reg >> 2) + 4 * hh; const float x = (key0 + ko < nv) ? s[reg] * ATT_C2 : ATT_NEG; s[reg] = x; mx = fmaxf(mx, x); }
            mx = xmax32(mx);
            const float mn = fmaxf(m, mx); float rs = 0.f;
#pragma unroll
            for (int reg = 0; reg < 16; ++reg) rs += (s[reg] > -1e29f) ? fexp2(s[reg] - mn) : 0.f;
            rs = xsum32(rs);
            l = l * fexp2(m - mn) + rs; m = mn;
            if (kt + 1 < ntile) { DMA_WAIT(); read_k(kc, la); } }
        const float rl = l > 0.f ? 1.f / l : 0.f;
        f32x16 o0 = zero16(), o1 = zero16();
        if (ntile > 0) { dma_k(wl, rsK, 0u, 128 * 2, kvo); dma_v(wl, rsV, 0u, VCT_LD * 2, vvo); DMA_WAIT(); read_k(kc, la); }
        for (int kt = 0; kt < ntile; ++kt) { const int key0 = 32 * kt;
            LDS_DRAIN(); if (kt + 1 < ntile) dma_k(wl, rsK, (unsigned)(key0 + 32) * (128 * 2), 128 * 2, kvo);
            read_v(vc, la);
            f32x16 s = qk32r(kc, qf);
            LDS_DRAIN_PINNED(); if (kt + 1 < ntile) dma_v(wl, rsV, (unsigned)(key0 + 32) * 2, VCT_LD * 2, vvo);
#pragma unroll
            for (int reg = 0; reg < 16; ++reg) { const int ko = (reg & 3) + 8 * (reg >> 2) + 4 * hh; s[reg] = (key0 + ko < nv) ? fexp2(s[reg] * ATT_C2 - m) * rl : 0.f; }
#pragma unroll
            for (int i = 0; i < 8; ++i) pb[i] = cvtpk(s[2 * i], s[2 * i + 1]);
            pv32r(o0, o1, vc, pb);
#pragma unroll
            for (int k = 0; k < 4; ++k) { float a = s[4 * k] + s[4 * k + 1] + s[4 * k + 2] + 0.5f * s[4 * k + 3], c = 0.5f * s[4 * k + 3];
                a += dpp_xor1(a); a += dpp_xor2(a); c += dpp_xor1(c); c += dpp_xor2(c);
                if (hg == 0) { const int j = (key0 >> 2) + 2 * k + hh; (void)__hip_atomic_fetch_add(imp + tl * IMP_LD + j, a, __ATOMIC_RELAXED, __HIP_MEMORY_SCOPE_WORKGROUP); (void)__hip_atomic_fetch_add(imp + tl * IMP_LD + j + 1, c, __ATOMIC_RELAXED, __HIP_MEMORY_SCOPE_WORKGROUP); } }
            if (kt + 1 < ntile) { DMA_WAIT(); read_k(kc, la); } }
        const float g0 = p.GATES[row * 24 + head * 3 + 0];
#pragma unroll
        for (int reg = 0; reg < 16; ++reg) { outacc[reg] = o0[reg] * g0; outacc[16 + reg] = o1[reg] * g0; }
    }
    for (int tk = 0; tk < 8; ++tk) { const int tt = t0 + tk, cur = tt >> 6; LAS unsigned* row = (LAS unsigned*)(imp + tk * IMP_LD);
        float v0 = imp[tk * IMP_LD + lane], v1 = imp[tk * IMP_LD + lane + 64];
        if (lane == 0 || lane == cur || lane == cur - 1) v0 += 1e4f;
        if (lane + 64 == cur || lane + 64 == cur - 1) v1 += 1e4f;
        const unsigned k0 = ((64 * lane > tt) ? 0u : (__builtin_bit_cast(unsigned, v0) & ~127u)) | (unsigned)(127 - lane);
        const unsigned k1 = ((64 * (lane + 64) > tt) ? 0u : (__builtin_bit_cast(unsigned, v1) & ~127u)) | (unsigned)(63 - lane);
        row[lane] = k0; row[lane + 64] = k1;
        int r0 = 0, r1 = 0;
        const int nq4 = min(32, ((cur >> 2) + 4) & ~3);
        typedef unsigned u32x4k __attribute__((ext_vector_type(4)));
        if (cur >= 64) {
#pragma unroll 4
            for (int q4 = 0; q4 < nq4; ++q4) { const u32x4k w = *(const LAS u32x4k*)(row + 4 * q4);
#pragma unroll
                for (int e = 0; e < 4; ++e) { r0 += (w[e] > k0) ? 1 : 0; r1 += (w[e] > k1) ? 1 : 0; } }
        } else {
#pragma unroll 4
            for (int q4 = 0; q4 < nq4; ++q4) { const u32x4k w = *(const LAS u32x4k*)(row + 4 * q4);
#pragma unroll
                for (int e = 0; e < 4; ++e) r0 += (w[e] > k0) ? 1 : 0; }
            r1 = 16; }
        const unsigned long long s0 = __ballot(r0 < 16), s1 = __ballot(r1 < 16);
        if (tl == tk) { m0 = s0; m1 = s1; } }
    {
        f32x16 o0 = zero16(), o1 = zero16(); float m = ATT_NEG, l = 0.f;
        const bf16* k0p = p.PROJ + (size_t)b * cS * PE_LD + 768 + g * 64;
        const bf16* v0p = VT + vt_tile_off(16, b, g, 0);
        const rsrc_t rsK = mkrsrc(k0p), rsV = mkrsrc(v0p); const unsigned kvo = kvoff(lane, PE_LD), vvo = vvoff(lane, 32);
        unsigned long long u0 = wave_or64(m0), u1 = wave_or64(m1);
        const int tmax = (t0 + 7) >> 5;
#define NSA_NEXT_TILE(tc) ({ int tt_ = (tc) + 1; if ((tt_ & 1) == 0) { const int j_ = tt_ >> 1; \
            const unsigned long long lo_ = j_ < 64 ? (u0 >> j_) : 0ull, hi_ = j_ < 64 ? u1 : (j_ < 128 ? (u1 >> (j_ - 64)) : 0ull); \
            tt_ = lo_ ? 2 * (j_ + __builtin_ctzll(lo_)) : (hi_ ? 2 * ((j_ < 64 ? 64 : j_) + __builtin_ctzll(hi_)) : 1 << 20); } tt_ <= tmax ? tt_ : -1; })
        int tn = NSA_NEXT_TILE(-1);
        KF kc; VF vc;
        if (tn >= 0) { dma_k(wl, rsK, (unsigned)(32 * tn) * (PE_LD * 2), PE_LD * 2, kvo); dma_v(wl, rsV, (unsigned)tn * 4096u, 64, vvo); DMA_WAIT(); read_k(kc, la); }
        while (tn >= 0 && 32 * tn + 31 <= t0) { const int tc = tn, key0 = 32 * tc, j = tc >> 1;
            tn = NSA_NEXT_TILE(tc);
            LDS_DRAIN(); if (tn >= 0) dma_k(wl, rsK, (unsigned)(32 * tn) * (PE_LD * 2), PE_LD * 2, kvo);
            read_v(vc, la);
            const bool selj = ((j < 64 ? m0 : m1) >> (j & 63)) & 1ull;
            f32x16 s = qk32r(kc, qf);
            LDS_DRAIN_PINNED(); if (tn >= 0) dma_v(wl, rsV, (unsigned)tn * 4096u, 64, vvo);
            sm_fast(s, kc, qf, selj, m, l, o0, o1, pb);
            pv32r(o0, o1, vc, pb);
            if (tn >= 0) { DMA_WAIT(); read_k(kc, la); } }
        while (tn >= 0) { const int tc = tn, key0 = 32 * tc, j = tc >> 1;
            tn = NSA_NEXT_TILE(tc);
            LDS_DRAIN(); if (tn >= 0) dma_k(wl, rsK, (unsigned)(32 * tn) * (PE_LD * 2), PE_LD * 2, kvo);
            read_v(vc, la);
            const bool selj = ((j < 64 ? m0 : m1) >> (j & 63)) & 1ull;
            f32x16 s = qk32r(kc, qf);
            LDS_DRAIN_PINNED(); if (tn >= 0) dma_v(wl, rsV, (unsigned)tn * 4096u, 64, vvo);
            sm_step(s, kc, qf, 0, selj ? t - key0 : -1, hh, m, l, o0, o1, pb);
            pv32r(o0, o1, vc, pb);
            if (tn >= 0) { DMA_WAIT(); read_k(kc, la); } }
        l = xsum32(l);
        const float sc = (l > 0.f ? 1.f / l : 0.f) * p.GATES[row * 24 + head * 3 + 1];
#pragma unroll
        for (int reg = 0; reg < 16; ++reg) { outacc[reg] += o0[reg] * sc; outacc[16 + reg] += o1[reg] * sc; }
    }
    {
        f32x16 o0 = zero16(), o1 = zero16(); float m = ATT_NEG, l = 0.f;
        const bf16* k0p = p.PROJ + (size_t)b * cS * PE_LD + 896 + g * 64;
        const bf16* v0p = VT + vt_tile_off(16, b, 2 + g, 0);
        const rsrc_t rsK = mkrsrc(k0p), rsV = mkrsrc(v0p); const unsigned kvo = kvoff(lane, PE_LD), vvo = vvoff(lane, 32);
        const int k_lo = t0 >= 511 ? (t0 - 511) >> 5 : 0, k_hi = (t0 + 7) >> 5;
        KF kc; VF vc;
        dma_k(wl, rsK, (unsigned)(32 * k_lo) * (PE_LD * 2), PE_LD * 2, kvo); dma_v(wl, rsV, (unsigned)k_lo * 4096u, 64, vvo); DMA_WAIT(); read_k(kc, la);
#define WIN_TILE(SM_) { const int key0 = 32 * kt; \
            LDS_DRAIN(); if (kt < k_hi) dma_k(wl, rsK, (unsigned)(key0 + 32) * (PE_LD * 2), PE_LD * 2, kvo); \
            read_v(vc, la); \
            f32x16 s = qk32r(kc, qf); \
            LDS_DRAIN_PINNED(); if (kt < k_hi) dma_v(wl, rsV, (unsigned)(kt + 1) * 4096u, 64, vvo); \
            SM_; \
            pv32r(o0, o1, vc, pb); \
            if (kt < k_hi) { DMA_WAIT(); read_k(kc, la); } }
        int kt = k_lo;
        for (; kt <= k_hi && 32 * kt < t0 + 7 - 511; ++kt) WIN_TILE(sm_step(s, kc, qf, t - 511 - key0, 31, hh, m, l, o0, o1, pb))
        for (; kt <= k_hi && 32 * kt + 31 <= t0; ++kt) WIN_TILE(sm_fast(s, kc, qf, true, m, l, o0, o1, pb))
        for (; kt <= k_hi; ++kt) WIN_TILE(sm_step(s, kc, qf, 0, t - key0, hh, m, l, o0, o1, pb))
#undef WIN_TILE
        l = xsum32(l);
        const float sc = (l > 0.f ? 1.f / l : 0.f) * p.GATES[row * 24 + head * 3 + 2];
#pragma unroll
        for (int reg = 0; reg < 16; ++reg) { outacc[reg] += o0[reg] * sc; outacc[16 + reg] += o1[reg] * sc; }
    }
    store_row64(p.ATT + (size_t)row * 768 + head * 64, hh, outacc, 1.f);
}

__device__ __forceinline__ void cmp1_unit(const P& p, const bf16* W1T, const float* PEB, int u, int lane) {
    const int r = lane & 31, hh = lane >> 5;
    const int ct = u & 7, rt = (u >> 3) & 127, which = u >> 10;
    const int NR = cB * cNC * 2;
    int i = rt * 32 + r; if (i >= NR) i = NR - 1;
    const int g = i & 1, n = (i >> 1) % cNC, b = (i >> 1) / cNC;
    const bf16* ap = p.PROJ + (size_t)(b * cS + 16 * n) * PE_LD + 512 + which * 128 + g * 64 + 8 * hh;
    const bf16* bp = W1T + ((size_t)which * 256 + ct * 32 + r) * 2048 + 8 * hh;
    f32x16 acc = zero16();
    for (int l = 0; l < 32; ++l) {
#pragma unroll
        for (int q = 0; q < 4; ++q) { const bf16x8v a = *(const bf16x8v*)(ap + (size_t)l * PE_LD + 16 * q), bb = *(const bf16x8v*)(bp + l * 64 + 16 * q);
            acc = __builtin_amdgcn_mfma_f32_32x32x16_bf16(a, bb, acc, 0, 0, 0); } }
    const int j = ct * 32 + r; const float bias = PEB[which * 256 + j];
#pragma unroll
    for (int reg = 0; reg < 16; ++reg) { const int io = rt * 32 + (reg & 3) + 8 * (reg >> 2) + 4 * hh;
        if (io < NR) p.HID[((size_t)which * NR + io) * 256 + j] = gelu_tanh(acc[reg] + bias); }
}
__device__ __forceinline__ void gates_unit(const P& p, const bf16* WGT, int u, int lane) {
    const int r = lane & 31, hh = lane >> 5;
    const bf16* ap = p.Y + (size_t)(u * 32 + r) * cDM + 8 * hh; const bf16* bp = WGT + (size_t)r * cDM + 8 * hh;
    f32x16 acc = zero16();
#pragma unroll 8
    for (int ks = 0; ks < cDM / 16; ++ks) { const bf16x8v a = *(const bf16x8v*)(ap + 16 * ks), bb = *(const bf16x8v*)(bp + 16 * ks);
        acc = __builtin_amdgcn_mfma_f32_32x32x16_bf16(a, bb, acc, 0, 0, 0); }
    if (r < 24) {
#pragma unroll
        for (int reg = 0; reg < 16; ++reg) { const int row = u * 32 + (reg & 3) + 8 * (reg >> 2) + 4 * hh; p.GATES[(size_t)row * 24 + r] = 1.f / (1.f + __expf(-acc[reg])); } }
}

__device__ __forceinline__ float xlo32(float x) { float y; asm volatile("v_mov_b32 %0, %1\n\ts_nop 1" : "=v"(y) : "v"(x));
    auto r = __builtin_amdgcn_permlane32_swap(__builtin_bit_cast(unsigned, x), __builtin_bit_cast(unsigned, y), false, false); const unsigned a = r[0]; return __builtin_bit_cast(float, a); }
template <bool DIAG>
__device__ __forceinline__ void sb_tile(const f32x16& z, const VF& vc, const bf16x8v (&TA)[2], int r, int hh, float& carry, f32x16& o0, f32x16& o1) {
    f32x16 l1; float lbv[16];
#pragma unroll
    for (int reg = 0; reg < 16; ++reg) { const int ko = (reg & 3) + 8 * (reg >> 2) + 4 * hh; float zr = z[reg]; OPQ(zr); const float zz = zr * 0.125f;
        const float e = fexp2(-fabsf(zz) * 1.4426950408889634f); const float sp = __builtin_amdgcn_logf(1.f + e) * 0.6931471805599453f;
        float lb = fminf(zz, 0.f) - sp; OPQ(lb); lbv[reg] = lb; float x = (!DIAG || ko < r) ? lb - zz : 0.f; OPQ(x); l1[reg] = x; }
    unsigned bh[8], bl[8];
#pragma unroll
    for (int i = 0; i < 8; ++i) { const float x0 = l1[2 * i], x1 = l1[2 * i + 1]; const unsigned hw = cvtpk(x0, x1); bh[i] = hw; float d0 = x0 - bflo(hw), d1 = x1 - bfhi(hw); OPQ(d0); OPQ(d1); bl[i] = cvtpk(d0, d1); }
    f32x16 af = zero16();
    typedef unsigned u32x4v __attribute__((ext_vector_type(4)));
#pragma unroll
    for (int s = 0; s < 2; ++s) { const u32x4v wh = {bh[4 * s], bh[4 * s + 1], bh[4 * s + 2], bh[4 * s + 3]}, wl = {bl[4 * s], bl[4 * s + 1], bl[4 * s + 2], bl[4 * s + 3]};
        af = __builtin_amdgcn_mfma_f32_32x32x16_bf16(TA[s], __builtin_bit_cast(bf16x8v, wh), af, 0, 0, 0);
        af = __builtin_amdgcn_mfma_f32_32x32x16_bf16(TA[s], __builtin_bit_cast(bf16x8v, wl), af, 0, 0, 0); }
    unsigned pb[8]; float av[16];
#pragma unroll
    for (int reg = 0; reg < 16; ++reg) { const int ko = (reg & 3) + 8 * (reg >> 2) + 4 * hh;
        float t = lbv[reg] + af[reg]; OPQ(t); av[reg] = (!DIAG || ko < r) ? fexp2((t + carry) * 1.4426950408889634f) : 0.f; }
#pragma unroll
    for (int i = 0; i < 8; ++i) pb[i] = cvtpk(av[2 * i], av[2 * i + 1]);
    pv32r(o0, o1, vc, pb);
    carry += xlo32(af[0] + l1[0]);
}
__device__ __forceinline__ void sb_unit(const P& p, const bf16* VT, LAS unsigned char* wl, int b, int h, int t0, int lane) {
    const int r = lane & 31, hh = lane >> 5; const long row = (long)b * cS + t0 + r; const LaneAddr la = lane_addr(wl, lane);
    bf16x8v qf[4];
    { const bf16* qp = p.PROJ + (size_t)row * PO_LD + h * 64 + 8 * hh;
#pragma unroll
      for (int ks = 0; ks < 4; ++ks) qf[ks] = *(const bf16x8v*)(qp + 16 * ks); }
    bf16x8v TA[2];
#pragma unroll
    for (int s = 0; s < 2; ++s)
#pragma unroll
        for (int j = 0; j < 8; ++j) { const int kk = 16 * s + 8 * (j >> 2) + 4 * hh + (j & 3); TA[s][j] = (short)(kk > r ? 0x3F80 : 0); }
    f32x16 o0 = zero16(), o1 = zero16(); float carry = 0.f;
    const bf16* k0p = p.PROJ + (size_t)b * cS * PO_LD + cDM + h * 64;
    const bf16* v0p = VT + vt_tile_off(16, b, h, 0);
    const rsrc_t rsK = mkrsrc(k0p), rsV = mkrsrc(v0p); const unsigned kvo = kvoff(lane, PO_LD), vvo = vvoff(lane, 32);
    KF kc; VF vc;
    dma_k(wl, rsK, (unsigned)t0 * (PO_LD * 2), PO_LD * 2, kvo); dma_v(wl, rsV, (unsigned)(t0 >> 5) * 4096u, 64, vvo); DMA_WAIT(); read_k(kc, la);
#define SB_TILE(DIAG_, key0_) do { LDS_DRAIN(); if ((key0_) > 0) dma_k(wl, rsK, (unsigned)((key0_) - 32) * (PO_LD * 2), PO_LD * 2, kvo); \
        read_v(vc, la); const f32x16 z_ = qk32r(kc, qf); \
        LDS_DRAIN_PINNED(); if ((key0_) > 0) dma_v(wl, rsV, (unsigned)(((key0_) - 32) >> 5) * 4096u, 64, vvo); \
        sb_tile<DIAG_>(z_, vc, TA, r, hh, carry, o0, o1); } while (0)
    int kt = t0 >> 5;
    SB_TILE(true, t0);
    for (--kt; kt >= 0; --kt) { const int key0 = 32 * kt;
        DMA_WAIT(); read_k(kc, la);
        SB_TILE(false, key0);
        if (__all(carry < -93.f)) break; }
#undef SB_TILE
    DMA_WAIT();
    { float ov[32];
#pragma unroll
      for (int reg = 0; reg < 16; ++reg) { ov[reg] = o0[reg]; ov[16 + reg] = o1[reg]; }
      store_row64(p.ATT + (size_t)row * cDM + h * 64, hh, ov, 1.f); }
}

template <int G>
__device__ __forceinline__ void dil_unit(const P& p, const bf16* VT, const bf16* VTP, bf16* DOUT, float* DLSE, LAS unsigned char* wl, int b, int hd, int rc, int tile, int lane) {
    constexpr int dil = G == 0 ? 1 : G == 1 ? 4 : 16; constexpr int slot0 = 4 * G;
    const int r = lane & 31, hh = lane >> 5, slot = slot0 + hd; const LaneAddr la = lane_addr(wl, lane);
    const long row = (long)b * cS + rc + (long)dil * (32 * tile + r);
    bf16x8v qf[4];
    { const bf16* qp = p.PROJ + (size_t)row * PE_LD + 1024 + slot * 64 + 8 * hh;
#pragma unroll
      for (int ks = 0; ks < 4; ++ks) qf[ks] = *(const bf16x8v*)(qp + 16 * ks); }
    f32x16 o0 = zero16(), o1 = zero16(); float m = ATT_NEG, l = 0.f; unsigned pb[8];
    const bf16* k0p = p.PROJ + ((size_t)b * cS + rc) * PE_LD + 1792 + slot * 64;
    const bf16* v0p = G == 0 ? VT + vt_tile_off(16, b, 4 + slot, 0)
                             : VTP + vt_tile_off(8, b, (G - 1) * 4 + hd, rc * (cS / dil / 32));
    const rsrc_t rsK = mkrsrc(k0p), rsV = mkrsrc(v0p); const unsigned kvo = kvoff(lane, (size_t)dil * PE_LD), vvo = vvoff(lane, 32);
    const int k_lo = tile >= 4 ? tile - 4 : 0;
    KF kc; VF vc;
    dma_k(wl, rsK, (unsigned)(32 * k_lo) * (dil * PE_LD * 2), dil * PE_LD * 2, kvo); dma_v(wl, rsV, (unsigned)k_lo * 4096u, 64, vvo); DMA_WAIT(); read_k(kc, la);
    for (int kt = k_lo; kt <= tile; ++kt) { const int D0 = 32 * (tile - kt);
        LDS_DRAIN(); if (kt < tile) dma_k(wl, rsK, (unsigned)(32 * kt + 32) * (dil * PE_LD * 2), dil * PE_LD * 2, kvo);
        read_v(vc, la);
        f32x16 s = qk32r(kc, qf);
        LDS_DRAIN_PINNED(); if (kt < tile) dma_v(wl, rsV, (unsigned)(kt + 1) * 4096u, 64, vvo);
        if (D0 >= 32 && D0 <= 96) sm_fast(s, kc, qf, true, m, l, o0, o1, pb);
        else sm_step(s, kc, qf, D0 + r - 128, D0 + r, hh, m, l, o0, o1, pb);
        pv32r(o0, o1, vc, pb);
        if (kt < tile) { DMA_WAIT(); read_k(kc, la); } }
    l = xsum32(l);
    const float rl = 1.f / l;
    { float ov[32];
#pragma unroll
      for (int reg = 0; reg < 16; ++reg) { ov[reg] = o0[reg]; ov[16 + reg] = o1[reg]; }
      store_row64(DOUT + ((size_t)G * cM + row) * 256 + hd * 64, hh, ov, rl); }
    if (hh == 0) DLSE[((size_t)G * cM + row) * 4 + hd] = m + __builtin_amdgcn_logf(l);
}
namespace pg8 {
#define PG8_LAS __attribute__((address_space(3)))
typedef unsigned short bf16_t;
typedef short bf16x8 __attribute__((ext_vector_type(8)));
typedef float f32x4 __attribute__((ext_vector_type(4)));
typedef unsigned u32x4 __attribute__((ext_vector_type(4)));
constexpr int BM = 256, BK = 64, HALF = 128, HTB = HALF * BK * 2  , STAGE_BYTES = 8 * HTB, NXCD = 8, WGM = 8;

__host__ __device__ __forceinline__ int lds_byte(int r, int c) { const int st = (r >> 4) * 2 + (c >> 5), rr = r & 15, cc = c & 31, ob = rr * 64 + cc * 2; return st * 1024 + (ob ^ (((ob >> 9) & 1) << 5)); }
__host__ __device__ __forceinline__ void stage_rc(int b, int& R, int& C) { const int st = b / 1024, sb = b % 1024, swz = sb ^ (((sb >> 9) & 1) << 5); R = (st >> 1) * 16 + swz / 64; C = (st & 1) * 32 + (swz % 64) / 2; }
__host__ __device__ __forceinline__ int perm32(int rho) { const int n = rho >> 4, i = rho & 15; return 8 * (i >> 2) + 4 * n + (i & 3); }

struct Unit { int pm, pn; };
struct Gemm { const bf16_t* A; const bf16_t* Bt; int M, N, K; };

struct StaticOrder {
    int nM, nN, nwg, G, c;
    __host__ __device__ void init(int M, int N, int G_, int c_) { nM = M / BM; nN = N / BM; nwg = nM * nN; G = G_; c = c_; }
    __host__ __device__ bool next(int i, Unit& u) const {
        const long L = (long)i * G + c; if (L >= nwg) return false;
        int wgid = (int)L; { const int q = nwg / NXCD, r = nwg % NXCD, xcd = wgid % NXCD, off = wgid / NXCD; wgid = (xcd < r ? xcd * (q + 1) : r * (q + 1) + (xcd - r) * q) + off; }
        const int nig = WGM * nN, gid = wgid / nig, fm = gid * WGM, gsz = (nM - fm) < WGM ? (nM - fm) : WGM;
        u.pm = fm + ((wgid % nig) % gsz); u.pn = (wgid % nig) / gsz; return true;
    }
    __device__ __forceinline__ void a_ready(const Unit&) const {}
    __device__ __forceinline__ void done(const Unit&) const {}
};

__device__ __forceinline__ unsigned cvt_pk_bf16(float lo, float hi) { unsigned r; asm volatile("v_cvt_pk_bf16_f32 %0, %1, %2" : "=v"(r) : "v"(lo), "v"(hi)); return r; }
typedef float f32x2 __attribute__((ext_vector_type(2)));
__device__ __forceinline__ f32x2 gelu_pk(f32x2 v) {
    const f32x2 av = __builtin_elementwise_abs(v), d = av * 0.2316418882f + 1.0f;
    f32x2 t; t.x = __builtin_amdgcn_rcpf(d.x); t.y = __builtin_amdgcn_rcpf(d.y);
    f32x2 q = t * 0.5307027145f + (-0.7265760135f); q = q * t + 0.7107068705f; q = q * t + (-0.142248368f); q = q * t + 0.127414796f; q = q * t;
    const f32x2 s = (v * v) * (-0.72134752044f);
    f32x2 e; e.x = __builtin_amdgcn_exp2f(s.x); e.y = __builtin_amdgcn_exp2f(s.y);
    const f32x2 m = v * (q * e), r = v - m;
    f32x2 o; o.x = v.x < 0.f ? m.x : r.x; o.y = v.y < 0.f ? m.y : r.y; return o;
}

template <int ACT  > struct EpiBf16 {
    static constexpr bool PERM = true, AFTER_DRAIN = false, TABLE = false; static_assert(ACT == 0 || ACT == 1, "EpiBf16: ACT is 0 (none) or 1 (gelu_pk)");
    bf16_t* O; int ldc; const float* bias; int split_cols; size_t split_stride; float scale0;
    __device__ __forceinline__ void operator()(const f32x4 (&acc)[2][2][4][2], const Unit& u, int wr, int wc, int fr, int fq) const {
        const int row0 = u.pm * BM + wr * 64 + fr; int colt = u.pn * BM; bf16_t* base = O;
        float sc = 1.f; if (split_cols) { const int t = colt / split_cols; base += (size_t)t * split_stride; colt -= t * split_cols; if (t == 0) sc = scale0; }
        const int col0 = colt + wc * 32 + 8 * fq, bcol0 = u.pn * BM + wc * 32 + 8 * fq;
        f32x4 bv[2][2];
#pragma unroll
        for (int bj = 0; bj < 2; ++bj)
#pragma unroll
            for (int n = 0; n < 2; ++n) bv[bj][n] = bias ? *(const f32x4*)(bias + bcol0 + bj * HALF + 4 * n) : (f32x4){0.f, 0.f, 0.f, 0.f};
#pragma unroll
        for (int ai = 0; ai < 2; ++ai)
#pragma unroll
            for (int m = 0; m < 4; ++m) { bf16_t* rowp = base + (size_t)(row0 + ai * HALF + m * 16) * ldc + col0;
#pragma unroll
                for (int bj = 0; bj < 2; ++bj) { f32x4 v0 = acc[ai][bj][m][0] + bv[bj][0], v1 = acc[ai][bj][m][1] + bv[bj][1];
                    if (ACT == 1) { f32x2 a = gelu_pk((f32x2){v0[0], v0[1]}), b = gelu_pk((f32x2){v0[2], v0[3]}), c = gelu_pk((f32x2){v1[0], v1[1]}), d = gelu_pk((f32x2){v1[2], v1[3]});
                        v0 = (f32x4){a.x, a.y, b.x, b.y}; v1 = (f32x4){c.x, c.y, d.x, d.y}; }
                    v0 = v0 * sc; v1 = v1 * sc; u32x4 w; w.x = cvt_pk_bf16(v0[0], v0[1]); w.y = cvt_pk_bf16(v0[2], v0[3]); w.z = cvt_pk_bf16(v1[0], v1[1]); w.w = cvt_pk_bf16(v1[2], v1[3]);
                    *(u32x4*)(rowp + bj * HALF) = w; } }
    }
};
template <class Epi, class Sched, bool ALIGN_EPI = false, bool SP2 = false>
__device__ __forceinline__ void gemm_phase(PG8_LAS unsigned char* lds, const Gemm g, const Sched& S, const Epi& E) {
    int tid_ = threadIdx.x; asm volatile("" : "+v"(tid_));
    const int tid = tid_, wid = __builtin_amdgcn_readfirstlane(tid >> 6), lane = tid & 63, wr = wid >> 2, wc = wid & 3, fr = lane & 15, fq = lane >> 4;
    const int K = g.K, nt = K / BK;
    unsigned voffA[2], voffB[2];
#pragma unroll
    for (int i = 0; i < 2; ++i) { int R, C; stage_rc(tid * 16 + i * 8192, R, C); const int Rb = Epi::PERM ? ((R & ~31) + perm32(R & 31)) : R;
        voffA[i] = (unsigned)(R * K + C) * 2u; voffB[i] = (unsigned)(Rb * K + C) * 2u; }
    const size_t kstep = (size_t)(BK * 2);
    const size_t hstep = (size_t)HALF * K * 2;
    const size_t tstep = 2 * hstep;
    const unsigned ldsw = (unsigned)wid * 1024u;
    const int aoff = lds_byte(wr * 64 + fr, fq * 8), boff = lds_byte(wc * 32 + fr, fq * 8);
#define PG8_SA(b, h) (((b) * 2 + (h)) * HTB)
#define PG8_SB(b, h) ((4 + (b) * 2 + (h)) * HTB)
#define PG8_STAGE(bufoff, gbase, voff) do { _Pragma("unroll") for (int _i = 0; _i < 2; ++_i) \
        __builtin_amdgcn_global_load_lds((const unsigned*)((const char*)(gbase) + (voff)[_i]), (PG8_LAS unsigned*)(lds + (bufoff) + ldsw + _i * 8192), 16, 0, 0); } while (0)
#define PG8_LDA(dst, b, h) do { _Pragma("unroll") for (int m = 0; m < 4; ++m) _Pragma("unroll") for (int k = 0; k < 2; ++k) dst[m][k] = *(const PG8_LAS bf16x8*)(lds + PG8_SA(b, h) + aoff + m * 2048 + k * 1024); } while (0)
#define PG8_LDB(dst, b, h) do { _Pragma("unroll") for (int n = 0; n < 2; ++n) _Pragma("unroll") for (int k = 0; k < 2; ++k) dst[n][k] = *(const PG8_LAS bf16x8*)(lds + PG8_SB(b, h) + boff + n * 2048 + k * 1024); } while (0)
#define PG8_MMA(ai, bj, At, Bt) do { __builtin_amdgcn_s_setprio(1); _Pragma("unroll") for (int m = 0; m < 4; ++m) _Pragma("unroll") for (int n = 0; n < 2; ++n) _Pragma("unroll") for (int k = 0; k < 2; ++k) \
        acc[ai][bj][m][n] = __builtin_amdgcn_mfma_f32_16x16x32_bf16(Bt[n][k], At[m][k], acc[ai][bj][m][n], 0, 0, 0); __builtin_amdgcn_s_setprio(0); } while (0)
#define PG8_WAIT_V(n) asm volatile("s_waitcnt vmcnt(" #n ")" ::: "memory")
#define PG8_WAIT_L(n) asm volatile("s_waitcnt lgkmcnt(" #n ")" ::: "memory")
#define PG8_BAR __builtin_amdgcn_s_barrier()
#define PG8_SCHED __builtin_amdgcn_sched_barrier(0)
    Unit cur, nxt; int ui = 0;
    if (!S.next(0, cur)) return;
    f32x4 acc[2][2][4][2];
#pragma unroll
    for (int a = 0; a < 2; ++a)
#pragma unroll
        for (int b = 0; b < 2; ++b)
#pragma unroll
            for (int m = 0; m < 4; ++m)
#pragma unroll
                for (int n = 0; n < 2; ++n) acc[a][b][m][n] = (f32x4){0.f, 0.f, 0.f, 0.f};
    bf16x8 At[4][2], B0[2][2], B1[2][2];
    const char* cA = (const char*)g.A + (size_t)cur.pm * tstep; const char* cB = (const char*)g.Bt + (size_t)cur.pn * tstep;
    S.a_ready(cur);
    if constexpr (SP2) {
        PG8_STAGE(PG8_SB(0, 0), cB, voffB); PG8_STAGE(PG8_SB(0, 1), cB + hstep, voffB); PG8_STAGE(PG8_SA(0, 0), cA, voffA); PG8_STAGE(PG8_SA(0, 1), cA + hstep, voffA);
        if (wr == 1) PG8_BAR;
        PG8_WAIT_V(2); PG8_BAR;
        PG8_STAGE(PG8_SB(1, 0), cB + kstep, voffB); PG8_STAGE(PG8_SA(1, 0), cA + kstep, voffA); PG8_STAGE(PG8_SB(1, 1), cB + hstep + kstep, voffB);
        PG8_WAIT_V(6); PG8_BAR;
    } else {
        PG8_STAGE(PG8_SB(0, 0), cB, voffB); PG8_STAGE(PG8_SA(0, 0), cA, voffA); PG8_STAGE(PG8_SB(0, 1), cB + hstep, voffB); PG8_STAGE(PG8_SA(0, 1), cA + hstep, voffA);
        if (wr == 1) PG8_BAR;
        PG8_WAIT_V(4); PG8_BAR;
        PG8_STAGE(PG8_SB(1, 0), cB + kstep, voffB); PG8_STAGE(PG8_SA(1, 0), cA + kstep, voffA); PG8_STAGE(PG8_SB(1, 1), cB + hstep + kstep, voffB);
        PG8_WAIT_V(6); PG8_BAR;
    }
    for (;;) {
        const bool has_next = S.next(ui + 1, nxt);
        if constexpr (Epi::TABLE) { if (tid < 256) E.stage_table(cur, lds + 131072 + (ui & 1) * 4096, tid); }
        const char* nA = has_next ? (const char*)g.A + (size_t)nxt.pm * tstep : cA; const char* nB = has_next ? (const char*)g.Bt + (size_t)nxt.pn * tstep : cB;
        for (int t = 0; t < nt; t += 2) {
            const bool last = (t == nt - 2);
            const char* a1 = cA + (size_t)(t + 1) * kstep;
            const char* a2 = last ? nA : cA + (size_t)(t + 2) * kstep; const char* b2 = last ? nB : cB + (size_t)(t + 2) * kstep;
            const char* a3 = a2 + kstep; const char* b3 = b2 + kstep;
            if (last && has_next) S.a_ready(nxt);
            if constexpr (SP2) {
            PG8_LDB(B0, 0, 0); PG8_LDB(B1, 0, 1); PG8_SCHED; PG8_LDA(At, 0, 0); PG8_STAGE(PG8_SA(1, 1), a1 + hstep, voffA);
            PG8_WAIT_V(8); PG8_WAIT_L(0); PG8_BAR; PG8_MMA(0, 0, At, B0); PG8_MMA(0, 1, At, B1); PG8_BAR; PG8_SCHED;
            PG8_LDA(At, 0, 1); PG8_STAGE(PG8_SB(0, 0), b2, voffB); PG8_STAGE(PG8_SB(0, 1), b2 + hstep, voffB); PG8_STAGE(PG8_SA(0, 0), a2, voffA);
            PG8_WAIT_V(8); PG8_WAIT_L(0); PG8_BAR; PG8_MMA(1, 0, At, B0); PG8_MMA(1, 1, At, B1); PG8_BAR; PG8_SCHED;
            PG8_LDB(B0, 1, 0); PG8_LDB(B1, 1, 1); PG8_SCHED; PG8_LDA(At, 1, 0); PG8_STAGE(PG8_SA(0, 1), a2 + hstep, voffA);
            PG8_WAIT_V(8); PG8_WAIT_L(0); PG8_BAR; PG8_MMA(0, 0, At, B0); PG8_MMA(0, 1, At, B1); PG8_BAR; PG8_SCHED;
            PG8_LDA(At, 1, 1); PG8_STAGE(PG8_SB(1, 0), b3, voffB); PG8_STAGE(PG8_SB(1, 1), b3 + hstep, voffB); PG8_STAGE(PG8_SA(1, 0), a3, voffA);
            PG8_WAIT_V(8); PG8_WAIT_L(0); PG8_BAR; PG8_MMA(1, 0, At, B0); PG8_MMA(1, 1, At, B1); PG8_BAR; PG8_SCHED;
            } else {
            PG8_LDB(B0, 0, 0); PG8_SCHED; PG8_LDA(At, 0, 0); PG8_STAGE(PG8_SA(1, 1), a1 + hstep, voffA);
            PG8_WAIT_L(8); PG8_BAR; PG8_WAIT_L(0); PG8_MMA(0, 0, At, B0); PG8_BAR; PG8_SCHED;
            PG8_LDB(B1, 0, 1); PG8_STAGE(PG8_SB(0, 0), b2, voffB);
            PG8_BAR; PG8_WAIT_L(0); PG8_MMA(0, 1, At, B1); PG8_BAR;
            PG8_LDA(At, 0, 1); PG8_STAGE(PG8_SA(0, 0), a2, voffA);
            PG8_BAR; PG8_WAIT_L(0); PG8_MMA(1, 0, At, B0); PG8_BAR; PG8_SCHED;
            PG8_STAGE(PG8_SB(0, 1), b2 + hstep, voffB);
            PG8_WAIT_V(6); PG8_BAR; PG8_MMA(1, 1, At, B1); PG8_BAR;
            PG8_LDB(B0, 1, 0); PG8_SCHED; PG8_LDA(At, 1, 0); PG8_STAGE(PG8_SA(0, 1), a2 + hstep, voffA);
            PG8_WAIT_L(8); PG8_BAR; PG8_WAIT_L(0); PG8_MMA(0, 0, At, B0); PG8_BAR; PG8_SCHED;
            PG8_LDB(B1, 1, 1); PG8_STAGE(PG8_SB(1, 0), b3, voffB);
            PG8_BAR; PG8_WAIT_L(0); PG8_MMA(0, 1, At, B1); PG8_BAR;
            PG8_LDA(At, 1, 1); PG8_STAGE(PG8_SA(1, 0), a3, voffA);
            PG8_BAR; PG8_WAIT_L(0); PG8_MMA(1, 0, At, B0); PG8_BAR; PG8_SCHED;
            PG8_STAGE(PG8_SB(1, 1), b3 + hstep, voffB);
            PG8_WAIT_V(6); PG8_BAR; PG8_MMA(1, 1, At, B1); PG8_BAR;
            }
        }
        if constexpr (ALIGN_EPI) { if (wr == 0) PG8_BAR; }
        if constexpr (!Epi::AFTER_DRAIN) { if constexpr (Epi::TABLE) E.run(acc, cur, wr, wc, fr, fq, lds + 131072 + (ui & 1) * 4096); else E(acc, cur, wr, wc, fr, fq); S.done(cur); }
        if (!has_next) break;
#pragma unroll
        for (int a = 0; a < 2; ++a)
#pragma unroll
            for (int b = 0; b < 2; ++b)
#pragma unroll
                for (int m = 0; m < 4; ++m)
#pragma unroll
                    for (int n = 0; n < 2; ++n) acc[a][b][m][n] = (f32x4){0.f, 0.f, 0.f, 0.f};
        cur = nxt; cA = nA; cB = nB; ++ui;
        if constexpr (ALIGN_EPI) { if (wr == 1) PG8_BAR; }
    }
    PG8_WAIT_V(0);
    if constexpr (!ALIGN_EPI) { if (wr == 0) PG8_BAR; }
    PG8_BAR;
    if constexpr (Epi::AFTER_DRAIN) { E.fused(acc, cur, wr, wc, fr, fq, lds, wid, lane); S.done(cur); }
#undef PG8_SA
#undef PG8_SB
#undef PG8_STAGE
#undef PG8_LDA
#undef PG8_LDB
#undef PG8_MMA
#undef PG8_WAIT_V
#undef PG8_WAIT_L
#undef PG8_BAR
#undef PG8_SCHED
}
}
namespace pg8 {
struct EpiRopeE {
    static constexpr bool PERM = true, AFTER_DRAIN = false, TABLE = false;
    bf16_t* O; int ldc; const float* rope;
    __device__ __forceinline__ void operator()(const f32x4 (&acc)[2][2][4][2], const Unit& u, int wr, int wc, int fr, int fq) const {
        const int row0 = u.pm * BM + wr * 64 + fr;
        if (u.pn == 2) {
            const int col0 = u.pn * BM + wc * 32 + 8 * fq;
#pragma unroll
            for (int ai = 0; ai < 2; ++ai)
#pragma unroll
                for (int m = 0; m < 4; ++m) { bf16_t* rowp = O + (size_t)(row0 + ai * HALF + m * 16) * ldc + col0;
#pragma unroll
                    for (int bj = 0; bj < 2; ++bj) { const f32x4 v0 = acc[ai][bj][m][0], v1 = acc[ai][bj][m][1]; u32x4 w;
                        w.x = cvt_pk_bf16(v0[0], v0[1]); w.y = cvt_pk_bf16(v0[2], v0[3]); w.z = cvt_pk_bf16(v1[0], v1[1]); w.w = cvt_pk_bf16(v1[2], v1[3]); *(u32x4*)(rowp + bj * HALF) = w; } }
        } else {
            const int kk = 4 * (wc & 1) + fq;
#pragma unroll
            for (int ai = 0; ai < 2; ++ai)
#pragma unroll
                for (int m = 0; m < 4; ++m) { const int row = row0 + ai * HALF + m * 16, pos = row & (cS - 1);
                    const f32x4 c0 = *(const f32x4*)(rope + (size_t)(pos * 32 + 4 * kk) * 2), c1 = *(const f32x4*)(rope + (size_t)(pos * 32 + 4 * kk) * 2 + 4);
#pragma unroll
                    for (int bj = 0; bj < 2; ++bj) { const f32x4 x1 = acc[ai][bj][m][0], x2 = acc[ai][bj][m][1];
                        bf16_t* op = O + (size_t)row * ldc + u.pn * BM + (2 * bj + (wc >> 1)) * 64 + 4 * kk;
                        const unsigned ax = cvt_pk_bf16(x1[0] * c0[0] - x2[0] * c0[1], x1[1] * c0[2] - x2[1] * c0[3]), ay = cvt_pk_bf16(x1[2] * c1[0] - x2[2] * c1[1], x1[3] * c1[2] - x2[3] * c1[3]);
                        const unsigned bx = cvt_pk_bf16(x2[0] * c0[0] + x1[0] * c0[1], x2[1] * c0[2] + x1[1] * c0[3]), by = cvt_pk_bf16(x2[2] * c1[0] + x1[2] * c1[1], x2[3] * c1[2] + x1[3] * c1[3]);
                        auto rx = __builtin_amdgcn_permlane16_swap(ax, bx, false, false); auto ry = __builtin_amdgcn_permlane16_swap(ay, by, false, false);
                        u32x4 w; w.x = rx[0]; w.y = ry[0]; w.z = rx[1]; w.w = ry[1];
                        *(u32x4*)((fq & 1) ? op + 32 - 4 : op) = w; } }
        }
    }
};
struct EpiVT {
    static constexpr bool PERM = true, AFTER_DRAIN = false, TABLE = false;
    bf16_t* O;
    __device__ __forceinline__ void operator()(const f32x4 (&acc)[2][2][4][2], const Unit& u, int wr, int wc, int fr, int fq) const {
        const int row0 = u.pm * BM + wr * 64 + fr, col0 = u.pn * BM + wc * 32 + 8 * fq;
#pragma unroll
        for (int ai = 0; ai < 2; ++ai)
#pragma unroll
            for (int m = 0; m < 4; ++m) { const int dg = row0 + ai * HALF + m * 16;
#pragma unroll
                for (int bj = 0; bj < 2; ++bj) { const int col = col0 + bj * HALF, b = col / cS, tk = col & (cS - 1);
                    const f32x4 v0 = acc[ai][bj][m][0], v1 = acc[ai][bj][m][1]; u32x4 w;
                    w.x = cvt_pk_bf16(v0[0], v0[1]); w.y = cvt_pk_bf16(v0[2], v0[3]); w.z = cvt_pk_bf16(v1[0], v1[1]); w.w = cvt_pk_bf16(v1[2], v1[3]);
                    *(u32x4*)(O + vt_elem_off(16, b, dg, tk)) = w; } }
    }
};
__device__ __forceinline__ float ror1f(float x) { return __builtin_bit_cast(float, __builtin_amdgcn_mov_dpp(__builtin_bit_cast(int, x), 0x121, 0xF, 0xF, false)); }
__device__ __forceinline__ float ror2f(float x) { return __builtin_bit_cast(float, __builtin_amdgcn_mov_dpp(__builtin_bit_cast(int, x), 0x122, 0xF, 0xF, false)); }
__device__ __forceinline__ float gelu_fast(float x) { const float w = __builtin_fmaf(x * x, -2.3022081981f * 0.044715f, -2.3022081981f); return x * __builtin_amdgcn_rcpf(1.f + __builtin_amdgcn_exp2f(x * w)); }
struct EpiConvGelu {
    static constexpr bool PERM = true, AFTER_DRAIN = false, TABLE = true;
    bf16_t* ACT; const float* cw; const float* cb; float* SB;
    __device__ __forceinline__ void stage_table(const Unit& u, PG8_LAS unsigned char* tab, int tid) const {
        constexpr int LD2 = 2 * cDFF; const int v = tid >> 5, c4 = tid & 31, j = u.pn * 128 + 4 * c4;
        const float* src = ((v & 3) == 3 ? cb : cw + (v & 3) * LD2) + (v >> 2) * cDFF + j;
        *(PG8_LAS f32x4*)(tab + (v * 128 + 4 * c4) * 4) = *(const f32x4*)src; }
    __device__ __forceinline__ void run(const f32x4 (&acc)[2][2][4][2], const Unit& u, int wr, int wc, int fr, int fq, const PG8_LAS unsigned char* tab) const {
        constexpr int LD2 = 2 * cDFF;
        typedef unsigned u32x2 __attribute__((ext_vector_type(2)));
        u32x2 hold[2][4];
#pragma unroll
        for (int n = 0; n < 2; ++n) {
            const int ch0 = wc * 32 + 8 * fq + 4 * n, j0 = u.pn * 128 + ch0;
            const PG8_LAS f32x4* tv = (const PG8_LAS f32x4*)(tab + ch0 * 4);
            const f32x4 w0g = tv[0], w1g = tv[32], w2g = tv[64], bg = tv[96], w0v = tv[128], w1v = tv[160], w2v = tv[192], bv = tv[224];
#pragma unroll
            for (int ai = 0; ai < 2; ++ai) { const int rb = u.pm * BM + ai * HALF + wr * 64, blk = rb >> 6;
                f32x4 pg1, pg2, pv1, pv2;
#pragma unroll
                for (int m = 0; m < 4; ++m) { const f32x4 g = acc[ai][0][m][n], v = acc[ai][1][m][n]; const int row = rb + 16 * m + fr;
                    f32x4 g1, g2, v1, v2;
#pragma unroll
                    for (int e = 0; e < 4; ++e) { g1[e] = ror1f(g[e]); g2[e] = ror2f(g[e]); v1[e] = ror1f(v[e]); v2[e] = ror2f(v[e]); }
                    f32x4 a1g = g1, a2g = g2, a1v = v1, a2v = v2;
                    if (m > 0) { if (fr < 1) { a1g = pg1; a1v = pv1; } if (fr < 2) { a2g = pg2; a2v = pv2; } }
                    pg1 = g1; pg2 = g2; pv1 = v1; pv2 = v2;
                    if (m > 0 || fr >= 2) { float o[4];
#pragma unroll
                        for (int e = 0; e < 4; ++e) { const float cg = bg[e] + w0g[e] * a2g[e] + w1g[e] * a1g[e] + w2g[e] * g[e], cv = bv[e] + w0v[e] * a2v[e] + w1v[e] * a1v[e] + w2v[e] * v[e]; o[e] = gelu_fast(cg) * cv; }
                        u32x2 w; w.x = cvt_pk_bf16(o[0], o[1]); w.y = cvt_pk_bf16(o[2], o[3]);
                        if (n == 0) hold[ai][m] = w; else { u32x4 q; q.x = hold[ai][m].x; q.y = hold[ai][m].y; q.z = w.x; q.w = w.y; *(u32x4*)(ACT + (size_t)row * cDFF + j0 - 4) = q; } }
                    if (m == 0 && fr < 2) { float* sp = SB + ((size_t)blk * 4 + fr) * LD2; *(f32x4*)(sp + j0) = g; *(f32x4*)(sp + cDFF + j0) = v; }
                    if (m == 3 && fr >= 14) { float* sp = SB + ((size_t)blk * 4 + 2 + (fr - 14)) * LD2; *(f32x4*)(sp + j0) = g; *(f32x4*)(sp + cDFF + j0) = v; }
                } }
        }
    }
};
}
#define XB_TMO      128
#define XB_XCNT(j)  (256  + 64 * (j))
#define XB_XSUB(j)  (1280 + 64 * (j))
#define XB_XGEN(j)  (2304 + 64 * (j))
#define XB_TOP      3328
#define XB_TOPGEN   3392
#define XCD_BAR_WORDS 3456
#define XB_SPIN_CAP (1u << 18)

__device__ __forceinline__ unsigned xb_ld(unsigned* p)              { return __hip_atomic_load(p, __ATOMIC_RELAXED, __HIP_MEMORY_SCOPE_AGENT); }
__device__ __forceinline__ unsigned xb_add(unsigned* p, unsigned v) { return __hip_atomic_fetch_add(p, v, __ATOMIC_RELAXED, __HIP_MEMORY_SCOPE_AGENT); }
__device__ __forceinline__ unsigned xb_xcc_id() { return (unsigned)__builtin_amdgcn_s_getreg((3 << 11) | 20) & 0xFu; }
#define XB_SPIN(cond, bar) do { unsigned _sp = 0; while (cond) { __builtin_amdgcn_s_sleep(1); \
    if ((++_sp & 255u) == 0u) { if (xb_ld(&(bar)[XB_TMO])) break; if (_sp > XB_SPIN_CAP) { atomicAdd(&(bar)[XB_TMO], 1u); break; } } } } while (0)

struct XcdBarrier {
    unsigned* bar; unsigned x;
    volatile LAS unsigned* st;
};

__device__ __forceinline__ XcdBarrier xcd_barrier_post(unsigned* bar, volatile LAS unsigned* st) {
    XcdBarrier b; b.bar = bar; b.x = xb_xcc_id(); b.st = st;
    if (threadIdx.x == 0) (void)xb_add(&bar[XB_XCNT(b.x)], 1u);
    return b;
}
__device__ __forceinline__ void xcd_barrier_complete(unsigned* bar, unsigned x, unsigned& nloc, unsigned& nx) {
    const unsigned G = gridDim.x * gridDim.y * gridDim.z;
    unsigned sum, cnt, mine, sp = 0u;
    for (;;) {
        sum = 0u; cnt = 0u; mine = 0u;
#pragma unroll
        for (unsigned j = 0; j < 16; ++j) { const unsigned c = xb_ld(&bar[XB_XCNT(j)]); sum += c; cnt += (c > 0u) ? 1u : 0u; mine = (j == x) ? c : mine; }
        if (sum == G) break;
        __builtin_amdgcn_s_sleep(1);
        if ((++sp & 255u) == 0u) { if (xb_ld(&bar[XB_TMO])) break; if (sp > XB_SPIN_CAP) { atomicAdd(&bar[XB_TMO], 1u); break; } }
    }
    nloc = mine > 0u ? mine : 1u; nx = cnt > 0u ? cnt : 1u;
}

__device__ __forceinline__ void xcd_barrier(const XcdBarrier& b) {
    asm volatile("s_waitcnt vmcnt(0)" ::: "memory");
    __syncthreads();
    if (threadIdx.x == 0) {
        unsigned* bar = b.bar;
        __builtin_amdgcn_s_waitcnt(0);
        unsigned nloc = b.st[0], nx = b.st[1];
        if (nloc == 0u) { xcd_barrier_complete(bar, b.x, nloc, nx); b.st[0] = nloc; b.st[1] = nx; }
        const unsigned old = xb_add(&bar[XB_XSUB(b.x)], 1u);
        const unsigned gen = old / nloc;
        if (old + 1u == (gen + 1u) * nloc) {
            __builtin_amdgcn_fence(__ATOMIC_RELEASE, "agent");
            asm volatile("s_waitcnt vmcnt(0)" ::: "memory");
            const unsigned og = xb_add(&bar[XB_TOP], 1u);
            const unsigned tg = og / nx;
            if (og + 1u == (tg + 1u) * nx) xb_add(&bar[XB_TOPGEN], 1u);
            else XB_SPIN(xb_ld(&bar[XB_TOPGEN]) == tg, bar);
            __builtin_amdgcn_fence(__ATOMIC_ACQUIRE, "agent");
            xb_add(&bar[XB_XGEN(b.x)], 1u);
            asm volatile("s_waitcnt vmcnt(0)" ::: "memory");
        } else {
            XB_SPIN(xb_ld(&bar[XB_XGEN(b.x)]) == gen, bar);
            __builtin_amdgcn_fence(__ATOMIC_ACQUIRE, "agent");
            asm volatile("s_waitcnt vmcnt(0)" ::: "memory");
        }
    }
    __syncthreads();
}
constexpr int NWAVES = 8, NTHREADS = 512;
constexpr size_t MiB = 1u << 20;
constexpr size_t WS_CTL = 0, CTL_ZERO_BYTES = 65536;
constexpr size_t WS_WGT = 128 * 1024, WS_PEB = 256 * 1024;
constexpr size_t WS_WIN = 1 * MiB, WS_WV = 6 * MiB, WS_WOUT = 8 * MiB, WS_WUP = 10 * MiB, WS_WDN = 21 * MiB, WS_ROPE = 27 * MiB, WS_GATES = 29 * MiB, WS_KCMP = 32 * MiB,
                 WS_HID = 33 * MiB, WS_VCT = 41 * MiB, WS_W1T = 42 * MiB, WS_Y = 44 * MiB, WS_ATT = 44 * MiB  ,
                 WS_H16 = 108 * MiB  , WS_PROJ = 172 * MiB, WS_VT = 340 * MiB, WS_ACT = 172 * MiB  ,
                 WS_SB = 348 * MiB  , WS_Y2 = 406 * MiB,
                 WS_DOUT = 406 * MiB  , WS_DLSE = 454 * MiB, WS_VTP = 470 * MiB, WS_END = 504 * MiB;
static_assert((size_t)3 * cM * 256 * 2 <= WS_DLSE - WS_DOUT && WS_DLSE + (size_t)3 * cM * 4 * 4 <= WS_VTP && WS_VTP + (size_t)512 * VT_LD * 2 <= WS_END && (size_t)cM * PE_LD * 2 <= WS_VT - WS_PROJ && (size_t)1024 * VT_LD * 2 <= WS_Y2 - WS_VT
              && WS_ACT + (size_t)cM * cDFF * 2 <= WS_SB && WS_SB + (size_t)(cM / 64) * 4 * 2 * cDFF * 4 <= WS_Y2 && WS_H16 + (size_t)cM * cDM * 2 <= WS_PROJ, "workspace map");
constexpr int CW_BAR = 4096;
constexpr int RING_BYTES = 131072, LDSCTL_OFF = 8 * 17408  , MISC_OFF = LDSCTL_OFF + 320, LDS_BYTES = 147456;
typedef float f32x4 __attribute__((ext_vector_type(4)));

__device__ __forceinline__ int opaque(int x) { asm volatile("" : "+v"(x)); return x; }
__device__ __forceinline__ float wave_sum(float v) {
#pragma unroll
    for (int o = 1; o < 64; o <<= 1) v += __shfl_xor(v, o);
    return v;
}
__device__ __forceinline__ void n_row_dev(const float* xrow, const float* g, bf16* yrow, int lane) {
    float v[16]; float ss = 0.f;
#pragma unroll
    for (int j = 0; j < 2; ++j)
#pragma unroll
        for (int q = 0; q < 2; ++q) { const f32x4 t = *(const f32x4*)(xrow + 8 * lane + 512 * j + 4 * q);
            v[8 * j + 4 * q + 0] = t.x; v[8 * j + 4 * q + 1] = t.y; v[8 * j + 4 * q + 2] = t.z; v[8 * j + 4 * q + 3] = t.w; ss += t.x * t.x + t.y * t.y + t.z * t.z + t.w * t.w; }
    const float r = 1.f / sqrtf(wave_sum(ss) * (1.f / cDM) + 1e-6f);
#pragma unroll
    for (int j = 0; j < 2; ++j) { const float* gp = g + 8 * lane + 512 * j; U4 o;
        o.x = cvtpk(v[8 * j + 0] * r * gp[0], v[8 * j + 1] * r * gp[1]); o.y = cvtpk(v[8 * j + 2] * r * gp[2], v[8 * j + 3] * r * gp[3]);
        o.z = cvtpk(v[8 * j + 4] * r * gp[4], v[8 * j + 5] * r * gp[5]); o.w = cvtpk(v[8 * j + 6] * r * gp[6], v[8 * j + 7] * r * gp[7]);
        *(U4*)(yrow + 8 * lane + 512 * j) = o; }
}
template <bool HIN_F32, bool HOUT_F32>
__device__ __forceinline__ void nrn_row_dev(const void* hin_, const bf16* y2, const float* g1, const float* g2, void* hout_, bf16* yrow, int lane) {
    float v[16]; float ss = 0.f;
#pragma unroll
    for (int j = 0; j < 2; ++j) { const U4 t = *(const U4*)(y2 + 8 * lane + 512 * j);
        v[8 * j + 0] = bflo(t.x); v[8 * j + 1] = bfhi(t.x); v[8 * j + 2] = bflo(t.y); v[8 * j + 3] = bfhi(t.y); v[8 * j + 4] = bflo(t.z); v[8 * j + 5] = bfhi(t.z); v[8 * j + 6] = bflo(t.w); v[8 * j + 7] = bfhi(t.w); }
#pragma unroll
    for (int e = 0; e < 16; ++e) ss += v[e] * v[e];
    const float r = 1.f / sqrtf(wave_sum(ss) * (1.f / cDM) + 1e-6f);
    float s2 = 0.f;
#pragma unroll
    for (int j = 0; j < 2; ++j) { const int e0 = 8 * lane + 512 * j; float hv[8];
        if (HIN_F32) { const f32x4 a = *(const f32x4*)((const float*)hin_ + e0), b = *(const f32x4*)((const float*)hin_ + e0 + 4); hv[0] = a.x; hv[1] = a.y; hv[2] = a.z; hv[3] = a.w; hv[4] = b.x; hv[5] = b.y; hv[6] = b.z; hv[7] = b.w; }
        else { const U4 t = *(const U4*)((const bf16*)hin_ + e0); hv[0] = bflo(t.x); hv[1] = bfhi(t.x); hv[2] = bflo(t.y); hv[3] = bfhi(t.y); hv[4] = bflo(t.z); hv[5] = bfhi(t.z); hv[6] = bflo(t.w); hv[7] = bfhi(t.w); }
        const f32x4 ga = *(const f32x4*)(g1 + e0), gb = *(const f32x4*)(g1 + e0 + 4); const float gg[8] = {ga.x, ga.y, ga.z, ga.w, gb.x, gb.y, gb.z, gb.w};
#pragma unroll
        for (int e = 0; e < 8; ++e) { const float hn = hv[e] + v[8 * j + e] * r * gg[e]; v[8 * j + e] = hn; }
        if (HOUT_F32) { f32x4 a, b; a.x = v[8 * j]; a.y = v[8 * j + 1]; a.z = v[8 * j + 2]; a.w = v[8 * j + 3]; b.x = v[8 * j + 4]; b.y = v[8 * j + 5]; b.z = v[8 * j + 6]; b.w = v[8 * j + 7];
            *(f32x4*)((float*)hout_ + e0) = a; *(f32x4*)((float*)hout_ + e0 + 4) = b; }
        else { U4 o; o.x = cvtpk(v[8 * j], v[8 * j + 1]); o.y = cvtpk(v[8 * j + 2], v[8 * j + 3]);
            o.z = cvtpk(v[8 * j + 4], v[8 * j + 5]); o.w = cvtpk(v[8 * j + 6], v[8 * j + 7]);
            *(U4*)((bf16*)hout_ + e0) = o;
            v[8 * j + 0] = bflo(o.x); v[8 * j + 1] = bfhi(o.x); v[8 * j + 2] = bflo(o.y); v[8 * j + 3] = bfhi(o.y); v[8 * j + 4] = bflo(o.z); v[8 * j + 5] = bfhi(o.z); v[8 * j + 6] = bflo(o.w); v[8 * j + 7] = bfhi(o.w); }
#pragma unroll
        for (int e = 0; e < 8; ++e) s2 += v[8 * j + e] * v[8 * j + e]; }
    if (g2) { const float r2 = 1.f / sqrtf(wave_sum(s2) * (1.f / cDM) + 1e-6f);
#pragma unroll
        for (int j = 0; j < 2; ++j) { const float* gp = g2 + 8 * lane + 512 * j; U4 o;
            o.x = cvtpk(v[8 * j + 0] * r2 * gp[0], v[8 * j + 1] * r2 * gp[1]); o.y = cvtpk(v[8 * j + 2] * r2 * gp[2], v[8 * j + 3] * r2 * gp[3]);
            o.z = cvtpk(v[8 * j + 4] * r2 * gp[4], v[8 * j + 5] * r2 * gp[5]); o.w = cvtpk(v[8 * j + 6] * r2 * gp[6], v[8 * j + 7] * r2 * gp[7]);
            *(U4*)(yrow + 8 * lane + 512 * j) = o; } }
}

template <int K, int ldw, int N, int mode, int c0>
__device__ __forceinline__ void wprep_tile(const float* W, bf16* Bt, int tile, int lane, LAS float* scr) {
    constexpr int nblk = N / 32; const int kb = tile / nblk, nb = tile % nblk, k0 = 64 * kb, n0 = 32 * nb;
    const int c4 = 4 * (lane & 7), col = c0 + (mode ? wsrc_col(mode, n0 + c4) : n0 + c4);
#pragma unroll
    for (int i = 0; i < 8; ++i) { const int kk = 8 * i + (lane >> 3); const f32x4 t = *(const f32x4*)(W + (size_t)(k0 + kk) * ldw + col);
        scr[kk * 33 + c4] = t.x; scr[kk * 33 + c4 + 1] = t.y; scr[kk * 33 + c4 + 2] = t.z; scr[kk * 33 + c4 + 3] = t.w; }
    const int c = lane & 7;
#pragma unroll
    for (int j = 0; j < 4; ++j) { const int n = (lane >> 3) + 8 * j; const LAS float* s = scr + (8 * c) * 33 + n;
        U4 o; o.x = cvtpk(s[0], s[33]); o.y = cvtpk(s[2 * 33], s[3 * 33]);
        o.z = cvtpk(s[4 * 33], s[5 * 33]); o.w = cvtpk(s[6 * 33], s[7 * 33]);
        *(U4*)(Bt + (size_t)(n0 + n) * K + k0 + 8 * c) = o; }
    asm volatile("s_waitcnt lgkmcnt(0)" ::: "memory");
}
struct Args { const float* in[13]; float* out; unsigned char* ws; };

__global__ void __launch_bounds__(NTHREADS, 2) fwd(Args a) {
    extern __shared__ __attribute__((aligned(16))) unsigned char lds[];
    LAS unsigned char* L = (LAS unsigned char*)lds;
    const int tid = threadIdx.x, lane = tid & 63, wave = __builtin_amdgcn_readfirstlane(tid >> 6);
#define VCU() ((gridDim.x % 8 == 0) ? (int)((blockIdx.x % 8) * (gridDim.x / 8) + blockIdx.x / 8) : (int)blockIdx.x)
    for (int u = tid; u < (LDS_BYTES - LDSCTL_OFF) / 4; u += NTHREADS) ((LAS unsigned*)(L + LDSCTL_OFF))[u] = 0u;
    __syncthreads();
    XcdBarrier bar;
    { unsigned char* ws0 = a.ws; bar = xcd_barrier_post((unsigned*)(ws0 + WS_CTL) + CW_BAR, (volatile LAS unsigned*)(L + MISC_OFF) + 8); }
#define MKP() P p; unsigned char* wsb; { int z_ = 0; asm volatile("" : "+s"(z_)); unsigned char* ws = a.ws + z_; wsb = ws; const float* const* in_ = a.in + z_; \
    p.x = in_[0]; p.norm_g = in_[1]; p.even_w_in = in_[2]; p.even_w_out = in_[3]; p.cmp_pe = in_[4]; p.cmp_w1 = in_[5]; p.cmp_w2 = in_[6]; p.odd_w_in = in_[7]; p.odd_w_out = in_[8]; \
    p.ffn_w_up = in_[9]; p.ffn_conv_w = in_[10]; p.ffn_conv_b = in_[11]; p.ffn_w_down = in_[12]; p.out = (&a.out)[z_]; \
    p.Wt_in = (bf16*)(ws + WS_WIN); p.Wt_out = (bf16*)(ws + WS_WOUT); p.Wt_up = (bf16*)(ws + WS_WUP); p.Wt_dn = (bf16*)(ws + WS_WDN); \
    p.ROPE = (float*)(ws + WS_ROPE); p.GATES = (float*)(ws + WS_GATES); p.KCMP = (bf16*)(ws + WS_KCMP); \
    p.HID = (float*)(ws + WS_HID); p.Y = (bf16*)(ws + WS_Y); p.PROJ = (bf16*)(ws + WS_PROJ); p.ATT = (bf16*)(ws + WS_ATT); p.Y2 = (bf16*)(ws + WS_Y2); \
    p.ACT = (bf16*)(ws + WS_ACT); p.VT = (bf16*)(ws + WS_VT); p.VCT = (bf16*)(ws + WS_VCT); }

#define GRUN(N, call) do { const long _n = (long)(N); const long gthreads = (long)gridDim.x * NTHREADS; for (long i = (long)blockIdx.x * NTHREADS + opaque((int)threadIdx.x); i < _n; i += gthreads) { call; } } while (0)
#define GRID_BAR() xcd_barrier(bar)
#define GEMM_E(EpiT, Einit, Aptr, Btptr, Mrows, Ncols, Kdim) do { pg8::Gemm g{(const pg8::bf16_t*)(Aptr), (const pg8::bf16_t*)(Btptr), (int)(Mrows), (int)(Ncols), (int)(Kdim)}; \
        pg8::StaticOrder S; S.init((int)(Mrows), (int)(Ncols), (int)gridDim.x, (int)blockIdx.x); EpiT E Einit; \
        pg8::gemm_phase<EpiT, pg8::StaticOrder, true, true>(L, g, S, E); } while (0)
#define COMMA ,
#define GEMM(Aptr, Btptr, Mrows, Ncols, Kdim, Optr, ldo) GEMM_E(pg8::EpiBf16<0>, {(pg8::bf16_t*)(Optr) COMMA (int)(ldo) COMMA nullptr COMMA 0 COMMA 0 COMMA 1.f}, Aptr, Btptr, Mrows, Ncols, Kdim)
#define WT(Wp, K_, ldw_, N_, Btp, mode_, c0_) do { const int nt_ = ((N_) / 32) * ((K_) / 64); LAS float* scr_ = (LAS float*)(L + wave * 17408); \
        for (int t_ = blockIdx.x * NWAVES + wave; t_ < nt_; t_ += gridDim.x * NWAVES) wprep_tile<(K_), (ldw_), (N_), (mode_), (c0_)>((Wp), (Btp), t_, lane, scr_); } while (0)
#define WPREP(LL) do { const int _li = (LL) / 2; \
        if (((LL) & 1) == 0) { const float* W = p.even_w_in + (size_t)_li * cDM * EIN_W; \
            WT(W, cDM, EIN_W, LDE2, p.Wt_in, 1, 0); \
            WT(W, cDM, EIN_W, 1024, (bf16*)(wsb + WS_WV), 2, 0); \
            WT(p.even_w_out + (size_t)_li * 768 * cDM, 768, cDM, cDM, p.Wt_out, 0, 0); \
            WT(W, cDM, EIN_W, 32, (bf16*)(wsb + WS_WGT), 0, 1280); \
            WT(p.cmp_w1 + ((size_t)_li * 2 + 0) * 2048 * 256, 2048, 256, 256, (bf16*)(wsb + WS_W1T), 0, 0); \
            WT(p.cmp_w1 + ((size_t)_li * 2 + 1) * 2048 * 256, 2048, 256, 256, (bf16*)(wsb + WS_W1T) + (size_t)256 * 2048, 0, 0); \
            GRUN(512, peb_item(p.cmp_pe + (size_t)_li * 2 * 2048, p.cmp_w1 + (size_t)_li * 2 * 2048 * 256, (float*)(wsb + WS_PEB), i)); } \
        else { const float* W = p.odd_w_in + (size_t)_li * cDM * 3 * cDM; \
            WT(W, cDM, 3 * cDM, 2 * cDM, p.Wt_in, 0, 0); \
            WT(W, cDM, 3 * cDM, cDM, (bf16*)(wsb + WS_WV), 0, 2 * cDM); \
            WT(p.odd_w_out + (size_t)_li * cDM * cDM, cDM, cDM, cDM, p.Wt_out, 0, 0); } \
        WT(p.ffn_w_up + (size_t)(LL) * cDM * 2 * cDFF, cDM, 2 * cDFF, 2 * cDFF, p.Wt_up, 3, 0); \
        WT(p.ffn_w_down + (size_t)(LL) * cDFF * cDM, cDFF, cDM, cDM, p.Wt_dn, 0, 0); } while (0)
#define NRN(FIN, FOUT, hin_, hout_, g1_, g2_) do { for (long r = blockIdx.x * NWAVES + wave; r < cM; r += gridDim.x * NWAVES) nrn_row_dev<FIN, FOUT>((hin_) + r * cDM, p.Y2 + r * cDM, (g1_), (g2_), (hout_) + r * cDM, p.Y + r * cDM, lane); } while (0)
#define H16P ((bf16*)(wsb + WS_H16))
#define FFN(LL) do { \
        { MKP(); GEMM_E(pg8::EpiConvGelu, {(pg8::bf16_t*)p.ACT COMMA p.ffn_conv_w + (size_t)(LL) * 3 * 2 * cDFF COMMA p.ffn_conv_b + (size_t)(LL) * 2 * cDFF COMMA (float*)(wsb + WS_SB)}, p.Y, p.Wt_up, cM, 2 * cDFF, cDM); } GRID_BAR(); \
        { MKP(); GRUN((long)(cM / 64) * 2 * (cDFF / 4), convfix_item(p, (const float*)(wsb + WS_SB), p.ffn_conv_w + (size_t)(LL) * 3 * 2 * cDFF, p.ffn_conv_b + (size_t)(LL) * 2 * cDFF, i)); } GRID_BAR(); \
        { MKP(); GEMM(p.ACT, p.Wt_dn, cM, cDM, cDFF, p.Y2, cDM); } GRID_BAR(); \
        { MKP(); const float* ng = p.norm_g + (size_t)(LL) * 4 * cDM; if ((LL) + 1 < 4) NRN(false, false, H16P, H16P, ng + 3 * cDM, ng + 4 * cDM); else NRN(false, true, H16P, p.out, ng + 3 * cDM, (const float*)nullptr); \
          if ((LL) + 1 < 4) WPREP((LL) + 1); } GRID_BAR(); } while (0)
#define EVEN_LAYER(lp) do { const int LL = 2 * (lp); \
          { MKP(); GEMM_E(pg8::EpiRopeE, {(pg8::bf16_t*)p.PROJ COMMA PE_LD COMMA p.ROPE}, p.Y, p.Wt_in, cM, LDE2, cDM); } \
          { MKP(); GEMM_E(pg8::EpiVT, {(pg8::bf16_t*)p.VT}, (const bf16*)(wsb + WS_WV), p.Y, 1024, cM, cDM); } GRID_BAR();            \
          { MKP(); GRUN((long)512 * cB * (cS / 128), vtp_item(p.VT, (bf16*)(wsb + WS_VTP), i)); if (wave < 4) for (int u = blockIdx.x * 4 + wave; u < cM / 32; u += gridDim.x * 4) gates_unit(p, (const bf16*)(wsb + WS_WGT), u, lane);     \
            for (int u = blockIdx.x * NWAVES + wave; u < 2048; u += gridDim.x * NWAVES) cmp1_unit(p, (const bf16*)(wsb + WS_W1T), (const float*)(wsb + WS_PEB), u, lane); } GRID_BAR(); \
          { MKP(); GRUN((long)2 * cB * cNC * 2 * 32, cmp2_item(p, p.cmp_w2 + (size_t)(lp) * 2 * 256 * 64, i)); } GRID_BAR(); \
          { MKP(); const int ngw = gridDim.x * NWAVES; bf16* DO_ = (bf16*)(wsb + WS_DOUT); float* DL_ = (float*)(wsb + WS_DLSE); const bf16* VP_ = (const bf16*)(wsb + WS_VTP); \
              \
            for (int u = VCU() * NWAVES + wave; u < cB * 4 * 256; u += ngw) { const int bh = u >> 8, x = u & 255; \
                dil_unit<0>(p, p.VT, VP_, DO_, DL_, L + wave * 17408, bh >> 2, bh & 3, 0, x, lane); \
                dil_unit<1>(p, p.VT, VP_, DO_, DL_, L + wave * 17408, bh >> 2, bh & 3, x >> 6, x & 63, lane); \
                dil_unit<2>(p, p.VT, VP_, DO_, DL_, L + wave * 17408, bh >> 2, bh & 3, x >> 4, x & 15, lane); } } \
          { MKP(); const int ngw = gridDim.x * NWAVES, NT = cS / 8; LAS unsigned char* wl = L + wave * 17408; \
              \
            for (int u = VCU() * NWAVES + wave; u < cB * 2 * NT; u += ngw) { const int gw = u % ngw, k = u / ngw; int bg, tile; \
                if (ngw == 2048) { bg = gw >> 8; const int i = gw & 255; tile = 256 * k + ((k & 1) ? 255 - i : i); } else { bg = u / NT; tile = u % NT; } \
                nsa_unit(p, p.VCT, p.VT, wl, bg >> 1, bg & 1, tile * 8, lane); } } GRID_BAR(); \
          { MKP(); GRUN((long)cM * 32, dil_combine_item(p, (const bf16*)(wsb + WS_DOUT), (const float*)(wsb + WS_DLSE), i)); } GRID_BAR(); \
          { MKP(); GEMM(p.ATT, p.Wt_out, cM, cDM, 768, p.Y2, cDM); } GRID_BAR(); \
          { MKP(); const float* ng = p.norm_g + (size_t)LL * 4 * cDM; if ((lp) == 0) NRN(true, false, p.x, H16P, ng + cDM, ng + 2 * cDM); else NRN(false, false, H16P, H16P, ng + cDM, ng + 2 * cDM); } GRID_BAR(); \
          FFN(LL); } while (0)
#define ODD_LAYER(lp) do { const int LL = 2 * (lp) + 1; \
          { MKP(); GEMM(p.Y, p.Wt_in, cM, LDO2, cDM, p.PROJ, PO_LD); } \
          { MKP(); GEMM_E(pg8::EpiVT, {(pg8::bf16_t*)p.VT}, (const bf16*)(wsb + WS_WV), p.Y, 1024, cM, cDM); } GRID_BAR(); \
          { MKP(); const int NT = cS / 32; for (int u = VCU() * NWAVES + wave; u < cB * cNSB * NT; u += gridDim.x * NWAVES) { const int bh = u / NT; \
                sb_unit(p, p.VT, L + wave * 17408, bh / cNSB, bh % cNSB, (u % NT) * 32, lane); } } GRID_BAR(); \
          { MKP(); GEMM(p.ATT, p.Wt_out, cM, cDM, cDM, p.Y2, cDM); } GRID_BAR(); \
          { MKP(); const float* ng = p.norm_g + (size_t)LL * 4 * cDM; NRN(false, false, H16P, H16P, ng + cDM, ng + 2 * cDM); } GRID_BAR(); \
          FFN(LL); } while (0)

    { MKP();
      GRUN((long)cS * 32, rope_table_item(p, i));
      WPREP(0);
      for (long r = blockIdx.x * NWAVES + wave; r < cM; r += gridDim.x * NWAVES) n_row_dev(p.x + r * cDM, p.norm_g, p.Y + r * cDM, lane); }
    GRID_BAR();
    EVEN_LAYER(0); ODD_LAYER(0); EVEN_LAYER(1); ODD_LAYER(1);
}

extern "C" void kernel_launch(void* const* d_in, const int* in_sizes, int n_in, void* d_out, int out_size, void* d_ws, size_t ws_size, hipStream_t stream) {
    static int grid = 0;
    if (grid == 0) {
        if (n_in != 13 || out_size != cM * cDM || ws_size < WS_END) { fprintf(stderr, "kernel_launch: unexpected shapes (n_in %d out %d ws %zu)\n", n_in, out_size, ws_size); grid = -1; return; }
        int dev = 0, cus = 0;
        if (hipGetDevice(&dev) != hipSuccess || hipDeviceGetAttribute(&cus, hipDeviceAttributeMultiprocessorCount, dev) != hipSuccess) { grid = -1; return; }
        if (hipFuncSetAttribute((const void*)fwd, hipFuncAttributeMaxDynamicSharedMemorySize, LDS_BYTES) != hipSuccess) { grid = -1; return; }
        int per_cu = 0; (void)hipOccupancyMaxActiveBlocksPerMultiprocessor(&per_cu, (const void*)fwd, NTHREADS, LDS_BYTES); (void)hipGetLastError();
        grid = cus;
    }
    if (grid < 0) return;
    (void)hipMemsetAsync((char*)d_ws + WS_CTL, 0, CTL_ZERO_BYTES, stream);
    Args a{};
    for (int i = 0; i < 13; ++i) a.in[i] = (const float*)d_in[i];
    a.out = (float*)d_out; a.ws = (unsigned char*)d_ws;
    hipLaunchKernelGGL(fwd, dim3(grid), dim3(NTHREADS), LDS_BYTES, stream, a);
}
```

```cpp
#include <hip/hip_runtime.h>
#include <cstdio>
#include <cstdint>
#include <cmath>
#ifdef HOST_TEST
#include <cmath>
#include <cstring>
#include <cstdio>
#include <cstdlib>
#define HD
static int cB = 1, cS = 1024, cDM = 128, cDFF = 192;
#else
#define HD __device__ __forceinline__
constexpr int cB = 4, cS = 8192, cDM = 1024, cDFF = 2816;
#endif
typedef unsigned short bf16;
#define cM (cB * cS)
#define cNC ((cS - 32) / 16 + 1)
#define cNS (cS / 64)
#define cTOPN (cNS < 16 ? cNS : 16)
#define cNSB (cDM / 64)
#define LDE 3584
#define LDE2 2560
#define LDO2 2048
#define LDO (3 * cDM)
#define EIN_W 3608
#define KCMP_ROWS 512
#define PE_LD (LDE2 + 128)
#define PO_LD (LDO2 + 128)
#define VT_LD (cM + 128)
#define VCT_LD (KCMP_ROWS + 128)

struct alignas(16) U4 { unsigned x, y, z, w; };
HD float u2f(unsigned u) { float f; __builtin_memcpy(&f, &u, 4); return f; }
HD unsigned f2u(float f) { unsigned u; __builtin_memcpy(&u, &f, 4); return u; }
HD float bf2f(bf16 v) { return u2f((unsigned)v << 16); }
HD bf16 f2bf(float f) { unsigned u = f2u(f); return (bf16)((u + 0x7fffu + ((u >> 16) & 1u)) >> 16); }
HD unsigned pk2bf(float lo, float hi) {
#if defined(__HIP_DEVICE_COMPILE__)
    typedef float pk2f_t __attribute__((ext_vector_type(2))); typedef __bf16 pk2b_t __attribute__((ext_vector_type(2)));
    pk2f_t v = {lo, hi}; pk2b_t b = __builtin_convertvector(v, pk2b_t); return __builtin_bit_cast(unsigned, b);
#else
    return (unsigned)f2bf(lo) | ((unsigned)f2bf(hi) << 16);
#endif
}
HD float fast_exp2(float x) {
#if defined(__HIP_DEVICE_COMPILE__)
    return __builtin_amdgcn_exp2f(x);
#else
    return exp2f(x);
#endif
}
HD float fast_rcp(float x) {
#if defined(__HIP_DEVICE_COMPILE__)
    return __builtin_amdgcn_rcpf(x);
#else
    return 1.f / x;
#endif
}
HD float bflo(unsigned w) { return u2f(w << 16); }
HD float bfhi(unsigned w) { return u2f(w & 0xffff0000u); }

struct P {
    const float *x, *norm_g, *even_w_in, *even_w_out, *cmp_pe, *cmp_w1, *cmp_w2, *odd_w_in, *odd_w_out, *ffn_w_up, *ffn_conv_w, *ffn_conv_b, *ffn_w_down;
    float* out;
    bf16 *Wt_in, *Wt_out, *Wt_up, *Wt_dn;
    float* ROPE;
    float* GATES;
    bf16* KCMP;
    float* HID;
    bf16 *Y, *PROJ, *ATT, *Y2, *ACT;
    bf16* VT;
    bf16* VCT;
};

HD float gelu_tanh(float x) { return 0.5f * x * (1.f + tanhf(0.7978845608028654f * (x + 0.044715f * x * x * x))); }

HD void rope_table_item(const P& p, long idx) {
    const int pos = (int)(idx / 32), i = (int)(idx % 32);
    const double ang = (double)pos * pow(10000.0, -(double)i / 32.0);
    p.ROPE[idx * 2] = (float)cos(ang); p.ROPE[idx * 2 + 1] = (float)sin(ang);
}
HD void cmp2_item(const P& p, const float* w2, long idx) {
    const int i = (int)(idx % 32), g = (int)((idx / 32) % 2), n = (int)((idx / 64) % cNC), b = (int)((idx / (64L * cNC)) % cB), which = (int)(idx / (64L * cNC * cB));
    const float* hid = p.HID + ((((size_t)which * cB + b) * cNC + n) * 2 + g) * 256; const float* ww = w2 + (size_t)which * 256 * 64;
    float a1 = 0.f, a2 = 0.f;
    for (int j = 0; j < 256; ++j) { a1 += hid[j] * ww[j * 64 + i]; a2 += hid[j] * ww[j * 64 + i + 32]; }
    bf16* o = p.KCMP + (((size_t)b * KCMP_ROWS + n) * 2 + g) * 64;
    if (which == 0) { const int pos = 16 * n + 31; const float c = p.ROPE[(pos * 32 + i) * 2], s = p.ROPE[(pos * 32 + i) * 2 + 1];
        o[i] = f2bf(a1 * c - a2 * s); o[i + 32] = f2bf(a2 * c + a1 * s); }
    else { bf16* ot = p.VCT + ((size_t)(b * 2 + g) * 64 + i) * VCT_LD + n; ot[0] = f2bf(a1); ot[(size_t)32 * VCT_LD] = f2bf(a2);
        if (n == 0) { ot[511] = 0; ot[(size_t)32 * VCT_LD + 511] = 0; } }
    if (which == 0 && n == 0) { bf16* oz = p.KCMP + (((size_t)b * KCMP_ROWS + 511) * 2 + g) * 64; oz[i] = 0; oz[i + 32] = 0; }
}
HD void peb_item(const float* pe, const float* w1, float* PEB, long idx) {
    const int j = (int)(idx % 256), which = (int)(idx / 256);
    float acc = 0.f;
    for (int k = 0; k < 2048; ++k) acc += pe[(size_t)which * 2048 + k] * w1[((size_t)which * 2048 + k) * 256 + j];
    PEB[idx] = acc;
}
HD int wsrc_col(int mode, int n) {
    if (mode == 1) { const int u = n >> 8, c = n & 255, hiu = c >> 6, w = c & 63;
        if (u == 2) return 512 + c;
        const int d = (w & 7) < 4 ? 4 * (w >> 3) + (w & 7) : 32 + 4 * (w >> 3) + ((w & 7) - 4);
        int base;
        if (u < 2) base = 64 * (4 * u + hiu); else if (u == 3) base = hiu < 2 ? 768 + 64 * hiu : 1024 + 64 * (hiu - 2);
        else if (u < 7) base = 1304 + 64 * (4 * (u - 4) + hiu); else base = 1304 + 768 + 64 * (4 * (u - 7) + hiu);
        return base + d; }
    if (mode == 2) return n < 128 ? 896 + n : n < 256 ? 1152 + (n - 128) : 2840 + (n - 256);
    if (mode == 3) { const int pn = n >> 8, bj = (n >> 7) & 1, x = n & 127; return bj * cDFF + 128 * pn + x; }
    return n;
}
HD float gelu_fast_h(float x) { const float z = x + 0.044715f * x * x * x; return x * fast_rcp(1.f + fast_exp2(-2.3022081981f * z)); }
struct alignas(16) F4 { float v[4]; };
HD void convfix_item(const P& p, const float* SB, const float* cw, const float* cb, long idx) {
    constexpr int Q = cDFF / 4; const int j = 4 * (int)(idx % Q), rr = (int)((idx / Q) % 2); const long blk = idx / (2L * Q); const long row = blk * 64 + rr; const int t = (int)(row % cS), LD2 = 2 * cDFF;
    const float* s0 = SB + ((size_t)blk * 4 + rr) * LD2; const float* sp = SB + ((size_t)(blk - 1) * 4) * LD2;
    const float* sm = SB + ((size_t)blk * 4) * LD2;
#define LD4(ptr) (*(const F4*)(ptr))
    const F4 bg = LD4(cb + j), bv = LD4(cb + cDFF + j), w2g = LD4(cw + 2 * LD2 + j), w2v = LD4(cw + 2 * LD2 + cDFF + j), w1g = LD4(cw + LD2 + j), w1v = LD4(cw + LD2 + cDFF + j), w0g = LD4(cw + j), w0v = LD4(cw + cDFF + j);
    const F4 ug = LD4(s0 + j), uv = LD4(s0 + cDFF + j);
    F4 g1 = {{0.f, 0.f, 0.f, 0.f}}, v1 = g1, g2 = g1, v2 = g1;
    if (rr == 0) { if (t >= 1) { g1 = LD4(sp + 3 * LD2 + j); v1 = LD4(sp + 3 * LD2 + cDFF + j); g2 = LD4(sp + 2 * LD2 + j); v2 = LD4(sp + 2 * LD2 + cDFF + j); } }
    else { g1 = LD4(sm + j); v1 = LD4(sm + cDFF + j); if (t >= 2) { g2 = LD4(sp + 3 * LD2 + j); v2 = LD4(sp + 3 * LD2 + cDFF + j); } }
#undef LD4
    float o[4];
#pragma unroll
    for (int e = 0; e < 4; ++e) { const float cg = bg.v[e] + w2g.v[e] * ug.v[e] + w1g.v[e] * g1.v[e] + w0g.v[e] * g2.v[e], cv = bv.v[e] + w2v.v[e] * uv.v[e] + w1v.v[e] * v1.v[e] + w0v.v[e] * v2.v[e];
        o[e] = gelu_fast_h(cg) * cv; }
    uint2 w; w.x = pk2bf(o[0], o[1]); w.y = pk2bf(o[2], o[3]);
    *(uint2*)(p.ACT + (size_t)row * cDFF + j) = w;
}
HD size_t vt_tile_off(int ngrp, int b, int grp, int tile) { return (((size_t)b * ngrp + grp) * (cS / 32) + tile) * 2048; }
HD size_t vt_elem_off(int ngrp, int b, int dg, int tk) { return vt_tile_off(ngrp, b, dg >> 6, tk >> 5) + (size_t)(dg & 63) * 32 + (tk & 31); }
template <int dil> HD void vtp_run(const bf16* src, bf16* VTP, int b, int pr, int G) {
    unsigned in[64];
#pragma unroll
    for (int q = 0; q < 4; ++q)
#pragma unroll
        for (int c = 0; c < 4; ++c) { const U4 v = *(const U4*)(src + (size_t)q * 2048 + 8 * c); in[16 * q + 4 * c] = v.x; in[16 * q + 4 * c + 1] = v.y; in[16 * q + 4 * c + 2] = v.z; in[16 * q + 4 * c + 3] = v.w; }
    constexpr int per = cS / dil, nm = 128 / dil;
#pragma unroll
    for (int rc = 0; rc < dil; ++rc)
#pragma unroll
        for (int o8 = 0; o8 < nm / 8; ++o8) { unsigned w[4];
#pragma unroll
            for (int e = 0; e < 4; ++e) { const int t0_ = dil * (8 * o8 + 2 * e) + rc, t1_ = t0_ + dil;
                const unsigned lo = (t0_ & 1) ? (in[t0_ >> 1] >> 16) : (in[t0_ >> 1] & 0xFFFFu), hi = (t1_ & 1) ? (in[t1_ >> 1] & 0xFFFF0000u) : (in[t1_ >> 1] << 16);
                w[e] = lo | hi; }
            U4 v; v.x = w[0]; v.y = w[1]; v.z = w[2]; v.w = w[3];
            *(U4*)(VTP + vt_elem_off(8, b, pr, rc * per + nm * G + 8 * o8)) = v; }
}
HD void vtp_item(const bf16* VT, bf16* VTP, long idx) {
    const int ng = cS / 128; const int G = (int)(idx % ng), b = (int)((idx / ng) % cB), pr = (int)(idx / ((long)ng * cB));
    const bf16* src = VT + vt_elem_off(16, b, 512 + pr, 128 * G);
    if (pr < 256) vtp_run<4>(src, VTP, b, pr, G); else vtp_run<16>(src, VTP, b, pr, G);
}
HD void dil_combine_item(const P& p, const bf16* DOUT, const float* DLSE, long idx) {
    const int c8 = (int)(idx % 8), hd = (int)((idx / 8) % 4); const long row = idx / 32;
    const float l0 = DLSE[((size_t)0 * cM + row) * 4 + hd], l1 = DLSE[((size_t)1 * cM + row) * 4 + hd], l2 = DLSE[((size_t)2 * cM + row) * 4 + hd];
    const float mx = fmaxf(l0, fmaxf(l1, l2)), e0 = fast_exp2(l0 - mx), e1 = fast_exp2(l1 - mx), e2 = fast_exp2(l2 - mx), rs = fast_rcp(e0 + e1 + e2);
    const U4 a = *(const U4*)(DOUT + ((size_t)0 * cM + row) * 256 + hd * 64 + 8 * c8), bq = *(const U4*)(DOUT + ((size_t)1 * cM + row) * 256 + hd * 64 + 8 * c8), cq = *(const U4*)(DOUT + ((size_t)2 * cM + row) * 256 + hd * 64 + 8 * c8);
    const float w0 = e0 * rs, w1 = e1 * rs, w2 = e2 * rs;
    U4 o;
    o.x = pk2bf(w0 * bflo(a.x) + w1 * bflo(bq.x) + w2 * bflo(cq.x), w0 * bfhi(a.x) + w1 * bfhi(bq.x) + w2 * bfhi(cq.x));
    o.y = pk2bf(w0 * bflo(a.y) + w1 * bflo(bq.y) + w2 * bflo(cq.y), w0 * bfhi(a.y) + w1 * bfhi(bq.y) + w2 * bfhi(cq.y));
    o.z = pk2bf(w0 * bflo(a.z) + w1 * bflo(bq.z) + w2 * bflo(cq.z), w0 * bfhi(a.z) + w1 * bfhi(bq.z) + w2 * bfhi(cq.z));
    o.w = pk2bf(w0 * bflo(a.w) + w1 * bflo(bq.w) + w2 * bflo(cq.w), w0 * bfhi(a.w) + w1 * bfhi(bq.w) + w2 * bfhi(cq.w));
    *(U4*)(p.ATT + (size_t)row * 768 + 512 + hd * 64 + 8 * c8) = o;
}
#define LAS __attribute__((address_space(3)))
typedef short bf16x8v __attribute__((ext_vector_type(8)));
typedef short bf16x4v __attribute__((ext_vector_type(4)));
typedef float f32x16 __attribute__((ext_vector_type(16)));
typedef float f32x2_t __attribute__((ext_vector_type(2)));
typedef float f32x4v __attribute__((ext_vector_type(4)));
typedef __bf16 bf16x2_t __attribute__((ext_vector_type(2)));
__device__ __forceinline__ unsigned cvtpk(float lo, float hi) { f32x2_t v = {lo, hi}; bf16x2_t b = __builtin_convertvector(v, bf16x2_t); return __builtin_bit_cast(unsigned, b); }
__device__ __forceinline__ float fexp2(float x) { return __builtin_amdgcn_exp2f(x); }
#define ATT_C2 (0.125f * 1.4426950408889634f)
#define ATT_NEG (-1e30f)
#define ATT_THR 8.0f

typedef unsigned u32x2v __attribute__((ext_vector_type(2)));
__device__ __forceinline__ float vmax2(float a, float b) { float d; asm("v_max_f32 %0, %1, %2" : "=v"(d) : "v"(a), "v"(b)); return d; }
__device__ __forceinline__ float vmax3(float a, float b, float c) { float d; asm("v_max3_f32 %0, %1, %2, %3" : "=v"(d) : "v"(a), "v"(b), "v"(c)); return d; }
__device__ __forceinline__ float vmax16(const f32x16& s) {
    const float a = vmax3(s[0], s[1], s[2]), b = vmax3(s[3], s[4], s[5]), c = vmax3(s[6], s[7], s[8]), d = vmax3(s[9], s[10], s[11]), e = vmax3(s[12], s[13], s[14]);
    return vmax2(vmax3(vmax3(a, b, c), d, e), s[15]); }
__device__ __forceinline__ float vmax16_acc(const f32x16& s) { float d;
    asm("s_nop 11\n\tv_max3_f32 %0, %1, %2, %3\n\tv_max3_f32 %0, %0, %4, %5\n\tv_max3_f32 %0, %0, %6, %7\n\tv_max3_f32 %0, %0, %8, %9\n\t"
        "v_max3_f32 %0, %0, %10, %11\n\tv_max3_f32 %0, %0, %12, %13\n\tv_max3_f32 %0, %0, %14, %15\n\tv_max_f32 %0, %0, %16"
        : "=&v"(d) : "v"(s[0]), "v"(s[1]), "v"(s[2]), "v"(s[3]), "v"(s[4]), "v"(s[5]), "v"(s[6]), "v"(s[7]), "v"(s[8]), "v"(s[9]), "v"(s[10]), "v"(s[11]), "v"(s[12]), "v"(s[13]), "v"(s[14]), "v"(s[15]));
    return d; }
#define OPQ(x) asm("" : "+v"(x))
__device__ __forceinline__ float vsum16(const f32x16& s) {
    float a0 = s[0] + s[1], a1 = s[2] + s[3], a2 = s[4] + s[5], a3 = s[6] + s[7], a4 = s[8] + s[9], a5 = s[10] + s[11], a6 = s[12] + s[13], a7 = s[14] + s[15];
    OPQ(a0); OPQ(a1); OPQ(a2); OPQ(a3); OPQ(a4); OPQ(a5); OPQ(a6); OPQ(a7);
    float b0 = a0 + a1, b1 = a2 + a3, b2 = a4 + a5, b3 = a6 + a7; OPQ(b0); OPQ(b1); OPQ(b2); OPQ(b3);
    float c0 = b0 + b1, c1 = b2 + b3; OPQ(c0); OPQ(c1);
    return c0 + c1; }
__device__ __forceinline__ float xmax32(float x) { float y; asm volatile("v_mov_b32 %0, %1\n\ts_nop 1" : "=v"(y) : "v"(x));
    auto r = __builtin_amdgcn_permlane32_swap(__builtin_bit_cast(unsigned, x), __builtin_bit_cast(unsigned, y), false, false); const unsigned a = r[0], b = r[1];
    return vmax2(__builtin_bit_cast(float, a), __builtin_bit_cast(float, b)); }
__device__ __forceinline__ float xsum32(float x) { float y; asm volatile("v_mov_b32 %0, %1\n\ts_nop 1" : "=v"(y) : "v"(x));
    auto r = __builtin_amdgcn_permlane32_swap(__builtin_bit_cast(unsigned, x), __builtin_bit_cast(unsigned, y), false, false); const unsigned a = r[0], b = r[1];
    return __builtin_bit_cast(float, a) + __builtin_bit_cast(float, b); }
__device__ __forceinline__ void store_row64(bf16* rowp, int hh, const float (&o)[32], float sc) {
#pragma unroll
    for (int dt = 0; dt < 2; ++dt)
#pragma unroll
        for (int kp = 0; kp < 2; ++kp) { const float* q = o + 16 * dt + 8 * kp;
            const unsigned a0 = cvtpk(q[0] * sc, q[1] * sc), a1 = cvtpk(q[2] * sc, q[3] * sc), b0 = cvtpk(q[4] * sc, q[5] * sc), b1 = cvtpk(q[6] * sc, q[7] * sc);
            auto r0 = __builtin_amdgcn_permlane32_swap(a0, b0, false, false); auto r1 = __builtin_amdgcn_permlane32_swap(a1, b1, false, false);
            U4 w; w.x = r0[0]; w.y = r1[0]; w.z = r0[1]; w.w = r1[1];
            *(U4*)(rowp + 32 * dt + 16 * kp + 8 * hh) = w; }
}
__device__ __forceinline__ f32x16 zero16() { f32x16 z;
#pragma unroll
    for (int i = 0; i < 16; ++i) z[i] = 0.f;
    return z; }
__device__ __forceinline__ f32x16 qk32(const bf16* kp, const bf16x8v (&qf)[4]) {
    f32x16 acc = zero16();
#pragma unroll
    for (int ks = 0; ks < 4; ++ks) { const bf16x8v kf = *(const bf16x8v*)(kp + 16 * ks); acc = __builtin_amdgcn_mfma_f32_32x32x16_bf16(kf, qf[ks], acc, 0, 0, 0); }
    return acc;
}
__device__ __forceinline__ void pv32(f32x16& o0, f32x16& o1, const bf16* vt, size_t dstep, const unsigned (&pb)[8]) {
#pragma unroll
    for (int s = 0; s < 2; ++s) {
        const bf16x4v a00 = *(const bf16x4v*)(vt + 16 * s), a01 = *(const bf16x4v*)(vt + 16 * s + 8);
        const bf16x4v a10 = *(const bf16x4v*)(vt + dstep + 16 * s), a11 = *(const bf16x4v*)(vt + dstep + 16 * s + 8);
        bf16x8v A0, A1, B;
        A0 = __builtin_shufflevector(a00, a01, 0, 1, 2, 3, 4, 5, 6, 7); A1 = __builtin_shufflevector(a10, a11, 0, 1, 2, 3, 4, 5, 6, 7);
        typedef unsigned u32x4v __attribute__((ext_vector_type(4)));
        u32x4v bw = {pb[4 * s + 0], pb[4 * s + 1], pb[4 * s + 2], pb[4 * s + 3]};
        B = __builtin_bit_cast(bf16x8v, bw);
        o0 = __builtin_amdgcn_mfma_f32_32x32x16_bf16(A0, B, o0, 0, 0, 0);
        o1 = __builtin_amdgcn_mfma_f32_32x32x16_bf16(A1, B, o1, 0, 0, 0);
    }
}
struct KF { bf16x8v k[4]; };
struct VF { bf16x4v v[8]; };
__device__ __forceinline__ void load_k(KF& f, const bf16* kp) {
#pragma unroll
    for (int ks = 0; ks < 4; ++ks) f.k[ks] = *(const bf16x8v*)(kp + 16 * ks); }
__device__ __forceinline__ void load_v(VF& f, const bf16* vt, size_t dstep) {
#pragma unroll
    for (int s = 0; s < 2; ++s) { f.v[2 * s] = *(const bf16x4v*)(vt + 16 * s); f.v[2 * s + 1] = *(const bf16x4v*)(vt + 16 * s + 8);
        f.v[4 + 2 * s] = *(const bf16x4v*)(vt + dstep + 16 * s); f.v[4 + 2 * s + 1] = *(const bf16x4v*)(vt + dstep + 16 * s + 8); } }
__device__ __forceinline__ f32x16 qk32r(const KF& f, const bf16x8v (&qf)[4]) {
    f32x16 acc = zero16();
#pragma unroll
    for (int ks = 0; ks < 4; ++ks) acc = __builtin_amdgcn_mfma_f32_32x32x16_bf16(f.k[ks], qf[ks], acc, 0, 0, 0);
    return acc; }
__device__ __forceinline__ void pv32r(f32x16& o0, f32x16& o1, const VF& f, const unsigned (&pb)[8]) {
    typedef unsigned u32x4v __attribute__((ext_vector_type(4)));
#pragma unroll
    for (int s = 0; s < 2; ++s) {
        const bf16x8v A0 = __builtin_shufflevector(f.v[2 * s], f.v[2 * s + 1], 0, 1, 2, 3, 4, 5, 6, 7), A1 = __builtin_shufflevector(f.v[4 + 2 * s], f.v[4 + 2 * s + 1], 0, 1, 2, 3, 4, 5, 6, 7);
        const u32x4v bw = {pb[4 * s + 0], pb[4 * s + 1], pb[4 * s + 2], pb[4 * s + 3]}; const bf16x8v B = __builtin_bit_cast(bf16x8v, bw);
        o0 = __builtin_amdgcn_mfma_f32_32x32x16_bf16(A0, B, o0, 0, 0, 0); o1 = __builtin_amdgcn_mfma_f32_32x32x16_bf16(A1, B, o1, 0, 0, 0); } }
__device__ __forceinline__ unsigned long long wave_or64(unsigned long long x) {
    unsigned lo = (unsigned)x, hi = (unsigned)(x >> 32);
#pragma unroll
    for (int o = 1; o < 64; o <<= 1) { lo |= (unsigned)__shfl_xor((int)lo, o); hi |= (unsigned)__shfl_xor((int)hi, o); }
    return ((unsigned long long)(unsigned)__builtin_amdgcn_readfirstlane((int)hi) << 32) | (unsigned)__builtin_amdgcn_readfirstlane((int)lo); }
struct LaneAddr { unsigned ck, cv; unsigned rk[4], rv[4], rw[4]; };
__device__ __forceinline__ LaneAddr lane_addr(LAS unsigned char* slot, int lane) {
    LaneAddr a; const int r = lane & 31, hh = lane >> 5; const unsigned sb = (unsigned)(size_t)slot;
    a.ck = (unsigned)lane; a.cv = (unsigned)lane;
#pragma unroll
    for (int ks = 0; ks < 4; ++ks) a.rk[ks] = sb + r * 128 + (((2 * ks + hh) ^ (r & 7)) * 16);
#pragma unroll
    for (int c = 0; c < 4; ++c) { a.rv[c] = sb + 4096 + r * 64 + ((c ^ ((r >> 2) & 3)) * 16) + 8 * hh; unsigned w = a.rv[c] + 2048; asm volatile("" : "+v"(w)); a.rw[c] = w; }
    return a; }
__device__ __forceinline__ unsigned kvoff(int lane, size_t pitch) { const int row = lane >> 3, ch = (lane & 7) ^ (row & 7); return (unsigned)((row * pitch + ch * 8) * 2); }
__device__ __forceinline__ unsigned vvoff(int lane, size_t pitch) { const int row = lane >> 2, ch = (lane & 3) ^ ((row >> 2) & 3); return (unsigned)((row * pitch + ch * 8) * 2); }
typedef __amdgpu_buffer_rsrc_t rsrc_t;
__device__ __forceinline__ rsrc_t mkrsrc(const void* base) { return __builtin_amdgcn_make_buffer_rsrc((void*)base, 0, 0x7FFFFFF0, 0x00020000); }
__device__ __forceinline__ void dma_k(LAS unsigned char* slot, rsrc_t rs, unsigned tile_off, unsigned pitchB, unsigned voff) {
#pragma unroll
    for (int q = 0; q < 4; ++q) __builtin_amdgcn_raw_ptr_buffer_load_lds(rs, (LAS unsigned*)(slot + q * 1024), 16, voff, tile_off + q * 8 * pitchB, 0, 0); }
__device__ __forceinline__ void dma_v(LAS unsigned char* slot, rsrc_t rs, unsigned tile_off, unsigned pitchB, unsigned voff) {
#pragma unroll
    for (int q = 0; q < 4; ++q) __builtin_amdgcn_raw_ptr_buffer_load_lds(rs, (LAS unsigned*)(slot + 4096 + q * 1024), 16, voff, tile_off + q * 16 * pitchB, 0, 0); }
__device__ __forceinline__ void read_k(KF& f, const LaneAddr& a) {
#pragma unroll
    for (int ks = 0; ks < 4; ++ks) f.k[ks] = *(const LAS bf16x8v*)(size_t)a.rk[ks]; }
__device__ __forceinline__ void read_v(VF& f, const LaneAddr& a) {
#pragma unroll
    for (int dt = 0; dt < 2; ++dt)
#pragma unroll
        for (int s = 0; s < 2; ++s) { f.v[4 * dt + 2 * s] = *(const LAS bf16x4v*)(size_t)(dt ? a.rw[2 * s] : a.rv[2 * s]); f.v[4 * dt + 2 * s + 1] = *(const LAS bf16x4v*)(size_t)(dt ? a.rw[2 * s + 1] : a.rv[2 * s + 1]); } }
#define DMA_WAIT() asm volatile("s_waitcnt vmcnt(0)" ::: "memory")
#define LDS_DRAIN() asm volatile("s_waitcnt lgkmcnt(0)" ::: "memory")
#define LDS_DRAIN_PINNED() do { __builtin_amdgcn_sched_barrier(0); asm volatile("s_waitcnt lgkmcnt(0)" ::: "memory"); } while (0)
#define ATT_BIG 1.152921504606847e18f
__device__ __forceinline__ void sm_fast(f32x16& s, const KF& kc, const bf16x8v (&qf)[4], bool lane_on, float& m, float& l, f32x16& o0, f32x16& o1, unsigned (&pb)[8]) {
    float nb = lane_on ? -m : -INFINITY;
#pragma unroll
    for (int reg = 0; reg < 16; ++reg) s[reg] = fexp2(__builtin_fmaf(s[reg], ATT_C2, nb));
    float rs = vsum16(s);
    if (__any(!(rs < ATT_BIG))) {
        s = qk32r(kc, qf);
        float mx = vmax16_acc(s);
        mx = xmax32(lane_on ? mx * ATT_C2 : ATT_NEG);
        const float mn = (mx > m + ATT_THR) ? mx : m, alpha = fexp2(m - mn); m = mn; l *= alpha;
#pragma unroll
        for (int reg = 0; reg < 16; ++reg) { o0[reg] *= alpha; o1[reg] *= alpha; }
        nb = lane_on ? -m : -INFINITY;
#pragma unroll
        for (int reg = 0; reg < 16; ++reg) s[reg] = fexp2(__builtin_fmaf(s[reg], ATT_C2, nb));
        rs = vsum16(s); }
    l += rs;
#pragma unroll
    for (int i = 0; i < 8; ++i) pb[i] = cvtpk(s[2 * i], s[2 * i + 1]);
}
__device__ __forceinline__ void sm_step(f32x16& s, const KF& kc, const bf16x8v (&qf)[4], int lo, int hi, int hh, float& m, float& l, f32x16& o0, f32x16& o1, unsigned (&pb)[8]) {
    const float nb = -m;
#pragma unroll
    for (int reg = 0; reg < 16; ++reg) { const int ko = (reg & 3) + 8 * (reg >> 2) + 4 * hh; const bool v = (ko >= lo) && (ko <= hi);
        const float e = fexp2(__builtin_fmaf(s[reg], ATT_C2, nb)); s[reg] = v ? e : 0.f; }
    float rs = vsum16(s);
    if (__any(!(rs < ATT_BIG))) {
        s = qk32r(kc, qf);
#pragma unroll
        for (int reg = 0; reg < 16; ++reg) { const int ko = (reg & 3) + 8 * (reg >> 2) + 4 * hh; const bool v = (ko >= lo) && (ko <= hi);
            s[reg] = v ? s[reg] * ATT_C2 : ATT_NEG; }
        const float mx = xmax32(vmax16(s));
        const float mn = (mx > m + ATT_THR) ? mx : m, alpha = fexp2(m - mn); m = mn; l *= alpha;
#pragma unroll
        for (int reg = 0; reg < 16; ++reg) { o0[reg] *= alpha; o1[reg] *= alpha; }
#pragma unroll
        for (int reg = 0; reg < 16; ++reg) s[reg] = (s[reg] > -1e29f) ? fexp2(s[reg] - m) : 0.f;
        rs = vsum16(s); }
    l += rs;
#pragma unroll
    for (int i = 0; i < 8; ++i) pb[i] = cvtpk(s[2 * i], s[2 * i + 1]);
}

__device__ __forceinline__ float dpp_xor1(float x) { return __builtin_bit_cast(float, __builtin_amdgcn_update_dpp(0, __builtin_bit_cast(int, x), 0xB1, 0xF, 0xF, true)); }
__device__ __forceinline__ float dpp_xor2(float x) { return __builtin_bit_cast(float, __builtin_amdgcn_update_dpp(0, __builtin_bit_cast(int, x), 0x4E, 0xF, 0xF, true)); }
#define IMP_LD 132
__device__ __forceinline__ void nsa_unit(const P& p, const bf16* VCT, const bf16* VT, LAS unsigned char* wl, int b, int g, int t0, int lane) {
    const LaneAddr la = lane_addr(wl, lane);
    LAS float* imp = (LAS float*)(wl + 8192);
    const int r = lane & 31, hh = lane >> 5, tl = r >> 2, hg = r & 3, head = g * 4 + hg, t = t0 + tl;
    const long row = (long)b * cS + t;
    bf16x8v qf[4];
    { const bf16* qp = p.PROJ + (size_t)row * PE_LD + head * 64 + 8 * hh;
#pragma unroll
      for (int ks = 0; ks < 4; ++ks) qf[ks] = *(const bf16x8v*)(qp + 16 * ks); }
    float outacc[32];
    unsigned pb[8];
    unsigned long long m0 = 0ull, m1 = 0ull;
    {
        for (int i = lane; i < 8 * IMP_LD; i += 64) imp[i] = 0.f;
        const int nv = t >= 31 ? (t - 31) / 16 + 1 : 0, nvmax = (t0 + 7) >= 31 ? (t0 + 7 - 31) / 16 + 1 : 0, ntile = (nvmax + 31) >> 5;
        float m = ATT_NEG, l = 0.f;
        const bf16* kc0 = p.KCMP + ((size_t)b * KCMP_ROWS * 2 + g) * 64;
        const bf16* vc0 = VCT + (size_t)(b * 2 + g) * 64 * VCT_LD;
        const rsrc_t rsK = mkrsrc(kc0), rsV = mkrsrc(vc0); const unsigned kvo = kvoff(lane, 128), vvo = vvoff(lane, VCT_LD);
        KF kc; VF vc;
        if (ntile > 0) { dma_k(wl, rsK, 0u, 128 * 2, kvo); DMA_WAIT(); read_k(kc, la); }
        for (int kt = 0; kt < ntile; ++kt) { const int key0 = 32 * kt;
            LDS_DRAIN();
            if (kt + 1 < ntile) dma_k(wl, rsK, (unsigned)(key0 + 32) * (128 * 2), 128 * 2, kvo);
            f32x16 s = qk32r(kc, qf);
            float mx = ATT_NEG;
#pragma unroll
            for (int reg = 0; reg < 16; ++reg) { const int ko = (reg & 3) + 8 * (reg >> 2) + 4 * hh; const float x = (key0 + ko < nv) ? s[reg] * ATT_C2 : ATT_NEG; s[reg] = x; mx = fmaxf(mx, x); }
            mx = xmax32(mx);
            const float mn = fmaxf(m, mx); float rs = 0.f;
#pragma unroll
            for (int reg = 0; reg < 16; ++reg) rs += (s[reg] > -1e29f) ? fexp2(s[reg] - mn) : 0.f;
            rs = xsum32(rs);
            l = l * fexp2(m - mn) + rs; m = mn;
            if (kt + 1 < ntile) { DMA_WAIT(); read_k(kc, la); } }
        const float rl = l > 0.f ? 1.f / l : 0.f;
        f32x16 o0 = zero16(), o1 = zero16();
        if (ntile > 0) { dma_k(wl, rsK, 0u, 128 * 2, kvo); dma_v(wl, rsV, 0u, VCT_LD * 2, vvo); DMA_WAIT(); read_k(kc, la); }
        for (int kt = 0; kt < ntile; ++kt) { const int key0 = 32 * kt;
            LDS_DRAIN(); if (kt + 1 < ntile) dma_k(wl, rsK, (unsigned)(key0 + 32) * (128 * 2), 128 * 2, kvo);
            read_v(vc, la);
            f32x16 s = qk32r(kc, qf);
            LDS_DRAIN_PINNED(); if (kt + 1 < ntile) dma_v(wl, rsV, (unsigned)(key0 + 32) * 2, VCT_LD * 2, vvo);
#pragma unroll
            for (int reg = 0; reg < 16; ++reg) { const int ko = (reg & 3) + 8 * (reg >> 2) + 4 * hh; s[reg] = (key0 + ko < nv) ? fexp2(s[reg] * ATT_C2 - m) * rl : 0.f; }
#pragma unroll
            for (int i = 0; i < 8; ++i) pb[i] = cvtpk(s[2 * i], s[2 * i + 1]);
            pv32r(o0, o1, vc, pb);
#pragma unroll
            for (int k = 0; k < 4; ++k) { float a = s[4 * k] + s[4 * k + 1] + s[4 * k + 2] + 0.5f * s[4 * k + 3], c = 0.5f * s[4 * k + 3];
                a += dpp_xor1(a); a += dpp_xor2(a); c += dpp_xor1(c); c += dpp_xor2(c);
                if (hg == 0) { const int j = (key0 >> 2) + 2 * k + hh; (void)__hip_atomic_fetch_add(imp + tl * IMP_LD + j, a, __ATOMIC_RELAXED, __HIP_MEMORY_SCOPE_WORKGROUP); (void)__hip_atomic_fetch_add(imp + tl * IMP_LD + j + 1, c, __ATOMIC_RELAXED, __HIP_MEMORY_SCOPE_WORKGROUP); } }
            if (kt + 1 < ntile) { DMA_WAIT(); read_k(kc, la); } }
        const float g0 = p.GATES[row * 24 + head * 3 + 0];
#pragma unroll
        for (int reg = 0; reg < 16; ++reg) { outacc[reg] = o0[reg] * g0; outacc[16 + reg] = o1[reg] * g0; }
    }
    unsigned long long u0 = 0ull, u1 = 0ull;
    for (int tk = 0; tk < 8; ++tk) { const int tt = t0 + tk, cur = tt >> 6; LAS unsigned* row = (LAS unsigned*)(imp + tk * IMP_LD);
        float v0 = imp[tk * IMP_LD + lane], v1 = imp[tk * IMP_LD + lane + 64];
        if (lane == 0 || lane == cur || lane == cur - 1) v0 += 1e4f;
        if (lane + 64 == cur || lane + 64 == cur - 1) v1 += 1e4f;
        const unsigned k0 = ((64 * lane > tt) ? 0u : (__builtin_bit_cast(unsigned, v0) & ~127u)) | (unsigned)(127 - lane);
        const unsigned k1 = ((64 * (lane + 64) > tt) ? 0u : (__builtin_bit_cast(unsigned, v1) & ~127u)) | (unsigned)(63 - lane);
        row[lane] = k0; row[lane + 64] = k1;
        int r0 = 0, r1 = 0;
        const int nq4 = min(32, ((cur >> 2) + 4) & ~3);
        typedef unsigned u32x4k __attribute__((ext_vector_type(4)));
        if (cur >= 64) {
#pragma unroll 4
            for (int q4 = 0; q4 < nq4; ++q4) { const u32x4k w = *(const LAS u32x4k*)(row + 4 * q4);
#pragma unroll
                for (int e = 0; e < 4; ++e) { r0 += (w[e] > k0) ? 1 : 0; r1 += (w[e] > k1) ? 1 : 0; } }
        } else {
#pragma unroll 4
            for (int q4 = 0; q4 < nq4; ++q4) { const u32x4k w = *(const LAS u32x4k*)(row + 4 * q4);
#pragma unroll
                for (int e = 0; e < 4; ++e) r0 += (w[e] > k0) ? 1 : 0; }
            r1 = 16; }
        const unsigned long long s0 = __ballot(r0 < 16), s1 = __ballot(r1 < 16);
        u0 |= s0; u1 |= s1;
        if (tl == tk) { m0 = s0; m1 = s1; } }
    {
        f32x16 o0 = zero16(), o1 = zero16(); float m = ATT_NEG, l = 0.f;
        const bf16* k0p = p.PROJ + (size_t)b * cS * PE_LD + 768 + g * 64;
        const bf16* v0p = VT + vt_tile_off(16, b, g, 0);
        const rsrc_t rsK = mkrsrc(k0p), rsV = mkrsrc(v0p); const unsigned kvo = kvoff(lane, PE_LD), vvo = vvoff(lane, 32);
        const int tmax = (t0 + 7) >> 5;
#define NSA_NEXT_TILE(tc) ({ int tt_ = (tc) + 1; if ((tt_ & 1) == 0) { const int j_ = tt_ >> 1; \
            const unsigned long long lo_ = j_ < 64 ? (u0 >> j_) : 0ull, hi_ = j_ < 64 ? u1 : (j_ < 128 ? (u1 >> (j_ - 64)) : 0ull); \
            tt_ = lo_ ? 2 * (j_ + __builtin_ctzll(lo_)) : (hi_ ? 2 * ((j_ < 64 ? 64 : j_) + __builtin_ctzll(hi_)) : 1 << 20); } tt_ <= tmax ? tt_ : -1; })
        int tn = NSA_NEXT_TILE(-1);
        KF kc; VF vc;
        if (tn >= 0) { dma_k(wl, rsK, (unsigned)(32 * tn) * (PE_LD * 2), PE_LD * 2, kvo); dma_v(wl, rsV, (unsigned)tn * 4096u, 64, vvo); DMA_WAIT(); read_k(kc, la); }
        while (tn >= 0 && 32 * tn + 31 <= t0) { const int tc = tn, key0 = 32 * tc, j = tc >> 1;
            tn = NSA_NEXT_TILE(tc);
            LDS_DRAIN(); if (tn >= 0) dma_k(wl, rsK, (unsigned)(32 * tn) * (PE_LD * 2), PE_LD * 2, kvo);
            read_v(vc, la);
            const bool selj = ((j < 64 ? m0 : m1) >> (j & 63)) & 1ull;
            f32x16 s = qk32r(kc, qf);
            LDS_DRAIN_PINNED(); if (tn >= 0) dma_v(wl, rsV, (unsigned)tn * 4096u, 64, vvo);
            sm_fast(s, kc, qf, selj, m, l, o0, o1, pb);
            pv32r(o0, o1, vc, pb);
            if (tn >= 0) { DMA_WAIT(); read_k(kc, la); } }
        while (tn >= 0) { const int tc = tn, key0 = 32 * tc, j = tc >> 1;
            tn = NSA_NEXT_TILE(tc);
            LDS_DRAIN(); if (tn >= 0) dma_k(wl, rsK, (unsigned)(32 * tn) * (PE_LD * 2), PE_LD * 2, kvo);
            read_v(vc, la);
            const bool selj = ((j < 64 ? m0 : m1) >> (j & 63)) & 1ull;
            f32x16 s = qk32r(kc, qf);
            LDS_DRAIN_PINNED(); if (tn >= 0) dma_v(wl, rsV, (unsigned)tn * 4096u, 64, vvo);
            sm_step(s, kc, qf, 0, selj ? t - key0 : -1, hh, m, l, o0, o1, pb);
            pv32r(o0, o1, vc, pb);
            if (tn >= 0) { DMA_WAIT(); read_k(kc, la); } }
        l = xsum32(l);
        const float sc = (l > 0.f ? 1.f / l : 0.f) * p.GATES[row * 24 + head * 3 + 1];
#pragma unroll
        for (int reg = 0; reg < 16; ++reg) { outacc[reg] += o0[reg] * sc; outacc[16 + reg] += o1[reg] * sc; }
    }
    {
        f32x16 o0 = zero16(), o1 = zero16(); float m = ATT_NEG, l = 0.f;
        const bf16* k0p = p.PROJ + (size_t)b * cS * PE_LD + 896 + g * 64;
        const bf16* v0p = VT + vt_tile_off(16, b, 2 + g, 0);
        const rsrc_t rsK = mkrsrc(k0p), rsV = mkrsrc(v0p); const unsigned kvo = kvoff(lane, PE_LD), vvo = vvoff(lane, 32);
        const int k_lo = t0 >= 511 ? (t0 - 511) >> 5 : 0, k_hi = (t0 + 7) >> 5;
        KF kc; VF vc;
        dma_k(wl, rsK, (unsigned)(32 * k_lo) * (PE_LD * 2), PE_LD * 2, kvo); dma_v(wl, rsV, (unsigned)k_lo * 4096u, 64, vvo); DMA_WAIT(); read_k(kc, la);
#define WIN_TILE(SM_) { const int key0 = 32 * kt; \
            LDS_DRAIN(); if (kt < k_hi) dma_k(wl, rsK, (unsigned)(key0 + 32) * (PE_LD * 2), PE_LD * 2, kvo); \
            read_v(vc, la); \
            f32x16 s = qk32r(kc, qf); \
            LDS_DRAIN_PINNED(); if (kt < k_hi) dma_v(wl, rsV, (unsigned)(kt + 1) * 4096u, 64, vvo); \
            SM_; \
            pv32r(o0, o1, vc, pb); \
            if (kt < k_hi) { DMA_WAIT(); read_k(kc, la); } }
        int kt = k_lo;
        for (; kt <= k_hi && 32 * kt < t0 + 7 - 511; ++kt) WIN_TILE(sm_step(s, kc, qf, t - 511 - key0, 31, hh, m, l, o0, o1, pb))
        for (; kt <= k_hi && 32 * kt + 31 <= t0; ++kt) WIN_TILE(sm_fast(s, kc, qf, true, m, l, o0, o1, pb))
        for (; kt <= k_hi; ++kt) WIN_TILE(sm_step(s, kc, qf, 0, t - key0, hh, m, l, o0, o1, pb))
#undef WIN_TILE
        l = xsum32(l);
        const float sc = (l > 0.f ? 1.f / l : 0.f) * p.GATES[row * 24 + head * 3 + 2];
#pragma unroll
        for (int reg = 0; reg < 16; ++reg) { outacc[reg] += o0[reg] * sc; outacc[16 + reg] += o1[reg] * sc; }
    }
    store_row64(p.ATT + (size_t)row * 768 + head * 64, hh, outacc, 1.f);
}

__device__ __forceinline__ void cmp1_unit(const P& p, const bf16* W1T, const float* PEB, int u, int lane) {
    const int r = lane & 31, hh = lane >> 5;
    const int ct = u & 7, rt = (u >> 3) & 127, which = u >> 10;
    const int NR = cB * cNC * 2;
    int i = rt * 32 + r; if (i >= NR) i = NR - 1;
    const int g = i & 1, n = (i >> 1) % cNC, b = (i >> 1) / cNC;
    const bf16* ap = p.PROJ + (size_t)(b * cS + 16 * n) * PE_LD + 512 + which * 128 + g * 64 + 8 * hh;
    const bf16* bp = W1T + ((size_t)which * 256 + ct * 32 + r) * 2048 + 8 * hh;
    f32x16 acc = zero16();
    for (int l = 0; l < 32; ++l) {
#pragma unroll
        for (int q = 0; q < 4; ++q) { const bf16x8v a = *(const bf16x8v*)(ap + (size_t)l * PE_LD + 16 * q), bb = *(const bf16x8v*)(bp + l * 64 + 16 * q);
            acc = __builtin_amdgcn_mfma_f32_32x32x16_bf16(a, bb, acc, 0, 0, 0); } }
    const int j = ct * 32 + r; const float bias = PEB[which * 256 + j];
#pragma unroll
    for (int reg = 0; reg < 16; ++reg) { const int io = rt * 32 + (reg & 3) + 8 * (reg >> 2) + 4 * hh;
        if (io < NR) p.HID[((size_t)which * NR + io) * 256 + j] = gelu_tanh(acc[reg] + bias); }
}
__device__ __forceinline__ void gates_unit(const P& p, const bf16* WGT, int u, int lane) {
    const int r = lane & 31, hh = lane >> 5;
    const bf16* ap = p.Y + (size_t)(u * 32 + r) * cDM + 8 * hh; const bf16* bp = WGT + (size_t)r * cDM + 8 * hh;
    f32x16 acc = zero16();
#pragma unroll 8
    for (int ks = 0; ks < cDM / 16; ++ks) { const bf16x8v a = *(const bf16x8v*)(ap + 16 * ks), bb = *(const bf16x8v*)(bp + 16 * ks);
        acc = __builtin_amdgcn_mfma_f32_32x32x16_bf16(a, bb, acc, 0, 0, 0); }
    if (r < 24) {
#pragma unroll
        for (int reg = 0; reg < 16; ++reg) { const int row = u * 32 + (reg & 3) + 8 * (reg >> 2) + 4 * hh; p.GATES[(size_t)row * 24 + r] = 1.f / (1.f + __expf(-acc[reg])); } }
}

__device__ __forceinline__ float xlo32(float x) { float y; asm volatile("v_mov_b32 %0, %1\n\ts_nop 1" : "=v"(y) : "v"(x));
    auto r = __builtin_amdgcn_permlane32_swap(__builtin_bit_cast(unsigned, x), __builtin_bit_cast(unsigned, y), false, false); const unsigned a = r[0]; return __builtin_bit_cast(float, a); }
template <bool DIAG>
__device__ __forceinline__ void sb_tile(const f32x16& z, const VF& vc, const bf16x8v (&TA)[2], int r, int hh, float& carry, f32x16& o0, f32x16& o1) {
    f32x16 l1; float lbv[16];
#pragma unroll
    for (int reg = 0; reg < 16; ++reg) { const int ko = (reg & 3) + 8 * (reg >> 2) + 4 * hh; float zr = z[reg]; OPQ(zr); const float zz = zr * 0.125f;
        const float e = fexp2(-fabsf(zz) * 1.4426950408889634f); const float sp = __builtin_amdgcn_logf(1.f + e) * 0.6931471805599453f;
        float lb = fminf(zz, 0.f) - sp; OPQ(lb); lbv[reg] = lb; float x = (!DIAG || ko < r) ? lb - zz : 0.f; OPQ(x); l1[reg] = x; }
    unsigned bh[8], bl[8];
#pragma unroll
    for (int i = 0; i < 8; ++i) { const float x0 = l1[2 * i], x1 = l1[2 * i + 1]; const unsigned hw = cvtpk(x0, x1); bh[i] = hw; float d0 = x0 - bflo(hw), d1 = x1 - bfhi(hw); OPQ(d0); OPQ(d1); bl[i] = cvtpk(d0, d1); }
    f32x16 af = zero16();
    typedef unsigned u32x4v __attribute__((ext_vector_type(4)));
#pragma unroll
    for (int s = 0; s < 2; ++s) { const u32x4v wh = {bh[4 * s], bh[4 * s + 1], bh[4 * s + 2], bh[4 * s + 3]}, wl = {bl[4 * s], bl[4 * s + 1], bl[4 * s + 2], bl[4 * s + 3]};
        af = __builtin_amdgcn_mfma_f32_32x32x16_bf16(TA[s], __builtin_bit_cast(bf16x8v, wh), af, 0, 0, 0);
        af = __builtin_amdgcn_mfma_f32_32x32x16_bf16(TA[s], __builtin_bit_cast(bf16x8v, wl), af, 0, 0, 0); }
    unsigned pb[8]; float av[16];
#pragma unroll
    for (int reg = 0; reg < 16; ++reg) { const int ko = (reg & 3) + 8 * (reg >> 2) + 4 * hh;
        float t = lbv[reg] + af[reg]; OPQ(t); av[reg] = (!DIAG || ko < r) ? fexp2((t + carry) * 1.4426950408889634f) : 0.f; }
#pragma unroll
    for (int i = 0; i < 8; ++i) pb[i] = cvtpk(av[2 * i], av[2 * i + 1]);
    pv32r(o0, o1, vc, pb);
    carry += xlo32(af[0] + l1[0]);
}
__device__ __forceinline__ void sb_unit(const P& p, const bf16* VT, LAS unsigned char* wl, int b, int h, int t0, int lane) {
    const int r = lane & 31, hh = lane >> 5; const long row = (long)b * cS + t0 + r; const LaneAddr la = lane_addr(wl, lane);
    bf16x8v qf[4];
    { const bf16* qp = p.PROJ + (size_t)row * PO_LD + h * 64 + 8 * hh;
#pragma unroll
      for (int ks = 0; ks < 4; ++ks) qf[ks] = *(const bf16x8v*)(qp + 16 * ks); }
    bf16x8v TA[2];
#pragma unroll
    for (int s = 0; s < 2; ++s)
#pragma unroll
        for (int j = 0; j < 8; ++j) { const int kk = 16 * s + 8 * (j >> 2) + 4 * hh + (j & 3); TA[s][j] = (short)(kk > r ? 0x3F80 : 0); }
    f32x16 o0 = zero16(), o1 = zero16(); float carry = 0.f;
    const bf16* k0p = p.PROJ + (size_t)b * cS * PO_LD + cDM + h * 64;
    const bf16* v0p = VT + vt_tile_off(16, b, h, 0);
    const rsrc_t rsK = mkrsrc(k0p), rsV = mkrsrc(v0p); const unsigned kvo = kvoff(lane, PO_LD), vvo = vvoff(lane, 32);
    KF kc; VF vc;
    dma_k(wl, rsK, (unsigned)t0 * (PO_LD * 2), PO_LD * 2, kvo); dma_v(wl, rsV, (unsigned)(t0 >> 5) * 4096u, 64, vvo); DMA_WAIT(); read_k(kc, la);
#define SB_TILE(DIAG_, key0_) do { LDS_DRAIN(); if ((key0_) > 0) dma_k(wl, rsK, (unsigned)((key0_) - 32) * (PO_LD * 2), PO_LD * 2, kvo); \
        read_v(vc, la); const f32x16 z_ = qk32r(kc, qf); \
        LDS_DRAIN_PINNED(); if ((key0_) > 0) dma_v(wl, rsV, (unsigned)(((key0_) - 32) >> 5) * 4096u, 64, vvo); \
        sb_tile<DIAG_>(z_, vc, TA, r, hh, carry, o0, o1); } while (0)
    int kt = t0 >> 5;
    SB_TILE(true, t0);
    for (--kt; kt >= 0; --kt) { const int key0 = 32 * kt;
        DMA_WAIT(); read_k(kc, la);
        SB_TILE(false, key0);
        if (__all(carry < -93.f)) break; }
#undef SB_TILE
    DMA_WAIT();
    { float ov[32];
#pragma unroll
      for (int reg = 0; reg < 16; ++reg) { ov[reg] = o0[reg]; ov[16 + reg] = o1[reg]; }
      store_row64(p.ATT + (size_t)row * cDM + h * 64, hh, ov, 1.f); }
}

template <int G>
__device__ __forceinline__ void dil_unit(const P& p, const bf16* VT, const bf16* VTP, bf16* DOUT, float* DLSE, LAS unsigned char* wl, int b, int hd, int rc, int tile, int lane) {
    constexpr int dil = G == 0 ? 1 : G == 1 ? 4 : 16; constexpr int slot0 = 4 * G;
    const int r = lane & 31, hh = lane >> 5, slot = slot0 + hd; const LaneAddr la = lane_addr(wl, lane);
    const long row = (long)b * cS + rc + (long)dil * (32 * tile + r);
    bf16x8v qf[4];
    { const bf16* qp = p.PROJ + (size_t)row * PE_LD + 1024 + slot * 64 + 8 * hh;
#pragma unroll
      for (int ks = 0; ks < 4; ++ks) qf[ks] = *(const bf16x8v*)(qp + 16 * ks); }
    f32x16 o0 = zero16(), o1 = zero16(); float m = ATT_NEG, l = 0.f; unsigned pb[8];
    const bf16* k0p = p.PROJ + ((size_t)b * cS + rc) * PE_LD + 1792 + slot * 64;
    const bf16* v0p = G == 0 ? VT + vt_tile_off(16, b, 4 + slot, 0)
                             : VTP + vt_tile_off(8, b, (G - 1) * 4 + hd, rc * (cS / dil / 32));
    const rsrc_t rsK = mkrsrc(k0p), rsV = mkrsrc(v0p); const unsigned kvo = kvoff(lane, (size_t)dil * PE_LD), vvo = vvoff(lane, 32);
    const int k_lo = tile >= 4 ? tile - 4 : 0;
    KF kc; VF vc;
    dma_k(wl, rsK, (unsigned)(32 * k_lo) * (dil * PE_LD * 2), dil * PE_LD * 2, kvo); dma_v(wl, rsV, (unsigned)k_lo * 4096u, 64, vvo); DMA_WAIT(); read_k(kc, la);
    for (int kt = k_lo; kt <= tile; ++kt) { const int D0 = 32 * (tile - kt);
        LDS_DRAIN(); if (kt < tile) dma_k(wl, rsK, (unsigned)(32 * kt + 32) * (dil * PE_LD * 2), dil * PE_LD * 2, kvo);
        read_v(vc, la);
        f32x16 s = qk32r(kc, qf);
        LDS_DRAIN_PINNED(); if (kt < tile) dma_v(wl, rsV, (unsigned)(kt + 1) * 4096u, 64, vvo);
        if (D0 >= 32 && D0 <= 96) sm_fast(s, kc, qf, true, m, l, o0, o1, pb);
        else sm_step(s, kc, qf, D0 + r - 128, D0 + r, hh, m, l, o0, o1, pb);
        pv32r(o0, o1, vc, pb);
        if (kt < tile) { DMA_WAIT(); read_k(kc, la); } }
    l = xsum32(l);
    const float rl = 1.f / l;
    { float ov[32];
#pragma unroll
      for (int reg = 0; reg < 16; ++reg) { ov[reg] = o0[reg]; ov[16 + reg] = o1[reg]; }
      store_row64(DOUT + ((size_t)G * cM + row) * 256 + hd * 64, hh, ov, rl); }
    if (hh == 0) DLSE[((size_t)G * cM + row) * 4 + hd] = m + __builtin_amdgcn_logf(l);
}
namespace pg8 {
#define PG8_LAS __attribute__((address_space(3)))
typedef unsigned short bf16_t;
typedef short bf16x8 __attribute__((ext_vector_type(8)));
typedef float f32x4 __attribute__((ext_vector_type(4)));
typedef unsigned u32x4 __attribute__((ext_vector_type(4)));
constexpr int BM = 256, BK = 64, HALF = 128, HTB = HALF * BK * 2  , STAGE_BYTES = 8 * HTB, NXCD = 8, WGM = 8;

__host__ __device__ __forceinline__ int lds_byte(int r, int c) { const int st = (r >> 4) * 2 + (c >> 5), rr = r & 15, cc = c & 31, ob = rr * 64 + cc * 2; return st * 1024 + (ob ^ (((ob >> 9) & 1) << 5)); }
__host__ __device__ __forceinline__ void stage_rc(int b, int& R, int& C) { const int st = b / 1024, sb = b % 1024, swz = sb ^ (((sb >> 9) & 1) << 5); R = (st >> 1) * 16 + swz / 64; C = (st & 1) * 32 + (swz % 64) / 2; }
__host__ __device__ __forceinline__ int perm32(int rho) { const int n = rho >> 4, i = rho & 15; return 8 * (i >> 2) + 4 * n + (i & 3); }

struct Unit { int pm, pn; };
struct Gemm { const bf16_t* A; const bf16_t* Bt; int M, N, K; };

struct StaticOrder {
    int nM, nN, nwg, G, c;
    __host__ __device__ void init(int M, int N, int G_, int c_) { nM = M / BM; nN = N / BM; nwg = nM * nN; G = G_; c = c_; }
    __host__ __device__ bool next(int i, Unit& u) const {
        const long L = (long)i * G + c; if (L >= nwg) return false;
        int wgid = (int)L; { const int q = nwg / NXCD, r = nwg % NXCD, xcd = wgid % NXCD, off = wgid / NXCD; wgid = (xcd < r ? xcd * (q + 1) : r * (q + 1) + (xcd - r) * q) + off; }
        const int nig = WGM * nN, gid = wgid / nig, fm = gid * WGM, gsz = (nM - fm) < WGM ? (nM - fm) : WGM;
        u.pm = fm + ((wgid % nig) % gsz); u.pn = (wgid % nig) / gsz; return true;
    }
    __device__ __forceinline__ void a_ready(const Unit&) const {}
    __device__ __forceinline__ void done(const Unit&) const {}
};

__device__ __forceinline__ unsigned cvt_pk_bf16(float lo, float hi) { unsigned r; asm volatile("v_cvt_pk_bf16_f32 %0, %1, %2" : "=v"(r) : "v"(lo), "v"(hi)); return r; }
typedef float f32x2 __attribute__((ext_vector_type(2)));
__device__ __forceinline__ f32x2 gelu_pk(f32x2 v) {
    const f32x2 av = __builtin_elementwise_abs(v), d = av * 0.2316418882f + 1.0f;
    f32x2 t; t.x = __builtin_amdgcn_rcpf(d.x); t.y = __builtin_amdgcn_rcpf(d.y);
    f32x2 q = t * 0.5307027145f + (-0.7265760135f); q = q * t + 0.7107068705f; q = q * t + (-0.142248368f); q = q * t + 0.127414796f; q = q * t;
    const f32x2 s = (v * v) * (-0.72134752044f);
    f32x2 e; e.x = __builtin_amdgcn_exp2f(s.x); e.y = __builtin_amdgcn_exp2f(s.y);
    const f32x2 m = v * (q * e), r = v - m;
    f32x2 o; o.x = v.x < 0.f ? m.x : r.x; o.y = v.y < 0.f ? m.y : r.y; return o;
}

template <int ACT  > struct EpiBf16 {
    static constexpr bool PERM = true, AFTER_DRAIN = false, TABLE = false; static_assert(ACT == 0 || ACT == 1, "EpiBf16: ACT is 0 (none) or 1 (gelu_pk)");
    bf16_t* O; int ldc; const float* bias; int split_cols; size_t split_stride; float scale0;
    __device__ __forceinline__ void operator()(const f32x4 (&acc)[2][2][4][2], const Unit& u, int wr, int wc, int fr, int fq) const {
        const int row0 = u.pm * BM + wr * 64 + fr; int colt = u.pn * BM; bf16_t* base = O;
        float sc = 1.f; if (split_cols) { const int t = colt / split_cols; base += (size_t)t * split_stride; colt -= t * split_cols; if (t == 0) sc = scale0; }
        const int col0 = colt + wc * 32 + 8 * fq, bcol0 = u.pn * BM + wc * 32 + 8 * fq;
        f32x4 bv[2][2];
#pragma unroll
        for (int bj = 0; bj < 2; ++bj)
#pragma unroll
            for (int n = 0; n < 2; ++n) bv[bj][n] = bias ? *(const f32x4*)(bias + bcol0 + bj * HALF + 4 * n) : (f32x4){0.f, 0.f, 0.f, 0.f};
#pragma unroll
        for (int ai = 0; ai < 2; ++ai)
#pragma unroll
            for (int m = 0; m < 4; ++m) { bf16_t* rowp = base + (size_t)(row0 + ai * HALF + m * 16) * ldc + col0;
#pragma unroll
                for (int bj = 0; bj < 2; ++bj) { f32x4 v0 = acc[ai][bj][m][0] + bv[bj][0], v1 = acc[ai][bj][m][1] + bv[bj][1];
                    if (ACT == 1) { f32x2 a = gelu_pk((f32x2){v0[0], v0[1]}), b = gelu_pk((f32x2){v0[2], v0[3]}), c = gelu_pk((f32x2){v1[0], v1[1]}), d = gelu_pk((f32x2){v1[2], v1[3]});
                        v0 = (f32x4){a.x, a.y, b.x, b.y}; v1 = (f32x4){c.x, c.y, d.x, d.y}; }
                    v0 = v0 * sc; v1 = v1 * sc; u32x4 w; w.x = cvt_pk_bf16(v0[0], v0[1]); w.y = cvt_pk_bf16(v0[2], v0[3]); w.z = cvt_pk_bf16(v1[0], v1[1]); w.w = cvt_pk_bf16(v1[2], v1[3]);
                    *(u32x4*)(rowp + bj * HALF) = w; } }
    }
};
template <class Epi, class Sched, bool ALIGN_EPI = false, bool SP2 = false>
__device__ __forceinline__ void gemm_phase(PG8_LAS unsigned char* lds, const Gemm g, const Sched& S, const Epi& E) {
    int tid_ = threadIdx.x; asm volatile("" : "+v"(tid_));
    const int tid = tid_, wid = __builtin_amdgcn_readfirstlane(tid >> 6), lane = tid & 63, wr = wid >> 2, wc = wid & 3, fr = lane & 15, fq = lane >> 4;
    const int K = g.K, nt = K / BK;
    unsigned voffA[2], voffB[2];
#pragma unroll
    for (int i = 0; i < 2; ++i) { int R, C; stage_rc(tid * 16 + i * 8192, R, C); const int Rb = Epi::PERM ? ((R & ~31) + perm32(R & 31)) : R;
        voffA[i] = (unsigned)(R * K + C) * 2u; voffB[i] = (unsigned)(Rb * K + C) * 2u; }
    const size_t kstep = (size_t)(BK * 2);
    const size_t hstep = (size_t)HALF * K * 2;
    const size_t tstep = 2 * hstep;
    const unsigned ldsw = (unsigned)wid * 1024u;
    const int aoff = lds_byte(wr * 64 + fr, fq * 8), boff = lds_byte(wc * 32 + fr, fq * 8);
#define PG8_SA(b, h) (((b) * 2 + (h)) * HTB)
#define PG8_SB(b, h) ((4 + (b) * 2 + (h)) * HTB)
#define PG8_STAGE(bufoff, gbase, voff) do { _Pragma("unroll") for (int _i = 0; _i < 2; ++_i) \
        __builtin_amdgcn_global_load_lds((const unsigned*)((const char*)(gbase) + (voff)[_i]), (PG8_LAS unsigned*)(lds + (bufoff) + ldsw + _i * 8192), 16, 0, 0); } while (0)
#define PG8_LDA(dst, b, h) do { _Pragma("unroll") for (int m = 0; m < 4; ++m) _Pragma("unroll") for (int k = 0; k < 2; ++k) dst[m][k] = *(const PG8_LAS bf16x8*)(lds + PG8_SA(b, h) + aoff + m * 2048 + k * 1024); } while (0)
#define PG8_LDB(dst, b, h) do { _Pragma("unroll") for (int n = 0; n < 2; ++n) _Pragma("unroll") for (int k = 0; k < 2; ++k) dst[n][k] = *(const PG8_LAS bf16x8*)(lds + PG8_SB(b, h) + boff + n * 2048 + k * 1024); } while (0)
#define PG8_MMA(ai, bj, At, Bt) do { __builtin_amdgcn_s_setprio(1); _Pragma("unroll") for (int m = 0; m < 4; ++m) _Pragma("unroll") for (int n = 0; n < 2; ++n) _Pragma("unroll") for (int k = 0; k < 2; ++k) \
        acc[ai][bj][m][n] = __builtin_amdgcn_mfma_f32_16x16x32_bf16(Bt[n][k], At[m][k], acc[ai][bj][m][n], 0, 0, 0); __builtin_amdgcn_s_setprio(0); } while (0)
#define PG8_WAIT_V(n) asm volatile("s_waitcnt vmcnt(" #n ")" ::: "memory")
#define PG8_WAIT_L(n) asm volatile("s_waitcnt lgkmcnt(" #n ")" ::: "memory")
#define PG8_BAR __builtin_amdgcn_s_barrier()
#define PG8_SCHED __builtin_amdgcn_sched_barrier(0)
    Unit cur, nxt; int ui = 0;
    if (!S.next(0, cur)) return;
    f32x4 acc[2][2][4][2];
#pragma unroll
    for (int a = 0; a < 2; ++a)
#pragma unroll
        for (int b = 0; b < 2; ++b)
#pragma unroll
            for (int m = 0; m < 4; ++m)
#pragma unroll
                for (int n = 0; n < 2; ++n) acc[a][b][m][n] = (f32x4){0.f, 0.f, 0.f, 0.f};
    bf16x8 At[4][2], B0[2][2], B1[2][2];
    const char* cA = (const char*)g.A + (size_t)cur.pm * tstep; const char* cB = (const char*)g.Bt + (size_t)cur.pn * tstep;
    S.a_ready(cur);
    if constexpr (SP2) {
        PG8_STAGE(PG8_SB(0, 0), cB, voffB); PG8_STAGE(PG8_SB(0, 1), cB + hstep, voffB); PG8_STAGE(PG8_SA(0, 0), cA, voffA); PG8_STAGE(PG8_SA(0, 1), cA + hstep, voffA);
        if (wr == 1) PG8_BAR;
        PG8_WAIT_V(2); PG8_BAR;
        PG8_STAGE(PG8_SB(1, 0), cB + kstep, voffB); PG8_STAGE(PG8_SA(1, 0), cA + kstep, voffA); PG8_STAGE(PG8_SB(1, 1), cB + hstep + kstep, voffB);
        PG8_WAIT_V(6); PG8_BAR;
    } else {
        PG8_STAGE(PG8_SB(0, 0), cB, voffB); PG8_STAGE(PG8_SA(0, 0), cA, voffA); PG8_STAGE(PG8_SB(0, 1), cB + hstep, voffB); PG8_STAGE(PG8_SA(0, 1), cA + hstep, voffA);
        if (wr == 1) PG8_BAR;
        PG8_WAIT_V(4); PG8_BAR;
        PG8_STAGE(PG8_SB(1, 0), cB + kstep, voffB); PG8_STAGE(PG8_SA(1, 0), cA + kstep, voffA); PG8_STAGE(PG8_SB(1, 1), cB + hstep + kstep, voffB);
        PG8_WAIT_V(6); PG8_BAR;
    }
    for (;;) {
        const bool has_next = S.next(ui + 1, nxt);
        if constexpr (Epi::TABLE) { if (tid < 256) E.stage_table(cur, lds + 131072 + (ui & 1) * 4096, tid); }
        const char* nA = has_next ? (const char*)g.A + (size_t)nxt.pm * tstep : cA; const char* nB = has_next ? (const char*)g.Bt + (size_t)nxt.pn * tstep : cB;
        for (int t = 0; t < nt; t += 2) {
            const bool last = (t == nt - 2);
            const char* a1 = cA + (size_t)(t + 1) * kstep;
            const char* a2 = last ? nA : cA + (size_t)(t + 2) * kstep; const char* b2 = last ? nB : cB + (size_t)(t + 2) * kstep;
            const char* a3 = a2 + kstep; const char* b3 = b2 + kstep;
            if (last && has_next) S.a_ready(nxt);
            if constexpr (SP2) {
            PG8_LDB(B0, 0, 0); PG8_LDB(B1, 0, 1); PG8_SCHED; PG8_LDA(At, 0, 0); PG8_STAGE(PG8_SA(1, 1), a1 + hstep, voffA);
            PG8_WAIT_V(8); PG8_WAIT_L(0); PG8_BAR; PG8_MMA(0, 0, At, B0); PG8_MMA(0, 1, At, B1); PG8_BAR; PG8_SCHED;
            PG8_LDA(At, 0, 1); PG8_STAGE(PG8_SB(0, 0), b2, voffB); PG8_STAGE(PG8_SB(0, 1), b2 + hstep, voffB); PG8_STAGE(PG8_SA(0, 0), a2, voffA);
            PG8_WAIT_V(8); PG8_WAIT_L(0); PG8_BAR; PG8_MMA(1, 0, At, B0); PG8_MMA(1, 1, At, B1); PG8_BAR; PG8_SCHED;
            PG8_LDB(B0, 1, 0); PG8_LDB(B1, 1, 1); PG8_SCHED; PG8_LDA(At, 1, 0); PG8_STAGE(PG8_SA(0, 1), a2 + hstep, voffA);
            PG8_WAIT_V(8); PG8_WAIT_L(0); PG8_BAR; PG8_MMA(0, 0, At, B0); PG8_MMA(0, 1, At, B1); PG8_BAR; PG8_SCHED;
            PG8_LDA(At, 1, 1); PG8_STAGE(PG8_SB(1, 0), b3, voffB); PG8_STAGE(PG8_SB(1, 1), b3 + hstep, voffB); PG8_STAGE(PG8_SA(1, 0), a3, voffA);
            PG8_WAIT_V(8); PG8_WAIT_L(0); PG8_BAR; PG8_MMA(1, 0, At, B0); PG8_MMA(1, 1, At, B1); PG8_BAR; PG8_SCHED;
            } else {
            PG8_LDB(B0, 0, 0); PG8_SCHED; PG8_LDA(At, 0, 0); PG8_STAGE(PG8_SA(1, 1), a1 + hstep, voffA);
            PG8_WAIT_L(8); PG8_BAR; PG8_WAIT_L(0); PG8_MMA(0, 0, At, B0); PG8_BAR; PG8_SCHED;
            PG8_LDB(B1, 0, 1); PG8_STAGE(PG8_SB(0, 0), b2, voffB);
            PG8_BAR; PG8_WAIT_L(0); PG8_MMA(0, 1, At, B1); PG8_BAR;
            PG8_LDA(At, 0, 1); PG8_STAGE(PG8_SA(0, 0), a2, voffA);
            PG8_BAR; PG8_WAIT_L(0); PG8_MMA(1, 0, At, B0); PG8_BAR; PG8_SCHED;
            PG8_STAGE(PG8_SB(0, 1), b2 + hstep, voffB);
            PG8_WAIT_V(6); PG8_BAR; PG8_MMA(1, 1, At, B1); PG8_BAR;
            PG8_LDB(B0, 1, 0); PG8_SCHED; PG8_LDA(At, 1, 0); PG8_STAGE(PG8_SA(0, 1), a2 + hstep, voffA);
            PG8_WAIT_L(8); PG8_BAR; PG8_WAIT_L(0); PG8_MMA(0, 0, At, B0); PG8_BAR; PG8_SCHED;
            PG8_LDB(B1, 1, 1); PG8_STAGE(PG8_SB(1, 0), b3, voffB);
            PG8_BAR; PG8_WAIT_L(0); PG8_MMA(0, 1, At, B1); PG8_BAR;
            PG8_LDA(At, 1, 1); PG8_STAGE(PG8_SA(1, 0), a3, voffA);
            PG8_BAR; PG8_WAIT_L(0); PG8_MMA(1, 0, At, B0); PG8_BAR; PG8_SCHED;
            PG8_STAGE(PG8_SB(1, 1), b3 + hstep, voffB);
            PG8_WAIT_V(6); PG8_BAR; PG8_MMA(1, 1, At, B1); PG8_BAR;
            }
        }
        if constexpr (ALIGN_EPI) { if (wr == 0) PG8_BAR; }
        if constexpr (!Epi::AFTER_DRAIN) { if constexpr (Epi::TABLE) E.run(acc, cur, wr, wc, fr, fq, lds + 131072 + (ui & 1) * 4096); else E(acc, cur, wr, wc, fr, fq); S.done(cur); }
        if (!has_next) break;
#pragma unroll
        for (int a = 0; a < 2; ++a)
#pragma unroll
            for (int b = 0; b < 2; ++b)
#pragma unroll
                for (int m = 0; m < 4; ++m)
#pragma unroll
                    for (int n = 0; n < 2; ++n) acc[a][b][m][n] = (f32x4){0.f, 0.f, 0.f, 0.f};
        cur = nxt; cA = nA; cB = nB; ++ui;
        if constexpr (ALIGN_EPI) { if (wr == 1) PG8_BAR; }
    }
    PG8_WAIT_V(0);
    if constexpr (!ALIGN_EPI) { if (wr == 0) PG8_BAR; }
    PG8_BAR;
    if constexpr (Epi::AFTER_DRAIN) { E.fused(acc, cur, wr, wc, fr, fq, lds, wid, lane); S.done(cur); }
#undef PG8_SA
#undef PG8_SB
#undef PG8_STAGE
#undef PG8_LDA
#undef PG8_LDB
#undef PG8_MMA
#undef PG8_WAIT_V
#undef PG8_WAIT_L
#undef PG8_BAR
#undef PG8_SCHED
}
}
namespace pg8 {
struct EpiRopeE {
    static constexpr bool PERM = true, AFTER_DRAIN = false, TABLE = false;
    bf16_t* O; int ldc; const float* rope;
    __device__ __forceinline__ void operator()(const f32x4 (&acc)[2][2][4][2], const Unit& u, int wr, int wc, int fr, int fq) const {
        const int row0 = u.pm * BM + wr * 64 + fr;
        if (u.pn == 2) {
            const int col0 = u.pn * BM + wc * 32 + 8 * fq;
#pragma unroll
            for (int ai = 0; ai < 2; ++ai)
#pragma unroll
                for (int m = 0; m < 4; ++m) { bf16_t* rowp = O + (size_t)(row0 + ai * HALF + m * 16) * ldc + col0;
#pragma unroll
                    for (int bj = 0; bj < 2; ++bj) { const f32x4 v0 = acc[ai][bj][m][0], v1 = acc[ai][bj][m][1]; u32x4 w;
                        w.x = cvt_pk_bf16(v0[0], v0[1]); w.y = cvt_pk_bf16(v0[2], v0[3]); w.z = cvt_pk_bf16(v1[0], v1[1]); w.w = cvt_pk_bf16(v1[2], v1[3]); *(u32x4*)(rowp + bj * HALF) = w; } }
        } else {
            const int kk = 4 * (wc & 1) + fq;
#pragma unroll
            for (int ai = 0; ai < 2; ++ai)
#pragma unroll
                for (int m = 0; m < 4; ++m) { const int row = row0 + ai * HALF + m * 16, pos = row & (cS - 1);
                    const f32x4 c0 = *(const f32x4*)(rope + (size_t)(pos * 32 + 4 * kk) * 2), c1 = *(const f32x4*)(rope + (size_t)(pos * 32 + 4 * kk) * 2 + 4);
#pragma unroll
                    for (int bj = 0; bj < 2; ++bj) { const f32x4 x1 = acc[ai][bj][m][0], x2 = acc[ai][bj][m][1];
                        bf16_t* op = O + (size_t)row * ldc + u.pn * BM + (2 * bj + (wc >> 1)) * 64 + 4 * kk;
                        const unsigned ax = cvt_pk_bf16(x1[0] * c0[0] - x2[0] * c0[1], x1[1] * c0[2] - x2[1] * c0[3]), ay = cvt_pk_bf16(x1[2] * c1[0] - x2[2] * c1[1], x1[3] * c1[2] - x2[3] * c1[3]);
                        const unsigned bx = cvt_pk_bf16(x2[0] * c0[0] + x1[0] * c0[1], x2[1] * c0[2] + x1[1] * c0[3]), by = cvt_pk_bf16(x2[2] * c1[0] + x1[2] * c1[1], x2[3] * c1[2] + x1[3] * c1[3]);
                        auto rx = __builtin_amdgcn_permlane16_swap(ax, bx, false, false); auto ry = __builtin_amdgcn_permlane16_swap(ay, by, false, false);
                        u32x4 w; w.x = rx[0]; w.y = ry[0]; w.z = rx[1]; w.w = ry[1];
                        *(u32x4*)((fq & 1) ? op + 32 - 4 : op) = w; } }
        }
    }
};
struct EpiVT {
    static constexpr bool PERM = true, AFTER_DRAIN = false, TABLE = false;
    bf16_t* O;
    __device__ __forceinline__ void operator()(const f32x4 (&acc)[2][2][4][2], const Unit& u, int wr, int wc, int fr, int fq) const {
        const int row0 = u.pm * BM + wr * 64 + fr, col0 = u.pn * BM + wc * 32 + 8 * fq;
#pragma unroll
        for (int ai = 0; ai < 2; ++ai)
#pragma unroll
            for (int m = 0; m < 4; ++m) { const int dg = row0 + ai * HALF + m * 16;
#pragma unroll
                for (int bj = 0; bj < 2; ++bj) { const int col = col0 + bj * HALF, b = col / cS, tk = col & (cS - 1);
                    const f32x4 v0 = acc[ai][bj][m][0], v1 = acc[ai][bj][m][1]; u32x4 w;
                    w.x = cvt_pk_bf16(v0[0], v0[1]); w.y = cvt_pk_bf16(v0[2], v0[3]); w.z = cvt_pk_bf16(v1[0], v1[1]); w.w = cvt_pk_bf16(v1[2], v1[3]);
                    *(u32x4*)(O + vt_elem_off(16, b, dg, tk)) = w; } }
    }
};
__device__ __forceinline__ float ror1f(float x) { return __builtin_bit_cast(float, __builtin_amdgcn_mov_dpp(__builtin_bit_cast(int, x), 0x121, 0xF, 0xF, false)); }
__device__ __forceinline__ float ror2f(float x) { return __builtin_bit_cast(float, __builtin_amdgcn_mov_dpp(__builtin_bit_cast(int, x), 0x122, 0xF, 0xF, false)); }
__device__ __forceinline__ float gelu_fast(float x) { const float w = __builtin_fmaf(x * x, -2.3022081981f * 0.044715f, -2.3022081981f); return x * __builtin_amdgcn_rcpf(1.f + __builtin_amdgcn_exp2f(x * w)); }
struct EpiConvGelu {
    static constexpr bool PERM = true, AFTER_DRAIN = false, TABLE = true;
    bf16_t* ACT; const float* cw; const float* cb; float* SB;
    __device__ __forceinline__ void stage_table(const Unit& u, PG8_LAS unsigned char* tab, int tid) const {
        constexpr int LD2 = 2 * cDFF; const int v = tid >> 5, c4 = tid & 31, j = u.pn * 128 + 4 * c4;
        const float* src = ((v & 3) == 3 ? cb : cw + (v & 3) * LD2) + (v >> 2) * cDFF + j;
        *(PG8_LAS f32x4*)(tab + (v * 128 + 4 * c4) * 4) = *(const f32x4*)src; }
    __device__ __forceinline__ void run(const f32x4 (&acc)[2][2][4][2], const Unit& u, int wr, int wc, int fr, int fq, const PG8_LAS unsigned char* tab) const {
        constexpr int LD2 = 2 * cDFF;
        typedef unsigned u32x2 __attribute__((ext_vector_type(2)));
        u32x2 hold[2][4];
#pragma unroll
        for (int n = 0; n < 2; ++n) {
            const int ch0 = wc * 32 + 8 * fq + 4 * n, j0 = u.pn * 128 + ch0;
            const PG8_LAS f32x4* tv = (const PG8_LAS f32x4*)(tab + ch0 * 4);
            const f32x4 w0g = tv[0], w1g = tv[32], w2g = tv[64], bg = tv[96], w0v = tv[128], w1v = tv[160], w2v = tv[192], bv = tv[224];
#pragma unroll
            for (int ai = 0; ai < 2; ++ai) { const int rb = u.pm * BM + ai * HALF + wr * 64, blk = rb >> 6;
                f32x4 pg1, pg2, pv1, pv2;
#pragma unroll
                for (int m = 0; m < 4; ++m) { const f32x4 g = acc[ai][0][m][n], v = acc[ai][1][m][n]; const int row = rb + 16 * m + fr;
                    f32x4 g1, g2, v1, v2;
#pragma unroll
                    for (int e = 0; e < 4; ++e) { g1[e] = ror1f(g[e]); g2[e] = ror2f(g[e]); v1[e] = ror1f(v[e]); v2[e] = ror2f(v[e]); }
                    f32x4 a1g = g1, a2g = g2, a1v = v1, a2v = v2;
                    if (m > 0) { if (fr < 1) { a1g = pg1; a1v = pv1; } if (fr < 2) { a2g = pg2; a2v = pv2; } }
                    pg1 = g1; pg2 = g2; pv1 = v1; pv2 = v2;
                    if (m > 0 || fr >= 2) { float o[4];
#pragma unroll
                        for (int e = 0; e < 4; ++e) { const float cg = bg[e] + w0g[e] * a2g[e] + w1g[e] * a1g[e] + w2g[e] * g[e], cv = bv[e] + w0v[e] * a2v[e] + w1v[e] * a1v[e] + w2v[e] * v[e]; o[e] = gelu_fast(cg) * cv; }
                        u32x2 w; w.x = cvt_pk_bf16(o[0], o[1]); w.y = cvt_pk_bf16(o[2], o[3]);
                        if (n == 0) hold[ai][m] = w; else { u32x4 q; q.x = hold[ai][m].x; q.y = hold[ai][m].y; q.z = w.x; q.w = w.y; *(u32x4*)(ACT + (size_t)row * cDFF + j0 - 4) = q; } }
                    if (m == 0 && fr < 2) { float* sp = SB + ((size_t)blk * 4 + fr) * LD2; *(f32x4*)(sp + j0) = g; *(f32x4*)(sp + cDFF + j0) = v; }
                    if (m == 3 && fr >= 14) { float* sp = SB + ((size_t)blk * 4 + 2 + (fr - 14)) * LD2; *(f32x4*)(sp + j0) = g; *(f32x4*)(sp + cDFF + j0) = v; }
                } }
        }
    }
};
}
#define XB_TMO      128
#define XB_XCNT(j)  (256  + 64 * (j))
#define XB_XSUB(j)  (1280 + 64 * (j))
#define XB_XGEN(j)  (2304 + 64 * (j))
#define XB_TOP      3328
#define XB_TOPGEN   3392
#define XCD_BAR_WORDS 3456
#define XB_SPIN_CAP (1u << 18)

__device__ __forceinline__ unsigned xb_ld(unsigned* p)              { return __hip_atomic_load(p, __ATOMIC_RELAXED, __HIP_MEMORY_SCOPE_AGENT); }
__device__ __forceinline__ unsigned xb_add(unsigned* p, unsigned v) { return __hip_atomic_fetch_add(p, v, __ATOMIC_RELAXED, __HIP_MEMORY_SCOPE_AGENT); }
__device__ __forceinline__ unsigned xb_xcc_id() { return (unsigned)__builtin_amdgcn_s_getreg((3 << 11) | 20) & 0xFu; }
#define XB_SPIN(cond, bar) do { unsigned _sp = 0; while (cond) { __builtin_amdgcn_s_sleep(1); \
    if ((++_sp & 255u) == 0u) { if (xb_ld(&(bar)[XB_TMO])) break; if (_sp > XB_SPIN_CAP) { atomicAdd(&(bar)[XB_TMO], 1u); break; } } } } while (0)

struct XcdBarrier {
    unsigned* bar; unsigned x;
    volatile LAS unsigned* st;
};

__device__ __forceinline__ XcdBarrier xcd_barrier_post(unsigned* bar, volatile LAS unsigned* st) {
    XcdBarrier b; b.bar = bar; b.x = xb_xcc_id(); b.st = st;
    if (threadIdx.x == 0) (void)xb_add(&bar[XB_XCNT(b.x)], 1u);
    return b;
}
__device__ __forceinline__ void xcd_barrier_complete(unsigned* bar, unsigned x, unsigned& nloc, unsigned& nx) {
    const unsigned G = gridDim.x * gridDim.y * gridDim.z;
    unsigned sum, cnt, mine, sp = 0u;
    for (;;) {
        sum = 0u; cnt = 0u; mine = 0u;
#pragma unroll
        for (unsigned j = 0; j < 16; ++j) { const unsigned c = xb_ld(&bar[XB_XCNT(j)]); sum += c; cnt += (c > 0u) ? 1u : 0u; mine = (j == x) ? c : mine; }
        if (sum == G) break;
        __builtin_amdgcn_s_sleep(1);
        if ((++sp & 255u) == 0u) { if (xb_ld(&bar[XB_TMO])) break; if (sp > XB_SPIN_CAP) { atomicAdd(&bar[XB_TMO], 1u); break; } }
    }
    nloc = mine > 0u ? mine : 1u; nx = cnt > 0u ? cnt : 1u;
}

__device__ __forceinline__ void xcd_barrier(const XcdBarrier& b) {
    asm volatile("s_waitcnt vmcnt(0)" ::: "memory");
    __syncthreads();
    if (threadIdx.x == 0) {
        unsigned* bar = b.bar;
        __builtin_amdgcn_s_waitcnt(0);
        unsigned nloc = b.st[0], nx = b.st[1];
        if (nloc == 0u) { xcd_barrier_complete(bar, b.x, nloc, nx); b.st[0] = nloc; b.st[1] = nx; }
        const unsigned old = xb_add(&bar[XB_XSUB(b.x)], 1u);
        const unsigned gen = old / nloc;
        if (old + 1u == (gen + 1u) * nloc) {
            __builtin_amdgcn_fence(__ATOMIC_RELEASE, "agent");
            asm volatile("s_waitcnt vmcnt(0)" ::: "memory");
            const unsigned og = xb_add(&bar[XB_TOP], 1u);
            const unsigned tg = og / nx;
            if (og + 1u == (tg + 1u) * nx) xb_add(&bar[XB_TOPGEN], 1u);
            else XB_SPIN(xb_ld(&bar[XB_TOPGEN]) == tg, bar);
            __builtin_amdgcn_fence(__ATOMIC_ACQUIRE, "agent");
            xb_add(&bar[XB_XGEN(b.x)], 1u);
            asm volatile("s_waitcnt vmcnt(0)" ::: "memory");
        } else {
            XB_SPIN(xb_ld(&bar[XB_XGEN(b.x)]) == gen, bar);
            __builtin_amdgcn_fence(__ATOMIC_ACQUIRE, "agent");
            asm volatile("s_waitcnt vmcnt(0)" ::: "memory");
        }
    }
    __syncthreads();
}
constexpr int NWAVES = 8, NTHREADS = 512;
constexpr size_t MiB = 1u << 20;
constexpr size_t WS_CTL = 0, CTL_ZERO_BYTES = 65536;
constexpr size_t WS_WGT = 128 * 1024, WS_PEB = 256 * 1024;
constexpr size_t WS_WIN = 1 * MiB, WS_WV = 6 * MiB, WS_WOUT = 8 * MiB, WS_WUP = 10 * MiB, WS_WDN = 21 * MiB, WS_ROPE = 27 * MiB, WS_GATES = 29 * MiB, WS_KCMP = 32 * MiB,
                 WS_HID = 33 * MiB, WS_VCT = 41 * MiB, WS_W1T = 42 * MiB, WS_Y = 44 * MiB, WS_ATT = 44 * MiB  ,
                 WS_H16 = 108 * MiB  , WS_PROJ = 172 * MiB, WS_VT = 340 * MiB, WS_ACT = 172 * MiB  ,
                 WS_SB = 348 * MiB  , WS_Y2 = 406 * MiB,
                 WS_DOUT = 406 * MiB  , WS_DLSE = 454 * MiB, WS_VTP = 470 * MiB, WS_END = 504 * MiB;
static_assert((size_t)3 * cM * 256 * 2 <= WS_DLSE - WS_DOUT && WS_DLSE + (size_t)3 * cM * 4 * 4 <= WS_VTP && WS_VTP + (size_t)512 * VT_LD * 2 <= WS_END && (size_t)cM * PE_LD * 2 <= WS_VT - WS_PROJ && (size_t)1024 * VT_LD * 2 <= WS_Y2 - WS_VT
              && WS_ACT + (size_t)cM * cDFF * 2 <= WS_SB && WS_SB + (size_t)(cM / 64) * 4 * 2 * cDFF * 4 <= WS_Y2 && WS_H16 + (size_t)cM * cDM * 2 <= WS_PROJ, "workspace map");
constexpr int CW_BAR = 4096;
constexpr int RING_BYTES = 131072, LDSCTL_OFF = 8 * 17408  , MISC_OFF = LDSCTL_OFF + 320, LDS_BYTES = 147456;
typedef float f32x4 __attribute__((ext_vector_type(4)));

__device__ __forceinline__ int opaque(int x) { asm volatile("" : "+v"(x)); return x; }
__device__ __forceinline__ float wave_sum(float v) {
#pragma unroll
    for (int o = 1; o < 64; o <<= 1) v += __shfl_xor(v, o);
    return v;
}
__device__ __forceinline__ void n_row_dev(const float* xrow, const float* g, bf16* yrow, int lane) {
    float v[16]; float ss = 0.f;
#pragma unroll
    for (int j = 0; j < 2; ++j)
#pragma unroll
        for (int q = 0; q < 2; ++q) { const f32x4 t = *(const f32x4*)(xrow + 8 * lane + 512 * j + 4 * q);
            v[8 * j + 4 * q + 0] = t.x; v[8 * j + 4 * q + 1] = t.y; v[8 * j + 4 * q + 2] = t.z; v[8 * j + 4 * q + 3] = t.w; ss += t.x * t.x + t.y * t.y + t.z * t.z + t.w * t.w; }
    const float r = 1.f / sqrtf(wave_sum(ss) * (1.f / cDM) + 1e-6f);
#pragma unroll
    for (int j = 0; j < 2; ++j) { const float* gp = g + 8 * lane + 512 * j; U4 o;
        o.x = cvtpk(v[8 * j + 0] * r * gp[0], v[8 * j + 1] * r * gp[1]); o.y = cvtpk(v[8 * j + 2] * r * gp[2], v[8 * j + 3] * r * gp[3]);
        o.z = cvtpk(v[8 * j + 4] * r * gp[4], v[8 * j + 5] * r * gp[5]); o.w = cvtpk(v[8 * j + 6] * r * gp[6], v[8 * j + 7] * r * gp[7]);
        *(U4*)(yrow + 8 * lane + 512 * j) = o; }
}
template <bool HIN_F32, bool HOUT_F32>
__device__ __forceinline__ void nrn_row_dev(const void* hin_, const bf16* y2, const float* g1, const float* g2, void* hout_, bf16* yrow, int lane) {
    float v[16]; float ss = 0.f;
#pragma unroll
    for (int j = 0; j < 2; ++j) { const U4 t = *(const U4*)(y2 + 8 * lane + 512 * j);
        v[8 * j + 0] = bflo(t.x); v[8 * j + 1] = bfhi(t.x); v[8 * j + 2] = bflo(t.y); v[8 * j + 3] = bfhi(t.y); v[8 * j + 4] = bflo(t.z); v[8 * j + 5] = bfhi(t.z); v[8 * j + 6] = bflo(t.w); v[8 * j + 7] = bfhi(t.w); }
#pragma unroll
    for (int e = 0; e < 16; ++e) ss += v[e] * v[e];
    const float r = 1.f / sqrtf(wave_sum(ss) * (1.f / cDM) + 1e-6f);
    float s2 = 0.f;
#pragma unroll
    for (int j = 0; j < 2; ++j) { const int e0 = 8 * lane + 512 * j; float hv[8];
        if (HIN_F32) { const f32x4 a = *(const f32x4*)((const float*)hin_ + e0), b = *(const f32x4*)((const float*)hin_ + e0 + 4); hv[0] = a.x; hv[1] = a.y; hv[2] = a.z; hv[3] = a.w; hv[4] = b.x; hv[5] = b.y; hv[6] = b.z; hv[7] = b.w; }
        else { const U4 t = *(const U4*)((const bf16*)hin_ + e0); hv[0] = bflo(t.x); hv[1] = bfhi(t.x); hv[2] = bflo(t.y); hv[3] = bfhi(t.y); hv[4] = bflo(t.z); hv[5] = bfhi(t.z); hv[6] = bflo(t.w); hv[7] = bfhi(t.w); }
        const f32x4 ga = *(const f32x4*)(g1 + e0), gb = *(const f32x4*)(g1 + e0 + 4); const float gg[8] = {ga.x, ga.y, ga.z, ga.w, gb.x, gb.y, gb.z, gb.w};
#pragma unroll
        for (int e = 0; e < 8; ++e) { const float hn = hv[e] + v[8 * j + e] * r * gg[e]; v[8 * j + e] = hn; }
        if (HOUT_F32) { f32x4 a, b; a.x = v[8 * j]; a.y = v[8 * j + 1]; a.z = v[8 * j + 2]; a.w = v[8 * j + 3]; b.x = v[8 * j + 4]; b.y = v[8 * j + 5]; b.z = v[8 * j + 6]; b.w = v[8 * j + 7];
            *(f32x4*)((float*)hout_ + e0) = a; *(f32x4*)((float*)hout_ + e0 + 4) = b; }
        else { U4 o; o.x = cvtpk(v[8 * j], v[8 * j + 1]); o.y = cvtpk(v[8 * j + 2], v[8 * j + 3]);
            o.z = cvtpk(v[8 * j + 4], v[8 * j + 5]); o.w = cvtpk(v[8 * j + 6], v[8 * j + 7]);
            *(U4*)((bf16*)hout_ + e0) = o;
            v[8 * j + 0] = bflo(o.x); v[8 * j + 1] = bfhi(o.x); v[8 * j + 2] = bflo(o.y); v[8 * j + 3] = bfhi(o.y); v[8 * j + 4] = bflo(o.z); v[8 * j + 5] = bfhi(o.z); v[8 * j + 6] = bflo(o.w); v[8 * j + 7] = bfhi(o.w); }
#pragma unroll
        for (int e = 0; e < 8; ++e) s2 += v[8 * j + e] * v[8 * j + e]; }
    if (g2) { const float r2 = 1.f / sqrtf(wave_sum(s2) * (1.f / cDM) + 1e-6f);
#pragma unroll
        for (int j = 0; j < 2; ++j) { const float* gp = g2 + 8 * lane + 512 * j; U4 o;
            o.x = cvtpk(v[8 * j + 0] * r2 * gp[0], v[8 * j + 1] * r2 * gp[1]); o.y = cvtpk(v[8 * j + 2] * r2 * gp[2], v[8 * j + 3] * r2 * gp[3]);
            o.z = cvtpk(v[8 * j + 4] * r2 * gp[4], v[8 * j + 5] * r2 * gp[5]); o.w = cvtpk(v[8 * j + 6] * r2 * gp[6], v[8 * j + 7] * r2 * gp[7]);
            *(U4*)(yrow + 8 * lane + 512 * j) = o; } }
}

template <int K, int ldw, int N, int mode, int c0>
__device__ __forceinline__ void wprep_tile(const float* W, bf16* Bt, int tile, int lane, LAS float* scr) {
    constexpr int nblk = N / 32; const int kb = tile / nblk, nb = tile % nblk, k0 = 64 * kb, n0 = 32 * nb;
    const int c4 = 4 * (lane & 7), col = c0 + (mode ? wsrc_col(mode, n0 + c4) : n0 + c4);
#pragma unroll
    for (int i = 0; i < 8; ++i) { const int kk = 8 * i + (lane >> 3); const f32x4 t = *(const f32x4*)(W + (size_t)(k0 + kk) * ldw + col);
        scr[kk * 33 + c4] = t.x; scr[kk * 33 + c4 + 1] = t.y; scr[kk * 33 + c4 + 2] = t.z; scr[kk * 33 + c4 + 3] = t.w; }
    const int c = lane & 7;
#pragma unroll
    for (int j = 0; j < 4; ++j) { const int n = (lane >> 3) + 8 * j; const LAS float* s = scr + (8 * c) * 33 + n;
        U4 o; o.x = cvtpk(s[0], s[33]); o.y = cvtpk(s[2 * 33], s[3 * 33]);
        o.z = cvtpk(s[4 * 33], s[5 * 33]); o.w = cvtpk(s[6 * 33], s[7 * 33]);
        *(U4*)(Bt + (size_t)(n0 + n) * K + k0 + 8 * c) = o; }
    asm volatile("s_waitcnt lgkmcnt(0)" ::: "memory");
}
struct Args { const float* in[13]; float* out; unsigned char* ws; };

__global__ void __launch_bounds__(NTHREADS, 2) fwd(Args a) {
    extern __shared__ __attribute__((aligned(16))) unsigned char lds[];
    LAS unsigned char* L = (LAS unsigned char*)lds;
    const int tid = threadIdx.x, lane = tid & 63, wave = __builtin_amdgcn_readfirstlane(tid >> 6);
#define VCU() ((gridDim.x % 8 == 0) ? (int)((blockIdx.x % 8) * (gridDim.x / 8) + blockIdx.x / 8) : (int)blockIdx.x)
    for (int u = tid; u < (LDS_BYTES - LDSCTL_OFF) / 4; u += NTHREADS) ((LAS unsigned*)(L + LDSCTL_OFF))[u] = 0u;
    __syncthreads();
    XcdBarrier bar;
    { unsigned char* ws0 = a.ws; bar = xcd_barrier_post((unsigned*)(ws0 + WS_CTL) + CW_BAR, (volatile LAS unsigned*)(L + MISC_OFF) + 8); }
#define MKP() P p; unsigned char* wsb; { int z_ = 0; asm volatile("" : "+s"(z_)); unsigned char* ws = a.ws + z_; wsb = ws; const float* const* in_ = a.in + z_; \
    p.x = in_[0]; p.norm_g = in_[1]; p.even_w_in = in_[2]; p.even_w_out = in_[3]; p.cmp_pe = in_[4]; p.cmp_w1 = in_[5]; p.cmp_w2 = in_[6]; p.odd_w_in = in_[7]; p.odd_w_out = in_[8]; \
    p.ffn_w_up = in_[9]; p.ffn_conv_w = in_[10]; p.ffn_conv_b = in_[11]; p.ffn_w_down = in_[12]; p.out = (&a.out)[z_]; \
    p.Wt_in = (bf16*)(ws + WS_WIN); p.Wt_out = (bf16*)(ws + WS_WOUT); p.Wt_up = (bf16*)(ws + WS_WUP); p.Wt_dn = (bf16*)(ws + WS_WDN); \
    p.ROPE = (float*)(ws + WS_ROPE); p.GATES = (float*)(ws + WS_GATES); p.KCMP = (bf16*)(ws + WS_KCMP); \
    p.HID = (float*)(ws + WS_HID); p.Y = (bf16*)(ws + WS_Y); p.PROJ = (bf16*)(ws + WS_PROJ); p.ATT = (bf16*)(ws + WS_ATT); p.Y2 = (bf16*)(ws + WS_Y2); \
    p.ACT = (bf16*)(ws + WS_ACT); p.VT = (bf16*)(ws + WS_VT); p.VCT = (bf16*)(ws + WS_VCT); }

#define GRUN(N, call) do { const long _n = (long)(N); const long gthreads = (long)gridDim.x * NTHREADS; for (long i = (long)blockIdx.x * NTHREADS + opaque((int)threadIdx.x); i < _n; i += gthreads) { call; } } while (0)
#define GRID_BAR() xcd_barrier(bar)
#define GEMM_E(EpiT, Einit, Aptr, Btptr, Mrows, Ncols, Kdim) do { pg8::Gemm g{(const pg8::bf16_t*)(Aptr), (const pg8::bf16_t*)(Btptr), (int)(Mrows), (int)(Ncols), (int)(Kdim)}; \
        pg8::StaticOrder S; S.init((int)(Mrows), (int)(Ncols), (int)gridDim.x, (int)blockIdx.x); EpiT E Einit; \
        pg8::gemm_phase<EpiT, pg8::StaticOrder, true, true>(L, g, S, E); } while (0)
#define COMMA ,
#define GEMM(Aptr, Btptr, Mrows, Ncols, Kdim, Optr, ldo) GEMM_E(pg8::EpiBf16<0>, {(pg8::bf16_t*)(Optr) COMMA (int)(ldo) COMMA nullptr COMMA 0 COMMA 0 COMMA 1.f}, Aptr, Btptr, Mrows, Ncols, Kdim)
#define WT(Wp, K_, ldw_, N_, Btp, mode_, c0_) do { const int nt_ = ((N_) / 32) * ((K_) / 64); LAS float* scr_ = (LAS float*)(L + wave * 17408); \
        for (int t_ = blockIdx.x * NWAVES + wave; t_ < nt_; t_ += gridDim.x * NWAVES) wprep_tile<(K_), (ldw_), (N_), (mode_), (c0_)>((Wp), (Btp), t_, lane, scr_); } while (0)
#define WPREP(LL) do { const int _li = (LL) / 2; \
        if (((LL) & 1) == 0) { const float* W = p.even_w_in + (size_t)_li * cDM * EIN_W; \
            WT(W, cDM, EIN_W, LDE2, p.Wt_in, 1, 0); \
            WT(W, cDM, EIN_W, 1024, (bf16*)(wsb + WS_WV), 2, 0); \
            WT(p.even_w_out + (size_t)_li * 768 * cDM, 768, cDM, cDM, p.Wt_out, 0, 0); \
            WT(W, cDM, EIN_W, 32, (bf16*)(wsb + WS_WGT), 0, 1280); \
            WT(p.cmp_w1 + ((size_t)_li * 2 + 0) * 2048 * 256, 2048, 256, 256, (bf16*)(wsb + WS_W1T), 0, 0); \
            WT(p.cmp_w1 + ((size_t)_li * 2 + 1) * 2048 * 256, 2048, 256, 256, (bf16*)(wsb + WS_W1T) + (size_t)256 * 2048, 0, 0); \
            GRUN(512, peb_item(p.cmp_pe + (size_t)_li * 2 * 2048, p.cmp_w1 + (size_t)_li * 2 * 2048 * 256, (float*)(wsb + WS_PEB), i)); } \
        else { const float* W = p.odd_w_in + (size_t)_li * cDM * 3 * cDM; \
            WT(W, cDM, 3 * cDM, 2 * cDM, p.Wt_in, 0, 0); \
            WT(W, cDM, 3 * cDM, cDM, (bf16*)(wsb + WS_WV), 0, 2 * cDM); \
            WT(p.odd_w_out + (size_t)_li * cDM * cDM, cDM, cDM, cDM, p.Wt_out, 0, 0); } \
        WT(p.ffn_w_up + (size_t)(LL) * cDM * 2 * cDFF, cDM, 2 * cDFF, 2 * cDFF, p.Wt_up, 3, 0); \
        WT(p.ffn_w_down + (size_t)(LL) * cDFF * cDM, cDFF, cDM, cDM, p.Wt_dn, 0, 0); } while (0)
#define NRN(FIN, FOUT, hin_, hout_, g1_, g2_) do { for (long r = blockIdx.x * NWAVES + wave; r < cM; r += gridDim.x * NWAVES) nrn_row_dev<FIN, FOUT>((hin_) + r * cDM, p.Y2 + r * cDM, (g1_), (g2_), (hout_) + r * cDM, p.Y + r * cDM, lane); } while (0)
#define H16P ((bf16*)(wsb + WS_H16))
#define FFN(LL) do { \
        { MKP(); GEMM_E(pg8::EpiConvGelu, {(pg8::bf16_t*)p.ACT COMMA p.ffn_conv_w + (size_t)(LL) * 3 * 2 * cDFF COMMA p.ffn_conv_b + (size_t)(LL) * 2 * cDFF COMMA (float*)(wsb + WS_SB)}, p.Y, p.Wt_up, cM, 2 * cDFF, cDM); } GRID_BAR(); \
        { MKP(); GRUN((long)(cM / 64) * 2 * (cDFF / 4), convfix_item(p, (const float*)(wsb + WS_SB), p.ffn_conv_w + (size_t)(LL) * 3 * 2 * cDFF, p.ffn_conv_b + (size_t)(LL) * 2 * cDFF, i)); } GRID_BAR(); \
        { MKP(); GEMM(p.ACT, p.Wt_dn, cM, cDM, cDFF, p.Y2, cDM); } GRID_BAR(); \
        { MKP(); const float* ng = p.norm_g + (size_t)(LL) * 4 * cDM; if ((LL) + 1 < 4) NRN(false, false, H16P, H16P, ng + 3 * cDM, ng + 4 * cDM); else NRN(false, true, H16P, p.out, ng + 3 * cDM, (const float*)nullptr); \
          if ((LL) + 1 < 4) WPREP((LL) + 1); } GRID_BAR(); } while (0)
#define EVEN_LAYER(lp) do { const int LL = 2 * (lp); \
          { MKP(); GEMM_E(pg8::EpiRopeE, {(pg8::bf16_t*)p.PROJ COMMA PE_LD COMMA p.ROPE}, p.Y, p.Wt_in, cM, LDE2, cDM); } \
          { MKP(); GEMM_E(pg8::EpiVT, {(pg8::bf16_t*)p.VT}, (const bf16*)(wsb + WS_WV), p.Y, 1024, cM, cDM); } GRID_BAR();            \
          { MKP(); GRUN((long)512 * cB * (cS / 128), vtp_item(p.VT, (bf16*)(wsb + WS_VTP), i)); if (wave < 4) for (int u = blockIdx.x * 4 + wave; u < cM / 32; u += gridDim.x * 4) gates_unit(p, (const bf16*)(wsb + WS_WGT), u, lane);     \
            for (int u = blockIdx.x * NWAVES + wave; u < 2048; u += gridDim.x * NWAVES) cmp1_unit(p, (const bf16*)(wsb + WS_W1T), (const float*)(wsb + WS_PEB), u, lane); } GRID_BAR(); \
          { MKP(); GRUN((long)2 * cB * cNC * 2 * 32, cmp2_item(p, p.cmp_w2 + (size_t)(lp) * 2 * 256 * 64, i)); } GRID_BAR(); \
          { MKP(); const int ngw = gridDim.x * NWAVES; bf16* DO_ = (bf16*)(wsb + WS_DOUT); float* DL_ = (float*)(wsb + WS_DLSE); const bf16* VP_ = (const bf16*)(wsb + WS_VTP); \
              \
            for (int u = VCU() * NWAVES + wave; u < cB * 4 * 256; u += ngw) { const int bh = u >> 8, x = u & 255; \
                dil_unit<0>(p, p.VT, VP_, DO_, DL_, L + wave * 17408, bh >> 2, bh & 3, 0, x, lane); \
                dil_unit<1>(p, p.VT, VP_, DO_, DL_, L + wave * 17408, bh >> 2, bh & 3, x >> 6, x & 63, lane); \
                dil_unit<2>(p, p.VT, VP_, DO_, DL_, L + wave * 17408, bh >> 2, bh & 3, x >> 4, x & 15, lane); } } \
          { MKP(); const int ngw = gridDim.x * NWAVES, NT = cS / 8; LAS unsigned char* wl = L + wave * 17408; \
              \
            for (int u = VCU() * NWAVES + wave; u < cB * 2 * NT; u += ngw) { const int gw = u % ngw, k = u / ngw; int bg, tile; \
                if (ngw == 2048) { bg = gw >> 8; const int i = gw & 255; tile = 256 * k + ((k & 1) ? 255 - i : i); } else { bg = u / NT; tile = u % NT; } \
                nsa_unit(p, p.VCT, p.VT, wl, bg >> 1, bg & 1, tile * 8, lane); } } GRID_BAR(); \
          { MKP(); GRUN((long)cM * 32, dil_combine_item(p, (const bf16*)(wsb + WS_DOUT), (const float*)(wsb + WS_DLSE), i)); } GRID_BAR(); \
          { MKP(); GEMM(p.ATT, p.Wt_out, cM, cDM, 768, p.Y2, cDM); } GRID_BAR(); \
          { MKP(); const float* ng = p.norm_g + (size_t)LL * 4 * cDM; if ((lp) == 0) NRN(true, false, p.x, H16P, ng + cDM, ng + 2 * cDM); else NRN(false, false, H16P, H16P, ng + cDM, ng + 2 * cDM); } GRID_BAR(); \
          FFN(LL); } while (0)
#define ODD_LAYER(lp) do { const int LL = 2 * (lp) + 1; \
          { MKP(); GEMM(p.Y, p.Wt_in, cM, LDO2, cDM, p.PROJ, PO_LD); } \
          { MKP(); GEMM_E(pg8::EpiVT, {(pg8::bf16_t*)p.VT}, (const bf16*)(wsb + WS_WV), p.Y, 1024, cM, cDM); } GRID_BAR(); \
          { MKP(); const int NT = cS / 32; for (int u = VCU() * NWAVES + wave; u < cB * cNSB * NT; u += gridDim.x * NWAVES) { const int bh = u / NT; \
                sb_unit(p, p.VT, L + wave * 17408, bh / cNSB, bh % cNSB, (u % NT) * 32, lane); } } GRID_BAR(); \
          { MKP(); GEMM(p.ATT, p.Wt_out, cM, cDM, cDM, p.Y2, cDM); } GRID_BAR(); \
          { MKP(); const float* ng = p.norm_g + (size_t)LL * 4 * cDM; NRN(false, false, H16P, H16P, ng + cDM, ng + 2 * cDM); } GRID_BAR(); \
          FFN(LL); } while (0)

    { MKP();
      GRUN((long)cS * 32, rope_table_item(p, i));
      WPREP(0);
      for (long r = blockIdx.x * NWAVES + wave; r < cM; r += gridDim.x * NWAVES) n_row_dev(p.x + r * cDM, p.norm_g, p.Y + r * cDM, lane); }
    GRID_BAR();
    EVEN_LAYER(0); ODD_LAYER(0); EVEN_LAYER(1); ODD_LAYER(1);
}

extern "C" void kernel_launch(void* const* d_in, const int* in_sizes, int n_in, void* d_out, int out_size, void* d_ws, size_t ws_size, hipStream_t stream) {
    static int grid = 0;
    if (grid == 0) {
        if (n_in != 13 || out_size != cM * cDM || ws_size < WS_END) { fprintf(stderr, "kernel_launch: unexpected shapes (n_in %d out %d ws %zu)\n", n_in, out_size, ws_size); grid = -1; return; }
        int dev = 0, cus = 0;
        if (hipGetDevice(&dev) != hipSuccess || hipDeviceGetAttribute(&cus, hipDeviceAttributeMultiprocessorCount, dev) != hipSuccess) { grid = -1; return; }
        if (hipFuncSetAttribute((const void*)fwd, hipFuncAttributeMaxDynamicSharedMemorySize, LDS_BYTES) != hipSuccess) { grid = -1; return; }
        int per_cu = 0; (void)hipOccupancyMaxActiveBlocksPerMultiprocessor(&per_cu, (const void*)fwd, NTHREADS, LDS_BYTES); (void)hipGetLastError();
        grid = cus;
    }
    if (grid < 0) return;
    (void)hipMemsetAsync((char*)d_ws + WS_CTL, 0, CTL_ZERO_BYTES, stream);
    Args a{};
    for (int i = 0; i < 13; ++i) a.in[i] = (const float*)d_in[i];
    a.out = (float*)d_out; a.ws = (unsigned char*)d_ws;
    hipLaunchKernelGGL(fwd, dim3(grid), dim3(NTHREADS), LDS_BYTES, stream, a);
}
```
